# Optimizing an MI355X kernel written in HIP

```python
import math
import jax, jax.numpy as jnp
from jax import lax
import numpy as np

D_MODEL = 2048
BATCH = 4
SEQ = 2048
DEPTH = 1

N_MEM = 256
HEAD_DIM = 128
FOX_HEADS = 8
FOX_W = FOX_HEADS * HEAD_DIM
LRU_W = D_MODEL - FOX_W
LRU_BLOCKS = 8
LRU_BLOCK = LRU_W // LRU_BLOCKS
LRU_C = 8.0
CONV_W = 4
MIX_W = FOX_W + LRU_W
IN_W = 3 * FOX_W + FOX_HEADS + 2 * LRU_W
XATT_HEADS = 4
XATT_W = XATT_HEADS * HEAD_DIM
FFN_HIDDEN = int(math.ceil((8 * D_MODEL / 3) / 256) * 256)
Q_BLOCK = 128
RMS_EPS = 1e-6

SPLITS = (FOX_W, 2 * FOX_W, 3 * FOX_W, 3 * FOX_W + FOX_HEADS, 3 * FOX_W + FOX_HEADS + LRU_W)

kernel_name = "hymba_fox_rglru_memxattn_block"


def rmsnorm(x, g):
    xf = x.astype(jnp.float32)
    y = xf * lax.rsqrt(jnp.mean(xf * xf, axis=-1, keepdims=True) + RMS_EPS)
    return (y * g.astype(jnp.float32)).astype(x.dtype)


def forgetting_attention(q, k, v, c):
    B, H, S, dh = q.shape
    nb = S // Q_BLOCK
    scale = 1.0 / math.sqrt(dh)
    qb = q.reshape(B, H, nb, Q_BLOCK, dh).transpose(2, 0, 1, 3, 4)
    cb = c.reshape(B, H, nb, Q_BLOCK).transpose(2, 0, 1, 3)
    k_pos = jnp.arange(S)

    def one_block(args):
        q_i, c_i, i = args
        s = jnp.einsum('bhqd,bhkd->bhqk', q_i, k, preferred_element_type=jnp.float32) * scale
        s = s + c_i[..., None] - c[:, :, None, :]
        q_pos = i * Q_BLOCK + jnp.arange(Q_BLOCK)
        causal = k_pos[None, :] <= q_pos[:, None]
        s = jnp.where(causal, s, -jnp.inf)
        p = jax.nn.softmax(s, axis=-1)
        return jnp.einsum('bhqk,bhkd->bhqd', p.astype(v.dtype), v)

    o = lax.map(one_block, (qb, cb, jnp.arange(nb)))
    return o.transpose(1, 2, 0, 3, 4).reshape(B, H, S, dh)


def causal_depthwise_conv(u, w, b):
    S = u.shape[1]
    up = jnp.pad(u, ((0, 0), (CONV_W - 1, 0), (0, 0)))
    return b + sum(w[j] * up[:, j:j + S] for j in range(CONV_W))


def rg_lru(u, w_ra, b_ra, w_ri, b_ri, lam):
    B, S, W = u.shape
    ub = u.reshape(B, S, LRU_BLOCKS, LRU_BLOCK)
    r = jax.nn.sigmoid(jnp.einsum('bsnc,ncd->bsnd', ub, w_ra).reshape(B, S, W) + b_ra)
    i = jax.nn.sigmoid(jnp.einsum('bsnc,ncd->bsnd', ub, w_ri).reshape(B, S, W) + b_ri)
    log_a = -LRU_C * r.astype(jnp.float32) * jax.nn.softplus(-lam.astype(jnp.float32))
    a = jnp.exp(log_a)
    b_in = jnp.sqrt(-jnp.expm1(2.0 * log_a)) * (i * u).astype(jnp.float32)

    def combine(left, right):
        a1, b1 = left
        a2, b2 = right
        return a1 * a2, a2 * b1 + b2

    _, h = lax.associative_scan(combine, (a, b_in), axis=1)
    return h.astype(u.dtype)


def setup_inputs(seed: int = 0) -> dict:
    key = jax.random.key(seed)
    ks = jax.random.split(key, 32)
    f32 = jnp.float32

    def nrm(k, shape, scale):
        return jax.random.normal(k, shape, f32) * scale

    def gain(k, shape):
        return 1.0 + 0.02 * jax.random.normal(k, shape, f32)

    L = DEPTH
    a_c = jax.random.uniform(ks[13], (L, LRU_W), f32, 0.9, 0.999)
    s_lam = a_c ** (1.0 / LRU_C)
    lam = jnp.log(s_lam) - jnp.log1p(-s_lam)
    return {
        "x": nrm(ks[0], (BATCH, SEQ, D_MODEL), 1.0),
        "mem": nrm(ks[1], (BATCH, N_MEM, D_MODEL), 1.0),
        "g_mix": gain(ks[2], (L, D_MODEL)),
        "w_in": nrm(ks[3], (L, D_MODEL, IN_W), D_MODEL ** -0.5),
        "b_f": jax.random.uniform(ks[4], (L, FOX_HEADS), f32, 3.0, 5.0),
        "g_q": gain(ks[5], (L, HEAD_DIM)),
        "g_k": gain(ks[6], (L, HEAD_DIM)),
        "conv_w": nrm(ks[7], (L, CONV_W, LRU_W), CONV_W ** -0.5),
        "conv_b": nrm(ks[8], (L, LRU_W), 0.02),
        "w_ra": nrm(ks[9], (L, LRU_BLOCKS, LRU_BLOCK, LRU_BLOCK), LRU_BLOCK ** -0.5),
        "b_ra": nrm(ks[10], (L, LRU_W), 0.02),
        "w_ri": nrm(ks[11], (L, LRU_BLOCKS, LRU_BLOCK, LRU_BLOCK), LRU_BLOCK ** -0.5),
        "b_ri": nrm(ks[12], (L, LRU_W), 0.02),
        "lam": lam,
        "g_fox_out": gain(ks[14], (L, FOX_W)),
        "g_lru_out": gain(ks[15], (L, LRU_W)),
        "w_out": nrm(ks[16], (L, MIX_W, D_MODEL), MIX_W ** -0.5),
        "g_xattn": gain(ks[17], (L, D_MODEL)),
        "g_mem": gain(ks[18], (L, D_MODEL)),
        "w_cq": nrm(ks[19], (L, D_MODEL, XATT_W), D_MODEL ** -0.5),
        "w_ckv": nrm(ks[20], (L, D_MODEL, 2 * XATT_W), D_MODEL ** -0.5),
        "g_cq": gain(ks[21], (L, HEAD_DIM)),
        "g_ck": gain(ks[22], (L, HEAD_DIM)),
        "w_co": nrm(ks[23], (L, XATT_W, D_MODEL), XATT_W ** -0.5),
        "g_ffn": gain(ks[24], (L, D_MODEL)),
        "w_gate_up": nrm(ks[25], (L, D_MODEL, 2 * FFN_HIDDEN), D_MODEL ** -0.5),
        "w_down": nrm(ks[26], (L, FFN_HIDDEN, D_MODEL), FFN_HIDDEN ** -0.5),
    }


def reference(x, mem, g_mix, w_in, b_f, g_q, g_k, conv_w, conv_b, w_ra, b_ra, w_ri, b_ri,
              lam, g_fox_out, g_lru_out, w_out, g_xattn, g_mem, w_cq, w_ckv, g_cq, g_ck,
              w_co, g_ffn, w_gate_up, w_down):
    B, S, _ = x.shape
    M = mem.shape[1]
    for l in range(DEPTH):
        h = rmsnorm(x, g_mix[l])
        proj = h @ w_in[l]
        q, k, v, f_logit, u, gate = jnp.split(proj, SPLITS, axis=-1)
        q = rmsnorm(q.reshape(B, S, FOX_HEADS, HEAD_DIM), g_q[l]).transpose(0, 2, 1, 3)
        k = rmsnorm(k.reshape(B, S, FOX_HEADS, HEAD_DIM), g_k[l]).transpose(0, 2, 1, 3)
        v = v.reshape(B, S, FOX_HEADS, HEAD_DIM).transpose(0, 2, 1, 3)
        log_f = jax.nn.log_sigmoid((f_logit + b_f[l]).astype(jnp.float32))
        c = lax.cumsum(log_f, axis=1).transpose(0, 2, 1)
        o_fox = forgetting_attention(q, k, v, c)
        o_fox = o_fox.transpose(0, 2, 1, 3).reshape(B, S, FOX_W)

        u = causal_depthwise_conv(u, conv_w[l], conv_b[l])
        y_lru = rg_lru(u, w_ra[l], b_ra[l], w_ri[l], b_ri[l], lam[l]) * jax.nn.gelu(gate)

        mix = jnp.concatenate([rmsnorm(o_fox, g_fox_out[l]), rmsnorm(y_lru, g_lru_out[l])], axis=-1)
        x = x + mix @ w_out[l]

        hq = rmsnorm(x, g_xattn[l])
        mn = rmsnorm(mem, g_mem[l])
        cq = rmsnorm((hq @ w_cq[l]).reshape(B, S, XATT_HEADS, HEAD_DIM), g_cq[l])
        ck, cv = jnp.split(mn @ w_ckv[l], 2, axis=-1)
        ck = rmsnorm(ck.reshape(B, M, XATT_HEADS, HEAD_DIM), g_ck[l])
        cv = cv.reshape(B, M, XATT_HEADS, HEAD_DIM)
        s = jnp.einsum('bshd,bmhd->bhsm', cq, ck, preferred_element_type=jnp.float32) / math.sqrt(HEAD_DIM)
        p = jax.nn.softmax(s, axis=-1)
        o_x = jnp.einsum('bhsm,bmhd->bshd', p.astype(cv.dtype), cv).reshape(B, S, XATT_W)
        x = x + o_x @ w_co[l]

        hf = rmsnorm(x, g_ffn[l])
        f_gate, f_up = jnp.split(hf @ w_gate_up[l], 2, axis=-1)
        x = x + (jax.nn.silu(f_gate) * f_up) @ w_down[l]
    return x
```

```cpp
#include <hip/hip_runtime.h>
#include <hip/hip_bf16.h>
#include <hip/hip_cooperative_groups.h>
#include <cstdio>
#include <cstdint>
namespace cg = cooperative_groups;


template <int K> __device__ __forceinline__ float shx(float v) { static_assert(K < 32, "use sum32"); return __int_as_float(__builtin_amdgcn_ds_swizzle(__float_as_int(v), (K << 10) | 0x1f)); }
__device__ __forceinline__ float sum32(float v) { auto rr = __builtin_amdgcn_permlane32_swap(__float_as_uint(v), __float_as_uint(v), false, false); return __uint_as_float(rr[0]) + __uint_as_float(rr[1]); }
constexpr int WTAB_OFF = 147456 - 256, XBST_OFF = 147456 - 512;
__device__ __forceinline__ int hw_slot() { return (int)(__builtin_amdgcn_s_getreg((5 << 11) | 4) & 63u); }
__device__ __forceinline__ int my_tid() {
    const int slot = hw_slot();
    const int wave = __builtin_amdgcn_readfirstlane(*(volatile __attribute__((address_space(3))) int*)(unsigned)(WTAB_OFF + slot * 4));
    int l; asm volatile("v_mbcnt_lo_u32_b32 %0, -1, 0\n\tv_mbcnt_hi_u32_b32 %0, -1, %0" : "=v"(l));
    return wave * 64 + l;
}
namespace pg8 {
#define PG8_LAS __attribute__((address_space(3)))
typedef unsigned short bf16_t;
typedef short bf16x8 __attribute__((ext_vector_type(8)));
typedef float f32x4 __attribute__((ext_vector_type(4)));
typedef unsigned u32x4 __attribute__((ext_vector_type(4)));
constexpr int BM = 256, BK = 64, HALF = 128, HTB = HALF * BK * 2  , STAGE_BYTES = 8 * HTB, NXCD = 8, WGM = 8;

__host__ __device__ __forceinline__ int lds_byte(int r, int c) { const int st = (r >> 4) * 2 + (c >> 5), rr = r & 15, cc = c & 31, ob = rr * 64 + cc * 2; return st * 1024 + (ob ^ (((ob >> 9) & 1) << 5)); }
__host__ __device__ __forceinline__ void stage_rc(int b, int& R, int& C) { const int st = b / 1024, sb = b % 1024, swz = sb ^ (((sb >> 9) & 1) << 5); R = (st >> 1) * 16 + swz / 64; C = (st & 1) * 32 + (swz % 64) / 2; }
__host__ __device__ __forceinline__ int perm32(int rho) { const int n = rho >> 4, i = rho & 15; return 8 * (i >> 2) + 4 * n + (i & 3); }

struct Unit { int pm, pn; };
struct Gemm { const bf16_t* A; const bf16_t* Bt; int M, N, K, lda, ldb; };

struct StaticOrder {
    int nM, nN, nwg, G, c;
    __host__ __device__ void init(int M, int N, int G_, int c_) { nM = M / BM; nN = N / BM; nwg = nM * nN; G = G_; c = c_; }
    __host__ __device__ bool next(int i, Unit& u) const {
        const long L = (long)i * G + c; if (L >= nwg) return false;
        int wgid = (int)L; { const int q = nwg / NXCD, r = nwg % NXCD, xcd = wgid % NXCD, off = wgid / NXCD; wgid = (xcd < r ? xcd * (q + 1) : r * (q + 1) + (xcd - r) * q) + off; }
        const int nig = WGM * nN, gid = wgid / nig, fm = gid * WGM, gsz = (nM - fm) < WGM ? (nM - fm) : WGM;
        u.pm = fm + ((wgid % nig) % gsz); u.pn = (wgid % nig) / gsz; return true;
    }
    __device__ __forceinline__ void a_ready(const Unit&) const {}
    __device__ __forceinline__ void done(const Unit&) const {}
};

__device__ __forceinline__ unsigned cvt_pk_bf16(float lo, float hi) { unsigned r; asm volatile("v_cvt_pk_bf16_f32 %0, %1, %2" : "=v"(r) : "v"(lo), "v"(hi)); return r; }

typedef float f32x2 __attribute__((ext_vector_type(2)));
constexpr float RMS_EPS = 1e-6f;
struct OneUnit {
    __device__ __forceinline__ bool next(int i, Unit& u) const { if (i != 0) return false; u.pm = 0; u.pn = 0; return true; }
    __device__ __forceinline__ void a_ready(const Unit&) const {}
    __device__ __forceinline__ void done(const Unit&) const {}
};
struct OffsetOrder {
    StaticOrder S;
    __device__ __forceinline__ bool next(int i, Unit& u) const { return S.next(i, u); }
    __device__ __forceinline__ void a_ready(const Unit&) const {}
    __device__ __forceinline__ void done(const Unit&) const {}
};
__device__ __forceinline__ float fast_log1p(float x) { const float sr = x * (1.0f - x * (0.5f - x * (0.33333334f - x * (0.25f - x * (0.2f - x * 0.16666667f))))); return x < 0.0625f ? sr : __logf(1.0f + x); }
__device__ __forceinline__ float sigmoidf_(float x) { return __builtin_amdgcn_rcpf(1.0f + __expf(-x)); }
__device__ __forceinline__ float gelu_tanh(float x) { const float u = 0.7978845608028654f * (x + 0.044715f * x * x * x); return x * sigmoidf_(2.0f * u); }
__device__ __forceinline__ float sum_f(const float* p, int n4) { float s = 0.f; for (int i = 0; i < n4; ++i) { const f32x4 v = *(const f32x4*)(p + 4 * i); s += (v[0] + v[1]) + (v[2] + v[3]); } return s; }
__device__ __forceinline__ u32x4 pack8(const f32x4& a, const f32x4& b) { u32x4 w; w.x = cvt_pk_bf16(a[0], a[1]); w.y = cvt_pk_bf16(a[2], a[3]); w.z = cvt_pk_bf16(b[0], b[1]); w.w = cvt_pk_bf16(b[2], b[3]); return w; }

template <int ACT  >
__device__ __forceinline__ void store_tile(const f32x4 (&acc)[2][2][4][2], bf16_t* d0, bf16_t* d1, size_t ld, int wr, int wc, int fr, int fq) {
#pragma unroll
    for (int ai = 0; ai < 2; ++ai)
#pragma unroll
        for (int m = 0; m < 4; ++m) { const size_t ro = (size_t)(ai * HALF + wr * 64 + m * 16 + fr) * ld + wc * 32 + fq * 8;
#pragma unroll
            for (int bj = 0; bj < 2; ++bj) { f32x4 v0 = acc[ai][bj][m][0], v1 = acc[ai][bj][m][1];
                if (ACT == 1) {
#pragma unroll
                    for (int j = 0; j < 4; ++j) { v0[j] = gelu_tanh(v0[j]); v1[j] = gelu_tanh(v1[j]); } }
                *(u32x4*)((bj ? d1 : d0) + ro) = pack8(v0, v1); } }
}
template <bool ROWSCALE>
__device__ __forceinline__ void head_norm_store(const f32x4 (&acc)[2][2][4][2], const float (&rs)[2][4], const float* gain, bf16_t* d0, bf16_t* d1, PG8_LAS float* red, int wr, int wc, int fr, int fq) {
#pragma unroll
    for (int ai = 0; ai < 2; ++ai)
#pragma unroll
        for (int m = 0; m < 4; ++m)
#pragma unroll
            for (int bj = 0; bj < 2; ++bj) { float s = 0.f;
#pragma unroll
                for (int n = 0; n < 2; ++n) { f32x4 v = acc[ai][bj][m][n]; if (ROWSCALE) v = v * rs[ai][m]; s += (v[0] * v[0] + v[1] * v[1]) + (v[2] * v[2] + v[3] * v[3]); }
                s += shx<16>(s); s = sum32(s);
                if (fq == 0) red[((ai * HALF + wr * 64 + m * 16 + fr) * 2 + bj) * 4 + wc] = s; }
    asm volatile("s_waitcnt lgkmcnt(0)" ::: "memory"); __builtin_amdgcn_s_barrier(); asm volatile("" ::: "memory");
    const f32x4 g0 = *(const f32x4*)(gain + wc * 32 + fq * 8), g1 = *(const f32x4*)(gain + wc * 32 + fq * 8 + 4);
#pragma unroll
    for (int ai = 0; ai < 2; ++ai)
#pragma unroll
        for (int m = 0; m < 4; ++m) { const int rl = ai * HALF + wr * 64 + m * 16 + fr;
#pragma unroll
            for (int bj = 0; bj < 2; ++bj) { const PG8_LAS float* rp = red + (rl * 2 + bj) * 4;
                const float ss = (rp[0] + rp[1]) + (rp[2] + rp[3]);
                float sc = __builtin_amdgcn_rsqf(ss * (1.0f / 128.0f) + RMS_EPS); if (ROWSCALE) sc *= rs[ai][m];
                const f32x4 v0 = acc[ai][bj][m][0] * sc * g0, v1 = acc[ai][bj][m][1] * sc * g1;
                *(u32x4*)((bj ? d1 : d0) + (size_t)rl * 128 + wc * 32 + fq * 8) = pack8(v0, v1); } }
}

struct EpiIn {
    static constexpr bool PERM = true, AFTER_DRAIN = false, HAS_MID = false; int mid_t;
    bf16_t *Q, *Kh, *V, *U, *GG; float* LF; const float *g_q, *g_k, *b_f; PG8_LAS float* red;
    __device__ __forceinline__ void operator()(const f32x4 (&acc)[2][2][4][2], const Unit& u, int wr, int wc, int fr, int fq) const {
        asm volatile("" : "+v"(fr), "+v"(fq));
        const int pn = u.pn, row0 = u.pm * BM, b = row0 >> 11, s0 = row0 & 2047;
        if (pn < 12) {
            const int h0 = (pn & 3) * 2; bf16_t* const q_ = Q; bf16_t* const k_ = Kh; bf16_t* const v_ = V; const float* const gq_ = g_q; const float* const gk_ = g_k;
            bf16_t* base = pn < 4 ? q_ : (pn < 8 ? k_ : v_);
            bf16_t* d0 = base + ((size_t)(b * 8 + h0) * 2048 + s0) * 128; bf16_t* d1 = d0 + (size_t)2048 * 128;
            if (pn < 8) { float rs[2][4]; head_norm_store<false>(acc, rs, pn < 4 ? gq_ : gk_, d0, d1, red, wr, wc, fr, fq); }
            else store_tile<0>(acc, d0, d1, 128, wr, wc, fr, fq);
        } else if (pn < 16) { bf16_t* const u_ = U; bf16_t* d0 = u_ + (size_t)row0 * 1024 + (pn - 12) * 256; store_tile<0>(acc, d0, d0 + 128, 1024, wr, wc, fr, fq); }
        else if (pn < 20) { bf16_t* const g_ = GG; bf16_t* d0 = g_ + (size_t)row0 * 1024 + (pn - 16) * 256; store_tile<1>(acc, d0, d0 + 128, 1024, wr, wc, fr, fq); }
        else if (wc == 0 && fq == 0) {
            const f32x4 b0 = *(const f32x4*)b_f, b1 = *(const f32x4*)(b_f + 4);
#pragma unroll
            for (int ai = 0; ai < 2; ++ai)
#pragma unroll
                for (int m = 0; m < 4; ++m) { const int row = row0 + ai * HALF + wr * 64 + m * 16 + fr; f32x4 z0 = acc[ai][0][m][0] + b0, z1 = acc[ai][0][m][1] + b1;
#pragma unroll
                    for (int j = 0; j < 4; ++j) { z0[j] = fminf(z0[j], 0.f) - fast_log1p(__expf(-fabsf(z0[j]))); z1[j] = fminf(z1[j], 0.f) - fast_log1p(__expf(-fabsf(z1[j]))); }
                    *(f32x4*)(LF + (size_t)row * 8) = z0; *(f32x4*)(LF + (size_t)row * 8 + 4) = z1; }
        }
    }
};
struct EpiCkv {
    static constexpr bool PERM = true, AFTER_DRAIN = false, HAS_MID = false; int mid_t;
    bf16_t *CK, *CV; const float* g_ck; PG8_LAS float* red;
    __device__ __forceinline__ void operator()(const f32x4 (&acc)[2][2][4][2], const Unit& u, int wr, int wc, int fr, int fq) const {
        asm volatile("" : "+v"(fr), "+v"(fq));
        const int pn = u.pn, b = u.pm, h0 = (pn & 1) * 2;
        bf16_t* const ck_ = CK; bf16_t* const cv_ = CV; bf16_t* d0 = (pn < 2 ? ck_ : cv_) + ((size_t)(b * 4 + h0) * 256) * 128; bf16_t* d1 = d0 + (size_t)256 * 128;
        if (pn < 2) { float rs[2][4]; head_norm_store<false>(acc, rs, g_ck, d0, d1, red, wr, wc, fr, fq); }
        else store_tile<0>(acc, d0, d1, 128, wr, wc, fr, fq);
    }
};
struct EpiCq {
    static constexpr bool PERM = true, AFTER_DRAIN = false, HAS_MID = false; int mid_t;
    bf16_t* CQ; const float* g_cq; const float* SSQ; PG8_LAS float* red;
    __device__ __forceinline__ void operator()(const f32x4 (&acc)[2][2][4][2], const Unit& u, int wr, int wc, int fr, int fq) const {
        asm volatile("" : "+v"(fr), "+v"(fq));
        const int pn = u.pn, row0 = u.pm * BM, b = row0 >> 11, s0 = row0 & 2047, h0 = pn * 2, tid = (wr * 4 + wc) * 64 + fq * 16 + fr;
        PG8_LAS float* tab = red + 2048;
        if (tid < 256) tab[tid] = __builtin_amdgcn_rsqf(sum_f(SSQ + (size_t)(row0 + tid) * 32, 8) * (1.0f / 2048.0f) + RMS_EPS);
        asm volatile("s_waitcnt lgkmcnt(0)" ::: "memory"); __builtin_amdgcn_s_barrier(); asm volatile("" ::: "memory");
        float rs[2][4];
#pragma unroll
        for (int ai = 0; ai < 2; ++ai)
#pragma unroll
            for (int m = 0; m < 4; ++m) rs[ai][m] = tab[ai * HALF + wr * 64 + m * 16 + fr];
        bf16_t* d0 = CQ + ((size_t)(b * 4 + h0) * 2048 + s0) * 128; bf16_t* d1 = d0 + (size_t)2048 * 128;
        head_norm_store<true>(acc, rs, g_cq, d0, d1, red, wr, wc, fr, fq);
    }
};
template <bool MID> struct EpiRes {
    static constexpr bool PERM = true, AFTER_DRAIN = false, HAS_MID = MID; int mid_t;
    const float* resid; const bf16_t* residb; float* outf; bf16_t* outb; float* ssq_out; const float *ssqf, *ssql;
    __device__ __forceinline__ void mid(f32x4 (&acc)[2][2][4][2], const Unit& u, int wr, int wc, int fr, int fq) const {
        asm volatile("" : "+v"(fr), "+v"(fq));
#pragma unroll
        for (int ai = 0; ai < 2; ++ai)
#pragma unroll
            for (int m = 0; m < 4; ++m) { const size_t row = (size_t)u.pm * BM + ai * HALF + wr * 64 + m * 16 + fr;
                const float rf = __builtin_amdgcn_rsqf(sum_f(ssqf + row * 8, 2) * (1.0f / 1024.0f) + RMS_EPS), rl = __builtin_amdgcn_rsqf(sum_f(ssql + row * 8, 2) * (1.0f / 1024.0f) + RMS_EPS);
                const float ratio = rf / rl;
#pragma unroll
                for (int bj = 0; bj < 2; ++bj)
#pragma unroll
                    for (int n = 0; n < 2; ++n) acc[ai][bj][m][n] = acc[ai][bj][m][n] * ratio;
                __builtin_amdgcn_sched_barrier(0); }
    }
    __device__ __forceinline__ void operator()(const f32x4 (&acc)[2][2][4][2], const Unit& u, int wr, int wc, int fr, int fq) const {
        asm volatile("" : "+v"(fr), "+v"(fq));
#pragma unroll
        for (int ai = 0; ai < 2; ++ai)
#pragma unroll
            for (int m = 0; m < 4; ++m) { const size_t row = (size_t)u.pm * BM + ai * HALF + wr * 64 + m * 16 + fr;
                float sc = 1.f; if (MID) sc = __builtin_amdgcn_rsqf(sum_f(ssql + row * 8, 2) * (1.0f / 1024.0f) + RMS_EPS);
                float ss = 0.f;
#pragma unroll
                for (int bj = 0; bj < 2; ++bj) { const size_t o = row * 2048 + u.pn * BM + bj * HALF + wc * 32 + fq * 8;
                    f32x4 r0, r1;
                    if (residb) { const u32x4 w = *(const u32x4*)(residb + o); r0 = (f32x4){__uint_as_float(w.x << 16), __uint_as_float(w.x & 0xffff0000u), __uint_as_float(w.y << 16), __uint_as_float(w.y & 0xffff0000u)};
                                  r1 = (f32x4){__uint_as_float(w.z << 16), __uint_as_float(w.z & 0xffff0000u), __uint_as_float(w.w << 16), __uint_as_float(w.w & 0xffff0000u)}; }
                    else { r0 = *(const f32x4*)(resid + o); r1 = *(const f32x4*)(resid + o + 4); }
                    const f32x4 v0 = r0 + acc[ai][bj][m][0] * sc, v1 = r1 + acc[ai][bj][m][1] * sc;
                    if (outf) { *(f32x4*)(outf + o) = v0; *(f32x4*)(outf + o + 4) = v1; }
                    ss += (v0[0] * v0[0] + v0[1] * v0[1]) + (v0[2] * v0[2] + v0[3] * v0[3]) + (v1[0] * v1[0] + v1[1] * v1[1]) + (v1[2] * v1[2] + v1[3] * v1[3]);
                    if (outb) *(u32x4*)(outb + o) = pack8(v0, v1); }
                if (ssq_out) { ss += shx<16>(ss); ss = sum32(ss); if (fq == 0) ssq_out[row * 32 + u.pn * 4 + wc] = ss; }
                __builtin_amdgcn_sched_barrier(0); }
    }
};
struct EpiGu {
    static constexpr bool PERM = true, AFTER_DRAIN = false, HAS_MID = false; int mid_t;
    bf16_t* H; const float* SSQ; PG8_LAS float* red;
    __device__ __forceinline__ void operator()(const f32x4 (&acc)[2][2][4][2], const Unit& u, int wr, int wc, int fr, int fq) const {
        asm volatile("" : "+v"(fr), "+v"(fq));
        const int tid = (wr * 4 + wc) * 64 + fq * 16 + fr; PG8_LAS float* tab = red + 2048;
        if (tid < 256) tab[tid] = __builtin_amdgcn_rsqf(sum_f(SSQ + ((size_t)u.pm * BM + tid) * 32, 8) * (1.0f / 2048.0f) + RMS_EPS);
        asm volatile("s_waitcnt lgkmcnt(0)" ::: "memory"); __builtin_amdgcn_s_barrier(); asm volatile("" ::: "memory");
#pragma unroll
        for (int ai = 0; ai < 2; ++ai)
#pragma unroll
            for (int m = 0; m < 4; ++m) { const size_t row = (size_t)u.pm * BM + ai * HALF + wr * 64 + m * 16 + fr;
                const float rs = tab[ai * HALF + wr * 64 + m * 16 + fr];
                f32x4 h[2];
#pragma unroll
                for (int n = 0; n < 2; ++n) { const f32x4 g = acc[ai][0][m][n] * rs, up = acc[ai][1][m][n] * rs;
#pragma unroll
                    for (int j = 0; j < 4; ++j) h[n][j] = g[j] * sigmoidf_(g[j]) * up[j]; }
                *(u32x4*)(H + row * 5632 + u.pn * HALF + wc * 32 + fq * 8) = pack8(h[0], h[1]); }
    }
};
struct EpiLru {
    static constexpr bool PERM = true, AFTER_DRAIN = true, HAS_MID = false; int mid_t;
    const bf16_t* UC; bf16_t* HL; bf16_t* AC; float* ENDH; float* ENDA; const float *b_ra, *b_ri, *lam; int row0, nblk;
    __device__ __forceinline__ void fused(f32x4 (&acc)[2][2][4][2], const Unit&, int wr, int wc, int fr, int fq, PG8_LAS unsigned char* lds, int wid, int lane) const {
        asm volatile("" : "+v"(fr), "+v"(fq));
        PG8_LAS float* LA = (PG8_LAS float*)lds; PG8_LAS float* LB = LA + 128 * 132;
        const int tid = wid * 64 + lane, ch0 = nblk * 128 + wc * 32 + fq * 8;
        float hc = 0.f, ac = 1.f;
#pragma unroll
        for (int ai = 0; ai < 2; ++ai) {
#pragma unroll
            for (int n = 0; n < 2; ++n) {
                const f32x4 bra = *(const f32x4*)(b_ra + ch0 + 4 * n), bri = *(const f32x4*)(b_ri + ch0 + 4 * n), lm = *(const f32x4*)(lam + ch0 + 4 * n); f32x4 sp;
#pragma unroll
                for (int j = 0; j < 4; ++j) sp[j] = -8.0f * fast_log1p(__expf(-lm[j]));
#pragma unroll
                for (int m = 0; m < 4; ++m) { const int rl = wr * 64 + m * 16 + fr; const unsigned grow = (unsigned)(row0 + ai * HALF + rl);
                    const f32x2 ucw = *(const f32x2*)((const char*)UC + (grow * 1024u + ch0 + 4 * n) * 2u); f32x4 av, bv;
#pragma unroll
                    for (int j = 0; j < 4; ++j) { const unsigned w = __float_as_uint(ucw[j >> 1]); const float uc = __uint_as_float((j & 1) ? (w & 0xffff0000u) : (w << 16));
                        const float r = sigmoidf_(acc[ai][0][m][n][j] + bra[j]), ig = sigmoidf_(acc[ai][1][m][n][j] + bri[j]);
                        const float la = r * sp[j], a_ = __expf(la); av[j] = a_; bv[j] = __builtin_amdgcn_sqrtf(fmaxf(fmaf(-a_, a_, 1.0f), 0.f)) * ig * uc; }
                    *(PG8_LAS f32x4*)(LA + rl * 132 + wc * 32 + fq * 8 + 4 * n) = av; *(PG8_LAS f32x4*)(LB + rl * 132 + wc * 32 + fq * 8 + 4 * n) = bv;
                    __builtin_amdgcn_sched_barrier(0); } }
            asm volatile("s_waitcnt lgkmcnt(0)" ::: "memory"); __builtin_amdgcn_s_barrier(); asm volatile("" ::: "memory");
            if (tid < 128) {
#pragma unroll 8
                for (int rl = 0; rl < 128; ++rl) { const float a_ = LA[rl * 132 + tid]; hc = a_ * hc + LB[rl * 132 + tid]; ac *= a_; LB[rl * 132 + tid] = hc; LA[rl * 132 + tid] = ac; }
                if (ai == 1) { ENDH[nblk * 128 + tid] = hc; ENDA[nblk * 128 + tid] = ac; } }
            asm volatile("s_waitcnt lgkmcnt(0)" ::: "memory"); __builtin_amdgcn_s_barrier(); asm volatile("" ::: "memory");
            const int c8 = (tid & 15) * 8;
#pragma unroll
            for (int p = 0; p < 4; ++p) { const int rl = p * 32 + (tid >> 4); const unsigned o = ((unsigned)(row0 + ai * HALF + rl) * 1024u + nblk * 128 + c8) * 2u;
                const f32x4 h0 = *(const PG8_LAS f32x4*)(LB + rl * 132 + c8), h1 = *(const PG8_LAS f32x4*)(LB + rl * 132 + c8 + 4);
                const f32x4 a0 = *(const PG8_LAS f32x4*)(LA + rl * 132 + c8), a1 = *(const PG8_LAS f32x4*)(LA + rl * 132 + c8 + 4);
                *(u32x4*)((char*)HL + o) = pack8(h0, h1); *(u32x4*)((char*)AC + o) = pack8(a0, a1); }
            asm volatile("s_waitcnt lgkmcnt(0)" ::: "memory"); __builtin_amdgcn_s_barrier(); asm volatile("" ::: "memory");
        }
    }
};
template <class Epi, class Sched, bool ALIGN_EPI = false, bool SP2 = false>
__device__ __forceinline__ void gemm_phase(PG8_LAS unsigned char* lds, const Gemm g, const Sched& S, const Epi& E) {
    int tid_ = my_tid();
    const int tid = tid_, wid = __builtin_amdgcn_readfirstlane(tid >> 6), lane = tid & 63, wr = wid >> 2, wc = wid & 3, fr = lane & 15, fq = lane >> 4;
    const int K = g.K, nt = K / BK;
    unsigned voffA[2], voffB[2];
#pragma unroll
    for (int i = 0; i < 2; ++i) { int R, C; stage_rc(tid * 16 + i * 8192, R, C); const int Rb = Epi::PERM ? ((R & ~31) + perm32(R & 31)) : R;
        voffA[i] = (unsigned)(R * g.lda + C) * 2u; voffB[i] = (unsigned)(Rb * g.ldb + C) * 2u; }
    const size_t kstep = (size_t)(BK * 2);
    const size_t hstepA = (size_t)HALF * g.lda * 2, hstepB = (size_t)HALF * g.ldb * 2;
    const size_t tstepA = 2 * hstepA, tstepB = 2 * hstepB;
    const unsigned ldsw = (unsigned)wid * 1024u;
    const int aoff = lds_byte(wr * 64 + fr, fq * 8), boff = lds_byte(wc * 32 + fr, fq * 8);
#define PG8_SA(b, h) (((b) * 2 + (h)) * HTB)
#define PG8_SB(b, h) ((4 + (b) * 2 + (h)) * HTB)
#define PG8_STAGE(bufoff, gbase, voff) do { _Pragma("unroll") for (int _i = 0; _i < 2; ++_i) \
        __builtin_amdgcn_global_load_lds((const unsigned*)((const char*)(gbase) + (voff)[_i]), (PG8_LAS unsigned*)(lds + (bufoff) + ldsw + _i * 8192), 16, 0, 0); } while (0)
#define PG8_LDA(dst, b, h) do { _Pragma("unroll") for (int m = 0; m < 4; ++m) _Pragma("unroll") for (int k = 0; k < 2; ++k) dst[m][k] = *(const PG8_LAS bf16x8*)(lds + PG8_SA(b, h) + aoff + m * 2048 + k * 1024); } while (0)
#define PG8_LDB(dst, b, h) do { _Pragma("unroll") for (int n = 0; n < 2; ++n) _Pragma("unroll") for (int k = 0; k < 2; ++k) dst[n][k] = *(const PG8_LAS bf16x8*)(lds + PG8_SB(b, h) + boff + n * 2048 + k * 1024); } while (0)
#define PG8_MMA(ai, bj, At, Bt) do { __builtin_amdgcn_s_setprio(1); _Pragma("unroll") for (int m = 0; m < 4; ++m) _Pragma("unroll") for (int n = 0; n < 2; ++n) _Pragma("unroll") for (int k = 0; k < 2; ++k) \
        acc[ai][bj][m][n] = __builtin_amdgcn_mfma_f32_16x16x32_bf16(Bt[n][k], At[m][k], acc[ai][bj][m][n], 0, 0, 0); __builtin_amdgcn_s_setprio(0); } while (0)
#define PG8_WAIT_V(n) asm volatile("s_waitcnt vmcnt(" #n ")" ::: "memory")
#define PG8_WAIT_L(n) asm volatile("s_waitcnt lgkmcnt(" #n ")" ::: "memory")
#define PG8_BAR __builtin_amdgcn_s_barrier()
#define PG8_SCHED __builtin_amdgcn_sched_barrier(0)
    Unit cur, nxt; int ui = 0;
    if (!S.next(0, cur)) return;
    f32x4 acc[2][2][4][2];
#pragma unroll
    for (int a = 0; a < 2; ++a)
#pragma unroll
        for (int b = 0; b < 2; ++b)
#pragma unroll
            for (int m = 0; m < 4; ++m)
#pragma unroll
                for (int n = 0; n < 2; ++n) acc[a][b][m][n] = (f32x4){0.f, 0.f, 0.f, 0.f};
    bf16x8 At[4][2], B0[2][2], B1[2][2];
    const char* cA = (const char*)g.A + (size_t)cur.pm * tstepA; const char* cB = (const char*)g.Bt + (size_t)cur.pn * tstepB;
    S.a_ready(cur);
    if constexpr (SP2) {
        PG8_STAGE(PG8_SB(0, 0), cB, voffB); PG8_STAGE(PG8_SB(0, 1), cB + hstepB, voffB); PG8_STAGE(PG8_SA(0, 0), cA, voffA); PG8_STAGE(PG8_SA(0, 1), cA + hstepA, voffA);
        if (wr == 1) PG8_BAR;
        PG8_WAIT_V(2); PG8_BAR;
        PG8_STAGE(PG8_SB(1, 0), cB + kstep, voffB); PG8_STAGE(PG8_SA(1, 0), cA + kstep, voffA); PG8_STAGE(PG8_SB(1, 1), cB + hstepB + kstep, voffB);
        PG8_WAIT_V(6); PG8_BAR;
    } else {
        PG8_STAGE(PG8_SB(0, 0), cB, voffB); PG8_STAGE(PG8_SA(0, 0), cA, voffA); PG8_STAGE(PG8_SB(0, 1), cB + hstepB, voffB); PG8_STAGE(PG8_SA(0, 1), cA + hstepA, voffA);
        if (wr == 1) PG8_BAR;
        PG8_WAIT_V(4); PG8_BAR;
        PG8_STAGE(PG8_SB(1, 0), cB + kstep, voffB); PG8_STAGE(PG8_SA(1, 0), cA + kstep, voffA); PG8_STAGE(PG8_SB(1, 1), cB + hstepB + kstep, voffB);
        PG8_WAIT_V(6); PG8_BAR;
    }
    for (;;) {
        const bool has_next = S.next(ui + 1, nxt);
        const char* nA = has_next ? (const char*)g.A + (size_t)nxt.pm * tstepA : cA; const char* nB = has_next ? (const char*)g.Bt + (size_t)nxt.pn * tstepB : cB;
        for (int t = 0; t < nt; t += 2) {
            const bool last = (t == nt - 2);
            if constexpr (Epi::HAS_MID) { if (t == E.mid_t) E.mid(acc, cur, wr, wc, fr, fq); }
            const char* a1 = cA + (size_t)(t + 1) * kstep;
            const char* a2 = last ? nA : cA + (size_t)(t + 2) * kstep; const char* b2 = last ? nB : cB + (size_t)(t + 2) * kstep;
            const char* a3 = a2 + kstep; const char* b3 = b2 + kstep;
            if (last && has_next) S.a_ready(nxt);
            if constexpr (SP2) {
            PG8_LDB(B0, 0, 0); PG8_LDB(B1, 0, 1); PG8_SCHED; PG8_LDA(At, 0, 0); PG8_STAGE(PG8_SA(1, 1), a1 + hstepA, voffA);
            PG8_WAIT_V(8); PG8_WAIT_L(0); PG8_BAR; PG8_MMA(0, 0, At, B0); PG8_MMA(0, 1, At, B1); PG8_BAR; PG8_SCHED;
            PG8_LDA(At, 0, 1); PG8_STAGE(PG8_SB(0, 0), b2, voffB); PG8_STAGE(PG8_SB(0, 1), b2 + hstepB, voffB); PG8_STAGE(PG8_SA(0, 0), a2, voffA);
            PG8_WAIT_V(8); PG8_WAIT_L(0); PG8_BAR; PG8_MMA(1, 0, At, B0); PG8_MMA(1, 1, At, B1); PG8_BAR; PG8_SCHED;
            PG8_LDB(B0, 1, 0); PG8_LDB(B1, 1, 1); PG8_SCHED; PG8_LDA(At, 1, 0); PG8_STAGE(PG8_SA(0, 1), a2 + hstepA, voffA);
            PG8_WAIT_V(8); PG8_WAIT_L(0); PG8_BAR; PG8_MMA(0, 0, At, B0); PG8_MMA(0, 1, At, B1); PG8_BAR; PG8_SCHED;
            PG8_LDA(At, 1, 1); PG8_STAGE(PG8_SB(1, 0), b3, voffB); PG8_STAGE(PG8_SB(1, 1), b3 + hstepB, voffB); PG8_STAGE(PG8_SA(1, 0), a3, voffA);
            PG8_WAIT_V(8); PG8_WAIT_L(0); PG8_BAR; PG8_MMA(1, 0, At, B0); PG8_MMA(1, 1, At, B1); PG8_BAR; PG8_SCHED;
            } else {
            PG8_LDB(B0, 0, 0); PG8_SCHED; PG8_LDA(At, 0, 0); PG8_STAGE(PG8_SA(1, 1), a1 + hstepA, voffA);
            PG8_WAIT_L(8); PG8_BAR; PG8_WAIT_L(0); PG8_MMA(0, 0, At, B0); PG8_BAR; PG8_SCHED;
            PG8_LDB(B1, 0, 1); PG8_STAGE(PG8_SB(0, 0), b2, voffB);
            PG8_BAR; PG8_WAIT_L(0); PG8_MMA(0, 1, At, B1); PG8_BAR;
            PG8_LDA(At, 0, 1); PG8_STAGE(PG8_SA(0, 0), a2, voffA);
            PG8_BAR; PG8_WAIT_L(0); PG8_MMA(1, 0, At, B0); PG8_BAR; PG8_SCHED;
            PG8_STAGE(PG8_SB(0, 1), b2 + hstepB, voffB);
            PG8_WAIT_V(6); PG8_BAR; PG8_MMA(1, 1, At, B1); PG8_BAR;
            PG8_LDB(B0, 1, 0); PG8_SCHED; PG8_LDA(At, 1, 0); PG8_STAGE(PG8_SA(0, 1), a2 + hstepA, voffA);
            PG8_WAIT_L(8); PG8_BAR; PG8_WAIT_L(0); PG8_MMA(0, 0, At, B0); PG8_BAR; PG8_SCHED;
            PG8_LDB(B1, 1, 1); PG8_STAGE(PG8_SB(1, 0), b3, voffB);
            PG8_BAR; PG8_WAIT_L(0); PG8_MMA(0, 1, At, B1); PG8_BAR;
            PG8_LDA(At, 1, 1); PG8_STAGE(PG8_SA(1, 0), a3, voffA);
            PG8_BAR; PG8_WAIT_L(0); PG8_MMA(1, 0, At, B0); PG8_BAR; PG8_SCHED;
            PG8_STAGE(PG8_SB(1, 1), b3 + hstepB, voffB);
            PG8_WAIT_V(6); PG8_BAR; PG8_MMA(1, 1, At, B1); PG8_BAR;
            }
        }
        if constexpr (ALIGN_EPI) { if (wr == 0) PG8_BAR; }
        if constexpr (!Epi::AFTER_DRAIN) { E(acc, cur, wr, wc, fr, fq); S.done(cur); }
        if (!has_next) break;
#pragma unroll
        for (int a = 0; a < 2; ++a)
#pragma unroll
            for (int b = 0; b < 2; ++b)
#pragma unroll
                for (int m = 0; m < 4; ++m)
#pragma unroll
                    for (int n = 0; n < 2; ++n) acc[a][b][m][n] = (f32x4){0.f, 0.f, 0.f, 0.f};
        cur = nxt; cA = nA; cB = nB; ++ui;
        if constexpr (ALIGN_EPI) { if (wr == 1) PG8_BAR; }
    }
    PG8_WAIT_V(0);
    if constexpr (!ALIGN_EPI) { if (wr == 0) PG8_BAR; }
    PG8_BAR;
    if constexpr (Epi::AFTER_DRAIN) { E.fused(acc, cur, wr, wc, fr, fq, lds, wid, lane); S.done(cur); }
#undef PG8_SA
#undef PG8_SB
#undef PG8_STAGE
#undef PG8_LDA
#undef PG8_LDB
#undef PG8_MMA
#undef PG8_WAIT_V
#undef PG8_WAIT_L
#undef PG8_BAR
#undef PG8_SCHED
}
}
namespace att {
constexpr int D = 128;
constexpr float THR = 8.f;
constexpr bool WSKIP = false;
constexpr float SCALE = 0.08838834764831845f;
constexpr int NW = 8, QBLK = 32, KVBLK = 64, QB = NW * QBLK;
constexpr int SHM_V = KVBLK * D * 2, SHM_K = KVBLK * D * 2;
constexpr int LDS_BYTES = 2 * SHM_V + 2 * SHM_K + NW * 64 * 4;
using bf16 = __hip_bfloat16;
typedef short bf16x8 __attribute__((ext_vector_type(8)));
typedef short s16x4 __attribute__((ext_vector_type(4)));
typedef float f32x16 __attribute__((ext_vector_type(16)));
typedef float f32x4 __attribute__((ext_vector_type(4)));
typedef unsigned u32x4 __attribute__((ext_vector_type(4)));
template <class A, class Bt> struct same_t { static constexpr bool v = false; };
template <class A> struct same_t<A, A> { static constexpr bool v = true; };

#define KSWZ(row, colB) ((row) * 256 + ((colB) ^ (((row) & 7) << 4)))
#define SBAR() __builtin_amdgcn_sched_barrier(0)
__device__ __forceinline__ int v_st(int k, int c) { const int kk = (k & ~0xC) | ((k & 4) << 1) | ((k & 8) >> 1); return ((kk >> 3) * 4 + (c >> 5)) * 512 + ((kk & 7) * 32 + (c & 31)) * 2; }
__device__ __forceinline__ int v_rd_base(int lane) { return ((lane & 3) << 3) | (((lane >> 2) & 3) << 6) | (((lane >> 4) & 1) << 5) | (((lane >> 5) & 1) << 8); }
constexpr int v_rd_off(int d0, int ks, int half) { return d0 * 512 + ks * 4096 + half * 2048; }
__device__ __forceinline__ int crow(int r, int hi) { return (r & 3) + 8 * (r >> 2) + 4 * hi; }
__device__ __forceinline__ unsigned cvtpk(float lo, float hi) {
    unsigned r; asm volatile("v_cvt_pk_bf16_f32 %0, %1, %2" : "=v"(r) : "v"(lo), "v"(hi)); return r;
}
__device__ __forceinline__ bf16x8 pack8(f32x4 a, f32x4 b) {
    u32x4 w = {cvtpk(a[0], a[1]), cvtpk(a[2], a[3]), cvtpk(b[0], b[1]), cvtpk(b[2], b[3])};
    return *reinterpret_cast<bf16x8*>(&w);
}
template <class T> __device__ __forceinline__ bf16x8 load8(const T* p) {
    if constexpr (same_t<T, float>::v) { return pack8(*(const f32x4*)p, *(const f32x4*)(p + 4)); }
    else { return *reinterpret_cast<const bf16x8*>(p); }
}
__device__ __forceinline__ void mask_tile(f32x16& p0, f32x16& p1, int dq, unsigned W) {
    const float NEG = -__builtin_inff();
#pragma unroll
    for (int r = 0; r < 16; ++r) {
        const int c = (r & 3) + 8 * (r >> 2);
        if ((unsigned)(dq - c) >= W) p0[r] = NEG;
        if ((unsigned)(dq - c - 32) >= W) p1[r] = NEG;
    }
}
__device__ __forceinline__ void partialSM(f32x16& p0, f32x16& p1, float& m_reg, float& mn, float& alpha) {
    float pmax = p0[0]; for (int r = 1; r < 16; ++r) pmax = fmaxf(pmax, p0[r]); for (int r = 0; r < 16; ++r) pmax = fmaxf(pmax, p1[r]);
    { auto rr = __builtin_amdgcn_permlane32_swap(__float_as_uint(pmax), __float_as_uint(pmax), false, false);
      pmax = fmaxf(__uint_as_float(rr[0]), __uint_as_float(rr[1])); }
    constexpr float C2 = 1.4426950408889634f * SCALE;
    if (__builtin_expect(__all((pmax - m_reg) * SCALE <= THR), 1)) { mn = m_reg; alpha = 1.f; }
    else { mn = fmaxf(m_reg, pmax); alpha = __builtin_amdgcn_exp2f((m_reg - mn) * C2); m_reg = mn; }
    const float mnL = -mn * C2;
    for (int r = 0; r < 16; ++r) p0[r] = fmaf(p0[r], C2, mnL); for (int r = 0; r < 16; ++r) p1[r] = fmaf(p1[r], C2, mnL);
    for (int r = 0; r < 16; ++r) p0[r] = __builtin_amdgcn_exp2f(p0[r]);
}
__device__ __forceinline__ void finishSM(f32x16& p0, f32x16& p1, float alpha, float& l_reg, bf16x8& pa0, bf16x8& pa1, bf16x8& pa2, bf16x8& pa3) {
    for (int r = 0; r < 16; ++r) p1[r] = __builtin_amdgcn_exp2f(p1[r]);
    float ps = 0; for (int r = 0; r < 16; ++r) ps += p0[r]; for (int r = 0; r < 16; ++r) ps += p1[r];
    { auto rr = __builtin_amdgcn_permlane32_swap(__float_as_uint(ps), __float_as_uint(ps), false, false);
      ps = __uint_as_float(rr[0]) + __uint_as_float(rr[1]); }
    l_reg = l_reg * alpha + ps;
#define PK4(P, B_, OUT) do { unsigned a0 = cvtpk(P[B_+0], P[B_+1]), a1 = cvtpk(P[B_+2], P[B_+3]);                          \
        unsigned b0 = cvtpk(P[B_+4], P[B_+5]), b1 = cvtpk(P[B_+6], P[B_+7]);                                             \
        auto r0 = __builtin_amdgcn_permlane32_swap(a0, b0, false, false); auto r1 = __builtin_amdgcn_permlane32_swap(a1, b1, false, false); \
        u32x4 w = {r0[0], r1[0], r0[1], r1[1]}; OUT = *reinterpret_cast<bf16x8*>(&w); } while (0)
    PK4(p0, 0, pa0); PK4(p0, 8, pa1); PK4(p1, 0, pa2); PK4(p1, 8, pa3);
#undef PK4
}
template <int KB, bool SK>
__device__ __forceinline__ void qkt(f32x16& p0, f32x16& p1, const char* K_lds, int r32, int hi, const bf16x8* qr, bool act, int cbo  ) {
    if (SK && !act) { const float NEG = -__builtin_inff();
#pragma unroll
        for (int r = 0; r < 16; ++r) { p0[r] = NEG; p1[r] = NEG; } return; }
    if (cbo >= 0) { int a_ = cbo + hi * 16; asm volatile("" : "+v"(a_)); const __attribute__((address_space(3))) float* cb = (const __attribute__((address_space(3))) float*)(unsigned)a_;
#pragma unroll
        for (int q_ = 0; q_ < 4; ++q_) { const f32x4 v0_ = *(const __attribute__((address_space(3))) f32x4*)(cb + 8 * q_), v1_ = *(const __attribute__((address_space(3))) f32x4*)(cb + 32 + 8 * q_);
#pragma unroll
            for (int j_ = 0; j_ < 4; ++j_) { p0[4 * q_ + j_] = v0_[j_]; p1[4 * q_ + j_] = v1_[j_]; } }
    } else { p0 = f32x16{}; p1 = f32x16{}; }
    const char* kb[4];
#pragma unroll
    for (int dd = 0; dd < 4; ++dd) kb[dd] = K_lds + KB * SHM_K + KSWZ(r32, (dd * 16 + hi * 8) * 2);
#pragma unroll
    for (int d0 = 0; d0 < 8; ++d0) { const char* a = kb[d0 & 3] + (d0 >> 2) * 128;
        bf16x8 b0 = *reinterpret_cast<const bf16x8*>(a);
        bf16x8 b1 = *reinterpret_cast<const bf16x8*>(a + 32 * 256);
        p0 = __builtin_amdgcn_mfma_f32_32x32x16_bf16(b0, qr[d0], p0, 0, 0, 0);
        p1 = __builtin_amdgcn_mfma_f32_32x32x16_bf16(b1, qr[d0], p1, 0, 0, 0); }
}
template <int VB, bool SK>
__device__ __forceinline__ void pv_tile(f32x16* o, int vb0, bf16x8 pa0, bf16x8 pa1, bf16x8 pa2, bf16x8 pa3, bool act) {
    if (SK && !act) return;
#define TRRD(dst, off) asm volatile("ds_read_b64_tr_b16 %0, %1 offset:%2" : "=&v"(dst) : "v"(vb0), "i"(off) : "memory")
#define PV_D0(d0) do { s16x4 l0, l1, l2, l3, h0, h1, h2, h3; constexpr int b_ = VB * SHM_V + v_rd_off(d0, 0, 0);     \
        TRRD(l0, b_); TRRD(h0, b_ + 2048); TRRD(l1, b_ + 4096); TRRD(h1, b_ + 6144); TRRD(l2, b_ + 8192); TRRD(h2, b_ + 10240); TRRD(l3, b_ + 12288); TRRD(h3, b_ + 14336); \
        asm volatile("s_waitcnt lgkmcnt(0)" ::: "memory"); SBAR();                 \
        o[d0] = __builtin_amdgcn_mfma_f32_32x32x16_bf16(pa0, (bf16x8){l0[0], l0[1], l0[2], l0[3], h0[0], h0[1], h0[2], h0[3]}, o[d0], 0, 0, 0);   \
        o[d0] = __builtin_amdgcn_mfma_f32_32x32x16_bf16(pa1, (bf16x8){l1[0], l1[1], l1[2], l1[3], h1[0], h1[1], h1[2], h1[3]}, o[d0], 0, 0, 0);   \
        o[d0] = __builtin_amdgcn_mfma_f32_32x32x16_bf16(pa2, (bf16x8){l2[0], l2[1], l2[2], l2[3], h2[0], h2[1], h2[2], h2[3]}, o[d0], 0, 0, 0);   \
        o[d0] = __builtin_amdgcn_mfma_f32_32x32x16_bf16(pa3, (bf16x8){l3[0], l3[1], l3[2], l3[3], h3[0], h3[1], h3[2], h3[3]}, o[d0], 0, 0, 0); } while (0)
    PV_D0(0); PV_D0(1); PV_D0(2); PV_D0(3);
#undef PV_D0
#undef TRRD
}

template <class T> __device__ __forceinline__ T* uptr(T* p) { const unsigned long long v = (unsigned long long)p; const unsigned lo = __builtin_amdgcn_readfirstlane((unsigned)v), hi = __builtin_amdgcn_readfirstlane((unsigned)(v >> 32)); return (T*)(((unsigned long long)hi << 32) | lo); }
template <class TIn, class TOut> struct BlockRef { const TIn* Q; const TIn* K; const TIn* V; TOut* O; float* SS; int P0; };
template <class TIn> struct Seam {
    bf16x8 qr[8];
    bf16x8 st_v0, st_v1, st_k0, st_k1; f32x4 sf0, sf1, sf2, sf3;
    f32x4 tq[16];
};
__device__ __forceinline__ int swa_jlo(int P0, int W) { const int lowk = P0 - W + 1; return lowk > 0 ? lowk / KVBLK : 0; }
#define ROW(p, k0, rr) ((decltype(p))((const char*)(p) + (unsigned)(((k0) + (rr)) * D + sc) * (unsigned)sizeof(*(p))))
#define VMW() asm volatile("s_waitcnt vmcnt(0)" ::: "memory")
#define VMWN(n) asm volatile("s_waitcnt vmcnt(%0)" :: "i"(n) : "memory")
#define SLOAD_H(Kp, Vp, k0) do { S.st_v0 = load8<TIn>(ROW(Vp, k0, sr)); S.st_v1 = load8<TIn>(ROW(Vp, k0, 32 + sr));              \
                         S.st_k0 = load8<TIn>(ROW(Kp, k0, sr)); S.st_k1 = load8<TIn>(ROW(Kp, k0, 32 + sr)); } while (0)
#define SWRITE_HK(bf) do { *(bf16x8*)(K_lds + (bf) * SHM_K + kws) = S.st_k0; *(bf16x8*)(K_lds + (bf) * SHM_K + kws + 32 * 256) = S.st_k1; } while (0)
#define SWRITE_HV(bf) do { *(bf16x8*)(V_lds + (bf) * SHM_V + vst0) = S.st_v0; *(bf16x8*)(V_lds + (bf) * SHM_V + vst1) = S.st_v1; } while (0)
#define SWRITE_H(bf) do { SWRITE_HV(bf); SWRITE_HK(bf); } while (0)
#define SLOAD_F(p, k0) do { S.sf0 = *(const f32x4*)ROW(p, k0, sr); S.sf1 = *(const f32x4*)(ROW(p, k0, sr) + 4);                \
                            S.sf2 = *(const f32x4*)ROW(p, k0, 32 + sr); S.sf3 = *(const f32x4*)(ROW(p, k0, 32 + sr) + 4); } while (0)
#define SWRITE_KF(bf) do { *(bf16x8*)(K_lds + (bf) * SHM_K + kws) = pack8(S.sf0, S.sf1); *(bf16x8*)(K_lds + (bf) * SHM_K + kws + 32 * 256) = pack8(S.sf2, S.sf3); } while (0)
#define SWRITE_VF(bf) do { *(bf16x8*)(V_lds + (bf) * SHM_V + vst0) = pack8(S.sf0, S.sf1); *(bf16x8*)(V_lds + (bf) * SHM_V + vst1) = pack8(S.sf2, S.sf3); } while (0)
template <class TIn, class TOut>
__device__ __forceinline__ void causal_swa_prime(const BlockRef<TIn, TOut>& cur_, int W, char* lds, Seam<TIn>& S) {
    BlockRef<TIn, TOut> cur; cur.Q = uptr(cur_.Q); cur.K = uptr(cur_.K); cur.V = uptr(cur_.V); cur.O = nullptr; cur.SS = nullptr; cur.P0 = __builtin_amdgcn_readfirstlane(cur_.P0);
    constexpr bool F32 = same_t<TIn, float>::v;
    int tid_ = my_tid();
    const int tid = tid_, wid = __builtin_amdgcn_readfirstlane(tid >> 6), lane = tid & 63, r32 = lane & 31, hi = lane >> 5;
    const int sr = tid >> 4, sc = (tid & 15) * 8, kws = KSWZ(sr, sc * 2); char* K_lds = lds + 2 * SHM_V;
    const int kb0 = swa_jlo(cur.P0, W) * KVBLK;
    for (int d0 = 0; d0 < 8; ++d0) S.qr[d0] = load8<TIn>((const TIn*)((const char*)cur.Q + (unsigned)((wid * QBLK + r32) * D + d0 * 16 + hi * 8) * (unsigned)sizeof(TIn)));
    if constexpr (F32) { SLOAD_F((const float*)cur.K, kb0); VMW(); SWRITE_KF(0); SBAR(); SLOAD_F((const float*)cur.V, kb0); }
    else { SLOAD_H(cur.K, cur.V, kb0); VMW(); SWRITE_HK(0); }
    __syncthreads();
}
template <class TIn, class TOut, int ost, bool HAS_SS>
__device__ __forceinline__ void causal_swa_block(const BlockRef<TIn, TOut>& cur_, const BlockRef<TIn, TOut>& nxt_, int skv, int W, char* lds, Seam<TIn>& S, int cbl  ) {
    constexpr bool F32 = same_t<TIn, float>::v;
    BlockRef<TIn, TOut> cur, nxt; cur.Q = uptr(cur_.Q); cur.K = uptr(cur_.K); cur.V = uptr(cur_.V); cur.O = uptr(cur_.O); cur.SS = uptr(cur_.SS); cur.P0 = __builtin_amdgcn_readfirstlane(cur_.P0);
    nxt.Q = uptr(nxt_.Q); nxt.K = uptr(nxt_.K); nxt.V = uptr(nxt_.V); nxt.O = nullptr; nxt.SS = nullptr; nxt.P0 = __builtin_amdgcn_readfirstlane(nxt_.P0);
    int tid_ = my_tid();
    const int tid = tid_, wid = __builtin_amdgcn_readfirstlane(tid >> 6), lane = tid & 63, r32 = lane & 31, hi = lane >> 5;
    const int j_lo = swa_jlo(cur.P0, W);
    int j_hi = (cur.P0 + QB - 1) / KVBLK + 1; if (j_hi > skv / KVBLK) j_hi = skv / KVBLK;
    const int NT = j_hi - j_lo;
    const int kbn = swa_jlo(nxt.P0, W) * KVBLK;
    const int qlo = cur.P0 + wid * QBLK, qm = qlo + r32 - 4 * hi;
    char* V_lds = lds; char* K_lds = lds + 2 * SHM_V;
    float* ws = (float*)(lds + 2 * SHM_V + 2 * SHM_K) + wid * 64; float* li_l = ws, * al_l = ws + 32;
    float m_reg = -1e30f, l_reg = 0; f32x16 o[4] = {};
    const int sr = tid >> 4, sc = (tid & 15) * 8, vst0 = v_st(sr, sc), vst1 = v_st(32 + sr, sc), kws = KSWZ(sr, sc * 2);
    const int vb0 = (int)(uintptr_t)V_lds + v_rd_base(lane);
    const TIn* Kh = cur.K; const TIn* Vh = cur.V;
#define RESC(a) do { if (__any((a) < 1.f)) { if (hi == 0) al_l[r32] = (a); asm volatile("s_waitcnt lgkmcnt(0)" ::: "memory");              \
                     for (int d_ = 0; d_ < 4; ++d_) for (int r = 0; r < 16; ++r) o[d_][r] *= al_l[crow(r, hi)]; } } while (0)
#define KBASE(t) ((j_lo + (t)) * KVBLK)
#define CBT(t) (cbl >= 0 ? cbl + KBASE(t) * 4 : -1)
#define ACT(t) (KBASE(t) <= qlo + QBLK - 1 && KBASE(t) + KVBLK - 1 >= qlo - W + 1)
#define MASKT(P0_, P1_, t) do { const int kb_ = KBASE(t); if ((!SK || ACT(t)) && (kb_ + KVBLK - 1 > qlo || kb_ <= qlo + QBLK - 1 - W)) mask_tile(P0_, P1_, qm - kb_, (unsigned)W); } while (0)
    constexpr int NQL = F32 ? 16 : 8;
    constexpr bool SK = WSKIP && !F32;
#define SEAM_K0() do { VMWN(NQL); if constexpr (F32) { SWRITE_KF(0); SBAR(); SLOAD_F((const float*)nxt.V, kbn); } else { SWRITE_HK(0); } SBAR(); } while (0)
    f32x16 pA0, pA1, pB0, pB1; float mnA, mnB, alA, alB; bf16x8 pa0, pa1, pa2, pa3;
    if constexpr (F32) { VMW(); SWRITE_VF(0); SBAR(); } else { SWRITE_HV(0); SBAR(); }
    if (NT > 1) { if constexpr (F32) SLOAD_F((const float*)Kh, KBASE(1)); else SLOAD_H(Kh, Vh, KBASE(1)); }
    SBAR(); qkt<0, SK>(pA0, pA1, K_lds, r32, hi, S.qr, ACT(0), CBT(0));
    if constexpr (F32) { if (NT > 1) { VMW(); SWRITE_KF(1); SBAR(); SLOAD_F((const float*)Vh, KBASE(1)); } }
    MASKT(pA0, pA1, 0); partialSM(pA0, pA1, m_reg, mnA, alA);
    if (NT > 1) { VMW(); if constexpr (F32) { SWRITE_VF(1); SBAR(); if (NT > 2) SLOAD_F((const float*)Kh, KBASE(2)); } else SWRITE_H(1); }
    __syncthreads();
#define HALF_STEP(PX0, PX1, mnX, alX, PY0, PY1, alY, t, KB, VB, SB) do {                                                      \
        SBAR(); qkt<KB, SK>(PX0, PX1, K_lds, r32, hi, S.qr, ACT(t), CBT(t));                                             \
        finishSM(PY0, PY1, alY, l_reg, pa0, pa1, pa2, pa3); SBAR();                                                           \
        if ((t) + 1 < NT) { if constexpr (F32) { VMW(); SWRITE_KF(SB); SBAR(); SLOAD_F((const float*)Vh, KBASE((t) + 1)); }  \
                            else { SLOAD_H(Kh, Vh, KBASE((t) + 1)); } SBAR(); }                                               \
        pv_tile<VB, SK>(o, vb0, pa0, pa1, pa2, pa3, ACT((t) - 1)); MASKT(PX0, PX1, (t)); partialSM(PX0, PX1, m_reg, mnX, alX);                                        \
        __syncthreads();                                                                                                      \
        if ((t) + 1 < NT) { VMW(); if constexpr (F32) { SWRITE_VF(SB); SBAR(); if ((t) + 2 < NT) SLOAD_F((const float*)Kh, KBASE((t) + 2)); } \
                            else { SWRITE_H(SB); } }                                                                          \
        RESC(alX); __syncthreads(); } while (0)
    for (int t = 1; t + 1 < NT; t += 2) {
        HALF_STEP(pB0, pB1, mnB, alB, pA0, pA1, alA, t, 1, 0, 0);
        HALF_STEP(pA0, pA1, mnA, alA, pB0, pB1, alB, t + 1, 0, 1, 1);
    }
    const bool even = (NT & 1) == 0;
    if (even) { SBAR(); qkt<1, SK>(pB0, pB1, K_lds, r32, hi, S.qr, ACT(NT - 1), CBT(NT - 1)); SBAR(); }
#define QROW(e) (nxt.Q + (size_t)(wid * QBLK + r32) * D + ((e) >> 1) * 16 + hi * 8 + ((e) & 1) * 4)
    if constexpr (F32) { SLOAD_F((const float*)nxt.K, kbn); SBAR();
#pragma unroll
        for (int e = 0; e < 8; ++e) S.tq[e] = *(const f32x4*)QROW(e); }
    else { SLOAD_H(nxt.K, nxt.V, kbn); SBAR();
#pragma unroll
        for (int d0 = 0; d0 < 8; ++d0) S.qr[d0] = load8<TIn>((const TIn*)((const char*)nxt.Q + (unsigned)((wid * QBLK + r32) * D + d0 * 16 + hi * 8) * (unsigned)sizeof(TIn))); }
    SBAR();
    finishSM(pA0, pA1, alA, l_reg, pa0, pa1, pa2, pa3); SBAR();
    if constexpr (F32) {
#pragma unroll
        for (int e = 8; e < 16; ++e) S.tq[e] = *(const f32x4*)QROW(e); SBAR(); }
#undef QROW
    pv_tile<0, SK>(o, vb0, pa0, pa1, pa2, pa3, ACT(even ? NT - 2 : NT - 1));
    if (even) { MASKT(pB0, pB1, NT - 1); partialSM(pB0, pB1, m_reg, mnB, alB); __syncthreads(); RESC(alB);
        finishSM(pB0, pB1, alB, l_reg, pa0, pa1, pa2, pa3); SBAR(); pv_tile<1, SK>(o, vb0, pa0, pa1, pa2, pa3, ACT(NT - 1)); }
    SBAR(); SEAM_K0();
    if (hi == 0) li_l[r32] = l_reg; asm volatile("s_waitcnt lgkmcnt(0)" ::: "memory");
    float rli[16];
#pragma unroll
    for (int r = 0; r < 16; ++r) rli[r] = __builtin_amdgcn_rcpf(li_l[crow(r, hi)]);
    int r32e = r32, hie = hi; asm volatile("" : "+v"(r32e), "+v"(hie));
    char* Ob = (char*)cur.O; const unsigned ob0 = (unsigned)((wid * QBLK + 4 * hie) * ost + r32e) * 2u;
#pragma unroll
    for (int r = 0; r < 16; ++r) { const unsigned rowoff = ob0 + (unsigned)(((r & 3) + 8 * (r >> 2)) * ost * 2); float ss_ = 0.f;
#pragma unroll
        for (int d0 = 0; d0 < 4; ++d0) { const float v = o[d0][r] * rli[r]; ss_ += v * v;
            const float vn = shx<1>(v);
            if ((r32e & 1) == 0) *(unsigned*)(Ob + rowoff + d0 * 64) = cvtpk(v, vn); }
        if (HAS_SS) { ss_ += shx<1>(ss_); ss_ += shx<2>(ss_); ss_ += shx<4>(ss_); ss_ += shx<8>(ss_); ss_ += shx<16>(ss_);
            if (r32e == 0) *(float*)((char*)cur.SS + (unsigned)(wid * QBLK + 4 * hie + (r & 3) + 8 * (r >> 2)) * 32u) = ss_; }
        SBAR(); }
    if constexpr (F32) {
#pragma unroll
        for (int d0 = 0; d0 < 8; ++d0) S.qr[d0] = pack8(S.tq[2 * d0], S.tq[2 * d0 + 1]); }
    __syncthreads();
#undef RESC
#undef KBASE
#undef CBT
#undef ACT
#undef MASKT
#undef SEAM_K0
#undef HALF_STEP
}
#undef ROW
}

#define GAS __attribute__((address_space(1)))
#define LAS __attribute__((address_space(3)))
typedef unsigned short bf16;
typedef unsigned v4u __attribute__((ext_vector_type(4)));
typedef float f32x4 __attribute__((ext_vector_type(4)));
#define LDS_WAIT() asm volatile("s_waitcnt lgkmcnt(0)" ::: "memory")
#define VM_WAIT() asm volatile("s_waitcnt vmcnt(0)" ::: "memory")
__device__ __forceinline__ unsigned f2bf(float f) { unsigned u = __builtin_bit_cast(unsigned, f); return (u + 0x7fffu + ((u >> 16) & 1u)) >> 16; }
__device__ __forceinline__ unsigned pk2(float lo, float hi) { return f2bf(lo) | (f2bf(hi) << 16); }
__device__ __forceinline__ float bflo(unsigned w) { return __uint_as_float(w << 16); }
__device__ __forceinline__ float bfhi(unsigned w) { return __uint_as_float(w & 0xffff0000u); }

#ifndef LB2
#define LB2 2
#endif
#ifndef FOX_HAS_SS
#define FOX_HAS_SS false
#endif
#ifndef FOX_SS
#define FOX_SS (SSQF + ((size_t)b * SEQ + x * 256) * 8 + h)
#endif
#ifndef FOX_CB
#define FOX_CB CB_OFF
#endif
#ifndef USE_XB
#define USE_XB 1
#endif
#if USE_XB
#define GSYNC() xcd_barrier(xbar)
#else
#define GSYNC() grid.sync()
#endif
#ifndef REP
#define REP 0
#endif
#ifndef PH
#define PH 0x1ff
#endif
constexpr int NWAVES = 8, NTHR = 512;
constexpr int BATCH = 4, SEQ = 2048, DM = 2048, M = BATCH * SEQ, NMEM = 256, MMEM = BATCH * NMEM;
constexpr int FOXW = 1024, LRUW = 1024, INW = 5128, INWP = 5376, XW = 512, FFN = 5632;
constexpr float EPS = 1e-6f;
constexpr size_t MiB = 1u << 20;
constexpr size_t WS_WIN = 1 * MiB, WS_WOUT = 22 * MiB, WS_WCQ = 30 * MiB, WS_WCKV = 32 * MiB, WS_WCO = 36 * MiB, WS_WGU = 38 * MiB, WS_WDN = 82 * MiB, WS_WLRU = 104 * MiB;
constexpr size_t WS_XN = 105 * MiB, WS_MN = 137 * MiB, WS_Q = 141 * MiB, WS_K = 157 * MiB, WS_V = 173 * MiB, WS_U = 189 * MiB, WS_GG = 205 * MiB, WS_UC = 221 * MiB;
constexpr size_t WS_LF = 237 * MiB, WS_CK = 238 * MiB, WS_CV = 239 * MiB, WS_MIX = 240 * MiB, WS_SSQF = 272 * MiB, WS_SSQL = 273 * MiB, WS_X1 = 274 * MiB;
constexpr size_t WS_SSQ1 = 338 * MiB, WS_CQ = 339 * MiB, WS_SSQ2 = 347 * MiB, WS_END = 348 * MiB;
constexpr size_t WS_HL = WS_X1, WS_AC = WS_X1 + 16 * MiB, WS_ENDH = WS_SSQ2, WS_ENDA = WS_SSQ2 + 256 * 1024;
constexpr size_t WS_X1B = WS_XN  , WS_OX = WS_Q  , WS_X2B = WS_MIX  , WS_H = WS_Q  ;
constexpr int LDS_BYTES = 147456, RED_OFF = 131072, CB_OFF = 69632, WSUM_OFF = 77824;

__device__ __forceinline__ float wave_sum(float v) { v += shx<1>(v); v += shx<2>(v); v += shx<4>(v); v += shx<8>(v); v += shx<16>(v); return sum32(v); }
__device__ __forceinline__ void transpose_item(const float* W, int ldw, int k0, int srcn0, int nvalid, const float* ks, bf16* WT, int ldt, int drow0, LAS float* scr, int lane) {
    f32x4 v[8];
#pragma unroll
    for (int i = 0; i < 8; ++i) { const int kk = 8 * i + (lane >> 3), n4 = (lane & 7) * 4;
        v[i] = (n4 < nvalid) ? *(const GAS f32x4*)(W + (size_t)(k0 + kk) * ldw + srcn0 + n4) : (f32x4){0.f, 0.f, 0.f, 0.f}; }
#pragma unroll
    for (int i = 0; i < 8; ++i) { const int kk = 8 * i + (lane >> 3), n4 = (lane & 7) * 4; f32x4 x = v[i]; if (ks) x = x * ks[k0 + kk];
        LAS float* d = scr + kk * 33 + n4; d[0] = x.x; d[1] = x.y; d[2] = x.z; d[3] = x.w; }
    LDS_WAIT(); asm volatile("" ::: "memory");
    const int c = lane & 7;
#pragma unroll
    for (int j = 0; j < 4; ++j) { const int n = (lane >> 3) + 8 * j; const LAS float* s = scr + (8 * c) * 33 + n;
        v4u o; o.x = pk2(s[0 * 33], s[1 * 33]); o.y = pk2(s[2 * 33], s[3 * 33]); o.z = pk2(s[4 * 33], s[5 * 33]); o.w = pk2(s[6 * 33], s[7 * 33]);
        *(GAS v4u*)(WT + (size_t)(drow0 + n) * ldt + k0 + 8 * c) = o; }
    LDS_WAIT(); asm volatile("" ::: "memory");
}
__device__ __forceinline__ void rms_row_to_bf16(const float* xrow, const float* g, bf16* orow, int lane) {
    const GAS f32x4* xr = (const GAS f32x4*)xrow + lane; const GAS f32x4* gr = (const GAS f32x4*)g + lane;
    f32x4 v[8]; float s = 0.f;
#pragma unroll
    for (int j = 0; j < 8; ++j) { v[j] = xr[64 * j]; s += (v[j].x * v[j].x + v[j].y * v[j].y) + (v[j].z * v[j].z + v[j].w * v[j].w); }
    const float rstd = 1.0f / sqrtf(wave_sum(s) * (1.f / DM) + EPS);
    GAS unsigned long long* o8 = (GAS unsigned long long*)orow + lane;
#pragma unroll
    for (int j = 0; j < 8; ++j) { const f32x4 gg = gr[64 * j]; o8[64 * j] = (unsigned long long)pk2(v[j].x * rstd * gg.x, v[j].y * rstd * gg.y) | ((unsigned long long)pk2(v[j].z * rstd * gg.z, v[j].w * rstd * gg.w) << 32); }
}

#define XB_TMO      128
#define XB_XCNT(j)  (256  + 64 * (j))
#define XB_XSUB(j)  (1280 + 64 * (j))
#define XB_XGEN(j)  (2304 + 64 * (j))
#define XB_TOP      3328
#define XB_TOPGEN   3392
#define XCD_BAR_WORDS 3456
#define XB_SPIN_CAP (1u << 18)

__device__ __forceinline__ unsigned xb_ld(unsigned* p)              { return __hip_atomic_load(p, __ATOMIC_RELAXED, __HIP_MEMORY_SCOPE_AGENT); }
__device__ __forceinline__ unsigned xb_add(unsigned* p, unsigned v) { return __hip_atomic_fetch_add(p, v, __ATOMIC_RELAXED, __HIP_MEMORY_SCOPE_AGENT); }
__device__ __forceinline__ unsigned xb_xcc_id() { return (unsigned)__builtin_amdgcn_s_getreg((3 << 11) | 20) & 0xFu; }
#define XB_SPIN(cond, bar) do { unsigned _sp = 0; while (cond) { __builtin_amdgcn_s_sleep(1); \
    if ((++_sp & 255u) == 0u) { if (xb_ld(&(bar)[XB_TMO])) break; if (_sp > XB_SPIN_CAP) { atomicAdd(&(bar)[XB_TMO], 1u); break; } } } } while (0)

struct XcdBarrier {
    unsigned* bar; unsigned x;
    volatile LAS unsigned* st;
};

__device__ __forceinline__ XcdBarrier xcd_barrier_post(unsigned* bar, volatile LAS unsigned* st) {
    XcdBarrier b; b.bar = bar; b.x = xb_xcc_id(); b.st = st;
    if (my_tid() == 0) (void)xb_add(&bar[XB_XCNT(b.x)], 1u);
    return b;
}
__device__ __forceinline__ void xcd_barrier_complete(unsigned* bar, unsigned x, unsigned& nloc, unsigned& nx) {
    const unsigned G = gridDim.x * gridDim.y * gridDim.z;
    unsigned sum, cnt, mine, sp = 0u;
    for (;;) {
        sum = 0u; cnt = 0u; mine = 0u;
#pragma unroll
        for (unsigned j = 0; j < 16; ++j) { const unsigned c = xb_ld(&bar[XB_XCNT(j)]); sum += c; cnt += (c > 0u) ? 1u : 0u; mine = (j == x) ? c : mine; }
        if (sum == G) break;
        __builtin_amdgcn_s_sleep(1);
        if ((++sp & 255u) == 0u) { if (xb_ld(&bar[XB_TMO])) break; if (sp > XB_SPIN_CAP) { atomicAdd(&bar[XB_TMO], 1u); break; } }
    }
    nloc = mine > 0u ? mine : 1u; nx = cnt > 0u ? cnt : 1u;
}

__device__ __forceinline__ void xcd_barrier(const XcdBarrier& b) {
    asm volatile("s_waitcnt vmcnt(0)" ::: "memory");
    __syncthreads();
    if (my_tid() == 0) {
        unsigned* bar = b.bar;
        __builtin_amdgcn_s_waitcnt(0);
        unsigned nloc = b.st[0], nx = b.st[1];
        if (nloc == 0u) { xcd_barrier_complete(bar, b.x, nloc, nx); b.st[0] = nloc; b.st[1] = nx; }
        const unsigned old = xb_add(&bar[XB_XSUB(b.x)], 1u);
        const unsigned gen = old / nloc;
        if (old + 1u == (gen + 1u) * nloc) {
            __builtin_amdgcn_fence(__ATOMIC_RELEASE, "agent");
            asm volatile("s_waitcnt vmcnt(0)" ::: "memory");
            const unsigned og = xb_add(&bar[XB_TOP], 1u);
            const unsigned tg = og / nx;
            if (og + 1u == (tg + 1u) * nx) xb_add(&bar[XB_TOPGEN], 1u);
            else XB_SPIN(xb_ld(&bar[XB_TOPGEN]) == tg, bar);
            __builtin_amdgcn_fence(__ATOMIC_ACQUIRE, "agent");
            xb_add(&bar[XB_XGEN(b.x)], 1u);
            asm volatile("s_waitcnt vmcnt(0)" ::: "memory");
        } else {
            XB_SPIN(xb_ld(&bar[XB_XGEN(b.x)]) == gen, bar);
            __builtin_amdgcn_fence(__ATOMIC_ACQUIRE, "agent");
            asm volatile("s_waitcnt vmcnt(0)" ::: "memory");
        }
    }
    __syncthreads();
}

struct Args { const float* in[27]; float* out; unsigned char* ws; };
enum { I_X = 0, I_MEM, I_GMIX, I_WIN, I_BF, I_GQ, I_GK, I_CONVW, I_CONVB, I_WRA, I_BRA, I_WRI, I_BRI, I_LAM, I_GFOX, I_GLRU, I_WOUT, I_GXATTN, I_GMEM, I_WCQ, I_WCKV, I_GCQ, I_GCK, I_WCO, I_GFFN, I_WGU, I_WDN };

constexpr int KB_D = DM / 64;
constexpr int I0 = (INWP / 32) * KB_D, I3 = (2 * XW / 32) * KB_D, I7 = 16 * 4 * 2, N_EARLY = I0 + I3 + I7;
constexpr int I1 = (DM / 32) * KB_D, I2 = (XW / 32) * KB_D, I4 = (DM / 32) * (XW / 64), I5 = (2 * FFN / 32) * KB_D, I6 = (DM / 32) * (FFN / 64), N_LATE = I1 + I2 + I4 + I5 + I6;
constexpr int N_LATE_P1 = I1 + I2 + I4 + 2560;
constexpr int N_LATE_P2 = N_LATE_P1 + 2440;
__device__ __forceinline__ void early_item(const Args& a, int r, LAS float* scr, int lane) {
    unsigned char* ws = a.ws;
    if (r < I0) { const int rg = r / KB_D, kb = r % KB_D, d = rg * 32; int src = d, nv = 32;
        if (d >= 3072 && d < 5120) src = d + 8; else if (d == 5120) { src = 3072; nv = 8; } else if (d > 5120) { src = 0; nv = 0; }
        transpose_item(a.in[I_WIN], INW, kb * 64, src, nv, nullptr, (bf16*)(ws + WS_WIN), DM, d, scr, lane); return; } r -= I0;
    if (r < I3) { const int rg = r / KB_D, kb = r % KB_D;
        transpose_item(a.in[I_WCKV], 2 * XW, kb * 64, rg * 32, 32, nullptr, (bf16*)(ws + WS_WCKV), DM, rg * 32, scr, lane); return; } r -= I3;
    { const int mtx = r >> 3, sub = r & 7, rg = sub >> 1, kb = sub & 1, n = mtx >> 1, which = mtx & 1;
        transpose_item((which ? a.in[I_WRI] : a.in[I_WRA]) + (size_t)n * 128 * 128, 128, kb * 64, rg * 32, 32, nullptr, (bf16*)(ws + WS_WLRU) + (size_t)(n * 256 + which * 128) * 128, 128, rg * 32, scr, lane); }
}
__device__ __forceinline__ void late_item(const Args& a, int r, LAS float* scr, int lane) {
    unsigned char* ws = a.ws;
    if (r < I1) { const int rg = r / KB_D, kb = r % KB_D; const float* ks = kb < 16 ? a.in[I_GFOX] : a.in[I_GLRU] - 1024;
        transpose_item(a.in[I_WOUT], DM, kb * 64, rg * 32, 32, ks, (bf16*)(ws + WS_WOUT), DM, rg * 32, scr, lane); return; } r -= I1;
    if (r < I2) { const int rg = r / KB_D, kb = r % KB_D;
        transpose_item(a.in[I_WCQ], XW, kb * 64, rg * 32, 32, a.in[I_GXATTN], (bf16*)(ws + WS_WCQ), DM, rg * 32, scr, lane); return; } r -= I2;
    if (r < I4) { const int rg = r / (XW / 64), kb = r % (XW / 64);
        transpose_item(a.in[I_WCO], DM, kb * 64, rg * 32, 32, nullptr, (bf16*)(ws + WS_WCO), XW, rg * 32, scr, lane); return; } r -= I4;
    if (r < I5) { const int rg = r / KB_D, kb = r % KB_D, d = rg * 32, tile = d >> 8, w = d & 255; const int src = w < 128 ? tile * 128 + w : FFN + tile * 128 + (w - 128);
        transpose_item(a.in[I_WGU], 2 * FFN, kb * 64, src, 32, a.in[I_GFFN], (bf16*)(ws + WS_WGU), DM, d, scr, lane); return; } r -= I5;
    { const int rg = r / (FFN / 64), kb = r % (FFN / 64);
        transpose_item(a.in[I_WDN], DM, kb * 64, rg * 32, 32, nullptr, (bf16*)(ws + WS_WDN), FFN, rg * 32, scr, lane); }
}
__device__ __forceinline__ void late_range(const Args& a, LAS unsigned char* lds, int lo, int hi, int w, int nw, int wave, int lane) {
    LAS float* scr = (LAS float*)(lds + wave * 16384);
    for (int it = lo + w; it < hi; it += nw) late_item(a, it, scr, lane);
}
__device__ __forceinline__ void p0_prologue(const Args& a, LAS unsigned char* lds, int wave, int lane, int G) {
    unsigned char* ws = a.ws;
    LAS float* scr = (LAS float*)(lds + wave * 16384);
    const int gw = blockIdx.x * NWAVES + wave, NGW = G * NWAVES;
    for (int it = gw; it < N_EARLY; it += NGW) early_item(a, it, scr, lane);
    if (G != 256) for (int it = gw; it < N_LATE; it += NGW) late_item(a, it, scr, lane);
    for (int m = gw; m < M + MMEM; m += NGW) {
        if (m < M) rms_row_to_bf16(a.in[I_X] + (size_t)m * DM, a.in[I_GMIX], (bf16*)(ws + WS_XN) + (size_t)m * DM, lane);
        else rms_row_to_bf16(a.in[I_MEM] + (size_t)(m - M) * DM, a.in[I_GMEM], (bf16*)(ws + WS_MN) + (size_t)(m - M) * DM, lane);
    }
}

__device__ __forceinline__ void conv_chunk(const bf16* U, bf16* UC, const float* cw, const float* cbias, int row0, int s0, int nblk, int tid) {
    asm volatile("" : "+v"(tid));
    const int c8 = nblk * 128 + (tid & 15) * 8;
    f32x4 w[4][2], bb[2];
#pragma unroll
    for (int j = 0; j < 4; ++j) { w[j][0] = *(const f32x4*)(cw + j * LRUW + c8); w[j][1] = *(const f32x4*)(cw + j * LRUW + c8 + 4); }
    bb[0] = *(const f32x4*)(cbias + c8); bb[1] = *(const f32x4*)(cbias + c8 + 4);
#pragma unroll 2
    for (int p = 0; p < 8; ++p) { const int rl = p * 32 + (tid >> 4), s = s0 + rl; const unsigned grow = (unsigned)(row0 + rl);
        f32x4 a0 = bb[0], a1 = bb[1];
#pragma unroll
        for (int j = 0; j < 4; ++j) { if (s - 3 + j >= 0) { const v4u uw = *(const v4u*)((const char*)U + ((grow - 3 + j) * LRUW + c8) * 2u);
            a0 += w[j][0] * (f32x4){bflo(uw.x), bfhi(uw.x), bflo(uw.y), bfhi(uw.y)}; a1 += w[j][1] * (f32x4){bflo(uw.z), bfhi(uw.z), bflo(uw.w), bfhi(uw.w)}; } }
        v4u o; o.x = pk2(a0.x, a0.y); o.y = pk2(a0.z, a0.w); o.z = pk2(a1.x, a1.y); o.w = pk2(a1.z, a1.w);
        *(v4u*)((char*)UC + (grow * LRUW + c8) * 2u) = o; }
}

__global__ void __launch_bounds__(NTHR, LB2) hymba_fwd(Args a) {
    extern __shared__ __attribute__((aligned(16))) unsigned char lds_raw[];
    cg::grid_group grid = cg::this_grid();
    LAS unsigned char* lds = (LAS unsigned char*)lds_raw;
    { const int t0 = threadIdx.x; if ((t0 & 63) == 0) *(volatile LAS int*)(lds + WTAB_OFF + hw_slot() * 4) = t0 >> 6;
      if (t0 < 2) *(volatile LAS unsigned*)(lds + XBST_OFF + t0 * 4) = 0u; }
    __syncthreads();
    const XcdBarrier xbar = xcd_barrier_post((unsigned*)a.ws, (volatile LAS unsigned*)(lds + XBST_OFF));
    const int G = gridDim.x, c = blockIdx.x;
#define WIN ((bf16*)(a.ws + WS_WIN))
#define WOUT ((bf16*)(a.ws + WS_WOUT))
#define WCQ ((bf16*)(a.ws + WS_WCQ))
#define WCKV ((bf16*)(a.ws + WS_WCKV))
#define WCO ((bf16*)(a.ws + WS_WCO))
#define WGU ((bf16*)(a.ws + WS_WGU))
#define WDN ((bf16*)(a.ws + WS_WDN))
#define WLRU ((bf16*)(a.ws + WS_WLRU))
#define XN ((bf16*)(a.ws + WS_XN))
#define MN ((bf16*)(a.ws + WS_MN))
#define Qh ((bf16*)(a.ws + WS_Q))
#define Kh ((bf16*)(a.ws + WS_K))
#define Vh ((bf16*)(a.ws + WS_V))
#define U ((bf16*)(a.ws + WS_U))
#define GG ((bf16*)(a.ws + WS_GG))
#define UC ((bf16*)(a.ws + WS_UC))
#define LF ((float*)(a.ws + WS_LF))
#define CK ((bf16*)(a.ws + WS_CK))
#define CV ((bf16*)(a.ws + WS_CV))
#define MIX ((bf16*)(a.ws + WS_MIX))
#define SSQF ((float*)(a.ws + WS_SSQF))
#define SSQL ((float*)(a.ws + WS_SSQL))
#define X1 ((float*)(a.ws + WS_X1))
#define X1B ((bf16*)(a.ws + WS_X1B))
#define SSQ1 ((float*)(a.ws + WS_SSQ1))
#define CQ ((bf16*)(a.ws + WS_CQ))
#define OX ((bf16*)(a.ws + WS_OX))
#define X2B ((bf16*)(a.ws + WS_X2B))
#define SSQ2 ((float*)(a.ws + WS_SSQ2))
#define H ((bf16*)(a.ws + WS_H))
#define HL ((bf16*)(a.ws + WS_HL))
#define AC ((bf16*)(a.ws + WS_AC))
#define ENDH ((float*)(a.ws + WS_ENDH))
#define ENDA ((float*)(a.ws + WS_ENDA))
#define red ((PG8_LAS float*)(lds + RED_OFF))

    for (int rep = 0; rep < 1 + ((REP >> 0) & 1); ++rep) {
    if (PH & 1) { int tid = my_tid(); p0_prologue(a, lds, __builtin_amdgcn_readfirstlane(tid >> 6), tid & 63, G); }
    GSYNC();
    if (a.ws == nullptr) grid.sync();
    }

    for (int rep = 0; rep < 1 + ((REP >> 1) & 1); ++rep) {
    if (PH & 2) {
        pg8::Gemm g{XN, WIN, M, INWP, DM, DM, DM}; pg8::StaticOrder S; S.init(M, INWP, G, c);
        pg8::EpiIn E{0, Qh, Kh, Vh, U, GG, LF, a.in[I_GQ], a.in[I_GK], a.in[I_BF], red};
        pg8::gemm_phase<pg8::EpiIn, pg8::StaticOrder, true, true>(lds, g, S, E);
        pg8::Gemm g2{MN, WCKV, MMEM, 2 * XW, DM, DM, DM}; pg8::StaticOrder S2; S2.init(MMEM, 2 * XW, G, (c + 16) % G);
        pg8::EpiCkv E2{0, CK, CV, a.in[I_GCK], red};
        pg8::gemm_phase<pg8::EpiCkv, pg8::StaticOrder, true, true>(lds, g2, S2, E2);
        if (G == 256 && c >= 160 && c < 240) { const int t2 = my_tid(); late_range(a, lds, 0, N_LATE_P1, (c - 160) * NWAVES + (t2 >> 6), 80 * NWAVES, __builtin_amdgcn_readfirstlane(t2 >> 6), t2 & 63); }
    }
    GSYNC();
    }

    for (int rep = 0; rep < 1 + ((REP >> 2) & 1); ++rep) {
    if (PH & 4) { int cF = c, tid = my_tid(); asm volatile("" : "+s"(cF)); const int lane = tid & 63, wave = __builtin_amdgcn_readfirstlane(tid >> 6);
      for (int L = cF; L < 256; L += G) {
        {
#if !defined(NO_FOX)
            const int bh = L >> 3, x = L & 7, b = bh >> 3, h = bh & 7;
            const int tid = my_tid();
            LAS float* cbl = (LAS float*)(lds + CB_OFF); LAS float* wsum = (LAS float*)(lds + WSUM_OFF);
            { const float* lf = LF + ((size_t)b * SEQ + tid * 4) * 8 + h;
              const float v0 = lf[0], v1 = lf[8], v2 = lf[16], v3 = lf[24]; const float t0 = v0, t1 = t0 + v1, t2 = t1 + v2, t3 = t2 + v3;
              wsum[tid] = t3; __syncthreads();
              for (int o = 1; o < 512; o <<= 1) { const float v = wsum[tid] + (tid >= o ? wsum[tid - o] : 0.f); __syncthreads(); wsum[tid] = v; __syncthreads(); }
              const float off = wsum[tid] - t3;
              const float ns = -1.0f / att::SCALE;
              *(LAS f32x4*)(cbl + tid * 4) = (f32x4){(off + t0) * ns, (off + t1) * ns, (off + t2) * ns, (off + t3) * ns};
              __syncthreads(); }
            typedef att::BlockRef<att::bf16, att::bf16> BR;
            BR cur, nxt;
            { const size_t hrow = (size_t)bh * SEQ;
              cur.Q = (const att::bf16*)Qh + (hrow + x * 256) * 128; cur.K = (const att::bf16*)Kh + hrow * 128; cur.V = (const att::bf16*)Vh + hrow * 128;
              cur.O = (att::bf16*)MIX + ((size_t)b * SEQ + x * 256) * 2048 + h * 128; cur.SS = FOX_SS; cur.P0 = x * 256;
              nxt = cur; }
            att::Seam<att::bf16> S;
            att::causal_swa_prime<att::bf16, att::bf16>(cur, 1 << 20, (char*)lds_raw, S);
            att::causal_swa_block<att::bf16, att::bf16, 2048, FOX_HAS_SS>(cur, nxt, SEQ, 1 << 20, (char*)lds_raw, S, FOX_CB);
            VM_WAIT(); __syncthreads(); __builtin_amdgcn_fence(__ATOMIC_ACQUIRE, "agent");
            const int tq = my_tid();
            for (int p = 0; p < 8; ++p) { const int qb = x, rl = p * 32 + (tq >> 4); const size_t trow = (size_t)b * SEQ + qb * 256 + rl;
                const v4u w = *(const v4u*)(MIX + trow * 2048 + h * 128 + (tq & 15) * 8);
                float ss = (bflo(w.x) * bflo(w.x) + bfhi(w.x) * bfhi(w.x)) + (bflo(w.y) * bflo(w.y) + bfhi(w.y) * bfhi(w.y)) + (bflo(w.z) * bflo(w.z) + bfhi(w.z) * bfhi(w.z)) + (bflo(w.w) * bflo(w.w) + bfhi(w.w) * bfhi(w.w));
                ss += shx<1>(ss); ss += shx<2>(ss); ss += shx<4>(ss); ss += shx<8>(ss);
                if ((tq & 15) == 0) SSQF[trow * 8 + h] = ss; }
            VM_WAIT(); __syncthreads();
#endif
        }
    } }
    if (PH & 4) { int cL = c, tid = my_tid(); asm volatile("" : "+s"(cL));
      const bool fast = (G == 256); const int xw = cL & 7;
      const int k0 = xw == 0 ? 0 : xw == 1 ? 3 : xw == 2 ? 5 : xw == 3 ? 7 : 8, k1 = xw == 0 ? 3 : xw == 1 ? 5 : xw == 2 ? 7 : 8;
      const int lfirst = fast ? (cL >> 3) * 8 + k0 : cL, lend = fast ? (cL >> 3) * 8 + k1 : 256, lstep = fast ? 1 : G;
      const bool in_lru = !fast || xw <= 3; const unsigned need = fast ? 128u : (unsigned)G;
      for (int L = lfirst; L < lend; L += lstep) {
            const int pm = L >> 3, nblk = L & 7, row0 = pm * 256;
            conv_chunk(U, UC, a.in[I_CONVW], a.in[I_CONVB], row0, (pm & 7) * 256, nblk, tid);
            VM_WAIT(); __syncthreads(); __builtin_amdgcn_fence(__ATOMIC_ACQUIRE, "agent");
            pg8::Gemm g{UC + (size_t)row0 * LRUW + nblk * 128, WLRU + (size_t)nblk * 256 * 128, 256, 256, 128, LRUW, 128}; pg8::OneUnit S;
            pg8::EpiLru E{0, UC, HL, AC, ENDH + pm * 1024, ENDA + pm * 1024, a.in[I_BRA], a.in[I_BRI], a.in[I_LAM], row0, nblk};
            pg8::gemm_phase<pg8::EpiLru, pg8::OneUnit, false, true>(lds, g, S, E);
      }
      if (in_lru) {
        VM_WAIT(); __syncthreads();
        if (my_tid() == 0) { unsigned* cnt = (unsigned*)(a.ws + 15360);
            __builtin_amdgcn_fence(__ATOMIC_RELEASE, "agent"); asm volatile("s_waitcnt vmcnt(0)" ::: "memory");
            (void)__hip_atomic_fetch_add(cnt, 1u, __ATOMIC_RELAXED, __HIP_MEMORY_SCOPE_AGENT);
            unsigned sp = 0; while (__hip_atomic_load(cnt, __ATOMIC_RELAXED, __HIP_MEMORY_SCOPE_AGENT) < need && ++sp < (1u << 22)) __builtin_amdgcn_s_sleep(1);
            __builtin_amdgcn_fence(__ATOMIC_ACQUIRE, "agent"); asm volatile("s_waitcnt vmcnt(0)" ::: "memory"); }
        __syncthreads();
    { int tid = my_tid();
      for (int L = lfirst; L < lend; L += lstep) { const int pm = L >> 3, nblk = L & 7, j = pm & 7, c8 = nblk * 128 + (tid & 15) * 8;
        f32x4 hi0 = {0.f, 0.f, 0.f, 0.f}, hi1 = {0.f, 0.f, 0.f, 0.f};
        for (int i = 0; i < j; ++i) { const float* eh = ENDH + (pm - j + i) * 1024 + c8; const float* ea = ENDA + (pm - j + i) * 1024 + c8;
            hi0 = *(const f32x4*)ea * hi0 + *(const f32x4*)eh; hi1 = *(const f32x4*)(ea + 4) * hi1 + *(const f32x4*)(eh + 4); }
#pragma unroll 2
        for (int p = 0; p < 8; ++p) { const unsigned row = (unsigned)(pm * 256 + p * 32 + (tid >> 4)), o = (row * 1024u + c8) * 2u;
            const v4u hw = *(const v4u*)((const char*)HL + o), aw = *(const v4u*)((const char*)AC + o), gw = *(const v4u*)((const char*)GG + o);
            const f32x4 y0 = ((f32x4){bflo(hw.x), bfhi(hw.x), bflo(hw.y), bfhi(hw.y)} + (f32x4){bflo(aw.x), bfhi(aw.x), bflo(aw.y), bfhi(aw.y)} * hi0) * (f32x4){bflo(gw.x), bfhi(gw.x), bflo(gw.y), bfhi(gw.y)};
            const f32x4 y1 = ((f32x4){bflo(hw.z), bfhi(hw.z), bflo(hw.w), bfhi(hw.w)} + (f32x4){bflo(aw.z), bfhi(aw.z), bflo(aw.w), bfhi(aw.w)} * hi1) * (f32x4){bflo(gw.z), bfhi(gw.z), bflo(gw.w), bfhi(gw.w)};
            float ss = (y0.x * y0.x + y0.y * y0.y) + (y0.z * y0.z + y0.w * y0.w) + (y1.x * y1.x + y1.y * y1.y) + (y1.z * y1.z + y1.w * y1.w);
            v4u ow; ow.x = pk2(y0.x, y0.y); ow.y = pk2(y0.z, y0.w); ow.z = pk2(y1.x, y1.y); ow.w = pk2(y1.z, y1.w);
            *(v4u*)((char*)MIX + ((size_t)row * 2048 + 1024 + c8) * 2) = ow;
            ss += shx<1>(ss); ss += shx<2>(ss); ss += shx<4>(ss); ss += shx<8>(ss);
            if ((tid & 15) == 0) SSQL[row * 8 + nblk] = ss; } } }
      }
      if (!fast || xw == 4 || xw == 5) { const int t2 = my_tid(); const int wi = fast ? ((cL >> 3) * 2 + (xw - 4)) : cL, nwi = fast ? 64 : G;
        late_range(a, lds, N_LATE_P1, N_LATE_P2, wi * NWAVES + (t2 >> 6), nwi * NWAVES, __builtin_amdgcn_readfirstlane(t2 >> 6), t2 & 63); } }
    GSYNC();
    }

    for (int rep = 0; rep < 1 + ((REP >> 3) & 1); ++rep) {
    if (PH & 8) {
        pg8::Gemm g{MIX, WOUT, M, DM, DM, DM, DM}; pg8::StaticOrder S; S.init(M, DM, G, c);
        pg8::EpiRes<true> E{16, a.in[I_X], nullptr, nullptr, X1B, SSQ1, SSQF, SSQL};
        pg8::gemm_phase<pg8::EpiRes<true>, pg8::StaticOrder, true, true>(lds, g, S, E);
    }
    GSYNC();
    }

    for (int rep = 0; rep < 1 + ((REP >> 4) & 1); ++rep) {
    if (PH & 16) {
        pg8::Gemm g{X1B, WCQ, M, XW, DM, DM, DM}; pg8::StaticOrder S; S.init(M, XW, G, c);
        pg8::EpiCq E{0, CQ, a.in[I_GCQ], SSQ1, red};
        pg8::gemm_phase<pg8::EpiCq, pg8::StaticOrder, true, true>(lds, g, S, E);
        if (G == 256 && c >= 64) { const int t2 = my_tid(); late_range(a, lds, N_LATE_P2, N_LATE, (c - 64) * NWAVES + (t2 >> 6), 192 * NWAVES, __builtin_amdgcn_readfirstlane(t2 >> 6), t2 & 63); }
    }
    GSYNC();
    }

    for (int rep = 0; rep < 1 + ((REP >> 5) & 1); ++rep) {
    if (PH & 32) for (int L = c; L < 128; L += G) {
        const int bh = L >> 3, qb = L & 7, b = bh >> 2, h = bh & 3;
        att::BlockRef<att::bf16, att::bf16> r;
        r.Q = (const att::bf16*)CQ + ((size_t)bh * SEQ + qb * 256) * 128; r.K = (const att::bf16*)CK + (size_t)bh * NMEM * 128; r.V = (const att::bf16*)CV + (size_t)bh * NMEM * 128;
        r.O = (att::bf16*)OX + ((size_t)b * SEQ + qb * 256) * XW + h * 128; r.SS = nullptr; r.P0 = 1 << 16;
        att::Seam<att::bf16> S;
        att::causal_swa_prime<att::bf16, att::bf16>(r, 1 << 20, (char*)lds_raw, S);
        att::causal_swa_block<att::bf16, att::bf16, XW, false>(r, r, NMEM, 1 << 20, (char*)lds_raw, S, -1);
        VM_WAIT(); __syncthreads();
    }
    GSYNC();
    }

    for (int rep = 0; rep < 1 + ((REP >> 6) & 1); ++rep) {
    if (PH & 64) {
        pg8::Gemm g{OX, WCO, M, DM, XW, XW, XW}; pg8::StaticOrder S; S.init(M, DM, G, c);
        pg8::EpiRes<false> E{0, nullptr, X1B, nullptr, X2B, SSQ2, nullptr, nullptr};
        pg8::gemm_phase<pg8::EpiRes<false>, pg8::StaticOrder, true, true>(lds, g, S, E);
    }
    GSYNC();
    }

    for (int rep = 0; rep < 1 + ((REP >> 7) & 1); ++rep) {
    if (PH & 128) {
        pg8::Gemm g{X2B, WGU, M, 2 * FFN, DM, DM, DM}; pg8::StaticOrder S; S.init(M, 2 * FFN, G, c);
        pg8::EpiGu E{0, H, SSQ2, red};
        pg8::gemm_phase<pg8::EpiGu, pg8::StaticOrder, true, true>(lds, g, S, E);
    }
    GSYNC();
    }

    if (PH & 256) {
        pg8::Gemm g{H, WDN, M, DM, FFN, FFN, FFN}; pg8::StaticOrder S; S.init(M, DM, G, c);
        pg8::EpiRes<false> E{0, nullptr, X2B, a.out, nullptr, nullptr, nullptr, nullptr};
        pg8::gemm_phase<pg8::EpiRes<false>, pg8::StaticOrder, true, true>(lds, g, S, E);
    }
}

#undef WIN
#undef WOUT
#undef WCQ
#undef WCKV
#undef WCO
#undef WGU
#undef WDN
#undef WLRU
#undef XN
#undef MN
#undef Qh
#undef Kh
#undef Vh
#undef U
#undef GG
#undef UC
#undef LF
#undef CK
#undef CV
#undef MIX
#undef SSQF
#undef SSQL
#undef X1
#undef X1B
#undef SSQ1
#undef CQ
#undef OX
#undef X2B
#undef SSQ2
#undef H
#undef HL
#undef AC
#undef ENDH
#undef ENDA
#undef red
extern "C" void kernel_launch(void* const* d_in, const int* in_sizes, int n_in, void* d_out, int out_size, void* d_ws, size_t ws_size, hipStream_t stream) {
    static int grid = 0;
    if (grid == 0) {
        if (n_in != 27 || in_sizes[0] != M * DM || out_size != M * DM || ws_size < WS_END) { fprintf(stderr, "kernel_launch: unexpected shapes (n_in %d, in0 %d, out %d, ws %zu)\n", n_in, n_in > 0 ? in_sizes[0] : -1, out_size, ws_size); grid = -1; return; }
        int dev = 0, cus = 0, per_cu = 0;
        (void)hipGetDevice(&dev); (void)hipDeviceGetAttribute(&cus, hipDeviceAttributeMultiprocessorCount, dev);
        if (hipFuncSetAttribute((const void*)hymba_fwd, hipFuncAttributeMaxDynamicSharedMemorySize, LDS_BYTES) != hipSuccess) { fprintf(stderr, "kernel_launch: hipFuncSetAttribute failed\n"); grid = -1; return; }
        if (hipOccupancyMaxActiveBlocksPerMultiprocessor(&per_cu, (const void*)hymba_fwd, NTHR, LDS_BYTES) != hipSuccess || per_cu < 1) { fprintf(stderr, "kernel_launch: occupancy query says %d\n", per_cu); per_cu = 1; }
        (void)hipGetLastError();
        grid = cus * per_cu;
    }
    if (grid < 0) return;
    Args a{};
    for (int i = 0; i < 27; ++i) a.in[i] = (const float*)d_in[i];
    a.out = (float*)d_out; a.ws = (unsigned char*)d_ws;
    if (hipMemsetAsync(d_ws, 0, 16384, stream) != hipSuccess) { fprintf(stderr, "kernel_launch: memset of the barrier words failed\n"); return; }
    void* args[] = {&a};
    hipError_t e = hipLaunchCooperativeKernel((const void*)hymba_fwd, dim3(grid), dim3(NTHR), args, LDS_BYTES, stream);
    if (e != hipSuccess) fprintf(stderr, "cooperative launch failed: %s (grid %d)\n", hipGetErrorString(e), grid);
}
```

```cpp
#include <hip/hip_runtime.h>
#include <hip/hip_bf16.h>
#include <hip/hip_cooperative_groups.h>
#include <cstdio>
#include <cstdint>
namespace cg = cooperative_groups;


template <int K> __device__ __forceinline__ float shx(float v) { static_assert(K < 32, "use sum32"); return __int_as_float(__builtin_amdgcn_ds_swizzle(__float_as_int(v), (K << 10) | 0x1f)); }
__device__ __forceinline__ float sum32(float v) { auto rr = __builtin_amdgcn_permlane32_swap(__float_as_uint(v), __float_as_uint(v), false, false); return __uint_as_float(rr[0]) + __uint_as_float(rr[1]); }
constexpr int WTAB_OFF = 147456 - 256, XBST_OFF = 147456 - 512;
__device__ __forceinline__ int hw_slot() { return (int)(__builtin_amdgcn_s_getreg((5 << 11) | 4) & 63u); }
__device__ __forceinline__ int my_tid() {
    const int slot = hw_slot();
    const int wave = __builtin_amdgcn_readfirstlane(*(volatile __attribute__((address_space(3))) int*)(unsigned)(WTAB_OFF + slot * 4));
    int l; asm volatile("v_mbcnt_lo_u32_b32 %0, -1, 0\n\tv_mbcnt_hi_u32_b32 %0, -1, %0" : "=v"(l));
    return wave * 64 + l;
}
namespace pg8 {
#define PG8_LAS __attribute__((address_space(3)))
typedef unsigned short bf16_t;
typedef short bf16x8 __attribute__((ext_vector_type(8)));
typedef float f32x4 __attribute__((ext_vector_type(4)));
typedef unsigned u32x4 __attribute__((ext_vector_type(4)));
constexpr int BM = 256, BK = 64, HALF = 128, HTB = HALF * BK * 2  , STAGE_BYTES = 8 * HTB, NXCD = 8, WGM = 8;

__host__ __device__ __forceinline__ int lds_byte(int r, int c) { const int st = (r >> 4) * 2 + (c >> 5), rr = r & 15, cc = c & 31, ob = rr * 64 + cc * 2; return st * 1024 + (ob ^ (((ob >> 9) & 1) << 5)); }
__host__ __device__ __forceinline__ void stage_rc(int b, int& R, int& C) { const int st = b / 1024, sb = b % 1024, swz = sb ^ (((sb >> 9) & 1) << 5); R = (st >> 1) * 16 + swz / 64; C = (st & 1) * 32 + (swz % 64) / 2; }
__host__ __device__ __forceinline__ int perm32(int rho) { const int n = rho >> 4, i = rho & 15; return 8 * (i >> 2) + 4 * n + (i & 3); }

struct Unit { int pm, pn; };
struct Gemm { const bf16_t* A; const bf16_t* Bt; int M, N, K, lda, ldb; };

struct StaticOrder {
    int nM, nN, nwg, G, c;
    __host__ __device__ void init(int M, int N, int G_, int c_) { nM = M / BM; nN = N / BM; nwg = nM * nN; G = G_; c = c_; }
    __host__ __device__ bool next(int i, Unit& u) const {
        const long L = (long)i * G + c; if (L >= nwg) return false;
        int wgid = (int)L; { const int q = nwg / NXCD, r = nwg % NXCD, xcd = wgid % NXCD, off = wgid / NXCD; wgid = (xcd < r ? xcd * (q + 1) : r * (q + 1) + (xcd - r) * q) + off; }
        const int nig = WGM * nN, gid = wgid / nig, fm = gid * WGM, gsz = (nM - fm) < WGM ? (nM - fm) : WGM;
        u.pm = fm + ((wgid % nig) % gsz); u.pn = (wgid % nig) / gsz; return true;
    }
    __device__ __forceinline__ void a_ready(const Unit&) const {}
    __device__ __forceinline__ void done(const Unit&) const {}
};

__device__ __forceinline__ unsigned cvt_pk_bf16(float lo, float hi) { unsigned r; asm volatile("v_cvt_pk_bf16_f32 %0, %1, %2" : "=v"(r) : "v"(lo), "v"(hi)); return r; }

typedef float f32x2 __attribute__((ext_vector_type(2)));
constexpr float RMS_EPS = 1e-6f;
struct OneUnit {
    __device__ __forceinline__ bool next(int i, Unit& u) const { if (i != 0) return false; u.pm = 0; u.pn = 0; return true; }
    __device__ __forceinline__ void a_ready(const Unit&) const {}
    __device__ __forceinline__ void done(const Unit&) const {}
};
struct OffsetOrder {
    StaticOrder S;
    __device__ __forceinline__ bool next(int i, Unit& u) const { return S.next(i, u); }
    __device__ __forceinline__ void a_ready(const Unit&) const {}
    __device__ __forceinline__ void done(const Unit&) const {}
};
__device__ __forceinline__ float fast_log1p(float x) { const float sr = x * (1.0f - x * (0.5f - x * (0.33333334f - x * (0.25f - x * (0.2f - x * 0.16666667f))))); return x < 0.0625f ? sr : __logf(1.0f + x); }
__device__ __forceinline__ float sigmoidf_(float x) { return __builtin_amdgcn_rcpf(1.0f + __expf(-x)); }
__device__ __forceinline__ float gelu_tanh(float x) { const float u = 0.7978845608028654f * (x + 0.044715f * x * x * x); return x * sigmoidf_(2.0f * u); }
__device__ __forceinline__ float sum_f(const float* p, int n4) { float s = 0.f; for (int i = 0; i < n4; ++i) { const f32x4 v = *(const f32x4*)(p + 4 * i); s += (v[0] + v[1]) + (v[2] + v[3]); } return s; }
__device__ __forceinline__ u32x4 pack8(const f32x4& a, const f32x4& b) { u32x4 w; w.x = cvt_pk_bf16(a[0], a[1]); w.y = cvt_pk_bf16(a[2], a[3]); w.z = cvt_pk_bf16(b[0], b[1]); w.w = cvt_pk_bf16(b[2], b[3]); return w; }

template <int ACT  >
__device__ __forceinline__ void store_tile(const f32x4 (&acc)[2][2][4][2], bf16_t* d0, bf16_t* d1, size_t ld, int wr, int wc, int fr, int fq) {
#pragma unroll
    for (int ai = 0; ai < 2; ++ai)
#pragma unroll
        for (int m = 0; m < 4; ++m) { const size_t ro = (size_t)(ai * HALF + wr * 64 + m * 16 + fr) * ld + wc * 32 + fq * 8;
#pragma unroll
            for (int bj = 0; bj < 2; ++bj) { f32x4 v0 = acc[ai][bj][m][0], v1 = acc[ai][bj][m][1];
                if (ACT == 1) {
#pragma unroll
                    for (int j = 0; j < 4; ++j) { v0[j] = gelu_tanh(v0[j]); v1[j] = gelu_tanh(v1[j]); } }
                *(u32x4*)((bj ? d1 : d0) + ro) = pack8(v0, v1); } }
}
template <bool ROWSCALE>
__device__ __forceinline__ void head_norm_store(const f32x4 (&acc)[2][2][4][2], const float (&rs)[2][4], const float* gain, bf16_t* d0, bf16_t* d1, PG8_LAS float* red, int wr, int wc, int fr, int fq) {
#pragma unroll
    for (int ai = 0; ai < 2; ++ai)
#pragma unroll
        for (int m = 0; m < 4; ++m)
#pragma unroll
            for (int bj = 0; bj < 2; ++bj) { float s = 0.f;
#pragma unroll
                for (int n = 0; n < 2; ++n) { f32x4 v = acc[ai][bj][m][n]; if (ROWSCALE) v = v * rs[ai][m]; s += (v[0] * v[0] + v[1] * v[1]) + (v[2] * v[2] + v[3] * v[3]); }
                s += shx<16>(s); s = sum32(s);
                if (fq == 0) red[((ai * HALF + wr * 64 + m * 16 + fr) * 2 + bj) * 4 + wc] = s; }
    asm volatile("s_waitcnt lgkmcnt(0)" ::: "memory"); __builtin_amdgcn_s_barrier(); asm volatile("" ::: "memory");
    const f32x4 g0 = *(const f32x4*)(gain + wc * 32 + fq * 8), g1 = *(const f32x4*)(gain + wc * 32 + fq * 8 + 4);
#pragma unroll
    for (int ai = 0; ai < 2; ++ai)
#pragma unroll
        for (int m = 0; m < 4; ++m) { const int rl = ai * HALF + wr * 64 + m * 16 + fr;
#pragma unroll
            for (int bj = 0; bj < 2; ++bj) { const PG8_LAS float* rp = red + (rl * 2 + bj) * 4;
                const float ss = (rp[0] + rp[1]) + (rp[2] + rp[3]);
                float sc = __builtin_amdgcn_rsqf(ss * (1.0f / 128.0f) + RMS_EPS); if (ROWSCALE) sc *= rs[ai][m];
                const f32x4 v0 = acc[ai][bj][m][0] * sc * g0, v1 = acc[ai][bj][m][1] * sc * g1;
                *(u32x4*)((bj ? d1 : d0) + (size_t)rl * 128 + wc * 32 + fq * 8) = pack8(v0, v1); } }
}

struct EpiIn {
    static constexpr bool PERM = true, AFTER_DRAIN = false, HAS_MID = false; int mid_t;
    bf16_t *Q, *Kh, *V, *U, *GG; float* LF; const float *g_q, *g_k, *b_f; PG8_LAS float* red;
    __device__ __forceinline__ void operator()(const f32x4 (&acc)[2][2][4][2], const Unit& u, int wr, int wc, int fr, int fq) const {
        asm volatile("" : "+v"(fr), "+v"(fq));
        const int pn = u.pn, row0 = u.pm * BM, b = row0 >> 11, s0 = row0 & 2047;
        if (pn < 12) {
            const int h0 = (pn & 3) * 2; bf16_t* const q_ = Q; bf16_t* const k_ = Kh; bf16_t* const v_ = V; const float* const gq_ = g_q; const float* const gk_ = g_k;
            bf16_t* base = pn < 4 ? q_ : (pn < 8 ? k_ : v_);
            bf16_t* d0 = base + ((size_t)(b * 8 + h0) * 2048 + s0) * 128; bf16_t* d1 = d0 + (size_t)2048 * 128;
            if (pn < 8) { float rs[2][4]; head_norm_store<false>(acc, rs, pn < 4 ? gq_ : gk_, d0, d1, red, wr, wc, fr, fq); }
            else store_tile<0>(acc, d0, d1, 128, wr, wc, fr, fq);
        } else if (pn < 16) { bf16_t* const u_ = U; bf16_t* d0 = u_ + (size_t)row0 * 1024 + (pn - 12) * 256; store_tile<0>(acc, d0, d0 + 128, 1024, wr, wc, fr, fq); }
        else if (pn < 20) { bf16_t* const g_ = GG; bf16_t* d0 = g_ + (size_t)row0 * 1024 + (pn - 16) * 256; store_tile<1>(acc, d0, d0 + 128, 1024, wr, wc, fr, fq); }
        else if (wc == 0 && fq == 0) {
            const f32x4 b0 = *(const f32x4*)b_f, b1 = *(const f32x4*)(b_f + 4);
#pragma unroll
            for (int ai = 0; ai < 2; ++ai)
#pragma unroll
                for (int m = 0; m < 4; ++m) { const int row = row0 + ai * HALF + wr * 64 + m * 16 + fr; f32x4 z0 = acc[ai][0][m][0] + b0, z1 = acc[ai][0][m][1] + b1;
#pragma unroll
                    for (int j = 0; j < 4; ++j) { z0[j] = fminf(z0[j], 0.f) - fast_log1p(__expf(-fabsf(z0[j]))); z1[j] = fminf(z1[j], 0.f) - fast_log1p(__expf(-fabsf(z1[j]))); }
                    *(f32x4*)(LF + (size_t)row * 8) = z0; *(f32x4*)(LF + (size_t)row * 8 + 4) = z1; }
        }
    }
};
struct EpiCkv {
    static constexpr bool PERM = true, AFTER_DRAIN = false, HAS_MID = false; int mid_t;
    bf16_t *CK, *CV; const float* g_ck; PG8_LAS float* red;
    __device__ __forceinline__ void operator()(const f32x4 (&acc)[2][2][4][2], const Unit& u, int wr, int wc, int fr, int fq) const {
        asm volatile("" : "+v"(fr), "+v"(fq));
        const int pn = u.pn, b = u.pm, h0 = (pn & 1) * 2;
        bf16_t* const ck_ = CK; bf16_t* const cv_ = CV; bf16_t* d0 = (pn < 2 ? ck_ : cv_) + ((size_t)(b * 4 + h0) * 256) * 128; bf16_t* d1 = d0 + (size_t)256 * 128;
        if (pn < 2) { float rs[2][4]; head_norm_store<false>(acc, rs, g_ck, d0, d1, red, wr, wc, fr, fq); }
        else store_tile<0>(acc, d0, d1, 128, wr, wc, fr, fq);
    }
};
struct EpiCq {
    static constexpr bool PERM = true, AFTER_DRAIN = false, HAS_MID = false; int mid_t;
    bf16_t* CQ; const float* g_cq; const float* SSQ; PG8_LAS float* red;
    __device__ __forceinline__ void operator()(const f32x4 (&acc)[2][2][4][2], const Unit& u, int wr, int wc, int fr, int fq) const {
        asm volatile("" : "+v"(fr), "+v"(fq));
        const int pn = u.pn, row0 = u.pm * BM, b = row0 >> 11, s0 = row0 & 2047, h0 = pn * 2, tid = (wr * 4 + wc) * 64 + fq * 16 + fr;
        PG8_LAS float* tab = red + 2048;
        if (tid < 256) tab[tid] = __builtin_amdgcn_rsqf(sum_f(SSQ + (size_t)(row0 + tid) * 32, 8) * (1.0f / 2048.0f) + RMS_EPS);
        asm volatile("s_waitcnt lgkmcnt(0)" ::: "memory"); __builtin_amdgcn_s_barrier(); asm volatile("" ::: "memory");
        float rs[2][4];
#pragma unroll
        for (int ai = 0; ai < 2; ++ai)
#pragma unroll
            for (int m = 0; m < 4; ++m) rs[ai][m] = tab[ai * HALF + wr * 64 + m * 16 + fr];
        bf16_t* d0 = CQ + ((size_t)(b * 4 + h0) * 2048 + s0) * 128; bf16_t* d1 = d0 + (size_t)2048 * 128;
        head_norm_store<true>(acc, rs, g_cq, d0, d1, red, wr, wc, fr, fq);
    }
};
template <bool MID> struct EpiRes {
    static constexpr bool PERM = true, AFTER_DRAIN = false, HAS_MID = MID; int mid_t;
    const float* resid; const bf16_t* residb; float* outf; bf16_t* outb; float* ssq_out; const float *ssqf, *ssql;
    __device__ __forceinline__ void mid(f32x4 (&acc)[2][2][4][2], const Unit& u, int wr, int wc, int fr, int fq) const {
        asm volatile("" : "+v"(fr), "+v"(fq));
#pragma unroll
        for (int ai = 0; ai < 2; ++ai)
#pragma unroll
            for (int m = 0; m < 4; ++m) { const size_t row = (size_t)u.pm * BM + ai * HALF + wr * 64 + m * 16 + fr;
                const float rf = __builtin_amdgcn_rsqf(sum_f(ssqf + row * 8, 2) * (1.0f / 1024.0f) + RMS_EPS), rl = __builtin_amdgcn_rsqf(sum_f(ssql + row * 8, 2) * (1.0f / 1024.0f) + RMS_EPS);
                const float ratio = rf / rl;
#pragma unroll
                for (int bj = 0; bj < 2; ++bj)
#pragma unroll
                    for (int n = 0; n < 2; ++n) acc[ai][bj][m][n] = acc[ai][bj][m][n] * ratio;
                __builtin_amdgcn_sched_barrier(0); }
    }
    __device__ __forceinline__ void operator()(const f32x4 (&acc)[2][2][4][2], const Unit& u, int wr, int wc, int fr, int fq) const {
        asm volatile("" : "+v"(fr), "+v"(fq));
#pragma unroll
        for (int ai = 0; ai < 2; ++ai)
#pragma unroll
            for (int m = 0; m < 4; ++m) { const size_t row = (size_t)u.pm * BM + ai * HALF + wr * 64 + m * 16 + fr;
                float sc = 1.f; if (MID) sc = __builtin_amdgcn_rsqf(sum_f(ssql + row * 8, 2) * (1.0f / 1024.0f) + RMS_EPS);
                float ss = 0.f;
#pragma unroll
                for (int bj = 0; bj < 2; ++bj) { const size_t o = row * 2048 + u.pn * BM + bj * HALF + wc * 32 + fq * 8;
                    f32x4 r0, r1;
                    if (residb) { const u32x4 w = *(const u32x4*)(residb + o); r0 = (f32x4){__uint_as_float(w.x << 16), __uint_as_float(w.x & 0xffff0000u), __uint_as_float(w.y << 16), __uint_as_float(w.y & 0xffff0000u)};
                                  r1 = (f32x4){__uint_as_float(w.z << 16), __uint_as_float(w.z & 0xffff0000u), __uint_as_float(w.w << 16), __uint_as_float(w.w & 0xffff0000u)}; }
                    else { r0 = *(const f32x4*)(resid + o); r1 = *(const f32x4*)(resid + o + 4); }
                    const f32x4 v0 = r0 + acc[ai][bj][m][0] * sc, v1 = r1 + acc[ai][bj][m][1] * sc;
                    if (outf) { *(f32x4*)(outf + o) = v0; *(f32x4*)(outf + o + 4) = v1; }
                    ss += (v0[0] * v0[0] + v0[1] * v0[1]) + (v0[2] * v0[2] + v0[3] * v0[3]) + (v1[0] * v1[0] + v1[1] * v1[1]) + (v1[2] * v1[2] + v1[3] * v1[3]);
                    if (outb) *(u32x4*)(outb + o) = pack8(v0, v1); }
                if (ssq_out) { ss += shx<16>(ss); ss = sum32(ss); if (fq == 0) ssq_out[row * 32 + u.pn * 4 + wc] = ss; }
                __builtin_amdgcn_sched_barrier(0); }
    }
};
struct EpiGu {
    static constexpr bool PERM = true, AFTER_DRAIN = false, HAS_MID = false; int mid_t;
    bf16_t* H; const float* SSQ; PG8_LAS float* red;
    __device__ __forceinline__ void operator()(const f32x4 (&acc)[2][2][4][2], const Unit& u, int wr, int wc, int fr, int fq) const {
        asm volatile("" : "+v"(fr), "+v"(fq));
        const int tid = (wr * 4 + wc) * 64 + fq * 16 + fr; PG8_LAS float* tab = red + 2048;
        if (tid < 256) tab[tid] = __builtin_amdgcn_rsqf(sum_f(SSQ + ((size_t)u.pm * BM + tid) * 32, 8) * (1.0f / 2048.0f) + RMS_EPS);
        asm volatile("s_waitcnt lgkmcnt(0)" ::: "memory"); __builtin_amdgcn_s_barrier(); asm volatile("" ::: "memory");
#pragma unroll
        for (int ai = 0; ai < 2; ++ai)
#pragma unroll
            for (int m = 0; m < 4; ++m) { const size_t row = (size_t)u.pm * BM + ai * HALF + wr * 64 + m * 16 + fr;
                const float rs = tab[ai * HALF + wr * 64 + m * 16 + fr];
                f32x4 h[2];
#pragma unroll
                for (int n = 0; n < 2; ++n) { const f32x4 g = acc[ai][0][m][n] * rs, up = acc[ai][1][m][n] * rs;
#pragma unroll
                    for (int j = 0; j < 4; ++j) h[n][j] = g[j] * sigmoidf_(g[j]) * up[j]; }
                *(u32x4*)(H + row * 5632 + u.pn * HALF + wc * 32 + fq * 8) = pack8(h[0], h[1]); }
    }
};
struct EpiLru {
    static constexpr bool PERM = true, AFTER_DRAIN = true, HAS_MID = false; int mid_t;
    const bf16_t* UC; bf16_t* HL; bf16_t* AC; float* ENDH; float* ENDA; const float *b_ra, *b_ri, *lam; int row0, nblk;
    __device__ __forceinline__ void fused(f32x4 (&acc)[2][2][4][2], const Unit&, int wr, int wc, int fr, int fq, PG8_LAS unsigned char* lds, int wid, int lane) const {
        asm volatile("" : "+v"(fr), "+v"(fq));
        PG8_LAS float* LA = (PG8_LAS float*)lds; PG8_LAS float* LB = LA + 128 * 132;
        const int tid = wid * 64 + lane, ch0 = nblk * 128 + wc * 32 + fq * 8;
        float hc = 0.f, ac = 1.f;
#pragma unroll
        for (int ai = 0; ai < 2; ++ai) {
#pragma unroll
            for (int n = 0; n < 2; ++n) {
                const f32x4 bra = *(const f32x4*)(b_ra + ch0 + 4 * n), bri = *(const f32x4*)(b_ri + ch0 + 4 * n), lm = *(const f32x4*)(lam + ch0 + 4 * n); f32x4 sp;
#pragma unroll
                for (int j = 0; j < 4; ++j) sp[j] = -8.0f * fast_log1p(__expf(-lm[j]));
#pragma unroll
                for (int m = 0; m < 4; ++m) { const int rl = wr * 64 + m * 16 + fr; const unsigned grow = (unsigned)(row0 + ai * HALF + rl);
                    const f32x2 ucw = *(const f32x2*)((const char*)UC + (grow * 1024u + ch0 + 4 * n) * 2u); f32x4 av, bv;
#pragma unroll
                    for (int j = 0; j < 4; ++j) { const unsigned w = __float_as_uint(ucw[j >> 1]); const float uc = __uint_as_float((j & 1) ? (w & 0xffff0000u) : (w << 16));
                        const float r = sigmoidf_(acc[ai][0][m][n][j] + bra[j]), ig = sigmoidf_(acc[ai][1][m][n][j] + bri[j]);
                        const float la = r * sp[j], a_ = __expf(la); av[j] = a_; bv[j] = __builtin_amdgcn_sqrtf(fmaxf(fmaf(-a_, a_, 1.0f), 0.f)) * ig * uc; }
                    *(PG8_LAS f32x4*)(LA + rl * 132 + wc * 32 + fq * 8 + 4 * n) = av; *(PG8_LAS f32x4*)(LB + rl * 132 + wc * 32 + fq * 8 + 4 * n) = bv;
                    __builtin_amdgcn_sched_barrier(0); } }
            asm volatile("s_waitcnt lgkmcnt(0)" ::: "memory"); __builtin_amdgcn_s_barrier(); asm volatile("" ::: "memory");
            if (tid < 128) {
#pragma unroll 8
                for (int rl = 0; rl < 128; ++rl) { const float a_ = LA[rl * 132 + tid]; hc = a_ * hc + LB[rl * 132 + tid]; ac *= a_; LB[rl * 132 + tid] = hc; LA[rl * 132 + tid] = ac; }
                if (ai == 1) { ENDH[nblk * 128 + tid] = hc; ENDA[nblk * 128 + tid] = ac; } }
            asm volatile("s_waitcnt lgkmcnt(0)" ::: "memory"); __builtin_amdgcn_s_barrier(); asm volatile("" ::: "memory");
            const int c8 = (tid & 15) * 8;
#pragma unroll
            for (int p = 0; p < 4; ++p) { const int rl = p * 32 + (tid >> 4); const unsigned o = ((unsigned)(row0 + ai * HALF + rl) * 1024u + nblk * 128 + c8) * 2u;
                const f32x4 h0 = *(const PG8_LAS f32x4*)(LB + rl * 132 + c8), h1 = *(const PG8_LAS f32x4*)(LB + rl * 132 + c8 + 4);
                const f32x4 a0 = *(const PG8_LAS f32x4*)(LA + rl * 132 + c8), a1 = *(const PG8_LAS f32x4*)(LA + rl * 132 + c8 + 4);
                *(u32x4*)((char*)HL + o) = pack8(h0, h1); *(u32x4*)((char*)AC + o) = pack8(a0, a1); }
            asm volatile("s_waitcnt lgkmcnt(0)" ::: "memory"); __builtin_amdgcn_s_barrier(); asm volatile("" ::: "memory");
        }
    }
};
template <class Epi, class Sched, bool ALIGN_EPI = false, bool SP2 = false>
__device__ __forceinline__ void gemm_phase(PG8_LAS unsigned char* lds, const Gemm g, const Sched& S, const Epi& E) {
    int tid_ = my_tid();
    const int tid = tid_, wid = __builtin_amdgcn_readfirstlane(tid >> 6), lane = tid & 63, wr = wid >> 2, wc = wid & 3, fr = lane & 15, fq = lane >> 4;
    const int K = g.K, nt = K / BK;
    unsigned voffA[2], voffB[2];
#pragma unroll
    for (int i = 0; i < 2; ++i) { int R, C; stage_rc(tid * 16 + i * 8192, R, C); const int Rb = Epi::PERM ? ((R & ~31) + perm32(R & 31)) : R;
        voffA[i] = (unsigned)(R * g.lda + C) * 2u; voffB[i] = (unsigned)(Rb * g.ldb + C) * 2u; }
    const size_t kstep = (size_t)(BK * 2);
    const size_t hstepA = (size_t)HALF * g.lda * 2, hstepB = (size_t)HALF * g.ldb * 2;
    const size_t tstepA = 2 * hstepA, tstepB = 2 * hstepB;
    const unsigned ldsw = (unsigned)wid * 1024u;
    const int aoff = lds_byte(wr * 64 + fr, fq * 8), boff = lds_byte(wc * 32 + fr, fq * 8);
#define PG8_SA(b, h) (((b) * 2 + (h)) * HTB)
#define PG8_SB(b, h) ((4 + (b) * 2 + (h)) * HTB)
#define PG8_STAGE(bufoff, gbase, voff) do { _Pragma("unroll") for (int _i = 0; _i < 2; ++_i) \
        __builtin_amdgcn_global_load_lds((const unsigned*)((const char*)(gbase) + (voff)[_i]), (PG8_LAS unsigned*)(lds + (bufoff) + ldsw + _i * 8192), 16, 0, 0); } while (0)
#define PG8_LDA(dst, b, h) do { _Pragma("unroll") for (int m = 0; m < 4; ++m) _Pragma("unroll") for (int k = 0; k < 2; ++k) dst[m][k] = *(const PG8_LAS bf16x8*)(lds + PG8_SA(b, h) + aoff + m * 2048 + k * 1024); } while (0)
#define PG8_LDB(dst, b, h) do { _Pragma("unroll") for (int n = 0; n < 2; ++n) _Pragma("unroll") for (int k = 0; k < 2; ++k) dst[n][k] = *(const PG8_LAS bf16x8*)(lds + PG8_SB(b, h) + boff + n * 2048 + k * 1024); } while (0)
#define PG8_MMA(ai, bj, At, Bt) do { __builtin_amdgcn_s_setprio(1); _Pragma("unroll") for (int m = 0; m < 4; ++m) _Pragma("unroll") for (int n = 0; n < 2; ++n) _Pragma("unroll") for (int k = 0; k < 2; ++k) \
        acc[ai][bj][m][n] = __builtin_amdgcn_mfma_f32_16x16x32_bf16(Bt[n][k], At[m][k], acc[ai][bj][m][n], 0, 0, 0); __builtin_amdgcn_s_setprio(0); } while (0)
#define PG8_WAIT_V(n) asm volatile("s_waitcnt vmcnt(" #n ")" ::: "memory")
#define PG8_WAIT_L(n) asm volatile("s_waitcnt lgkmcnt(" #n ")" ::: "memory")
#define PG8_BAR __builtin_amdgcn_s_barrier()
#define PG8_SCHED __builtin_amdgcn_sched_barrier(0)
    Unit cur, nxt; int ui = 0;
    if (!S.next(0, cur)) return;
    f32x4 acc[2][2][4][2];
#pragma unroll
    for (int a = 0; a < 2; ++a)
#pragma unroll
        for (int b = 0; b < 2; ++b)
#pragma unroll
            for (int m = 0; m < 4; ++m)
#pragma unroll
                for (int n = 0; n < 2; ++n) acc[a][b][m][n] = (f32x4){0.f, 0.f, 0.f, 0.f};
    bf16x8 At[4][2], B0[2][2], B1[2][2];
    const char* cA = (const char*)g.A + (size_t)cur.pm * tstepA; const char* cB = (const char*)g.Bt + (size_t)cur.pn * tstepB;
    S.a_ready(cur);
    if constexpr (SP2) {
        PG8_STAGE(PG8_SB(0, 0), cB, voffB); PG8_STAGE(PG8_SB(0, 1), cB + hstepB, voffB); PG8_STAGE(PG8_SA(0, 0), cA, voffA); PG8_STAGE(PG8_SA(0, 1), cA + hstepA, voffA);
        if (wr == 1) PG8_BAR;
        PG8_WAIT_V(2); PG8_BAR;
        PG8_STAGE(PG8_SB(1, 0), cB + kstep, voffB); PG8_STAGE(PG8_SA(1, 0), cA + kstep, voffA); PG8_STAGE(PG8_SB(1, 1), cB + hstepB + kstep, voffB);
        PG8_WAIT_V(6); PG8_BAR;
    } else {
        PG8_STAGE(PG8_SB(0, 0), cB, voffB); PG8_STAGE(PG8_SA(0, 0), cA, voffA); PG8_STAGE(PG8_SB(0, 1), cB + hstepB, voffB); PG8_STAGE(PG8_SA(0, 1), cA + hstepA, voffA);
        if (wr == 1) PG8_BAR;
        PG8_WAIT_V(4); PG8_BAR;
        PG8_STAGE(PG8_SB(1, 0), cB + kstep, voffB); PG8_STAGE(PG8_SA(1, 0), cA + kstep, voffA); PG8_STAGE(PG8_SB(1, 1), cB + hstepB + kstep, voffB);
        PG8_WAIT_V(6); PG8_BAR;
    }
    for (;;) {
        const bool has_next = S.next(ui + 1, nxt);
        const char* nA = has_next ? (const char*)g.A + (size_t)nxt.pm * tstepA : cA; const char* nB = has_next ? (const char*)g.Bt + (size_t)nxt.pn * tstepB : cB;
        for (int t = 0; t < nt; t += 2) {
            const bool last = (t == nt - 2);
            if constexpr (Epi::HAS_MID) { if (t == E.mid_t) E.mid(acc, cur, wr, wc, fr, fq); }
            const char* a1 = cA + (size_t)(t + 1) * kstep;
            const char* a2 = last ? nA : cA + (size_t)(t + 2) * kstep; const char* b2 = last ? nB : cB + (size_t)(t + 2) * kstep;
            const char* a3 = a2 + kstep; const char* b3 = b2 + kstep;
            if (last && has_next) S.a_ready(nxt);
            if constexpr (SP2) {
            PG8_LDB(B0, 0, 0); PG8_LDB(B1, 0, 1); PG8_SCHED; PG8_LDA(At, 0, 0); PG8_STAGE(PG8_SA(1, 1), a1 + hstepA, voffA);
            PG8_WAIT_V(8); PG8_WAIT_L(0); PG8_BAR; PG8_MMA(0, 0, At, B0); PG8_MMA(0, 1, At, B1); PG8_BAR; PG8_SCHED;
            PG8_LDA(At, 0, 1); PG8_STAGE(PG8_SB(0, 0), b2, voffB); PG8_STAGE(PG8_SB(0, 1), b2 + hstepB, voffB); PG8_STAGE(PG8_SA(0, 0), a2, voffA);
            PG8_WAIT_V(8); PG8_WAIT_L(0); PG8_BAR; PG8_MMA(1, 0, At, B0); PG8_MMA(1, 1, At, B1); PG8_BAR; PG8_SCHED;
            PG8_LDB(B0, 1, 0); PG8_LDB(B1, 1, 1); PG8_SCHED; PG8_LDA(At, 1, 0); PG8_STAGE(PG8_SA(0, 1), a2 + hstepA, voffA);
            PG8_WAIT_V(8); PG8_WAIT_L(0); PG8_BAR; PG8_MMA(0, 0, At, B0); PG8_MMA(0, 1, At, B1); PG8_BAR; PG8_SCHED;
            PG8_LDA(At, 1, 1); PG8_STAGE(PG8_SB(1, 0), b3, voffB); PG8_STAGE(PG8_SB(1, 1), b3 + hstepB, voffB); PG8_STAGE(PG8_SA(1, 0), a3, voffA);
            PG8_WAIT_V(8); PG8_WAIT_L(0); PG8_BAR; PG8_MMA(1, 0, At, B0); PG8_MMA(1, 1, At, B1); PG8_BAR; PG8_SCHED;
            } else {
            PG8_LDB(B0, 0, 0); PG8_SCHED; PG8_LDA(At, 0, 0); PG8_STAGE(PG8_SA(1, 1), a1 + hstepA, voffA);
            PG8_WAIT_L(8); PG8_BAR; PG8_WAIT_L(0); PG8_MMA(0, 0, At, B0); PG8_BAR; PG8_SCHED;
            PG8_LDB(B1, 0, 1); PG8_STAGE(PG8_SB(0, 0), b2, voffB);
            PG8_BAR; PG8_WAIT_L(0); PG8_MMA(0, 1, At, B1); PG8_BAR;
            PG8_LDA(At, 0, 1); PG8_STAGE(PG8_SA(0, 0), a2, voffA);
            PG8_BAR; PG8_WAIT_L(0); PG8_MMA(1, 0, At, B0); PG8_BAR; PG8_SCHED;
            PG8_STAGE(PG8_SB(0, 1), b2 + hstepB, voffB);
            PG8_WAIT_V(6); PG8_BAR; PG8_MMA(1, 1, At, B1); PG8_BAR;
            PG8_LDB(B0, 1, 0); PG8_SCHED; PG8_LDA(At, 1, 0); PG8_STAGE(PG8_SA(0, 1), a2 + hstepA, voffA);
            PG8_WAIT_L(8); PG8_BAR; PG8_WAIT_L(0); PG8_MMA(0, 0, At, B0); PG8_BAR; PG8_SCHED;
            PG8_LDB(B1, 1, 1); PG8_STAGE(PG8_SB(1, 0), b3, voffB);
            PG8_BAR; PG8_WAIT_L(0); PG8_MMA(0, 1, At, B1); PG8_BAR;
            PG8_LDA(At, 1, 1); PG8_STAGE(PG8_SA(1, 0), a3, voffA);
            PG8_BAR; PG8_WAIT_L(0); PG8_MMA(1, 0, At, B0); PG8_BAR; PG8_SCHED;
            PG8_STAGE(PG8_SB(1, 1), b3 + hstepB, voffB);
            PG8_WAIT_V(6); PG8_BAR; PG8_MMA(1, 1, At, B1); PG8_BAR;
            }
        }
        if constexpr (ALIGN_EPI) { if (wr == 0) PG8_BAR; }
        if constexpr (!Epi::AFTER_DRAIN) { E(acc, cur, wr, wc, fr, fq); S.done(cur); }
        if (!has_next) break;
#pragma unroll
        for (int a = 0; a < 2; ++a)
#pragma unroll
            for (int b = 0; b < 2; ++b)
#pragma unroll
                for (int m = 0; m < 4; ++m)
#pragma unroll
                    for (int n = 0; n < 2; ++n) acc[a][b][m][n] = (f32x4){0.f, 0.f, 0.f, 0.f};
        cur = nxt; cA = nA; cB = nB; ++ui;
        if constexpr (ALIGN_EPI) { if (wr == 1) PG8_BAR; }
    }
    PG8_WAIT_V(0);
    if constexpr (!ALIGN_EPI) { if (wr == 0) PG8_BAR; }
    PG8_BAR;
    if constexpr (Epi::AFTER_DRAIN) { E.fused(acc, cur, wr, wc, fr, fq, lds, wid, lane); S.done(cur); }
#undef PG8_SA
#undef PG8_SB
#undef PG8_STAGE
#undef PG8_LDA
#undef PG8_LDB
#undef PG8_MMA
#undef PG8_WAIT_V
#undef PG8_WAIT_L
#undef PG8_BAR
#undef PG8_SCHED
}
}
namespace att {
constexpr int D = 128;
constexpr float THR = 8.f;
constexpr bool WSKIP = false;
constexpr float SCALE = 0.08838834764831845f;
constexpr int NW = 8, QBLK = 32, KVBLK = 64, QB = NW * QBLK;
constexpr int SHM_V = KVBLK * D * 2, SHM_K = KVBLK * D * 2;
constexpr int LDS_BYTES = 2 * SHM_V + 2 * SHM_K + NW * 64 * 4;
using bf16 = __hip_bfloat16;
typedef short bf16x8 __attribute__((ext_vector_type(8)));
typedef short s16x4 __attribute__((ext_vector_type(4)));
typedef float f32x16 __attribute__((ext_vector_type(16)));
typedef float f32x4 __attribute__((ext_vector_type(4)));
typedef unsigned u32x4 __attribute__((ext_vector_type(4)));
template <class A, class Bt> struct same_t { static constexpr bool v = false; };
template <class A> struct same_t<A, A> { static constexpr bool v = true; };

#define KSWZ(row, colB) ((row) * 256 + ((colB) ^ (((row) & 7) << 4)))
#define SBAR() __builtin_amdgcn_sched_barrier(0)
__device__ __forceinline__ int v_st(int k, int c) { const int kk = (k & ~0xC) | ((k & 4) << 1) | ((k & 8) >> 1); return ((kk >> 3) * 4 + (c >> 5)) * 512 + ((kk & 7) * 32 + (c & 31)) * 2; }
__device__ __forceinline__ int v_rd_base(int lane) { return ((lane & 3) << 3) | (((lane >> 2) & 3) << 6) | (((lane >> 4) & 1) << 5) | (((lane >> 5) & 1) << 8); }
constexpr int v_rd_off(int d0, int ks, int half) { return d0 * 512 + ks * 4096 + half * 2048; }
__device__ __forceinline__ int crow(int r, int hi) { return (r & 3) + 8 * (r >> 2) + 4 * hi; }
__device__ __forceinline__ unsigned cvtpk(float lo, float hi) {
    unsigned r; asm volatile("v_cvt_pk_bf16_f32 %0, %1, %2" : "=v"(r) : "v"(lo), "v"(hi)); return r;
}
__device__ __forceinline__ bf16x8 pack8(f32x4 a, f32x4 b) {
    u32x4 w = {cvtpk(a[0], a[1]), cvtpk(a[2], a[3]), cvtpk(b[0], b[1]), cvtpk(b[2], b[3])};
    return *reinterpret_cast<bf16x8*>(&w);
}
template <class T> __device__ __forceinline__ bf16x8 load8(const T* p) {
    if constexpr (same_t<T, float>::v) { return pack8(*(const f32x4*)p, *(const f32x4*)(p + 4)); }
    else { return *reinterpret_cast<const bf16x8*>(p); }
}
__device__ __forceinline__ void mask_tile(f32x16& p0, f32x16& p1, int dq, unsigned W) {
    const float NEG = -__builtin_inff();
#pragma unroll
    for (int r = 0; r < 16; ++r) {
        const int c = (r & 3) + 8 * (r >> 2);
        if ((unsigned)(dq - c) >= W) p0[r] = NEG;
        if ((unsigned)(dq - c - 32) >= W) p1[r] = NEG;
    }
}
__device__ __forceinline__ void partialSM(f32x16& p0, f32x16& p1, float& m_reg, float& mn, float& alpha) {
    float pmax = p0[0]; for (int r = 1; r < 16; ++r) pmax = fmaxf(pmax, p0[r]); for (int r = 0; r < 16; ++r) pmax = fmaxf(pmax, p1[r]);
    { auto rr = __builtin_amdgcn_permlane32_swap(__float_as_uint(pmax), __float_as_uint(pmax), false, false);
      pmax = fmaxf(__uint_as_float(rr[0]), __uint_as_float(rr[1])); }
    constexpr float C2 = 1.4426950408889634f * SCALE;
    if (__builtin_expect(__all((pmax - m_reg) * SCALE <= THR), 1)) { mn = m_reg; alpha = 1.f; }
    else { mn = fmaxf(m_reg, pmax); alpha = __builtin_amdgcn_exp2f((m_reg - mn) * C2); m_reg = mn; }
    const float mnL = -mn * C2;
    for (int r = 0; r < 16; ++r) p0[r] = fmaf(p0[r], C2, mnL); for (int r = 0; r < 16; ++r) p1[r] = fmaf(p1[r], C2, mnL);
    for (int r = 0; r < 16; ++r) p0[r] = __builtin_amdgcn_exp2f(p0[r]);
}
__device__ __forceinline__ void finishSM(f32x16& p0, f32x16& p1, float alpha, float& l_reg, bf16x8& pa0, bf16x8& pa1, bf16x8& pa2, bf16x8& pa3) {
    for (int r = 0; r < 16; ++r) p1[r] = __builtin_amdgcn_exp2f(p1[r]);
    float ps = 0; for (int r = 0; r < 16; ++r) ps += p0[r]; for (int r = 0; r < 16; ++r) ps += p1[r];
    { auto rr = __builtin_amdgcn_permlane32_swap(__float_as_uint(ps), __float_as_uint(ps), false, false);
      ps = __uint_as_float(rr[0]) + __uint_as_float(rr[1]); }
    l_reg = l_reg * alpha + ps;
#define PK4(P, B_, OUT) do { unsigned a0 = cvtpk(P[B_+0], P[B_+1]), a1 = cvtpk(P[B_+2], P[B_+3]);                          \
        unsigned b0 = cvtpk(P[B_+4], P[B_+5]), b1 = cvtpk(P[B_+6], P[B_+7]);                                             \
        auto r0 = __builtin_amdgcn_permlane32_swap(a0, b0, false, false); auto r1 = __builtin_amdgcn_permlane32_swap(a1, b1, false, false); \
        u32x4 w = {r0[0], r1[0], r0[1], r1[1]}; OUT = *reinterpret_cast<bf16x8*>(&w); } while (0)
    PK4(p0, 0, pa0); PK4(p0, 8, pa1); PK4(p1, 0, pa2); PK4(p1, 8, pa3);
#undef PK4
}
template <int KB, bool SK>
__device__ __forceinline__ void qkt(f32x16& p0, f32x16& p1, const char* K_lds, int r32, int hi, const bf16x8* qr, bool act, int cbo  ) {
    if (SK && !act) { const float NEG = -__builtin_inff();
#pragma unroll
        for (int r = 0; r < 16; ++r) { p0[r] = NEG; p1[r] = NEG; } return; }
    if (cbo >= 0) { int a_ = cbo + hi * 16; asm volatile("" : "+v"(a_)); const __attribute__((address_space(3))) float* cb = (const __attribute__((address_space(3))) float*)(unsigned)a_;
#pragma unroll
        for (int q_ = 0; q_ < 4; ++q_) { const f32x4 v0_ = *(const __attribute__((address_space(3))) f32x4*)(cb + 8 * q_), v1_ = *(const __attribute__((address_space(3))) f32x4*)(cb + 32 + 8 * q_);
#pragma unroll
            for (int j_ = 0; j_ < 4; ++j_) { p0[4 * q_ + j_] = v0_[j_]; p1[4 * q_ + j_] = v1_[j_]; } }
    } else { p0 = f32x16{}; p1 = f32x16{}; }
    const char* kb[4];
#pragma unroll
    for (int dd = 0; dd < 4; ++dd) kb[dd] = K_lds + KB * SHM_K + KSWZ(r32, (dd * 16 + hi * 8) * 2);
#pragma unroll
    for (int d0 = 0; d0 < 8; ++d0) { const char* a = kb[d0 & 3] + (d0 >> 2) * 128;
        bf16x8 b0 = *reinterpret_cast<const bf16x8*>(a);
        bf16x8 b1 = *reinterpret_cast<const bf16x8*>(a + 32 * 256);
        p0 = __builtin_amdgcn_mfma_f32_32x32x16_bf16(b0, qr[d0], p0, 0, 0, 0);
        p1 = __builtin_amdgcn_mfma_f32_32x32x16_bf16(b1, qr[d0], p1, 0, 0, 0); }
}
template <int VB, bool SK>
__device__ __forceinline__ void pv_tile(f32x16* o, int vb0, bf16x8 pa0, bf16x8 pa1, bf16x8 pa2, bf16x8 pa3, bool act) {
    if (SK && !act) return;
#define TRRD(dst, off) asm volatile("ds_read_b64_tr_b16 %0, %1 offset:%2" : "=&v"(dst) : "v"(vb0), "i"(off) : "memory")
#define PV_D0(d0) do { s16x4 l0, l1, l2, l3, h0, h1, h2, h3; constexpr int b_ = VB * SHM_V + v_rd_off(d0, 0, 0);     \
        TRRD(l0, b_); TRRD(h0, b_ + 2048); TRRD(l1, b_ + 4096); TRRD(h1, b_ + 6144); TRRD(l2, b_ + 8192); TRRD(h2, b_ + 10240); TRRD(l3, b_ + 12288); TRRD(h3, b_ + 14336); \
        asm volatile("s_waitcnt lgkmcnt(0)" ::: "memory"); SBAR();                 \
        o[d0] = __builtin_amdgcn_mfma_f32_32x32x16_bf16(pa0, (bf16x8){l0[0], l0[1], l0[2], l0[3], h0[0], h0[1], h0[2], h0[3]}, o[d0], 0, 0, 0);   \
        o[d0] = __builtin_amdgcn_mfma_f32_32x32x16_bf16(pa1, (bf16x8){l1[0], l1[1], l1[2], l1[3], h1[0], h1[1], h1[2], h1[3]}, o[d0], 0, 0, 0);   \
        o[d0] = __builtin_amdgcn_mfma_f32_32x32x16_bf16(pa2, (bf16x8){l2[0], l2[1], l2[2], l2[3], h2[0], h2[1], h2[2], h2[3]}, o[d0], 0, 0, 0);   \
        o[d0] = __builtin_amdgcn_mfma_f32_32x32x16_bf16(pa3, (bf16x8){l3[0], l3[1], l3[2], l3[3], h3[0], h3[1], h3[2], h3[3]}, o[d0], 0, 0, 0); } while (0)
    PV_D0(0); PV_D0(1); PV_D0(2); PV_D0(3);
#undef PV_D0
#undef TRRD
}

template <class T> __device__ __forceinline__ T* uptr(T* p) { const unsigned long long v = (unsigned long long)p; const unsigned lo = __builtin_amdgcn_readfirstlane((unsigned)v), hi = __builtin_amdgcn_readfirstlane((unsigned)(v >> 32)); return (T*)(((unsigned long long)hi << 32) | lo); }
template <class TIn, class TOut> struct BlockRef { const TIn* Q; const TIn* K; const TIn* V; TOut* O; float* SS; int P0; };
template <class TIn> struct Seam {
    bf16x8 qr[8];
    bf16x8 st_v0, st_v1, st_k0, st_k1; f32x4 sf0, sf1, sf2, sf3;
    f32x4 tq[16];
};
__device__ __forceinline__ int swa_jlo(int P0, int W) { const int lowk = P0 - W + 1; return lowk > 0 ? lowk / KVBLK : 0; }
#define ROW(p, k0, rr) ((decltype(p))((const char*)(p) + (unsigned)(((k0) + (rr)) * D + sc) * (unsigned)sizeof(*(p))))
#define VMW() asm volatile("s_waitcnt vmcnt(0)" ::: "memory")
#define VMWN(n) asm volatile("s_waitcnt vmcnt(%0)" :: "i"(n) : "memory")
#define SLOAD_H(Kp, Vp, k0) do { S.st_v0 = load8<TIn>(ROW(Vp, k0, sr)); S.st_v1 = load8<TIn>(ROW(Vp, k0, 32 + sr));              \
                         S.st_k0 = load8<TIn>(ROW(Kp, k0, sr)); S.st_k1 = load8<TIn>(ROW(Kp, k0, 32 + sr)); } while (0)
#define SWRITE_HK(bf) do { *(bf16x8*)(K_lds + (bf) * SHM_K + kws) = S.st_k0; *(bf16x8*)(K_lds + (bf) * SHM_K + kws + 32 * 256) = S.st_k1; } while (0)
#define SWRITE_HV(bf) do { *(bf16x8*)(V_lds + (bf) * SHM_V + vst0) = S.st_v0; *(bf16x8*)(V_lds + (bf) * SHM_V + vst1) = S.st_v1; } while (0)
#define SWRITE_H(bf) do { SWRITE_HV(bf); SWRITE_HK(bf); } while (0)
#define SLOAD_F(p, k0) do { S.sf0 = *(const f32x4*)ROW(p, k0, sr); S.sf1 = *(const f32x4*)(ROW(p, k0, sr) + 4);                \
                            S.sf2 = *(const f32x4*)ROW(p, k0, 32 + sr); S.sf3 = *(const f32x4*)(ROW(p, k0, 32 + sr) + 4); } while (0)
#define SWRITE_KF(bf) do { *(bf16x8*)(K_lds + (bf) * SHM_K + kws) = pack8(S.sf0, S.sf1); *(bf16x8*)(K_lds + (bf) * SHM_K + kws + 32 * 256) = pack8(S.sf2, S.sf3); } while (0)
#define SWRITE_VF(bf) do { *(bf16x8*)(V_lds + (bf) * SHM_V + vst0) = pack8(S.sf0, S.sf1); *(bf16x8*)(V_lds + (bf) * SHM_V + vst1) = pack8(S.sf2, S.sf3); } while (0)
template <class TIn, class TOut>
__device__ __forceinline__ void causal_swa_prime(const BlockRef<TIn, TOut>& cur_, int W, char* lds, Seam<TIn>& S) {
    BlockRef<TIn, TOut> cur; cur.Q = uptr(cur_.Q); cur.K = uptr(cur_.K); cur.V = uptr(cur_.V); cur.O = nullptr; cur.SS = nullptr; cur.P0 = __builtin_amdgcn_readfirstlane(cur_.P0);
    constexpr bool F32 = same_t<TIn, float>::v;
    int tid_ = my_tid();
    const int tid = tid_, wid = __builtin_amdgcn_readfirstlane(tid >> 6), lane = tid & 63, r32 = lane & 31, hi = lane >> 5;
    const int sr = tid >> 4, sc = (tid & 15) * 8, kws = KSWZ(sr, sc * 2); char* K_lds = lds + 2 * SHM_V;
    const int kb0 = swa_jlo(cur.P0, W) * KVBLK;
    for (int d0 = 0; d0 < 8; ++d0) S.qr[d0] = load8<TIn>((const TIn*)((const char*)cur.Q + (unsigned)((wid * QBLK + r32) * D + d0 * 16 + hi * 8) * (unsigned)sizeof(TIn)));
    if constexpr (F32) { SLOAD_F((const float*)cur.K, kb0); VMW(); SWRITE_KF(0); SBAR(); SLOAD_F((const float*)cur.V, kb0); }
    else { SLOAD_H(cur.K, cur.V, kb0); VMW(); SWRITE_HK(0); }
    __syncthreads();
}
template <class TIn, class TOut, int ost, bool HAS_SS>
__device__ __forceinline__ void causal_swa_block(const BlockRef<TIn, TOut>& cur_, const BlockRef<TIn, TOut>& nxt_, int skv, int W, char* lds, Seam<TIn>& S, int cbl  ) {
    constexpr bool F32 = same_t<TIn, float>::v;
    BlockRef<TIn, TOut> cur, nxt; cur.Q = uptr(cur_.Q); cur.K = uptr(cur_.K); cur.V = uptr(cur_.V); cur.O = uptr(cur_.O); cur.SS = uptr(cur_.SS); cur.P0 = __builtin_amdgcn_readfirstlane(cur_.P0);
    nxt.Q = uptr(nxt_.Q); nxt.K = uptr(nxt_.K); nxt.V = uptr(nxt_.V); nxt.O = nullptr; nxt.SS = nullptr; nxt.P0 = __builtin_amdgcn_readfirstlane(nxt_.P0);
    int tid_ = my_tid();
    const int tid = tid_, wid = __builtin_amdgcn_readfirstlane(tid >> 6), lane = tid & 63, r32 = lane & 31, hi = lane >> 5;
    const int j_lo = swa_jlo(cur.P0, W);
    int j_hi = (cur.P0 + QB - 1) / KVBLK + 1; if (j_hi > skv / KVBLK) j_hi = skv / KVBLK;
    const int NT = j_hi - j_lo;
    const int kbn = swa_jlo(nxt.P0, W) * KVBLK;
    const int qlo = cur.P0 + wid * QBLK, qm = qlo + r32 - 4 * hi;
    char* V_lds = lds; char* K_lds = lds + 2 * SHM_V;
    float* ws = (float*)(lds + 2 * SHM_V + 2 * SHM_K) + wid * 64; float* li_l = ws, * al_l = ws + 32;
    float m_reg = -1e30f, l_reg = 0; f32x16 o[4] = {};
    const int sr = tid >> 4, sc = (tid & 15) * 8, vst0 = v_st(sr, sc), vst1 = v_st(32 + sr, sc), kws = KSWZ(sr, sc * 2);
    const int vb0 = (int)(uintptr_t)V_lds + v_rd_base(lane);
    const TIn* Kh = cur.K; const TIn* Vh = cur.V;
#define RESC(a) do { if (__any((a) < 1.f)) { if (hi == 0) al_l[r32] = (a); asm volatile("s_waitcnt lgkmcnt(0)" ::: "memory");              \
                     for (int d_ = 0; d_ < 4; ++d_) for (int r = 0; r < 16; ++r) o[d_][r] *= al_l[crow(r, hi)]; } } while (0)
#define KBASE(t) ((j_lo + (t)) * KVBLK)
#define CBT(t) (cbl >= 0 ? cbl + KBASE(t) * 4 : -1)
#define ACT(t) (KBASE(t) <= qlo + QBLK - 1 && KBASE(t) + KVBLK - 1 >= qlo - W + 1)
#define MASKT(P0_, P1_, t) do { const int kb_ = KBASE(t); if ((!SK || ACT(t)) && (kb_ + KVBLK - 1 > qlo || kb_ <= qlo + QBLK - 1 - W)) mask_tile(P0_, P1_, qm - kb_, (unsigned)W); } while (0)
    constexpr int NQL = F32 ? 16 : 8;
    constexpr bool SK = WSKIP && !F32;
#define SEAM_K0() do { VMWN(NQL); if constexpr (F32) { SWRITE_KF(0); SBAR(); SLOAD_F((const float*)nxt.V, kbn); } else { SWRITE_HK(0); } SBAR(); } while (0)
    f32x16 pA0, pA1, pB0, pB1; float mnA, mnB, alA, alB; bf16x8 pa0, pa1, pa2, pa3;
    if constexpr (F32) { VMW(); SWRITE_VF(0); SBAR(); } else { SWRITE_HV(0); SBAR(); }
    if (NT > 1) { if constexpr (F32) SLOAD_F((const float*)Kh, KBASE(1)); else SLOAD_H(Kh, Vh, KBASE(1)); }
    SBAR(); qkt<0, SK>(pA0, pA1, K_lds, r32, hi, S.qr, ACT(0), CBT(0));
    if constexpr (F32) { if (NT > 1) { VMW(); SWRITE_KF(1); SBAR(); SLOAD_F((const float*)Vh, KBASE(1)); } }
    MASKT(pA0, pA1, 0); partialSM(pA0, pA1, m_reg, mnA, alA);
    if (NT > 1) { VMW(); if constexpr (F32) { SWRITE_VF(1); SBAR(); if (NT > 2) SLOAD_F((const float*)Kh, KBASE(2)); } else SWRITE_H(1); }
    __syncthreads();
#define HALF_STEP(PX0, PX1, mnX, alX, PY0, PY1, alY, t, KB, VB, SB) do {                                                      \
        SBAR(); qkt<KB, SK>(PX0, PX1, K_lds, r32, hi, S.qr, ACT(t), CBT(t));                                             \
        finishSM(PY0, PY1, alY, l_reg, pa0, pa1, pa2, pa3); SBAR();                                                           \
        if ((t) + 1 < NT) { if constexpr (F32) { VMW(); SWRITE_KF(SB); SBAR(); SLOAD_F((const float*)Vh, KBASE((t) + 1)); }  \
                            else { SLOAD_H(Kh, Vh, KBASE((t) + 1)); } SBAR(); }                                               \
        pv_tile<VB, SK>(o, vb0, pa0, pa1, pa2, pa3, ACT((t) - 1)); MASKT(PX0, PX1, (t)); partialSM(PX0, PX1, m_reg, mnX, alX);                                        \
        __syncthreads();                                                                                                      \
        if ((t) + 1 < NT) { VMW(); if constexpr (F32) { SWRITE_VF(SB); SBAR(); if ((t) + 2 < NT) SLOAD_F((const float*)Kh, KBASE((t) + 2)); } \
                            else { SWRITE_H(SB); } }                                                                          \
        RESC(alX); __syncthreads(); } while (0)
    for (int t = 1; t + 1 < NT; t += 2) {
        HALF_STEP(pB0, pB1, mnB, alB, pA0, pA1, alA, t, 1, 0, 0);
        HALF_STEP(pA0, pA1, mnA, alA, pB0, pB1, alB, t + 1, 0, 1, 1);
    }
    const bool even = (NT & 1) == 0;
    if (even) { SBAR(); qkt<1, SK>(pB0, pB1, K_lds, r32, hi, S.qr, ACT(NT - 1), CBT(NT - 1)); SBAR(); }
#define QROW(e) (nxt.Q + (size_t)(wid * QBLK + r32) * D + ((e) >> 1) * 16 + hi * 8 + ((e) & 1) * 4)
    if constexpr (F32) { SLOAD_F((const float*)nxt.K, kbn); SBAR();
#pragma unroll
        for (int e = 0; e < 8; ++e) S.tq[e] = *(const f32x4*)QROW(e); }
    else { SLOAD_H(nxt.K, nxt.V, kbn); SBAR();
#pragma unroll
        for (int d0 = 0; d0 < 8; ++d0) S.qr[d0] = load8<TIn>((const TIn*)((const char*)nxt.Q + (unsigned)((wid * QBLK + r32) * D + d0 * 16 + hi * 8) * (unsigned)sizeof(TIn))); }
    SBAR();
    finishSM(pA0, pA1, alA, l_reg, pa0, pa1, pa2, pa3); SBAR();
    if constexpr (F32) {
#pragma unroll
        for (int e = 8; e < 16; ++e) S.tq[e] = *(const f32x4*)QROW(e); SBAR(); }
#undef QROW
    pv_tile<0, SK>(o, vb0, pa0, pa1, pa2, pa3, ACT(even ? NT - 2 : NT - 1));
    if (even) { MASKT(pB0, pB1, NT - 1); partialSM(pB0, pB1, m_reg, mnB, alB); __syncthreads(); RESC(alB);
        finishSM(pB0, pB1, alB, l_reg, pa0, pa1, pa2, pa3); SBAR(); pv_tile<1, SK>(o, vb0, pa0, pa1, pa2, pa3, ACT(NT - 1)); }
    SBAR(); SEAM_K0();
    if (hi == 0) li_l[r32] = l_reg; asm volatile("s_waitcnt lgkmcnt(0)" ::: "memory");
    float rli[16];
#pragma unroll
    for (int r = 0; r < 16; ++r) rli[r] = __builtin_amdgcn_rcpf(li_l[crow(r, hi)]);
    int r32e = r32, hie = hi; asm volatile("" : "+v"(r32e), "+v"(hie));
    char* Ob = (char*)cur.O; const unsigned ob0 = (unsigned)((wid * QBLK + 4 * hie) * ost + r32e) * 2u;
#pragma unroll
    for (int r = 0; r < 16; ++r) { const unsigned rowoff = ob0 + (unsigned)(((r & 3) + 8 * (r >> 2)) * ost * 2); float ss_ = 0.f;
#pragma unroll
        for (int d0 = 0; d0 < 4; ++d0) { const float v = o[d0][r] * rli[r]; ss_ += v * v;
            const float vn = shx<1>(v);
            if ((r32e & 1) == 0) *(unsigned*)(Ob + rowoff + d0 * 64) = cvtpk(v, vn); }
        if (HAS_SS) { ss_ += shx<1>(ss_); ss_ += shx<2>(ss_); ss_ += shx<4>(ss_); ss_ += shx<8>(ss_); ss_ += shx<16>(ss_);
            if (r32e == 0) *(float*)((char*)cur.SS + (unsigned)(wid * QBLK + 4 * hie + (r & 3) + 8 * (r >> 2)) * 32u) = ss_; }
        SBAR(); }
    if constexpr (F32) {
#pragma unroll
        for (int d0 = 0; d0 < 8; ++d0) S.qr[d0] = pack8(S.tq[2 * d0], S.tq[2 * d0 + 1]); }
    __syncthreads();
#undef RESC
#undef KBASE
#undef CBT
#undef ACT
#undef MASKT
#undef SEAM_K0
#undef HALF_STEP
}
#undef ROW
}

#define GAS __attribute__((address_space(1)))
#define LAS __attribute__((address_space(3)))
typedef unsigned short bf16;
typedef unsigned v4u __attribute__((ext_vector_type(4)));
typedef float f32x4 __attribute__((ext_vector_type(4)));
#define LDS_WAIT() asm volatile("s_waitcnt lgkmcnt(0)" ::: "memory")
#define VM_WAIT() asm volatile("s_waitcnt vmcnt(0)" ::: "memory")
__device__ __forceinline__ unsigned f2bf(float f) { unsigned u = __builtin_bit_cast(unsigned, f); return (u + 0x7fffu + ((u >> 16) & 1u)) >> 16; }
__device__ __forceinline__ unsigned pk2(float lo, float hi) { return f2bf(lo) | (f2bf(hi) << 16); }
__device__ __forceinline__ float bflo(unsigned w) { return __uint_as_float(w << 16); }
__device__ __forceinline__ float bfhi(unsigned w) { return __uint_as_float(w & 0xffff0000u); }

#ifndef LB2
#define LB2 2
#endif
#ifndef FOX_HAS_SS
#define FOX_HAS_SS false
#endif
#ifndef FOX_SS
#define FOX_SS (SSQF + ((size_t)b * SEQ + x * 256) * 8 + h)
#endif
#ifndef FOX_CB
#define FOX_CB CB_OFF
#endif
#ifndef USE_XB
#define USE_XB 1
#endif
#if USE_XB
#define GSYNC() xcd_barrier(xbar)
#else
#define GSYNC() grid.sync()
#endif
#ifndef REP
#define REP 0
#endif
#ifndef PH
#define PH 0x1ff
#endif
constexpr int NWAVES = 8, NTHR = 512;
constexpr int BATCH = 4, SEQ = 2048, DM = 2048, M = BATCH * SEQ, NMEM = 256, MMEM = BATCH * NMEM;
constexpr int FOXW = 1024, LRUW = 1024, INW = 5128, INWP = 5376, XW = 512, FFN = 5632;
constexpr float EPS = 1e-6f;
constexpr size_t MiB = 1u << 20;
constexpr size_t WS_WIN = 1 * MiB, WS_WOUT = 22 * MiB, WS_WCQ = 30 * MiB, WS_WCKV = 32 * MiB, WS_WCO = 36 * MiB, WS_WGU = 38 * MiB, WS_WDN = 82 * MiB, WS_WLRU = 104 * MiB;
constexpr size_t WS_XN = 105 * MiB, WS_MN = 137 * MiB, WS_Q = 141 * MiB, WS_K = 157 * MiB, WS_V = 173 * MiB, WS_U = 189 * MiB, WS_GG = 205 * MiB, WS_UC = 221 * MiB;
constexpr size_t WS_LF = 237 * MiB, WS_CK = 238 * MiB, WS_CV = 239 * MiB, WS_MIX = 240 * MiB, WS_SSQF = 272 * MiB, WS_SSQL = 273 * MiB, WS_X1 = 274 * MiB;
constexpr size_t WS_SSQ1 = 338 * MiB, WS_CQ = 339 * MiB, WS_SSQ2 = 347 * MiB, WS_END = 348 * MiB;
constexpr size_t WS_HL = WS_X1, WS_AC = WS_X1 + 16 * MiB, WS_ENDH = WS_SSQ2, WS_ENDA = WS_SSQ2 + 256 * 1024;
constexpr size_t WS_X1B = WS_XN  , WS_OX = WS_Q  , WS_X2B = WS_MIX  , WS_H = WS_Q  ;
constexpr int LDS_BYTES = 147456, RED_OFF = 131072, CB_OFF = 69632, WSUM_OFF = 77824;

__device__ __forceinline__ float wave_sum(float v) { v += shx<1>(v); v += shx<2>(v); v += shx<4>(v); v += shx<8>(v); v += shx<16>(v); return sum32(v); }
__device__ __forceinline__ void transpose_item(const float* W, int ldw, int k0, int srcn0, int nvalid, const float* ks, bf16* WT, int ldt, int drow0, LAS float* scr, int lane) {
    f32x4 v[8];
#pragma unroll
    for (int i = 0; i < 8; ++i) { const int kk = 8 * i + (lane >> 3), n4 = (lane & 7) * 4;
        v[i] = (n4 < nvalid) ? *(const GAS f32x4*)(W + (size_t)(k0 + kk) * ldw + srcn0 + n4) : (f32x4){0.f, 0.f, 0.f, 0.f}; }
#pragma unroll
    for (int i = 0; i < 8; ++i) { const int kk = 8 * i + (lane >> 3), n4 = (lane & 7) * 4; f32x4 x = v[i]; if (ks) x = x * ks[k0 + kk];
        LAS float* d = scr + kk * 33 + n4; d[0] = x.x; d[1] = x.y; d[2] = x.z; d[3] = x.w; }
    LDS_WAIT(); asm volatile("" ::: "memory");
    const int c = lane & 7;
#pragma unroll
    for (int j = 0; j < 4; ++j) { const int n = (lane >> 3) + 8 * j; const LAS float* s = scr + (8 * c) * 33 + n;
        v4u o; o.x = pk2(s[0 * 33], s[1 * 33]); o.y = pk2(s[2 * 33], s[3 * 33]); o.z = pk2(s[4 * 33], s[5 * 33]); o.w = pk2(s[6 * 33], s[7 * 33]);
        *(GAS v4u*)(WT + (size_t)(drow0 + n) * ldt + k0 + 8 * c) = o; }
    LDS_WAIT(); asm volatile("" ::: "memory");
}
__device__ __forceinline__ void rms_row_to_bf16(const float* xrow, const float* g, bf16* orow, int lane) {
    const GAS f32x4* xr = (const GAS f32x4*)xrow + lane; const GAS f32x4* gr = (const GAS f32x4*)g + lane;
    f32x4 v[8]; float s = 0.f;
#pragma unroll
    for (int j = 0; j < 8; ++j) { v[j] = xr[64 * j]; s += (v[j].x * v[j].x + v[j].y * v[j].y) + (v[j].z * v[j].z + v[j].w * v[j].w); }
    const float rstd = 1.0f / sqrtf(wave_sum(s) * (1.f / DM) + EPS);
    GAS unsigned long long* o8 = (GAS unsigned long long*)orow + lane;
#pragma unroll
    for (int j = 0; j < 8; ++j) { const f32x4 gg = gr[64 * j]; o8[64 * j] = (unsigned long long)pk2(v[j].x * rstd * gg.x, v[j].y * rstd * gg.y) | ((unsigned long long)pk2(v[j].z * rstd * gg.z, v[j].w * rstd * gg.w) << 32); }
}

#define XB_TMO      128
#define XB_XCNT(j)  (256  + 64 * (j))
#define XB_XSUB(j)  (1280 + 64 * (j))
#define XB_XGEN(j)  (2304 + 64 * (j))
#define XB_TOP      3328
#define XB_TOPGEN   3392
#define XCD_BAR_WORDS 3456
#define XB_SPIN_CAP (1u << 18)

__device__ __forceinline__ unsigned xb_ld(unsigned* p)              { return __hip_atomic_load(p, __ATOMIC_RELAXED, __HIP_MEMORY_SCOPE_AGENT); }
__device__ __forceinline__ unsigned xb_add(unsigned* p, unsigned v) { return __hip_atomic_fetch_add(p, v, __ATOMIC_RELAXED, __HIP_MEMORY_SCOPE_AGENT); }
__device__ __forceinline__ unsigned xb_xcc_id() { return (unsigned)__builtin_amdgcn_s_getreg((3 << 11) | 20) & 0xFu; }
#define XB_SPIN(cond, bar) do { unsigned _sp = 0; while (cond) { __builtin_amdgcn_s_sleep(1); \
    if ((++_sp & 255u) == 0u) { if (xb_ld(&(bar)[XB_TMO])) break; if (_sp > XB_SPIN_CAP) { atomicAdd(&(bar)[XB_TMO], 1u); break; } } } } while (0)

struct XcdBarrier {
    unsigned* bar; unsigned x;
    volatile LAS unsigned* st;
};

__device__ __forceinline__ XcdBarrier xcd_barrier_post(unsigned* bar, volatile LAS unsigned* st) {
    XcdBarrier b; b.bar = bar; b.x = xb_xcc_id(); b.st = st;
    if (my_tid() == 0) (void)xb_add(&bar[XB_XCNT(b.x)], 1u);
    return b;
}
__device__ __forceinline__ void xcd_barrier_complete(unsigned* bar, unsigned x, unsigned& nloc, unsigned& nx) {
    const unsigned G = gridDim.x * gridDim.y * gridDim.z;
    unsigned sum, cnt, mine, sp = 0u;
    for (;;) {
        sum = 0u; cnt = 0u; mine = 0u;
#pragma unroll
        for (unsigned j = 0; j < 16; ++j) { const unsigned c = xb_ld(&bar[XB_XCNT(j)]); sum += c; cnt += (c > 0u) ? 1u : 0u; mine = (j == x) ? c : mine; }
        if (sum == G) break;
        __builtin_amdgcn_s_sleep(1);
        if ((++sp & 255u) == 0u) { if (xb_ld(&bar[XB_TMO])) break; if (sp > XB_SPIN_CAP) { atomicAdd(&bar[XB_TMO], 1u); break; } }
    }
    nloc = mine > 0u ? mine : 1u; nx = cnt > 0u ? cnt : 1u;
}

__device__ __forceinline__ void xcd_barrier(const XcdBarrier& b) {
    asm volatile("s_waitcnt vmcnt(0)" ::: "memory");
    __syncthreads();
    if (my_tid() == 0) {
        unsigned* bar = b.bar;
        __builtin_amdgcn_s_waitcnt(0);
        unsigned nloc = b.st[0], nx = b.st[1];
        if (nloc == 0u) { xcd_barrier_complete(bar, b.x, nloc, nx); b.st[0] = nloc; b.st[1] = nx; }
        const unsigned old = xb_add(&bar[XB_XSUB(b.x)], 1u);
        const unsigned gen = old / nloc;
        if (old + 1u == (gen + 1u) * nloc) {
            __builtin_amdgcn_fence(__ATOMIC_RELEASE, "agent");
            asm volatile("s_waitcnt vmcnt(0)" ::: "memory");
            const unsigned og = xb_add(&bar[XB_TOP], 1u);
            const unsigned tg = og / nx;
            if (og + 1u == (tg + 1u) * nx) xb_add(&bar[XB_TOPGEN], 1u);
            else XB_SPIN(xb_ld(&bar[XB_TOPGEN]) == tg, bar);
            __builtin_amdgcn_fence(__ATOMIC_ACQUIRE, "agent");
            xb_add(&bar[XB_XGEN(b.x)], 1u);
            asm volatile("s_waitcnt vmcnt(0)" ::: "memory");
        } else {
            XB_SPIN(xb_ld(&bar[XB_XGEN(b.x)]) == gen, bar);
            __builtin_amdgcn_fence(__ATOMIC_ACQUIRE, "agent");
            asm volatile("s_waitcnt vmcnt(0)" ::: "memory");
        }
    }
    __syncthreads();
}

struct Args { const float* in[27]; float* out; unsigned char* ws; };
enum { I_X = 0, I_MEM, I_GMIX, I_WIN, I_BF, I_GQ, I_GK, I_CONVW, I_CONVB, I_WRA, I_BRA, I_WRI, I_BRI, I_LAM, I_GFOX, I_GLRU, I_WOUT, I_GXATTN, I_GMEM, I_WCQ, I_WCKV, I_GCQ, I_GCK, I_WCO, I_GFFN, I_WGU, I_WDN };

constexpr int KB_D = DM / 64;
constexpr int I0 = (INWP / 32) * KB_D, I3 = (2 * XW / 32) * KB_D, I7 = 16 * 4 * 2, N_EARLY = I0 + I3 + I7;
constexpr int I1 = (DM / 32) * KB_D, I2 = (XW / 32) * KB_D, I4 = (DM / 32) * (XW / 64), I5 = (2 * FFN / 32) * KB_D, I6 = (DM / 32) * (FFN / 64), N_LATE = I1 + I2 + I4 + I5 + I6;
constexpr int N_LATE_P1 = I1 + I2 + I4 + 2560;
constexpr int N_LATE_P2 = N_LATE_P1 + 2440;
__device__ __forceinline__ void early_item(const Args& a, int r, LAS float* scr, int lane) {
    unsigned char* ws = a.ws;
    if (r < I0) { const int rg = r / KB_D, kb = r % KB_D, d = rg * 32; int src = d, nv = 32;
        if (d >= 3072 && d < 5120) src = d + 8; else if (d == 5120) { src = 3072; nv = 8; } else if (d > 5120) { src = 0; nv = 0; }
        transpose_item(a.in[I_WIN], INW, kb * 64, src, nv, nullptr, (bf16*)(ws + WS_WIN), DM, d, scr, lane); return; } r -= I0;
    if (r < I3) { const int rg = r / KB_D, kb = r % KB_D;
        transpose_item(a.in[I_WCKV], 2 * XW, kb * 64, rg * 32, 32, nullptr, (bf16*)(ws + WS_WCKV), DM, rg * 32, scr, lane); return; } r -= I3;
    { const int mtx = r >> 3, sub = r & 7, rg = sub >> 1, kb = sub & 1, n = mtx >> 1, which = mtx & 1;
        transpose_item((which ? a.in[I_WRI] : a.in[I_WRA]) + (size_t)n * 128 * 128, 128, kb * 64, rg * 32, 32, nullptr, (bf16*)(ws + WS_WLRU) + (size_t)(n * 256 + which * 128) * 128, 128, rg * 32, scr, lane); }
}
__device__ __forceinline__ void late_item(const Args& a, int r, LAS float* scr, int lane) {
    unsigned char* ws = a.ws;
    if (r < I1) { const int rg = r / KB_D, kb = r % KB_D; const float* ks = kb < 16 ? a.in[I_GFOX] : a.in[I_GLRU] - 1024;
        transpose_item(a.in[I_WOUT], DM, kb * 64, rg * 32, 32, ks, (bf16*)(ws + WS_WOUT), DM, rg * 32, scr, lane); return; } r -= I1;
    if (r < I2) { const int rg = r / KB_D, kb = r % KB_D;
        transpose_item(a.in[I_WCQ], XW, kb * 64, rg * 32, 32, a.in[I_GXATTN], (bf16*)(ws + WS_WCQ), DM, rg * 32, scr, lane); return; } r -= I2;
    if (r < I4) { const int rg = r / (XW / 64), kb = r % (XW / 64);
        transpose_item(a.in[I_WCO], DM, kb * 64, rg * 32, 32, nullptr, (bf16*)(ws + WS_WCO), XW, rg * 32, scr, lane); return; } r -= I4;
    if (r < I5) { const int rg = r / KB_D, kb = r % KB_D, d = rg * 32, tile = d >> 8, w = d & 255; const int src = w < 128 ? tile * 128 + w : FFN + tile * 128 + (w - 128);
        transpose_item(a.in[I_WGU], 2 * FFN, kb * 64, src, 32, a.in[I_GFFN], (bf16*)(ws + WS_WGU), DM, d, scr, lane); return; } r -= I5;
    { const int rg = r / (FFN / 64), kb = r % (FFN / 64);
        transpose_item(a.in[I_WDN], DM, kb * 64, rg * 32, 32, nullptr, (bf16*)(ws + WS_WDN), FFN, rg * 32, scr, lane); }
}
__device__ __forceinline__ void late_range(const Args& a, LAS unsigned char* lds, int lo, int hi, int w, int nw, int wave, int lane) {
    LAS float* scr = (LAS float*)(lds + wave * 16384);
    for (int it = lo + w; it < hi; it += nw) late_item(a, it, scr, lane);
}
__device__ __forceinline__ void p0_prologue(const Args& a, LAS unsigned char* lds, int wave, int lane, int G) {
    unsigned char* ws = a.ws;
    LAS float* scr = (LAS float*)(lds + wave * 16384);
    const int gw = blockIdx.x * NWAVES + wave, NGW = G * NWAVES;
    for (int it = gw; it < N_EARLY; it += NGW) early_item(a, it, scr, lane);
    if (G != 256) for (int it = gw; it < N_LATE; it += NGW) late_item(a, it, scr, lane);
    for (int m = gw; m < M + MMEM; m += NGW) {
        if (m < M) rms_row_to_bf16(a.in[I_X] + (size_t)m * DM, a.in[I_GMIX], (bf16*)(ws + WS_XN) + (size_t)m * DM, lane);
        else rms_row_to_bf16(a.in[I_MEM] + (size_t)(m - M) * DM, a.in[I_GMEM], (bf16*)(ws + WS_MN) + (size_t)(m - M) * DM, lane);
    }
}

__device__ __forceinline__ void conv_chunk(const bf16* U, bf16* UC, const float* cw, const float* cbias, int row0, int s0, int nblk, int tid) {
    asm volatile("" : "+v"(tid));
    const int c8 = nblk * 128 + (tid & 15) * 8;
    f32x4 w[4][2], bb[2];
#pragma unroll
    for (int j = 0; j < 4; ++j) { w[j][0] = *(const f32x4*)(cw + j * LRUW + c8); w[j][1] = *(const f32x4*)(cw + j * LRUW + c8 + 4); }
    bb[0] = *(const f32x4*)(cbias + c8); bb[1] = *(const f32x4*)(cbias + c8 + 4);
#pragma unroll 2
    for (int p = 0; p < 8; ++p) { const int rl = p * 32 + (tid >> 4), s = s0 + rl; const unsigned grow = (unsigned)(row0 + rl);
        f32x4 a0 = bb[0], a1 = bb[1];
#pragma unroll
        for (int j = 0; j < 4; ++j) { if (s - 3 + j >= 0) { const v4u uw = *(const v4u*)((const char*)U + ((grow - 3 + j) * LRUW + c8) * 2u);
            a0 += w[j][0] * (f32x4){bflo(uw.x), bfhi(uw.x), bflo(uw.y), bfhi(uw.y)}; a1 += w[j][1] * (f32x4){bflo(uw.z), bfhi(uw.z), bflo(uw.w), bfhi(uw.w)}; } }
        v4u o; o.x = pk2(a0.x, a0.y); o.y = pk2(a0.z, a0.w); o.z = pk2(a1.x, a1.y); o.w = pk2(a1.z, a1.w);
        *(v4u*)((char*)UC + (grow * LRUW + c8) * 2u) = o; }
}

__global__ void __launch_bounds__(NTHR, LB2) hymba_fwd(Args a) {
    extern __shared__ __attribute__((aligned(16))) unsigned char lds_raw[];
    cg::grid_group grid = cg::this_grid();
    LAS unsigned char* lds = (LAS unsigned char*)lds_raw;
    { const int t0 = threadIdx.x; if ((t0 & 63) == 0) *(volatile LAS int*)(lds + WTAB_OFF + hw_slot() * 4) = t0 >> 6;
      if (t0 < 2) *(volatile LAS unsigned*)(lds + XBST_OFF + t0 * 4) = 0u; }
    __syncthreads();
    const XcdBarrier xbar = xcd_barrier_post((unsigned*)a.ws, (volatile LAS unsigned*)(lds + XBST_OFF));
    const int G = gridDim.x, c = blockIdx.x;
#define WIN ((bf16*)(a.ws + WS_WIN))
#define WOUT ((bf16*)(a.ws + WS_WOUT))
#define WCQ ((bf16*)(a.ws + WS_WCQ))
#define WCKV ((bf16*)(a.ws + WS_WCKV))
#define WCO ((bf16*)(a.ws + WS_WCO))
#define WGU ((bf16*)(a.ws + WS_WGU))
#define WDN ((bf16*)(a.ws + WS_WDN))
#define WLRU ((bf16*)(a.ws + WS_WLRU))
#define XN ((bf16*)(a.ws + WS_XN))
#define MN ((bf16*)(a.ws + WS_MN))
#define Qh ((bf16*)(a.ws + WS_Q))
#define Kh ((bf16*)(a.ws + WS_K))
#define Vh ((bf16*)(a.ws + WS_V))
#define U ((bf16*)(a.ws + WS_U))
#define GG ((bf16*)(a.ws + WS_GG))
#define UC ((bf16*)(a.ws + WS_UC))
#define LF ((float*)(a.ws + WS_LF))
#define CK ((bf16*)(a.ws + WS_CK))
#define CV ((bf16*)(a.ws + WS_CV))
#define MIX ((bf16*)(a.ws + WS_MIX))
#define SSQF ((float*)(a.ws + WS_SSQF))
#define SSQL ((float*)(a.ws + WS_SSQL))
#define X1 ((float*)(a.ws + WS_X1))
#define X1B ((bf16*)(a.ws + WS_X1B))
#define SSQ1 ((float*)(a.ws + WS_SSQ1))
#define CQ ((bf16*)(a.ws + WS_CQ))
#define OX ((bf16*)(a.ws + WS_OX))
#define X2B ((bf16*)(a.ws + WS_X2B))
#define SSQ2 ((float*)(a.ws + WS_SSQ2))
#define H ((bf16*)(a.ws + WS_H))
#define HL ((bf16*)(a.ws + WS_HL))
#define AC ((bf16*)(a.ws + WS_AC))
#define ENDH ((float*)(a.ws + WS_ENDH))
#define ENDA ((float*)(a.ws + WS_ENDA))
#define red ((PG8_LAS float*)(lds + RED_OFF))

    for (int rep = 0; rep < 1 + ((REP >> 0) & 1); ++rep) {
    if (PH & 1) { int tid = my_tid(); p0_prologue(a, lds, __builtin_amdgcn_readfirstlane(tid >> 6), tid & 63, G); }
    GSYNC();
    if (a.ws == nullptr) grid.sync();
    }

    for (int rep = 0; rep < 1 + ((REP >> 1) & 1); ++rep) {
    if (PH & 2) {
        pg8::Gemm g{XN, WIN, M, INWP, DM, DM, DM}; pg8::StaticOrder S; S.init(M, INWP, G, c);
        pg8::EpiIn E{0, Qh, Kh, Vh, U, GG, LF, a.in[I_GQ], a.in[I_GK], a.in[I_BF], red};
        pg8::gemm_phase<pg8::EpiIn, pg8::StaticOrder, true, true>(lds, g, S, E);
        pg8::Gemm g2{MN, WCKV, MMEM, 2 * XW, DM, DM, DM}; pg8::StaticOrder S2; S2.init(MMEM, 2 * XW, G, (c + 16) % G);
        pg8::EpiCkv E2{0, CK, CV, a.in[I_GCK], red};
        pg8::gemm_phase<pg8::EpiCkv, pg8::StaticOrder, true, true>(lds, g2, S2, E2);
        if (G == 256 && c >= 160 && c < 240) { const int t2 = my_tid(); late_range(a, lds, 0, N_LATE_P1, (c - 160) * NWAVES + (t2 >> 6), 80 * NWAVES, __builtin_amdgcn_readfirstlane(t2 >> 6), t2 & 63); }
    }
    GSYNC();
    }

    for (int rep = 0; rep < 1 + ((REP >> 2) & 1); ++rep) {
    if (PH & 4) { int cL = c, tid = my_tid(); asm volatile("" : "+s"(cL));
      const int nl = G > 128 ? G - 128 : G;
      if (G <= 128 || cL >= 128)
      for (int L = (G > 128 ? cL - 128 : cL); L < 256; L += nl) {
            const int pm = L >> 3, nblk = L & 7, row0 = pm * 256;
            conv_chunk(U, UC, a.in[I_CONVW], a.in[I_CONVB], row0, (pm & 7) * 256, nblk, tid);
            VM_WAIT(); __syncthreads(); __builtin_amdgcn_fence(__ATOMIC_ACQUIRE, "agent");
            pg8::Gemm g{UC + (size_t)row0 * LRUW + nblk * 128, WLRU + (size_t)nblk * 256 * 128, 256, 256, 128, LRUW, 128}; pg8::OneUnit S;
            pg8::EpiLru E{0, UC, HL, AC, ENDH + pm * 1024, ENDA + pm * 1024, a.in[I_BRA], a.in[I_BRI], a.in[I_LAM], row0, nblk};
            pg8::gemm_phase<pg8::EpiLru, pg8::OneUnit, false, true>(lds, g, S, E);
      }
      if (G == 256 && cL >= 128) {
        VM_WAIT(); __syncthreads();
        if (my_tid() == 0) { unsigned* cnt = (unsigned*)(a.ws + 15360);
            __builtin_amdgcn_fence(__ATOMIC_RELEASE, "agent"); asm volatile("s_waitcnt vmcnt(0)" ::: "memory");
            (void)__hip_atomic_fetch_add(cnt, 1u, __ATOMIC_RELAXED, __HIP_MEMORY_SCOPE_AGENT);
            unsigned sp = 0; while (__hip_atomic_load(cnt, __ATOMIC_RELAXED, __HIP_MEMORY_SCOPE_AGENT) < 128u && ++sp < (1u << 22)) __builtin_amdgcn_s_sleep(1);
            __builtin_amdgcn_fence(__ATOMIC_ACQUIRE, "agent"); asm volatile("s_waitcnt vmcnt(0)" ::: "memory"); }
        __syncthreads();
#define P2B_FIRST (cL - 128)
#define P2B_STRIDE 128
    { int tid = my_tid();
      for (int L = P2B_FIRST; L < 256; L += P2B_STRIDE) { const int pm = L >> 3, nblk = L & 7, j = pm & 7, c8 = nblk * 128 + (tid & 15) * 8;
        f32x4 hi0 = {0.f, 0.f, 0.f, 0.f}, hi1 = {0.f, 0.f, 0.f, 0.f};
        for (int i = 0; i < j; ++i) { const float* eh = ENDH + (pm - j + i) * 1024 + c8; const float* ea = ENDA + (pm - j + i) * 1024 + c8;
            hi0 = *(const f32x4*)ea * hi0 + *(const f32x4*)eh; hi1 = *(const f32x4*)(ea + 4) * hi1 + *(const f32x4*)(eh + 4); }
#pragma unroll 2
        for (int p = 0; p < 8; ++p) { const unsigned row = (unsigned)(pm * 256 + p * 32 + (tid >> 4)), o = (row * 1024u + c8) * 2u;
            const v4u hw = *(const v4u*)((const char*)HL + o), aw = *(const v4u*)((const char*)AC + o), gw = *(const v4u*)((const char*)GG + o);
            const f32x4 y0 = ((f32x4){bflo(hw.x), bfhi(hw.x), bflo(hw.y), bfhi(hw.y)} + (f32x4){bflo(aw.x), bfhi(aw.x), bflo(aw.y), bfhi(aw.y)} * hi0) * (f32x4){bflo(gw.x), bfhi(gw.x), bflo(gw.y), bfhi(gw.y)};
            const f32x4 y1 = ((f32x4){bflo(hw.z), bfhi(hw.z), bflo(hw.w), bfhi(hw.w)} + (f32x4){bflo(aw.z), bfhi(aw.z), bflo(aw.w), bfhi(aw.w)} * hi1) * (f32x4){bflo(gw.z), bfhi(gw.z), bflo(gw.w), bfhi(gw.w)};
            float ss = (y0.x * y0.x + y0.y * y0.y) + (y0.z * y0.z + y0.w * y0.w) + (y1.x * y1.x + y1.y * y1.y) + (y1.z * y1.z + y1.w * y1.w);
            v4u ow; ow.x = pk2(y0.x, y0.y); ow.y = pk2(y0.z, y0.w); ow.z = pk2(y1.x, y1.y); ow.w = pk2(y1.z, y1.w);
            *(v4u*)((char*)MIX + ((size_t)row * 2048 + 1024 + c8) * 2) = ow;
            ss += shx<1>(ss); ss += shx<2>(ss); ss += shx<4>(ss); ss += shx<8>(ss);
            if ((tid & 15) == 0) SSQL[row * 8 + nblk] = ss; } } }
#undef P2B_FIRST
#undef P2B_STRIDE
        { const int t2 = my_tid(); late_range(a, lds, N_LATE_P1, N_LATE_P2, (cL - 128) * NWAVES + (t2 >> 6), 128 * NWAVES, __builtin_amdgcn_readfirstlane(t2 >> 6), t2 & 63); } } }
    if (PH & 4) { int cF = c, tid = my_tid(); asm volatile("" : "+s"(cF)); const int lane = tid & 63, wave = __builtin_amdgcn_readfirstlane(tid >> 6);
      for (int L = cF; L < 128; L += G) {
        {
#if !defined(NO_FOX)
            const int bh = (L & 7) * 4 + ((L >> 3) >> 2), x = (L >> 3) & 3, b = bh >> 3, h = bh & 7;
            LAS float* cbl = (LAS float*)(lds + CB_OFF); LAS float* wsum = (LAS float*)(lds + WSUM_OFF);
            { const float* lf = LF + ((size_t)b * SEQ + tid * 4) * 8 + h;
              const float v0 = lf[0], v1 = lf[8], v2 = lf[16], v3 = lf[24]; const float t0 = v0, t1 = t0 + v1, t2 = t1 + v2, t3 = t2 + v3;
              wsum[tid] = t3; __syncthreads();
              for (int o = 1; o < 512; o <<= 1) { const float v = wsum[tid] + (tid >= o ? wsum[tid - o] : 0.f); __syncthreads(); wsum[tid] = v; __syncthreads(); }
              const float off = wsum[tid] - t3;
              const float ns = -1.0f / att::SCALE;
              *(LAS f32x4*)(cbl + tid * 4) = (f32x4){(off + t0) * ns, (off + t1) * ns, (off + t2) * ns, (off + t3) * ns};
              __syncthreads(); }
            typedef att::BlockRef<att::bf16, att::bf16> BR;
            BR cur, nxt;
            { const size_t hrow = (size_t)bh * SEQ;
              cur.Q = (const att::bf16*)Qh + (hrow + x * 256) * 128; cur.K = (const att::bf16*)Kh + hrow * 128; cur.V = (const att::bf16*)Vh + hrow * 128;
              cur.O = (att::bf16*)MIX + ((size_t)b * SEQ + x * 256) * 2048 + h * 128; cur.SS = FOX_SS; cur.P0 = x * 256;
              nxt = cur; const int d = (7 - 2 * x) * 256;
              nxt.Q += (size_t)d * 128; nxt.O += (size_t)d * 2048; nxt.SS += (size_t)d * 8; nxt.P0 += d; }
            att::Seam<att::bf16> S;
            att::causal_swa_prime<att::bf16, att::bf16>(cur, 1 << 20, (char*)lds_raw, S);
            for (int p = 0; p < 2; ++p) {
                att::causal_swa_block<att::bf16, att::bf16, 2048, FOX_HAS_SS>(cur, nxt, SEQ, 1 << 20, (char*)lds_raw, S, FOX_CB);
                cur = nxt; }
            VM_WAIT(); __syncthreads(); __builtin_amdgcn_fence(__ATOMIC_ACQUIRE, "agent");
            for (int p = 0; p < 16; ++p) { const int qb = (p < 8) ? x : 7 - x, rl = (p & 7) * 32 + (tid >> 4); const size_t trow = (size_t)b * SEQ + qb * 256 + rl;
                const v4u w = *(const v4u*)(MIX + trow * 2048 + h * 128 + (tid & 15) * 8);
                float ss = (bflo(w.x) * bflo(w.x) + bfhi(w.x) * bfhi(w.x)) + (bflo(w.y) * bflo(w.y) + bfhi(w.y) * bfhi(w.y)) + (bflo(w.z) * bflo(w.z) + bfhi(w.z) * bfhi(w.z)) + (bflo(w.w) * bflo(w.w) + bfhi(w.w) * bfhi(w.w));
                ss += shx<1>(ss); ss += shx<2>(ss); ss += shx<4>(ss); ss += shx<8>(ss);
                if ((tid & 15) == 0) SSQF[trow * 8 + h] = ss; }
            VM_WAIT(); __syncthreads();
#endif
        }
    } }
    GSYNC();
    }

    if (G != 256) {
#define P2B_FIRST c
#define P2B_STRIDE G
    { int tid = my_tid();
      for (int L = P2B_FIRST; L < 256; L += P2B_STRIDE) { const int pm = L >> 3, nblk = L & 7, j = pm & 7, c8 = nblk * 128 + (tid & 15) * 8;
        f32x4 hi0 = {0.f, 0.f, 0.f, 0.f}, hi1 = {0.f, 0.f, 0.f, 0.f};
        for (int i = 0; i < j; ++i) { const float* eh = ENDH + (pm - j + i) * 1024 + c8; const float* ea = ENDA + (pm - j + i) * 1024 + c8;
            hi0 = *(const f32x4*)ea * hi0 + *(const f32x4*)eh; hi1 = *(const f32x4*)(ea + 4) * hi1 + *(const f32x4*)(eh + 4); }
#pragma unroll 2
        for (int p = 0; p < 8; ++p) { const unsigned row = (unsigned)(pm * 256 + p * 32 + (tid >> 4)), o = (row * 1024u + c8) * 2u;
            const v4u hw = *(const v4u*)((const char*)HL + o), aw = *(const v4u*)((const char*)AC + o), gw = *(const v4u*)((const char*)GG + o);
            const f32x4 y0 = ((f32x4){bflo(hw.x), bfhi(hw.x), bflo(hw.y), bfhi(hw.y)} + (f32x4){bflo(aw.x), bfhi(aw.x), bflo(aw.y), bfhi(aw.y)} * hi0) * (f32x4){bflo(gw.x), bfhi(gw.x), bflo(gw.y), bfhi(gw.y)};
            const f32x4 y1 = ((f32x4){bflo(hw.z), bfhi(hw.z), bflo(hw.w), bfhi(hw.w)} + (f32x4){bflo(aw.z), bfhi(aw.z), bflo(aw.w), bfhi(aw.w)} * hi1) * (f32x4){bflo(gw.z), bfhi(gw.z), bflo(gw.w), bfhi(gw.w)};
            float ss = (y0.x * y0.x + y0.y * y0.y) + (y0.z * y0.z + y0.w * y0.w) + (y1.x * y1.x + y1.y * y1.y) + (y1.z * y1.z + y1.w * y1.w);
            v4u ow; ow.x = pk2(y0.x, y0.y); ow.y = pk2(y0.z, y0.w); ow.z = pk2(y1.x, y1.y); ow.w = pk2(y1.z, y1.w);
            *(v4u*)((char*)MIX + ((size_t)row * 2048 + 1024 + c8) * 2) = ow;
            ss += shx<1>(ss); ss += shx<2>(ss); ss += shx<4>(ss); ss += shx<8>(ss);
            if ((tid & 15) == 0) SSQL[row * 8 + nblk] = ss; } } }
#undef P2B_FIRST
#undef P2B_STRIDE
    GSYNC(); }

    for (int rep = 0; rep < 1 + ((REP >> 3) & 1); ++rep) {
    if (PH & 8) {
        pg8::Gemm g{MIX, WOUT, M, DM, DM, DM, DM}; pg8::StaticOrder S; S.init(M, DM, G, c);
        pg8::EpiRes<true> E{16, a.in[I_X], nullptr, nullptr, X1B, SSQ1, SSQF, SSQL};
        pg8::gemm_phase<pg8::EpiRes<true>, pg8::StaticOrder, true, true>(lds, g, S, E);
    }
    GSYNC();
    }

    for (int rep = 0; rep < 1 + ((REP >> 4) & 1); ++rep) {
    if (PH & 16) {
        pg8::Gemm g{X1B, WCQ, M, XW, DM, DM, DM}; pg8::StaticOrder S; S.init(M, XW, G, c);
        pg8::EpiCq E{0, CQ, a.in[I_GCQ], SSQ1, red};
        pg8::gemm_phase<pg8::EpiCq, pg8::StaticOrder, true, true>(lds, g, S, E);
        if (G == 256 && c >= 64) { const int t2 = my_tid(); late_range(a, lds, N_LATE_P2, N_LATE, (c - 64) * NWAVES + (t2 >> 6), 192 * NWAVES, __builtin_amdgcn_readfirstlane(t2 >> 6), t2 & 63); }
    }
    GSYNC();
    }

    for (int rep = 0; rep < 1 + ((REP >> 5) & 1); ++rep) {
    if (PH & 32) for (int L = c; L < 128; L += G) {
        const int bh = L >> 3, qb = L & 7, b = bh >> 2, h = bh & 3;
        att::BlockRef<att::bf16, att::bf16> r;
        r.Q = (const att::bf16*)CQ + ((size_t)bh * SEQ + qb * 256) * 128; r.K = (const att::bf16*)CK + (size_t)bh * NMEM * 128; r.V = (const att::bf16*)CV + (size_t)bh * NMEM * 128;
        r.O = (att::bf16*)OX + ((size_t)b * SEQ + qb * 256) * XW + h * 128; r.SS = nullptr; r.P0 = 1 << 16;
        att::Seam<att::bf16> S;
        att::causal_swa_prime<att::bf16, att::bf16>(r, 1 << 20, (char*)lds_raw, S);
        att::causal_swa_block<att::bf16, att::bf16, XW, false>(r, r, NMEM, 1 << 20, (char*)lds_raw, S, -1);
        VM_WAIT(); __syncthreads();
    }
    GSYNC();
    }

    for (int rep = 0; rep < 1 + ((REP >> 6) & 1); ++rep) {
    if (PH & 64) {
        pg8::Gemm g{OX, WCO, M, DM, XW, XW, XW}; pg8::StaticOrder S; S.init(M, DM, G, c);
        pg8::EpiRes<false> E{0, nullptr, X1B, nullptr, X2B, SSQ2, nullptr, nullptr};
        pg8::gemm_phase<pg8::EpiRes<false>, pg8::StaticOrder, true, true>(lds, g, S, E);
    }
    GSYNC();
    }

    for (int rep = 0; rep < 1 + ((REP >> 7) & 1); ++rep) {
    if (PH & 128) {
        pg8::Gemm g{X2B, WGU, M, 2 * FFN, DM, DM, DM}; pg8::StaticOrder S; S.init(M, 2 * FFN, G, c);
        pg8::EpiGu E{0, H, SSQ2, red};
        pg8::gemm_phase<pg8::EpiGu, pg8::StaticOrder, true, true>(lds, g, S, E);
    }
    GSYNC();
    }

    if (PH & 256) {
        pg8::Gemm g{H, WDN, M, DM, FFN, FFN, FFN}; pg8::StaticOrder S; S.init(M, DM, G, c);
        pg8::EpiRes<false> E{0, nullptr, X2B, a.out, nullptr, nullptr, nullptr, nullptr};
        pg8::gemm_phase<pg8::EpiRes<false>, pg8::StaticOrder, true, true>(lds, g, S, E);
    }
}

#undef WIN
#undef WOUT
#undef WCQ
#undef WCKV
#undef WCO
#undef WGU
#undef WDN
#undef WLRU
#undef XN
#undef MN
#undef Qh
#undef Kh
#undef Vh
#undef U
#undef GG
#undef UC
#undef LF
#undef CK
#undef CV
#undef MIX
#undef SSQF
#undef SSQL
#undef X1
#undef X1B
#undef SSQ1
#undef CQ
#undef OX
#undef X2B
#undef SSQ2
#undef H
#undef HL
#undef AC
#undef ENDH
#undef ENDA
#undef red
extern "C" void kernel_launch(void* const* d_in, const int* in_sizes, int n_in, void* d_out, int out_size, void* d_ws, size_t ws_size, hipStream_t stream) {
    static int grid = 0;
    if (grid == 0) {
        if (n_in != 27 || in_sizes[0] != M * DM || out_size != M * DM || ws_size < WS_END) { fprintf(stderr, "kernel_launch: unexpected shapes (n_in %d, in0 %d, out %d, ws %zu)\n", n_in, n_in > 0 ? in_sizes[0] : -1, out_size, ws_size); grid = -1; return; }
        int dev = 0, cus = 0, per_cu = 0;
        (void)hipGetDevice(&dev); (void)hipDeviceGetAttribute(&cus, hipDeviceAttributeMultiprocessorCount, dev);
        if (hipFuncSetAttribute((const void*)hymba_fwd, hipFuncAttributeMaxDynamicSharedMemorySize, LDS_BYTES) != hipSuccess) { fprintf(stderr, "kernel_launch: hipFuncSetAttribute failed\n"); grid = -1; return; }
        if (hipOccupancyMaxActiveBlocksPerMultiprocessor(&per_cu, (const void*)hymba_fwd, NTHR, LDS_BYTES) != hipSuccess || per_cu < 1) { fprintf(stderr, "kernel_launch: occupancy query says %d\n", per_cu); per_cu = 1; }
        (void)hipGetLastError();
        grid = cus * per_cu;
    }
    if (grid < 0) return;
    Args a{};
    for (int i = 0; i < 27; ++i) a.in[i] = (const float*)d_in[i];
    a.out = (float*)d_out; a.ws = (unsigned char*)d_ws;
    if (hipMemsetAsync(d_ws, 0, 16384, stream) != hipSuccess) { fprintf(stderr, "kernel_launch: memset of the barrier words failed\n"); return; }
    void* args[] = {&a};
    hipError_t e = hipLaunchCooperativeKernel((const void*)hymba_fwd, dim3(grid), dim3(NTHR), args, LDS_BYTES, stream);
    if (e != hipSuccess) fprintf(stderr, "cooperative launch failed: %s (grid %d)\n", hipGetErrorString(e), grid);
}
```

```cpp
#include <hip/hip_runtime.h>
#include <hip/hip_bf16.h>
#include <hip/hip_cooperative_groups.h>
#include <cstdio>
#include <cstdint>
namespace cg = cooperative_groups;


template <int K> __device__ __forceinline__ float shx(float v) { static_assert(K < 32, "use sum32"); return __int_as_float(__builtin_amdgcn_ds_swizzle(__float_as_int(v), (K << 10) | 0x1f)); }
__device__ __forceinline__ float sum32(float v) { auto rr = __builtin_amdgcn_permlane32_swap(__float_as_uint(v), __float_as_uint(v), false, false); return __uint_as_float(rr[0]) + __uint_as_float(rr[1]); }
constexpr int WTAB_OFF = 147456 - 256, XBST_OFF = 147456 - 512;
__device__ __forceinline__ int hw_slot() { return (int)(__builtin_amdgcn_s_getreg((5 << 11) | 4) & 63u); }
__device__ __forceinline__ int my_tid() {
    const int slot = hw_slot();
    const int wave = __builtin_amdgcn_readfirstlane(*(volatile __attribute__((address_space(3))) int*)(unsigned)(WTAB_OFF + slot * 4));
    int l; asm volatile("v_mbcnt_lo_u32_b32 %0, -1, 0\n\tv_mbcnt_hi_u32_b32 %0, -1, %0" : "=v"(l));
    return wave * 64 + l;
}
namespace pg8 {
#define PG8_LAS __attribute__((address_space(3)))
typedef unsigned short bf16_t;
typedef short bf16x8 __attribute__((ext_vector_type(8)));
typedef float f32x4 __attribute__((ext_vector_type(4)));
typedef unsigned u32x4 __attribute__((ext_vector_type(4)));
constexpr int BM = 256, BK = 64, HALF = 128, HTB = HALF * BK * 2  , STAGE_BYTES = 8 * HTB, NXCD = 8, WGM = 8;

__host__ __device__ __forceinline__ int lds_byte(int r, int c) { const int st = (r >> 4) * 2 + (c >> 5), rr = r & 15, cc = c & 31, ob = rr * 64 + cc * 2; return st * 1024 + (ob ^ (((ob >> 9) & 1) << 5)); }
__host__ __device__ __forceinline__ void stage_rc(int b, int& R, int& C) { const int st = b / 1024, sb = b % 1024, swz = sb ^ (((sb >> 9) & 1) << 5); R = (st >> 1) * 16 + swz / 64; C = (st & 1) * 32 + (swz % 64) / 2; }
__host__ __device__ __forceinline__ int perm32(int rho) { const int n = rho >> 4, i = rho & 15; return 8 * (i >> 2) + 4 * n + (i & 3); }

struct Unit { int pm, pn; };
struct Gemm { const bf16_t* A; const bf16_t* Bt; int M, N, K, lda, ldb; };

struct StaticOrder {
    int nM, nN, nwg, G, c;
    __host__ __device__ void init(int M, int N, int G_, int c_) { nM = M / BM; nN = N / BM; nwg = nM * nN; G = G_; c = c_; }
    __host__ __device__ bool next(int i, Unit& u) const {
        const long L = (long)i * G + c; if (L >= nwg) return false;
        int wgid = (int)L; { const int q = nwg / NXCD, r = nwg % NXCD, xcd = wgid % NXCD, off = wgid / NXCD; wgid = (xcd < r ? xcd * (q + 1) : r * (q + 1) + (xcd - r) * q) + off; }
        const int nig = WGM * nN, gid = wgid / nig, fm = gid * WGM, gsz = (nM - fm) < WGM ? (nM - fm) : WGM;
        u.pm = fm + ((wgid % nig) % gsz); u.pn = (wgid % nig) / gsz; return true;
    }
    __device__ __forceinline__ void a_ready(const Unit&) const {}
    __device__ __forceinline__ void done(const Unit&) const {}
};

__device__ __forceinline__ unsigned cvt_pk_bf16(float lo, float hi) { unsigned r; asm volatile("v_cvt_pk_bf16_f32 %0, %1, %2" : "=v"(r) : "v"(lo), "v"(hi)); return r; }

typedef float f32x2 __attribute__((ext_vector_type(2)));
constexpr float RMS_EPS = 1e-6f;
struct OneUnit {
    __device__ __forceinline__ bool next(int i, Unit& u) const { if (i != 0) return false; u.pm = 0; u.pn = 0; return true; }
    __device__ __forceinline__ void a_ready(const Unit&) const {}
    __device__ __forceinline__ void done(const Unit&) const {}
};
struct OffsetOrder {
    StaticOrder S;
    __device__ __forceinline__ bool next(int i, Unit& u) const { return S.next(i, u); }
    __device__ __forceinline__ void a_ready(const Unit&) const {}
    __device__ __forceinline__ void done(const Unit&) const {}
};
__device__ __forceinline__ float fast_log1p(float x) { const float sr = x * (1.0f - x * (0.5f - x * (0.33333334f - x * (0.25f - x * (0.2f - x * 0.16666667f))))); return x < 0.0625f ? sr : __logf(1.0f + x); }
__device__ __forceinline__ float sigmoidf_(float x) { return __builtin_amdgcn_rcpf(1.0f + __expf(-x)); }
__device__ __forceinline__ float gelu_tanh(float x) { const float u = 0.7978845608028654f * (x + 0.044715f * x * x * x); return x * sigmoidf_(2.0f * u); }
__device__ __forceinline__ float sum_f(const float* p, int n4) { float s = 0.f; for (int i = 0; i < n4; ++i) { const f32x4 v = *(const f32x4*)(p + 4 * i); s += (v[0] + v[1]) + (v[2] + v[3]); } return s; }
__device__ __forceinline__ u32x4 pack8(const f32x4& a, const f32x4& b) { u32x4 w; w.x = cvt_pk_bf16(a[0], a[1]); w.y = cvt_pk_bf16(a[2], a[3]); w.z = cvt_pk_bf16(b[0], b[1]); w.w = cvt_pk_bf16(b[2], b[3]); return w; }

template <int ACT  >
__device__ __forceinline__ void store_tile(const f32x4 (&acc)[2][2][4][2], bf16_t* d0, bf16_t* d1, size_t ld, int wr, int wc, int fr, int fq) {
#pragma unroll
    for (int ai = 0; ai < 2; ++ai)
#pragma unroll
        for (int m = 0; m < 4; ++m) { const size_t ro = (size_t)(ai * HALF + wr * 64 + m * 16 + fr) * ld + wc * 32 + fq * 8;
#pragma unroll
            for (int bj = 0; bj < 2; ++bj) { f32x4 v0 = acc[ai][bj][m][0], v1 = acc[ai][bj][m][1];
                if (ACT == 1) {
#pragma unroll
                    for (int j = 0; j < 4; ++j) { v0[j] = gelu_tanh(v0[j]); v1[j] = gelu_tanh(v1[j]); } }
                *(u32x4*)((bj ? d1 : d0) + ro) = pack8(v0, v1); } }
}
template <bool ROWSCALE>
__device__ __forceinline__ void head_norm_store(const f32x4 (&acc)[2][2][4][2], const float (&rs)[2][4], const float* gain, bf16_t* d0, bf16_t* d1, PG8_LAS float* red, int wr, int wc, int fr, int fq) {
#pragma unroll
    for (int ai = 0; ai < 2; ++ai)
#pragma unroll
        for (int m = 0; m < 4; ++m)
#pragma unroll
            for (int bj = 0; bj < 2; ++bj) { float s = 0.f;
#pragma unroll
                for (int n = 0; n < 2; ++n) { f32x4 v = acc[ai][bj][m][n]; if (ROWSCALE) v = v * rs[ai][m]; s += (v[0] * v[0] + v[1] * v[1]) + (v[2] * v[2] + v[3] * v[3]); }
                s += shx<16>(s); s = sum32(s);
                if (fq == 0) red[((ai * HALF + wr * 64 + m * 16 + fr) * 2 + bj) * 4 + wc] = s; }
    asm volatile("s_waitcnt lgkmcnt(0)" ::: "memory"); __builtin_amdgcn_s_barrier(); asm volatile("" ::: "memory");
    const f32x4 g0 = *(const f32x4*)(gain + wc * 32 + fq * 8), g1 = *(const f32x4*)(gain + wc * 32 + fq * 8 + 4);
#pragma unroll
    for (int ai = 0; ai < 2; ++ai)
#pragma unroll
        for (int m = 0; m < 4; ++m) { const int rl = ai * HALF + wr * 64 + m * 16 + fr;
#pragma unroll
            for (int bj = 0; bj < 2; ++bj) { const PG8_LAS float* rp = red + (rl * 2 + bj) * 4;
                const float ss = (rp[0] + rp[1]) + (rp[2] + rp[3]);
                float sc = __builtin_amdgcn_rsqf(ss * (1.0f / 128.0f) + RMS_EPS); if (ROWSCALE) sc *= rs[ai][m];
                const f32x4 v0 = acc[ai][bj][m][0] * sc * g0, v1 = acc[ai][bj][m][1] * sc * g1;
                *(u32x4*)((bj ? d1 : d0) + (size_t)rl * 128 + wc * 32 + fq * 8) = pack8(v0, v1); } }
}

struct EpiIn {
    static constexpr bool PERM = true, AFTER_DRAIN = false, HAS_MID = false; int mid_t;
    bf16_t *Q, *Kh, *V, *U, *GG; float* LF; const float *g_q, *g_k, *b_f; PG8_LAS float* red;
    __device__ __forceinline__ void operator()(const f32x4 (&acc)[2][2][4][2], const Unit& u, int wr, int wc, int fr, int fq) const {
        asm volatile("" : "+v"(fr), "+v"(fq));
        const int pn = u.pn, row0 = u.pm * BM, b = row0 >> 11, s0 = row0 & 2047;
        if (pn < 12) {
            const int h0 = (pn & 3) * 2; bf16_t* const q_ = Q; bf16_t* const k_ = Kh; bf16_t* const v_ = V; const float* const gq_ = g_q; const float* const gk_ = g_k;
            bf16_t* base = pn < 4 ? q_ : (pn < 8 ? k_ : v_);
            bf16_t* d0 = base + ((size_t)(b * 8 + h0) * 2048 + s0) * 128; bf16_t* d1 = d0 + (size_t)2048 * 128;
            if (pn < 8) { float rs[2][4]; head_norm_store<false>(acc, rs, pn < 4 ? gq_ : gk_, d0, d1, red, wr, wc, fr, fq); }
            else store_tile<0>(acc, d0, d1, 128, wr, wc, fr, fq);
        } else if (pn < 16) { bf16_t* const u_ = U; bf16_t* d0 = u_ + (size_t)row0 * 1024 + (pn - 12) * 256; store_tile<0>(acc, d0, d0 + 128, 1024, wr, wc, fr, fq); }
        else if (pn < 20) { bf16_t* const g_ = GG; bf16_t* d0 = g_ + (size_t)row0 * 1024 + (pn - 16) * 256; store_tile<1>(acc, d0, d0 + 128, 1024, wr, wc, fr, fq); }
        else if (wc == 0 && fq == 0) {
            const f32x4 b0 = *(const f32x4*)b_f, b1 = *(const f32x4*)(b_f + 4);
#pragma unroll
            for (int ai = 0; ai < 2; ++ai)
#pragma unroll
                for (int m = 0; m < 4; ++m) { const int row = row0 + ai * HALF + wr * 64 + m * 16 + fr; f32x4 z0 = acc[ai][0][m][0] + b0, z1 = acc[ai][0][m][1] + b1;
#pragma unroll
                    for (int j = 0; j < 4; ++j) { z0[j] = fminf(z0[j], 0.f) - fast_log1p(__expf(-fabsf(z0[j]))); z1[j] = fminf(z1[j], 0.f) - fast_log1p(__expf(-fabsf(z1[j]))); }
                    *(f32x4*)(LF + (size_t)row * 8) = z0; *(f32x4*)(LF + (size_t)row * 8 + 4) = z1; }
        }
    }
};
struct EpiCkv {
    static constexpr bool PERM = true, AFTER_DRAIN = false, HAS_MID = false; int mid_t;
    bf16_t *CK, *CV; const float* g_ck; PG8_LAS float* red;
    __device__ __forceinline__ void operator()(const f32x4 (&acc)[2][2][4][2], const Unit& u, int wr, int wc, int fr, int fq) const {
        asm volatile("" : "+v"(fr), "+v"(fq));
        const int pn = u.pn, b = u.pm, h0 = (pn & 1) * 2;
        bf16_t* const ck_ = CK; bf16_t* const cv_ = CV; bf16_t* d0 = (pn < 2 ? ck_ : cv_) + ((size_t)(b * 4 + h0) * 256) * 128; bf16_t* d1 = d0 + (size_t)256 * 128;
        if (pn < 2) { float rs[2][4]; head_norm_store<false>(acc, rs, g_ck, d0, d1, red, wr, wc, fr, fq); }
        else store_tile<0>(acc, d0, d1, 128, wr, wc, fr, fq);
    }
};
struct EpiCq {
    static constexpr bool PERM = true, AFTER_DRAIN = false, HAS_MID = false; int mid_t;
    bf16_t* CQ; const float* g_cq; const float* SSQ; PG8_LAS float* red;
    __device__ __forceinline__ void operator()(const f32x4 (&acc)[2][2][4][2], const Unit& u, int wr, int wc, int fr, int fq) const {
        asm volatile("" : "+v"(fr), "+v"(fq));
        const int pn = u.pn, row0 = u.pm * BM, b = row0 >> 11, s0 = row0 & 2047, h0 = pn * 2, tid = (wr * 4 + wc) * 64 + fq * 16 + fr;
        PG8_LAS float* tab = red + 2048;
        if (tid < 256) tab[tid] = __builtin_amdgcn_rsqf(sum_f(SSQ + (size_t)(row0 + tid) * 32, 8) * (1.0f / 2048.0f) + RMS_EPS);
        asm volatile("s_waitcnt lgkmcnt(0)" ::: "memory"); __builtin_amdgcn_s_barrier(); asm volatile("" ::: "memory");
        float rs[2][4];
#pragma unroll
        for (int ai = 0; ai < 2; ++ai)
#pragma unroll
            for (int m = 0; m < 4; ++m) rs[ai][m] = tab[ai * HALF + wr * 64 + m * 16 + fr];
        bf16_t* d0 = CQ + ((size_t)(b * 4 + h0) * 2048 + s0) * 128; bf16_t* d1 = d0 + (size_t)2048 * 128;
        head_norm_store<true>(acc, rs, g_cq, d0, d1, red, wr, wc, fr, fq);
    }
};
template <bool MID> struct EpiRes {
    static constexpr bool PERM = true, AFTER_DRAIN = false, HAS_MID = MID; int mid_t;
    const float* resid; const bf16_t* residb; float* outf; bf16_t* outb; float* ssq_out; const float *ssqf, *ssql;
    __device__ __forceinline__ void mid(f32x4 (&acc)[2][2][4][2], const Unit& u, int wr, int wc, int fr, int fq) const {
        asm volatile("" : "+v"(fr), "+v"(fq));
#pragma unroll
        for (int ai = 0; ai < 2; ++ai)
#pragma unroll
            for (int m = 0; m < 4; ++m) { const size_t row = (size_t)u.pm * BM + ai * HALF + wr * 64 + m * 16 + fr;
                const float rf = __builtin_amdgcn_rsqf(sum_f(ssqf + row * 8, 2) * (1.0f / 1024.0f) + RMS_EPS), rl = __builtin_amdgcn_rsqf(sum_f(ssql + row * 8, 2) * (1.0f / 1024.0f) + RMS_EPS);
                const float ratio = rf / rl;
#pragma unroll
                for (int bj = 0; bj < 2; ++bj)
#pragma unroll
                    for (int n = 0; n < 2; ++n) acc[ai][bj][m][n] = acc[ai][bj][m][n] * ratio;
                __builtin_amdgcn_sched_barrier(0); }
    }
    __device__ __forceinline__ void operator()(const f32x4 (&acc)[2][2][4][2], const Unit& u, int wr, int wc, int fr, int fq) const {
        asm volatile("" : "+v"(fr), "+v"(fq));
#pragma unroll
        for (int ai = 0; ai < 2; ++ai)
#pragma unroll
            for (int m = 0; m < 4; ++m) { const size_t row = (size_t)u.pm * BM + ai * HALF + wr * 64 + m * 16 + fr;
                float sc = 1.f; if (MID) sc = __builtin_amdgcn_rsqf(sum_f(ssql + row * 8, 2) * (1.0f / 1024.0f) + RMS_EPS);
                float ss = 0.f;
#pragma unroll
                for (int bj = 0; bj < 2; ++bj) { const size_t o = row * 2048 + u.pn * BM + bj * HALF + wc * 32 + fq * 8;
                    f32x4 r0, r1;
                    if (residb) { const u32x4 w = *(const u32x4*)(residb + o); r0 = (f32x4){__uint_as_float(w.x << 16), __uint_as_float(w.x & 0xffff0000u), __uint_as_float(w.y << 16), __uint_as_float(w.y & 0xffff0000u)};
                                  r1 = (f32x4){__uint_as_float(w.z << 16), __uint_as_float(w.z & 0xffff0000u), __uint_as_float(w.w << 16), __uint_as_float(w.w & 0xffff0000u)}; }
                    else { r0 = *(const f32x4*)(resid + o); r1 = *(const f32x4*)(resid + o + 4); }
                    const f32x4 v0 = r0 + acc[ai][bj][m][0] * sc, v1 = r1 + acc[ai][bj][m][1] * sc;
                    if (outf) { *(f32x4*)(outf + o) = v0; *(f32x4*)(outf + o + 4) = v1; }
                    ss += (v0[0] * v0[0] + v0[1] * v0[1]) + (v0[2] * v0[2] + v0[3] * v0[3]) + (v1[0] * v1[0] + v1[1] * v1[1]) + (v1[2] * v1[2] + v1[3] * v1[3]);
                    if (outb) *(u32x4*)(outb + o) = pack8(v0, v1); }
                if (ssq_out) { ss += shx<16>(ss); ss = sum32(ss); if (fq == 0) ssq_out[row * 32 + u.pn * 4 + wc] = ss; }
                __builtin_amdgcn_sched_barrier(0); }
    }
};
struct EpiGu {
    static constexpr bool PERM = true, AFTER_DRAIN = false, HAS_MID = false; int mid_t;
    bf16_t* H; const float* SSQ; PG8_LAS float* red;
    __device__ __forceinline__ void operator()(const f32x4 (&acc)[2][2][4][2], const Unit& u, int wr, int wc, int fr, int fq) const {
        asm volatile("" : "+v"(fr), "+v"(fq));
        const int tid = (wr * 4 + wc) * 64 + fq * 16 + fr; PG8_LAS float* tab = red + 2048;
        if (tid < 256) tab[tid] = __builtin_amdgcn_rsqf(sum_f(SSQ + ((size_t)u.pm * BM + tid) * 32, 8) * (1.0f / 2048.0f) + RMS_EPS);
        asm volatile("s_waitcnt lgkmcnt(0)" ::: "memory"); __builtin_amdgcn_s_barrier(); asm volatile("" ::: "memory");
#pragma unroll
        for (int ai = 0; ai < 2; ++ai)
#pragma unroll
            for (int m = 0; m < 4; ++m) { const size_t row = (size_t)u.pm * BM + ai * HALF + wr * 64 + m * 16 + fr;
                const float rs = tab[ai * HALF + wr * 64 + m * 16 + fr];
                f32x4 h[2];
#pragma unroll
                for (int n = 0; n < 2; ++n) { const f32x4 g = acc[ai][0][m][n] * rs, up = acc[ai][1][m][n] * rs;
#pragma unroll
                    for (int j = 0; j < 4; ++j) h[n][j] = g[j] * sigmoidf_(g[j]) * up[j]; }
                *(u32x4*)(H + row * 5632 + u.pn * HALF + wc * 32 + fq * 8) = pack8(h[0], h[1]); }
    }
};
struct EpiLru {
    static constexpr bool PERM = true, AFTER_DRAIN = true, HAS_MID = false; int mid_t;
    const bf16_t* UC; bf16_t* HL; bf16_t* AC; float* ENDH; float* ENDA; const float *b_ra, *b_ri, *lam; int row0, nblk;
    __device__ __forceinline__ void fused(f32x4 (&acc)[2][2][4][2], const Unit&, int wr, int wc, int fr, int fq, PG8_LAS unsigned char* lds, int wid, int lane) const {
        asm volatile("" : "+v"(fr), "+v"(fq));
        PG8_LAS float* LA = (PG8_LAS float*)lds; PG8_LAS float* LB = LA + 128 * 132;
        const int tid = wid * 64 + lane, ch0 = nblk * 128 + wc * 32 + fq * 8;
        float hc = 0.f, ac = 1.f;
#pragma unroll
        for (int ai = 0; ai < 2; ++ai) {
#pragma unroll
            for (int n = 0; n < 2; ++n) {
                const f32x4 bra = *(const f32x4*)(b_ra + ch0 + 4 * n), bri = *(const f32x4*)(b_ri + ch0 + 4 * n), lm = *(const f32x4*)(lam + ch0 + 4 * n); f32x4 sp;
#pragma unroll
                for (int j = 0; j < 4; ++j) sp[j] = -8.0f * fast_log1p(__expf(-lm[j]));
#pragma unroll
                for (int m = 0; m < 4; ++m) { const int rl = wr * 64 + m * 16 + fr; const unsigned grow = (unsigned)(row0 + ai * HALF + rl);
                    const f32x2 ucw = *(const f32x2*)((const char*)UC + (grow * 1024u + ch0 + 4 * n) * 2u); f32x4 av, bv;
#pragma unroll
                    for (int j = 0; j < 4; ++j) { const unsigned w = __float_as_uint(ucw[j >> 1]); const float uc = __uint_as_float((j & 1) ? (w & 0xffff0000u) : (w << 16));
                        const float r = sigmoidf_(acc[ai][0][m][n][j] + bra[j]), ig = sigmoidf_(acc[ai][1][m][n][j] + bri[j]);
                        const float la = r * sp[j], a_ = __expf(la); av[j] = a_; bv[j] = __builtin_amdgcn_sqrtf(fmaxf(fmaf(-a_, a_, 1.0f), 0.f)) * ig * uc; }
                    *(PG8_LAS f32x4*)(LA + rl * 132 + wc * 32 + fq * 8 + 4 * n) = av; *(PG8_LAS f32x4*)(LB + rl * 132 + wc * 32 + fq * 8 + 4 * n) = bv;
                    __builtin_amdgcn_sched_barrier(0); } }
            asm volatile("s_waitcnt lgkmcnt(0)" ::: "memory"); __builtin_amdgcn_s_barrier(); asm volatile("" ::: "memory");
            if (tid < 128) {
#pragma unroll 8
                for (int rl = 0; rl < 128; ++rl) { const float a_ = LA[rl * 132 + tid]; hc = a_ * hc + LB[rl * 132 + tid]; ac *= a_; LB[rl * 132 + tid] = hc; LA[rl * 132 + tid] = ac; }
                if (ai == 1) { ENDH[nblk * 128 + tid] = hc; ENDA[nblk * 128 + tid] = ac; } }
            asm volatile("s_waitcnt lgkmcnt(0)" ::: "memory"); __builtin_amdgcn_s_barrier(); asm volatile("" ::: "memory");
            const int c8 = (tid & 15) * 8;
#pragma unroll
            for (int p = 0; p < 4; ++p) { const int rl = p * 32 + (tid >> 4); const unsigned o = ((unsigned)(row0 + ai * HALF + rl) * 1024u + nblk * 128 + c8) * 2u;
                const f32x4 h0 = *(const PG8_LAS f32x4*)(LB + rl * 132 + c8), h1 = *(const PG8_LAS f32x4*)(LB + rl * 132 + c8 + 4);
                const f32x4 a0 = *(const PG8_LAS f32x4*)(LA + rl * 132 + c8), a1 = *(const PG8_LAS f32x4*)(LA + rl * 132 + c8 + 4);
                *(u32x4*)((char*)HL + o) = pack8(h0, h1); *(u32x4*)((char*)AC + o) = pack8(a0, a1); }
            asm volatile("s_waitcnt lgkmcnt(0)" ::: "memory"); __builtin_amdgcn_s_barrier(); asm volatile("" ::: "memory");
        }
    }
};
template <class Epi, class Sched, bool ALIGN_EPI = false, bool SP2 = false>
__device__ __forceinline__ void gemm_phase(PG8_LAS unsigned char* lds, const Gemm g, const Sched& S, const Epi& E) {
    int tid_ = my_tid();
    const int tid = tid_, wid = __builtin_amdgcn_readfirstlane(tid >> 6), lane = tid & 63, wr = wid >> 2, wc = wid & 3, fr = lane & 15, fq = lane >> 4;
    const int K = g.K, nt = K / BK;
    unsigned voffA[2], voffB[2];
#pragma unroll
    for (int i = 0; i < 2; ++i) { int R, C; stage_rc(tid * 16 + i * 8192, R, C); const int Rb = Epi::PERM ? ((R & ~31) + perm32(R & 31)) : R;
        voffA[i] = (unsigned)(R * g.lda + C) * 2u; voffB[i] = (unsigned)(Rb * g.ldb + C) * 2u; }
    const size_t kstep = (size_t)(BK * 2);
    const size_t hstepA = (size_t)HALF * g.lda * 2, hstepB = (size_t)HALF * g.ldb * 2;
    const size_t tstepA = 2 * hstepA, tstepB = 2 * hstepB;
    const unsigned ldsw = (unsigned)wid * 1024u;
    const int aoff = lds_byte(wr * 64 + fr, fq * 8), boff = lds_byte(wc * 32 + fr, fq * 8);
#define PG8_SA(b, h) (((b) * 2 + (h)) * HTB)
#define PG8_SB(b, h) ((4 + (b) * 2 + (h)) * HTB)
#define PG8_STAGE(bufoff, gbase, voff) do { _Pragma("unroll") for (int _i = 0; _i < 2; ++_i) \
        __builtin_amdgcn_global_load_lds((const unsigned*)((const char*)(gbase) + (voff)[_i]), (PG8_LAS unsigned*)(lds + (bufoff) + ldsw + _i * 8192), 16, 0, 0); } while (0)
#define PG8_LDA(dst, b, h) do { _Pragma("unroll") for (int m = 0; m < 4; ++m) _Pragma("unroll") for (int k = 0; k < 2; ++k) dst[m][k] = *(const PG8_LAS bf16x8*)(lds + PG8_SA(b, h) + aoff + m * 2048 + k * 1024); } while (0)
#define PG8_LDB(dst, b, h) do { _Pragma("unroll") for (int n = 0; n < 2; ++n) _Pragma("unroll") for (int k = 0; k < 2; ++k) dst[n][k] = *(const PG8_LAS bf16x8*)(lds + PG8_SB(b, h) + boff + n * 2048 + k * 1024); } while (0)
#define PG8_MMA(ai, bj, At, Bt) do { __builtin_amdgcn_s_setprio(1); _Pragma("unroll") for (int m = 0; m < 4; ++m) _Pragma("unroll") for (int n = 0; n < 2; ++n) _Pragma("unroll") for (int k = 0; k < 2; ++k) \
        acc[ai][bj][m][n] = __builtin_amdgcn_mfma_f32_16x16x32_bf16(Bt[n][k], At[m][k], acc[ai][bj][m][n], 0, 0, 0); __builtin_amdgcn_s_setprio(0); } while (0)
#define PG8_WAIT_V(n) asm volatile("s_waitcnt vmcnt(" #n ")" ::: "memory")
#define PG8_WAIT_L(n) asm volatile("s_waitcnt lgkmcnt(" #n ")" ::: "memory")
#define PG8_BAR __builtin_amdgcn_s_barrier()
#define PG8_SCHED __builtin_amdgcn_sched_barrier(0)
    Unit cur, nxt; int ui = 0;
    if (!S.next(0, cur)) return;
    f32x4 acc[2][2][4][2];
#pragma unroll
    for (int a = 0; a < 2; ++a)
#pragma unroll
        for (int b = 0; b < 2; ++b)
#pragma unroll
            for (int m = 0; m < 4; ++m)
#pragma unroll
                for (int n = 0; n < 2; ++n) acc[a][b][m][n] = (f32x4){0.f, 0.f, 0.f, 0.f};
    bf16x8 At[4][2], B0[2][2], B1[2][2];
    const char* cA = (const char*)g.A + (size_t)cur.pm * tstepA; const char* cB = (const char*)g.Bt + (size_t)cur.pn * tstepB;
    S.a_ready(cur);
    if constexpr (SP2) {
        PG8_STAGE(PG8_SB(0, 0), cB, voffB); PG8_STAGE(PG8_SB(0, 1), cB + hstepB, voffB); PG8_STAGE(PG8_SA(0, 0), cA, voffA); PG8_STAGE(PG8_SA(0, 1), cA + hstepA, voffA);
        if (wr == 1) PG8_BAR;
        PG8_WAIT_V(2); PG8_BAR;
        PG8_STAGE(PG8_SB(1, 0), cB + kstep, voffB); PG8_STAGE(PG8_SA(1, 0), cA + kstep, voffA); PG8_STAGE(PG8_SB(1, 1), cB + hstepB + kstep, voffB);
        PG8_WAIT_V(6); PG8_BAR;
    } else {
        PG8_STAGE(PG8_SB(0, 0), cB, voffB); PG8_STAGE(PG8_SA(0, 0), cA, voffA); PG8_STAGE(PG8_SB(0, 1), cB + hstepB, voffB); PG8_STAGE(PG8_SA(0, 1), cA + hstepA, voffA);
        if (wr == 1) PG8_BAR;
        PG8_WAIT_V(4); PG8_BAR;
        PG8_STAGE(PG8_SB(1, 0), cB + kstep, voffB); PG8_STAGE(PG8_SA(1, 0), cA + kstep, voffA); PG8_STAGE(PG8_SB(1, 1), cB + hstepB + kstep, voffB);
        PG8_WAIT_V(6); PG8_BAR;
    }
    for (;;) {
        const bool has_next = S.next(ui + 1, nxt);
        const char* nA = has_next ? (const char*)g.A + (size_t)nxt.pm * tstepA : cA; const char* nB = has_next ? (const char*)g.Bt + (size_t)nxt.pn * tstepB : cB;
        for (int t = 0; t < nt; t += 2) {
            const bool last = (t == nt - 2);
            if constexpr (Epi::HAS_MID) { if (t == E.mid_t) E.mid(acc, cur, wr, wc, fr, fq); }
            const char* a1 = cA + (size_t)(t + 1) * kstep;
            const char* a2 = last ? nA : cA + (size_t)(t + 2) * kstep; const char* b2 = last ? nB : cB + (size_t)(t + 2) * kstep;
            const char* a3 = a2 + kstep; const char* b3 = b2 + kstep;
            if (last && has_next) S.a_ready(nxt);
            if constexpr (SP2) {
            PG8_LDB(B0, 0, 0); PG8_LDB(B1, 0, 1); PG8_SCHED; PG8_LDA(At, 0, 0); PG8_STAGE(PG8_SA(1, 1), a1 + hstepA, voffA);
            PG8_WAIT_V(8); PG8_WAIT_L(0); PG8_BAR; PG8_MMA(0, 0, At, B0); PG8_MMA(0, 1, At, B1); PG8_BAR; PG8_SCHED;
            PG8_LDA(At, 0, 1); PG8_STAGE(PG8_SB(0, 0), b2, voffB); PG8_STAGE(PG8_SB(0, 1), b2 + hstepB, voffB); PG8_STAGE(PG8_SA(0, 0), a2, voffA);
            PG8_WAIT_V(8); PG8_WAIT_L(0); PG8_BAR; PG8_MMA(1, 0, At, B0); PG8_MMA(1, 1, At, B1); PG8_BAR; PG8_SCHED;
            PG8_LDB(B0, 1, 0); PG8_LDB(B1, 1, 1); PG8_SCHED; PG8_LDA(At, 1, 0); PG8_STAGE(PG8_SA(0, 1), a2 + hstepA, voffA);
            PG8_WAIT_V(8); PG8_WAIT_L(0); PG8_BAR; PG8_MMA(0, 0, At, B0); PG8_MMA(0, 1, At, B1); PG8_BAR; PG8_SCHED;
            PG8_LDA(At, 1, 1); PG8_STAGE(PG8_SB(1, 0), b3, voffB); PG8_STAGE(PG8_SB(1, 1), b3 + hstepB, voffB); PG8_STAGE(PG8_SA(1, 0), a3, voffA);
            PG8_WAIT_V(8); PG8_WAIT_L(0); PG8_BAR; PG8_MMA(1, 0, At, B0); PG8_MMA(1, 1, At, B1); PG8_BAR; PG8_SCHED;
            } else {
            PG8_LDB(B0, 0, 0); PG8_SCHED; PG8_LDA(At, 0, 0); PG8_STAGE(PG8_SA(1, 1), a1 + hstepA, voffA);
            PG8_WAIT_L(8); PG8_BAR; PG8_WAIT_L(0); PG8_MMA(0, 0, At, B0); PG8_BAR; PG8_SCHED;
            PG8_LDB(B1, 0, 1); PG8_STAGE(PG8_SB(0, 0), b2, voffB);
            PG8_BAR; PG8_WAIT_L(0); PG8_MMA(0, 1, At, B1); PG8_BAR;
            PG8_LDA(At, 0, 1); PG8_STAGE(PG8_SA(0, 0), a2, voffA);
            PG8_BAR; PG8_WAIT_L(0); PG8_MMA(1, 0, At, B0); PG8_BAR; PG8_SCHED;
            PG8_STAGE(PG8_SB(0, 1), b2 + hstepB, voffB);
            PG8_WAIT_V(6); PG8_BAR; PG8_MMA(1, 1, At, B1); PG8_BAR;
            PG8_LDB(B0, 1, 0); PG8_SCHED; PG8_LDA(At, 1, 0); PG8_STAGE(PG8_SA(0, 1), a2 + hstepA, voffA);
            PG8_WAIT_L(8); PG8_BAR; PG8_WAIT_L(0); PG8_MMA(0, 0, At, B0); PG8_BAR; PG8_SCHED;
            PG8_LDB(B1, 1, 1); PG8_STAGE(PG8_SB(1, 0), b3, voffB);
            PG8_BAR; PG8_WAIT_L(0); PG8_MMA(0, 1, At, B1); PG8_BAR;
            PG8_LDA(At, 1, 1); PG8_STAGE(PG8_SA(1, 0), a3, voffA);
            PG8_BAR; PG8_WAIT_L(0); PG8_MMA(1, 0, At, B0); PG8_BAR; PG8_SCHED;
            PG8_STAGE(PG8_SB(1, 1), b3 + hstepB, voffB);
            PG8_WAIT_V(6); PG8_BAR; PG8_MMA(1, 1, At, B1); PG8_BAR;
            }
        }
        if constexpr (ALIGN_EPI) { if (wr == 0) PG8_BAR; }
        if constexpr (!Epi::AFTER_DRAIN) { E(acc, cur, wr, wc, fr, fq); S.done(cur); }
        if (!has_next) break;
#pragma unroll
        for (int a = 0; a < 2; ++a)
#pragma unroll
            for (int b = 0; b < 2; ++b)
#pragma unroll
                for (int m = 0; m < 4; ++m)
#pragma unroll
                    for (int n = 0; n < 2; ++n) acc[a][b][m][n] = (f32x4){0.f, 0.f, 0.f, 0.f};
        cur = nxt; cA = nA; cB = nB; ++ui;
        if constexpr (ALIGN_EPI) { if (wr == 1) PG8_BAR; }
    }
    PG8_WAIT_V(0);
    if constexpr (!ALIGN_EPI) { if (wr == 0) PG8_BAR; }
    PG8_BAR;
    if constexpr (Epi::AFTER_DRAIN) { E.fused(acc, cur, wr, wc, fr, fq, lds, wid, lane); S.done(cur); }
#undef PG8_SA
#undef PG8_SB
#undef PG8_STAGE
#undef PG8_LDA
#undef PG8_LDB
#undef PG8_MMA
#undef PG8_WAIT_V
#undef PG8_WAIT_L
#undef PG8_BAR
#undef PG8_SCHED
}
}
namespace att {
constexpr int D = 128;
constexpr float THR = 8.f;
constexpr bool WSKIP = false;
constexpr float SCALE = 0.08838834764831845f;
constexpr int NW = 8, QBLK = 32, KVBLK = 64, QB = NW * QBLK;
constexpr int SHM_V = KVBLK * D * 2, SHM_K = KVBLK * D * 2;
constexpr int LDS_BYTES = 2 * SHM_V + 2 * SHM_K + NW * 64 * 4;
using bf16 = __hip_bfloat16;
typedef short bf16x8 __attribute__((ext_vector_type(8)));
typedef short s16x4 __attribute__((ext_vector_type(4)));
typedef float f32x16 __attribute__((ext_vector_type(16)));
typedef float f32x4 __attribute__((ext_vector_type(4)));
typedef unsigned u32x4 __attribute__((ext_vector_type(4)));
template <class A, class Bt> struct same_t { static constexpr bool v = false; };
template <class A> struct same_t<A, A> { static constexpr bool v = true; };

#define KSWZ(row, colB) ((row) * 256 + ((colB) ^ (((row) & 7) << 4)))
#define SBAR() __builtin_amdgcn_sched_barrier(0)
__device__ __forceinline__ int v_st(int k, int c) { const int kk = (k & ~0xC) | ((k & 4) << 1) | ((k & 8) >> 1); return ((kk >> 3) * 4 + (c >> 5)) * 512 + ((kk & 7) * 32 + (c & 31)) * 2; }
__device__ __forceinline__ int v_rd_base(int lane) { return ((lane & 3) << 3) | (((lane >> 2) & 3) << 6) | (((lane >> 4) & 1) << 5) | (((lane >> 5) & 1) << 8); }
constexpr int v_rd_off(int d0, int ks, int half) { return d0 * 512 + ks * 4096 + half * 2048; }
__device__ __forceinline__ int crow(int r, int hi) { return (r & 3) + 8 * (r >> 2) + 4 * hi; }
__device__ __forceinline__ unsigned cvtpk(float lo, float hi) {
    unsigned r; asm volatile("v_cvt_pk_bf16_f32 %0, %1, %2" : "=v"(r) : "v"(lo), "v"(hi)); return r;
}
__device__ __forceinline__ bf16x8 pack8(f32x4 a, f32x4 b) {
    u32x4 w = {cvtpk(a[0], a[1]), cvtpk(a[2], a[3]), cvtpk(b[0], b[1]), cvtpk(b[2], b[3])};
    return *reinterpret_cast<bf16x8*>(&w);
}
template <class T> __device__ __forceinline__ bf16x8 load8(const T* p) {
    if constexpr (same_t<T, float>::v) { return pack8(*(const f32x4*)p, *(const f32x4*)(p + 4)); }
    else { return *reinterpret_cast<const bf16x8*>(p); }
}
__device__ __forceinline__ void mask_tile(f32x16& p0, f32x16& p1, int dq, unsigned W) {
    const float NEG = -__builtin_inff();
#pragma unroll
    for (int r = 0; r < 16; ++r) {
        const int c = (r & 3) + 8 * (r >> 2);
        if ((unsigned)(dq - c) >= W) p0[r] = NEG;
        if ((unsigned)(dq - c - 32) >= W) p1[r] = NEG;
    }
}
__device__ __forceinline__ void partialSM(f32x16& p0, f32x16& p1, float& m_reg, float& mn, float& alpha) {
    float pmax = p0[0]; for (int r = 1; r < 16; ++r) pmax = fmaxf(pmax, p0[r]); for (int r = 0; r < 16; ++r) pmax = fmaxf(pmax, p1[r]);
    { auto rr = __builtin_amdgcn_permlane32_swap(__float_as_uint(pmax), __float_as_uint(pmax), false, false);
      pmax = fmaxf(__uint_as_float(rr[0]), __uint_as_float(rr[1])); }
    constexpr float C2 = 1.4426950408889634f * SCALE;
    if (__builtin_expect(__all((pmax - m_reg) * SCALE <= THR), 1)) { mn = m_reg; alpha = 1.f; }
    else { mn = fmaxf(m_reg, pmax); alpha = __builtin_amdgcn_exp2f((m_reg - mn) * C2); m_reg = mn; }
    const float mnL = -mn * C2;
    for (int r = 0; r < 16; ++r) p0[r] = fmaf(p0[r], C2, mnL); for (int r = 0; r < 16; ++r) p1[r] = fmaf(p1[r], C2, mnL);
    for (int r = 0; r < 16; ++r) p0[r] = __builtin_amdgcn_exp2f(p0[r]);
}
__device__ __forceinline__ void finishSM(f32x16& p0, f32x16& p1, float alpha, float& l_reg, bf16x8& pa0, bf16x8& pa1, bf16x8& pa2, bf16x8& pa3) {
    for (int r = 0; r < 16; ++r) p1[r] = __builtin_amdgcn_exp2f(p1[r]);
    float ps = 0; for (int r = 0; r < 16; ++r) ps += p0[r]; for (int r = 0; r < 16; ++r) ps += p1[r];
    { auto rr = __builtin_amdgcn_permlane32_swap(__float_as_uint(ps), __float_as_uint(ps), false, false);
      ps = __uint_as_float(rr[0]) + __uint_as_float(rr[1]); }
    l_reg = l_reg * alpha + ps;
#define PK4(P, B_, OUT) do { unsigned a0 = cvtpk(P[B_+0], P[B_+1]), a1 = cvtpk(P[B_+2], P[B_+3]);                          \
        unsigned b0 = cvtpk(P[B_+4], P[B_+5]), b1 = cvtpk(P[B_+6], P[B_+7]);                                             \
        auto r0 = __builtin_amdgcn_permlane32_swap(a0, b0, false, false); auto r1 = __builtin_amdgcn_permlane32_swap(a1, b1, false, false); \
        u32x4 w = {r0[0], r1[0], r0[1], r1[1]}; OUT = *reinterpret_cast<bf16x8*>(&w); } while (0)
    PK4(p0, 0, pa0); PK4(p0, 8, pa1); PK4(p1, 0, pa2); PK4(p1, 8, pa3);
#undef PK4
}
template <int KB, bool SK>
__device__ __forceinline__ void qkt(f32x16& p0, f32x16& p1, const char* K_lds, int r32, int hi, const bf16x8* qr, bool act, int cbo  ) {
    if (SK && !act) { const float NEG = -__builtin_inff();
#pragma unroll
        for (int r = 0; r < 16; ++r) { p0[r] = NEG; p1[r] = NEG; } return; }
    if (cbo >= 0) { int a_ = cbo + hi * 16; asm volatile("" : "+v"(a_)); const __attribute__((address_space(3))) float* cb = (const __attribute__((address_space(3))) float*)(unsigned)a_;
#pragma unroll
        for (int q_ = 0; q_ < 4; ++q_) { const f32x4 v0_ = *(const __attribute__((address_space(3))) f32x4*)(cb + 8 * q_), v1_ = *(const __attribute__((address_space(3))) f32x4*)(cb + 32 + 8 * q_);
#pragma unroll
            for (int j_ = 0; j_ < 4; ++j_) { p0[4 * q_ + j_] = v0_[j_]; p1[4 * q_ + j_] = v1_[j_]; } }
    } else { p0 = f32x16{}; p1 = f32x16{}; }
    const char* kb[4];
#pragma unroll
    for (int dd = 0; dd < 4; ++dd) kb[dd] = K_lds + KB * SHM_K + KSWZ(r32, (dd * 16 + hi * 8) * 2);
#pragma unroll
    for (int d0 = 0; d0 < 8; ++d0) { const char* a = kb[d0 & 3] + (d0 >> 2) * 128;
        bf16x8 b0 = *reinterpret_cast<const bf16x8*>(a);
        bf16x8 b1 = *reinterpret_cast<const bf16x8*>(a + 32 * 256);
        p0 = __builtin_amdgcn_mfma_f32_32x32x16_bf16(b0, qr[d0], p0, 0, 0, 0);
        p1 = __builtin_amdgcn_mfma_f32_32x32x16_bf16(b1, qr[d0], p1, 0, 0, 0); }
}
template <int VB, bool SK>
__device__ __forceinline__ void pv_tile(f32x16* o, int vb0, bf16x8 pa0, bf16x8 pa1, bf16x8 pa2, bf16x8 pa3, bool act) {
    if (SK && !act) return;
#define TRRD(dst, off) asm volatile("ds_read_b64_tr_b16 %0, %1 offset:%2" : "=&v"(dst) : "v"(vb0), "i"(off) : "memory")
#define PV_D0(d0) do { s16x4 l0, l1, l2, l3, h0, h1, h2, h3; constexpr int b_ = VB * SHM_V + v_rd_off(d0, 0, 0);     \
        TRRD(l0, b_); TRRD(h0, b_ + 2048); TRRD(l1, b_ + 4096); TRRD(h1, b_ + 6144); TRRD(l2, b_ + 8192); TRRD(h2, b_ + 10240); TRRD(l3, b_ + 12288); TRRD(h3, b_ + 14336); \
        asm volatile("s_waitcnt lgkmcnt(0)" ::: "memory"); SBAR();                 \
        o[d0] = __builtin_amdgcn_mfma_f32_32x32x16_bf16(pa0, (bf16x8){l0[0], l0[1], l0[2], l0[3], h0[0], h0[1], h0[2], h0[3]}, o[d0], 0, 0, 0);   \
        o[d0] = __builtin_amdgcn_mfma_f32_32x32x16_bf16(pa1, (bf16x8){l1[0], l1[1], l1[2], l1[3], h1[0], h1[1], h1[2], h1[3]}, o[d0], 0, 0, 0);   \
        o[d0] = __builtin_amdgcn_mfma_f32_32x32x16_bf16(pa2, (bf16x8){l2[0], l2[1], l2[2], l2[3], h2[0], h2[1], h2[2], h2[3]}, o[d0], 0, 0, 0);   \
        o[d0] = __builtin_amdgcn_mfma_f32_32x32x16_bf16(pa3, (bf16x8){l3[0], l3[1], l3[2], l3[3], h3[0], h3[1], h3[2], h3[3]}, o[d0], 0, 0, 0); } while (0)
    PV_D0(0); PV_D0(1); PV_D0(2); PV_D0(3);
#undef PV_D0
#undef TRRD
}

template <class T> __device__ __forceinline__ T* uptr(T* p) { const unsigned long long v = (unsigned long long)p; const unsigned lo = __builtin_amdgcn_readfirstlane((unsigned)v), hi = __builtin_amdgcn_readfirstlane((unsigned)(v >> 32)); return (T*)(((unsigned long long)hi << 32) | lo); }
template <class TIn, class TOut> struct BlockRef { const TIn* Q; const TIn* K; const TIn* V; TOut* O; float* SS; int P0; };
template <class TIn> struct Seam {
    bf16x8 qr[8];
    bf16x8 st_v0, st_v1, st_k0, st_k1; f32x4 sf0, sf1, sf2, sf3;
    f32x4 tq[16];
};
__device__ __forceinline__ int swa_jlo(int P0, int W) { const int lowk = P0 - W + 1; return lowk > 0 ? lowk / KVBLK : 0; }
#define ROW(p, k0, rr) ((decltype(p))((const char*)(p) + (unsigned)(((k0) + (rr)) * D + sc) * (unsigned)sizeof(*(p))))
#define VMW() asm volatile("s_waitcnt vmcnt(0)" ::: "memory")
#define VMWN(n) asm volatile("s_waitcnt vmcnt(%0)" :: "i"(n) : "memory")
#define SLOAD_H(Kp, Vp, k0) do { S.st_v0 = load8<TIn>(ROW(Vp, k0, sr)); S.st_v1 = load8<TIn>(ROW(Vp, k0, 32 + sr));              \
                         S.st_k0 = load8<TIn>(ROW(Kp, k0, sr)); S.st_k1 = load8<TIn>(ROW(Kp, k0, 32 + sr)); } while (0)
#define SWRITE_HK(bf) do { *(bf16x8*)(K_lds + (bf) * SHM_K + kws) = S.st_k0; *(bf16x8*)(K_lds + (bf) * SHM_K + kws + 32 * 256) = S.st_k1; } while (0)
#define SWRITE_HV(bf) do { *(bf16x8*)(V_lds + (bf) * SHM_V + vst0) = S.st_v0; *(bf16x8*)(V_lds + (bf) * SHM_V + vst1) = S.st_v1; } while (0)
#define SWRITE_H(bf) do { SWRITE_HV(bf); SWRITE_HK(bf); } while (0)
#define SLOAD_F(p, k0) do { S.sf0 = *(const f32x4*)ROW(p, k0, sr); S.sf1 = *(const f32x4*)(ROW(p, k0, sr) + 4);                \
                            S.sf2 = *(const f32x4*)ROW(p, k0, 32 + sr); S.sf3 = *(const f32x4*)(ROW(p, k0, 32 + sr) + 4); } while (0)
#define SWRITE_KF(bf) do { *(bf16x8*)(K_lds + (bf) * SHM_K + kws) = pack8(S.sf0, S.sf1); *(bf16x8*)(K_lds + (bf) * SHM_K + kws + 32 * 256) = pack8(S.sf2, S.sf3); } while (0)
#define SWRITE_VF(bf) do { *(bf16x8*)(V_lds + (bf) * SHM_V + vst0) = pack8(S.sf0, S.sf1); *(bf16x8*)(V_lds + (bf) * SHM_V + vst1) = pack8(S.sf2, S.sf3); } while (0)
template <class TIn, class TOut>
__device__ __forceinline__ void causal_swa_prime(const BlockRef<TIn, TOut>& cur_, int W, char* lds, Seam<TIn>& S) {
    BlockRef<TIn, TOut> cur; cur.Q = uptr(cur_.Q); cur.K = uptr(cur_.K); cur.V = uptr(cur_.V); cur.O = nullptr; cur.SS = nullptr; cur.P0 = __builtin_amdgcn_readfirstlane(cur_.P0);
    constexpr bool F32 = same_t<TIn, float>::v;
    int tid_ = my_tid();
    const int tid = tid_, wid = __builtin_amdgcn_readfirstlane(tid >> 6), lane = tid & 63, r32 = lane & 31, hi = lane >> 5;
    const int sr = tid >> 4, sc = (tid & 15) * 8, kws = KSWZ(sr, sc * 2); char* K_lds = lds + 2 * SHM_V;
    const int kb0 = swa_jlo(cur.P0, W) * KVBLK;
    for (int d0 = 0; d0 < 8; ++d0) S.qr[d0] = load8<TIn>((const TIn*)((const char*)cur.Q + (unsigned)((wid * QBLK + r32) * D + d0 * 16 + hi * 8) * (unsigned)sizeof(TIn)));
    if constexpr (F32) { SLOAD_F((const float*)cur.K, kb0); VMW(); SWRITE_KF(0); SBAR(); SLOAD_F((const float*)cur.V, kb0); }
    else { SLOAD_H(cur.K, cur.V, kb0); VMW(); SWRITE_HK(0); }
    __syncthreads();
}
template <class TIn, class TOut, int ost, bool HAS_SS>
__device__ __forceinline__ void causal_swa_block(const BlockRef<TIn, TOut>& cur_, const BlockRef<TIn, TOut>& nxt_, int skv, int W, char* lds, Seam<TIn>& S, int cbl  ) {
    constexpr bool F32 = same_t<TIn, float>::v;
    BlockRef<TIn, TOut> cur, nxt; cur.Q = uptr(cur_.Q); cur.K = uptr(cur_.K); cur.V = uptr(cur_.V); cur.O = uptr(cur_.O); cur.SS = uptr(cur_.SS); cur.P0 = __builtin_amdgcn_readfirstlane(cur_.P0);
    nxt.Q = uptr(nxt_.Q); nxt.K = uptr(nxt_.K); nxt.V = uptr(nxt_.V); nxt.O = nullptr; nxt.SS = nullptr; nxt.P0 = __builtin_amdgcn_readfirstlane(nxt_.P0);
    int tid_ = my_tid();
    const int tid = tid_, wid = __builtin_amdgcn_readfirstlane(tid >> 6), lane = tid & 63, r32 = lane & 31, hi = lane >> 5;
    const int j_lo = swa_jlo(cur.P0, W);
    int j_hi = (cur.P0 + QB - 1) / KVBLK + 1; if (j_hi > skv / KVBLK) j_hi = skv / KVBLK;
    const int NT = j_hi - j_lo;
    const int kbn = swa_jlo(nxt.P0, W) * KVBLK;
    const int qlo = cur.P0 + wid * QBLK, qm = qlo + r32 - 4 * hi;
    char* V_lds = lds; char* K_lds = lds + 2 * SHM_V;
    float* ws = (float*)(lds + 2 * SHM_V + 2 * SHM_K) + wid * 64; float* li_l = ws, * al_l = ws + 32;
    float m_reg = -1e30f, l_reg = 0; f32x16 o[4] = {};
    const int sr = tid >> 4, sc = (tid & 15) * 8, vst0 = v_st(sr, sc), vst1 = v_st(32 + sr, sc), kws = KSWZ(sr, sc * 2);
    const int vb0 = (int)(uintptr_t)V_lds + v_rd_base(lane);
    const TIn* Kh = cur.K; const TIn* Vh = cur.V;
#define RESC(a) do { if (__any((a) < 1.f)) { if (hi == 0) al_l[r32] = (a); asm volatile("s_waitcnt lgkmcnt(0)" ::: "memory");              \
                     for (int d_ = 0; d_ < 4; ++d_) for (int r = 0; r < 16; ++r) o[d_][r] *= al_l[crow(r, hi)]; } } while (0)
#define KBASE(t) ((j_lo + (t)) * KVBLK)
#define CBT(t) (cbl >= 0 ? cbl + KBASE(t) * 4 : -1)
#define ACT(t) (KBASE(t) <= qlo + QBLK - 1 && KBASE(t) + KVBLK - 1 >= qlo - W + 1)
#define MASKT(P0_, P1_, t) do { const int kb_ = KBASE(t); if ((!SK || ACT(t)) && (kb_ + KVBLK - 1 > qlo || kb_ <= qlo + QBLK - 1 - W)) mask_tile(P0_, P1_, qm - kb_, (unsigned)W); } while (0)
    constexpr int NQL = F32 ? 16 : 8;
    constexpr bool SK = WSKIP && !F32;
#define SEAM_K0() do { VMWN(NQL); if constexpr (F32) { SWRITE_KF(0); SBAR(); SLOAD_F((const float*)nxt.V, kbn); } else { SWRITE_HK(0); } SBAR(); } while (0)
    f32x16 pA0, pA1, pB0, pB1; float mnA, mnB, alA, alB; bf16x8 pa0, pa1, pa2, pa3;
    if constexpr (F32) { VMW(); SWRITE_VF(0); SBAR(); } else { SWRITE_HV(0); SBAR(); }
    if (NT > 1) { if constexpr (F32) SLOAD_F((const float*)Kh, KBASE(1)); else SLOAD_H(Kh, Vh, KBASE(1)); }
    SBAR(); qkt<0, SK>(pA0, pA1, K_lds, r32, hi, S.qr, ACT(0), CBT(0));
    if constexpr (F32) { if (NT > 1) { VMW(); SWRITE_KF(1); SBAR(); SLOAD_F((const float*)Vh, KBASE(1)); } }
    MASKT(pA0, pA1, 0); partialSM(pA0, pA1, m_reg, mnA, alA);
    if (NT > 1) { VMW(); if constexpr (F32) { SWRITE_VF(1); SBAR(); if (NT > 2) SLOAD_F((const float*)Kh, KBASE(2)); } else SWRITE_H(1); }
    __syncthreads();
#define HALF_STEP(PX0, PX1, mnX, alX, PY0, PY1, alY, t, KB, VB, SB) do {                                                      \
        SBAR(); qkt<KB, SK>(PX0, PX1, K_lds, r32, hi, S.qr, ACT(t), CBT(t));                                             \
        finishSM(PY0, PY1, alY, l_reg, pa0, pa1, pa2, pa3); SBAR();                                                           \
        if ((t) + 1 < NT) { if constexpr (F32) { VMW(); SWRITE_KF(SB); SBAR(); SLOAD_F((const float*)Vh, KBASE((t) + 1)); }  \
                            else { SLOAD_H(Kh, Vh, KBASE((t) + 1)); } SBAR(); }                                               \
        pv_tile<VB, SK>(o, vb0, pa0, pa1, pa2, pa3, ACT((t) - 1)); MASKT(PX0, PX1, (t)); partialSM(PX0, PX1, m_reg, mnX, alX);                                        \
        __syncthreads();                                                                                                      \
        if ((t) + 1 < NT) { VMW(); if constexpr (F32) { SWRITE_VF(SB); SBAR(); if ((t) + 2 < NT) SLOAD_F((const float*)Kh, KBASE((t) + 2)); } \
                            else { SWRITE_H(SB); } }                                                                          \
        RESC(alX); __syncthreads(); } while (0)
    for (int t = 1; t + 1 < NT; t += 2) {
        HALF_STEP(pB0, pB1, mnB, alB, pA0, pA1, alA, t, 1, 0, 0);
        HALF_STEP(pA0, pA1, mnA, alA, pB0, pB1, alB, t + 1, 0, 1, 1);
    }
    const bool even = (NT & 1) == 0;
    if (even) { SBAR(); qkt<1, SK>(pB0, pB1, K_lds, r32, hi, S.qr, ACT(NT - 1), CBT(NT - 1)); SBAR(); }
#define QROW(e) (nxt.Q + (size_t)(wid * QBLK + r32) * D + ((e) >> 1) * 16 + hi * 8 + ((e) & 1) * 4)
    if constexpr (F32) { SLOAD_F((const float*)nxt.K, kbn); SBAR();
#pragma unroll
        for (int e = 0; e < 8; ++e) S.tq[e] = *(const f32x4*)QROW(e); }
    else { SLOAD_H(nxt.K, nxt.V, kbn); SBAR();
#pragma unroll
        for (int d0 = 0; d0 < 8; ++d0) S.qr[d0] = load8<TIn>((const TIn*)((const char*)nxt.Q + (unsigned)((wid * QBLK + r32) * D + d0 * 16 + hi * 8) * (unsigned)sizeof(TIn))); }
    SBAR();
    finishSM(pA0, pA1, alA, l_reg, pa0, pa1, pa2, pa3); SBAR();
    if constexpr (F32) {
#pragma unroll
        for (int e = 8; e < 16; ++e) S.tq[e] = *(const f32x4*)QROW(e); SBAR(); }
#undef QROW
    pv_tile<0, SK>(o, vb0, pa0, pa1, pa2, pa3, ACT(even ? NT - 2 : NT - 1));
    if (even) { MASKT(pB0, pB1, NT - 1); partialSM(pB0, pB1, m_reg, mnB, alB); __syncthreads(); RESC(alB);
        finishSM(pB0, pB1, alB, l_reg, pa0, pa1, pa2, pa3); SBAR(); pv_tile<1, SK>(o, vb0, pa0, pa1, pa2, pa3, ACT(NT - 1)); }
    SBAR(); SEAM_K0();
    if (hi == 0) li_l[r32] = l_reg; asm volatile("s_waitcnt lgkmcnt(0)" ::: "memory");
    float rli[16];
#pragma unroll
    for (int r = 0; r < 16; ++r) rli[r] = __builtin_amdgcn_rcpf(li_l[crow(r, hi)]);
    int r32e = r32, hie = hi; asm volatile("" : "+v"(r32e), "+v"(hie));
    char* Ob = (char*)cur.O; const unsigned ob0 = (unsigned)((wid * QBLK + 4 * hie) * ost + r32e) * 2u;
#pragma unroll
    for (int r = 0; r < 16; ++r) { const unsigned rowoff = ob0 + (unsigned)(((r & 3) + 8 * (r >> 2)) * ost * 2); float ss_ = 0.f;
#pragma unroll
        for (int d0 = 0; d0 < 4; ++d0) { const float v = o[d0][r] * rli[r]; ss_ += v * v;
            const float vn = shx<1>(v);
            if ((r32e & 1) == 0) *(unsigned*)(Ob + rowoff + d0 * 64) = cvtpk(v, vn); }
        if (HAS_SS) { ss_ += shx<1>(ss_); ss_ += shx<2>(ss_); ss_ += shx<4>(ss_); ss_ += shx<8>(ss_); ss_ += shx<16>(ss_);
            if (r32e == 0) *(float*)((char*)cur.SS + (unsigned)(wid * QBLK + 4 * hie + (r & 3) + 8 * (r >> 2)) * 32u) = ss_; }
        SBAR(); }
    if constexpr (F32) {
#pragma unroll
        for (int d0 = 0; d0 < 8; ++d0) S.qr[d0] = pack8(S.tq[2 * d0], S.tq[2 * d0 + 1]); }
    __syncthreads();
#undef RESC
#undef KBASE
#undef CBT
#undef ACT
#undef MASKT
#undef SEAM_K0
#undef HALF_STEP
}
#undef ROW
}

#define GAS __attribute__((address_space(1)))
#define LAS __attribute__((address_space(3)))
typedef unsigned short bf16;
typedef unsigned v4u __attribute__((ext_vector_type(4)));
typedef float f32x4 __attribute__((ext_vector_type(4)));
#define LDS_WAIT() asm volatile("s_waitcnt lgkmcnt(0)" ::: "memory")
#define VM_WAIT() asm volatile("s_waitcnt vmcnt(0)" ::: "memory")
__device__ __forceinline__ unsigned f2bf(float f) { unsigned u = __builtin_bit_cast(unsigned, f); return (u + 0x7fffu + ((u >> 16) & 1u)) >> 16; }
__device__ __forceinline__ unsigned pk2(float lo, float hi) { return f2bf(lo) | (f2bf(hi) << 16); }
__device__ __forceinline__ float bflo(unsigned w) { return __uint_as_float(w << 16); }
__device__ __forceinline__ float bfhi(unsigned w) { return __uint_as_float(w & 0xffff0000u); }

#ifndef LB2
#define LB2 2
#endif
#ifndef FOX_HAS_SS
#define FOX_HAS_SS false
#endif
#ifndef FOX_SS
#define FOX_SS (SSQF + ((size_t)b * SEQ + x * 256) * 8 + h)
#endif
#ifndef FOX_CB
#define FOX_CB CB_OFF
#endif
#ifndef USE_XB
#define USE_XB 1
#endif
#if USE_XB
#define GSYNC() xcd_barrier(xbar)
#else
#define GSYNC() grid.sync()
#endif
#ifndef REP
#define REP 0
#endif
#ifndef PH
#define PH 0x1ff
#endif
constexpr int NWAVES = 8, NTHR = 512;
constexpr int BATCH = 4, SEQ = 2048, DM = 2048, M = BATCH * SEQ, NMEM = 256, MMEM = BATCH * NMEM;
constexpr int FOXW = 1024, LRUW = 1024, INW = 5128, INWP = 5376, XW = 512, FFN = 5632;
constexpr float EPS = 1e-6f;
constexpr size_t MiB = 1u << 20;
constexpr size_t WS_WIN = 1 * MiB, WS_WOUT = 22 * MiB, WS_WCQ = 30 * MiB, WS_WCKV = 32 * MiB, WS_WCO = 36 * MiB, WS_WGU = 38 * MiB, WS_WDN = 82 * MiB, WS_WLRU = 104 * MiB;
constexpr size_t WS_XN = 105 * MiB, WS_MN = 137 * MiB, WS_Q = 141 * MiB, WS_K = 157 * MiB, WS_V = 173 * MiB, WS_U = 189 * MiB, WS_GG = 205 * MiB, WS_UC = 221 * MiB;
constexpr size_t WS_LF = 237 * MiB, WS_CK = 238 * MiB, WS_CV = 239 * MiB, WS_MIX = 240 * MiB, WS_SSQF = 272 * MiB, WS_SSQL = 273 * MiB, WS_X1 = 274 * MiB;
constexpr size_t WS_SSQ1 = 338 * MiB, WS_CQ = 339 * MiB, WS_SSQ2 = 347 * MiB, WS_END = 348 * MiB;
constexpr size_t WS_HL = WS_X1, WS_AC = WS_X1 + 16 * MiB, WS_ENDH = WS_SSQ2, WS_ENDA = WS_SSQ2 + 256 * 1024;
constexpr size_t WS_X1B = WS_XN  , WS_OX = WS_Q  , WS_X2B = WS_MIX  , WS_H = WS_Q  ;
constexpr int LDS_BYTES = 147456, RED_OFF = 131072, CB_OFF = 69632, WSUM_OFF = 77824;

__device__ __forceinline__ float wave_sum(float v) { v += shx<1>(v); v += shx<2>(v); v += shx<4>(v); v += shx<8>(v); v += shx<16>(v); return sum32(v); }
__device__ __forceinline__ void transpose_item(const float* W, int ldw, int k0, int srcn0, int nvalid, const float* ks, bf16* WT, int ldt, int drow0, LAS float* scr, int lane) {
    f32x4 v[8];
#pragma unroll
    for (int i = 0; i < 8; ++i) { const int kk = 8 * i + (lane >> 3), n4 = (lane & 7) * 4;
        v[i] = (n4 < nvalid) ? *(const GAS f32x4*)(W + (size_t)(k0 + kk) * ldw + srcn0 + n4) : (f32x4){0.f, 0.f, 0.f, 0.f}; }
#pragma unroll
    for (int i = 0; i < 8; ++i) { const int kk = 8 * i + (lane >> 3), n4 = (lane & 7) * 4; f32x4 x = v[i]; if (ks) x = x * ks[k0 + kk];
        LAS float* d = scr + kk * 33 + n4; d[0] = x.x; d[1] = x.y; d[2] = x.z; d[3] = x.w; }
    LDS_WAIT(); asm volatile("" ::: "memory");
    const int c = lane & 7;
#pragma unroll
    for (int j = 0; j < 4; ++j) { const int n = (lane >> 3) + 8 * j; const LAS float* s = scr + (8 * c) * 33 + n;
        v4u o; o.x = pk2(s[0 * 33], s[1 * 33]); o.y = pk2(s[2 * 33], s[3 * 33]); o.z = pk2(s[4 * 33], s[5 * 33]); o.w = pk2(s[6 * 33], s[7 * 33]);
        *(GAS v4u*)(WT + (size_t)(drow0 + n) * ldt + k0 + 8 * c) = o; }
    LDS_WAIT(); asm volatile("" ::: "memory");
}
__device__ __forceinline__ void rms_row_to_bf16(const float* xrow, const float* g, bf16* orow, int lane) {
    const GAS f32x4* xr = (const GAS f32x4*)xrow + lane; const GAS f32x4* gr = (const GAS f32x4*)g + lane;
    f32x4 v[8]; float s = 0.f;
#pragma unroll
    for (int j = 0; j < 8; ++j) { v[j] = xr[64 * j]; s += (v[j].x * v[j].x + v[j].y * v[j].y) + (v[j].z * v[j].z + v[j].w * v[j].w); }
    const float rstd = 1.0f / sqrtf(wave_sum(s) * (1.f / DM) + EPS);
    GAS unsigned long long* o8 = (GAS unsigned long long*)orow + lane;
#pragma unroll
    for (int j = 0; j < 8; ++j) { const f32x4 gg = gr[64 * j]; o8[64 * j] = (unsigned long long)pk2(v[j].x * rstd * gg.x, v[j].y * rstd * gg.y) | ((unsigned long long)pk2(v[j].z * rstd * gg.z, v[j].w * rstd * gg.w) << 32); }
}

#define XB_TMO      128
#define XB_XCNT(j)  (256  + 64 * (j))
#define XB_XSUB(j)  (1280 + 64 * (j))
#define XB_XGEN(j)  (2304 + 64 * (j))
#define XB_TOP      3328
#define XB_TOPGEN   3392
#define XCD_BAR_WORDS 3456
#define XB_SPIN_CAP (1u << 18)

__device__ __forceinline__ unsigned xb_ld(unsigned* p)              { return __hip_atomic_load(p, __ATOMIC_RELAXED, __HIP_MEMORY_SCOPE_AGENT); }
__device__ __forceinline__ unsigned xb_add(unsigned* p, unsigned v) { return __hip_atomic_fetch_add(p, v, __ATOMIC_RELAXED, __HIP_MEMORY_SCOPE_AGENT); }
__device__ __forceinline__ unsigned xb_xcc_id() { return (unsigned)__builtin_amdgcn_s_getreg((3 << 11) | 20) & 0xFu; }
#define XB_SPIN(cond, bar) do { unsigned _sp = 0; while (cond) { __builtin_amdgcn_s_sleep(1); \
    if ((++_sp & 255u) == 0u) { if (xb_ld(&(bar)[XB_TMO])) break; if (_sp > XB_SPIN_CAP) { atomicAdd(&(bar)[XB_TMO], 1u); break; } } } } while (0)

struct XcdBarrier {
    unsigned* bar; unsigned x;
    volatile LAS unsigned* st;
};

__device__ __forceinline__ XcdBarrier xcd_barrier_post(unsigned* bar, volatile LAS unsigned* st) {
    XcdBarrier b; b.bar = bar; b.x = xb_xcc_id(); b.st = st;
    if (my_tid() == 0) (void)xb_add(&bar[XB_XCNT(b.x)], 1u);
    return b;
}
__device__ __forceinline__ void xcd_barrier_complete(unsigned* bar, unsigned x, unsigned& nloc, unsigned& nx) {
    const unsigned G = gridDim.x * gridDim.y * gridDim.z;
    unsigned sum, cnt, mine, sp = 0u;
    for (;;) {
        sum = 0u; cnt = 0u; mine = 0u;
#pragma unroll
        for (unsigned j = 0; j < 16; ++j) { const unsigned c = xb_ld(&bar[XB_XCNT(j)]); sum += c; cnt += (c > 0u) ? 1u : 0u; mine = (j == x) ? c : mine; }
        if (sum == G) break;
        __builtin_amdgcn_s_sleep(1);
        if ((++sp & 255u) == 0u) { if (xb_ld(&bar[XB_TMO])) break; if (sp > XB_SPIN_CAP) { atomicAdd(&bar[XB_TMO], 1u); break; } }
    }
    nloc = mine > 0u ? mine : 1u; nx = cnt > 0u ? cnt : 1u;
}

__device__ __forceinline__ void xcd_barrier(const XcdBarrier& b) {
    asm volatile("s_waitcnt vmcnt(0)" ::: "memory");
    __syncthreads();
    if (my_tid() == 0) {
        unsigned* bar = b.bar;
        __builtin_amdgcn_s_waitcnt(0);
        unsigned nloc = b.st[0], nx = b.st[1];
        if (nloc == 0u) { xcd_barrier_complete(bar, b.x, nloc, nx); b.st[0] = nloc; b.st[1] = nx; }
        const unsigned old = xb_add(&bar[XB_XSUB(b.x)], 1u);
        const unsigned gen = old / nloc;
        if (old + 1u == (gen + 1u) * nloc) {
            __builtin_amdgcn_fence(__ATOMIC_RELEASE, "agent");
            asm volatile("s_waitcnt vmcnt(0)" ::: "memory");
            const unsigned og = xb_add(&bar[XB_TOP], 1u);
            const unsigned tg = og / nx;
            if (og + 1u == (tg + 1u) * nx) xb_add(&bar[XB_TOPGEN], 1u);
            else XB_SPIN(xb_ld(&bar[XB_TOPGEN]) == tg, bar);
            __builtin_amdgcn_fence(__ATOMIC_ACQUIRE, "agent");
            xb_add(&bar[XB_XGEN(b.x)], 1u);
            asm volatile("s_waitcnt vmcnt(0)" ::: "memory");
        } else {
            XB_SPIN(xb_ld(&bar[XB_XGEN(b.x)]) == gen, bar);
            __builtin_amdgcn_fence(__ATOMIC_ACQUIRE, "agent");
            asm volatile("s_waitcnt vmcnt(0)" ::: "memory");
        }
    }
    __syncthreads();
}

struct Args { const float* in[27]; float* out; unsigned char* ws; };
enum { I_X = 0, I_MEM, I_GMIX, I_WIN, I_BF, I_GQ, I_GK, I_CONVW, I_CONVB, I_WRA, I_BRA, I_WRI, I_BRI, I_LAM, I_GFOX, I_GLRU, I_WOUT, I_GXATTN, I_GMEM, I_WCQ, I_WCKV, I_GCQ, I_GCK, I_WCO, I_GFFN, I_WGU, I_WDN };

constexpr int KB_D = DM / 64;
constexpr int I0 = (INWP / 32) * KB_D, I3 = (2 * XW / 32) * KB_D, I7 = 16 * 4 * 2, N_EARLY = I0 + I3 + I7;
constexpr int I1 = (DM / 32) * KB_D, I2 = (XW / 32) * KB_D, I4 = (DM / 32) * (XW / 64), I5 = (2 * FFN / 32) * KB_D, I6 = (DM / 32) * (FFN / 64), N_LATE = I1 + I2 + I4 + I5 + I6;
constexpr int N_LATE_P1 = I1 + I2 + I4 + 2560;
constexpr int N_LATE_P2 = N_LATE_P1 + 2440;
__device__ __forceinline__ void early_item(const Args& a, int r, LAS float* scr, int lane) {
    unsigned char* ws = a.ws;
    if (r < I0) { const int rg = r / KB_D, kb = r % KB_D, d = rg * 32; int src = d, nv = 32;
        if (d >= 3072 && d < 5120) src = d + 8; else if (d == 5120) { src = 3072; nv = 8; } else if (d > 5120) { src = 0; nv = 0; }
        transpose_item(a.in[I_WIN], INW, kb * 64, src, nv, nullptr, (bf16*)(ws + WS_WIN), DM, d, scr, lane); return; } r -= I0;
    if (r < I3) { const int rg = r / KB_D, kb = r % KB_D;
        transpose_item(a.in[I_WCKV], 2 * XW, kb * 64, rg * 32, 32, nullptr, (bf16*)(ws + WS_WCKV), DM, rg * 32, scr, lane); return; } r -= I3;
    { const int mtx = r >> 3, sub = r & 7, rg = sub >> 1, kb = sub & 1, n = mtx >> 1, which = mtx & 1;
        transpose_item((which ? a.in[I_WRI] : a.in[I_WRA]) + (size_t)n * 128 * 128, 128, kb * 64, rg * 32, 32, nullptr, (bf16*)(ws + WS_WLRU) + (size_t)(n * 256 + which * 128) * 128, 128, rg * 32, scr, lane); }
}
__device__ __forceinline__ void late_item(const Args& a, int r, LAS float* scr, int lane) {
    unsigned char* ws = a.ws;
    if (r < I1) { const int rg = r / KB_D, kb = r % KB_D; const float* ks = kb < 16 ? a.in[I_GFOX] : a.in[I_GLRU] - 1024;
        transpose_item(a.in[I_WOUT], DM, kb * 64, rg * 32, 32, ks, (bf16*)(ws + WS_WOUT), DM, rg * 32, scr, lane); return; } r -= I1;
    if (r < I2) { const int rg = r / KB_D, kb = r % KB_D;
        transpose_item(a.in[I_WCQ], XW, kb * 64, rg * 32, 32, a.in[I_GXATTN], (bf16*)(ws + WS_WCQ), DM, rg * 32, scr, lane); return; } r -= I2;
    if (r < I4) { const int rg = r / (XW / 64), kb = r % (XW / 64);
        transpose_item(a.in[I_WCO], DM, kb * 64, rg * 32, 32, nullptr, (bf16*)(ws + WS_WCO), XW, rg * 32, scr, lane); return; } r -= I4;
    if (r < I5) { const int rg = r / KB_D, kb = r % KB_D, d = rg * 32, tile = d >> 8, w = d & 255; const int src = w < 128 ? tile * 128 + w : FFN + tile * 128 + (w - 128);
        transpose_item(a.in[I_WGU], 2 * FFN, kb * 64, src, 32, a.in[I_GFFN], (bf16*)(ws + WS_WGU), DM, d, scr, lane); return; } r -= I5;
    { const int rg = r / (FFN / 64), kb = r % (FFN / 64);
        transpose_item(a.in[I_WDN], DM, kb * 64, rg * 32, 32, nullptr, (bf16*)(ws + WS_WDN), FFN, rg * 32, scr, lane); }
}
__device__ __forceinline__ void late_range(const Args& a, LAS unsigned char* lds, int lo, int hi, int w, int nw, int wave, int lane) {
    LAS float* scr = (LAS float*)(lds + wave * 16384);
    for (int it = lo + w; it < hi; it += nw) late_item(a, it, scr, lane);
}
__device__ __forceinline__ void p0_prologue(const Args& a, LAS unsigned char* lds, int wave, int lane, int G) {
    unsigned char* ws = a.ws;
    LAS float* scr = (LAS float*)(lds + wave * 16384);
    const int gw = blockIdx.x * NWAVES + wave, NGW = G * NWAVES;
    for (int it = gw; it < N_EARLY; it += NGW) early_item(a, it, scr, lane);
    if (G != 256) for (int it = gw; it < N_LATE; it += NGW) late_item(a, it, scr, lane);
    for (int m = gw; m < M + MMEM; m += NGW) {
        if (m < M) rms_row_to_bf16(a.in[I_X] + (size_t)m * DM, a.in[I_GMIX], (bf16*)(ws + WS_XN) + (size_t)m * DM, lane);
        else rms_row_to_bf16(a.in[I_MEM] + (size_t)(m - M) * DM, a.in[I_GMEM], (bf16*)(ws + WS_MN) + (size_t)(m - M) * DM, lane);
    }
}

__device__ __forceinline__ void conv_chunk(const bf16* U, bf16* UC, const float* cw, const float* cbias, int row0, int s0, int nblk, int tid) {
    asm volatile("" : "+v"(tid));
    const int c8 = nblk * 128 + (tid & 15) * 8;
    f32x4 w[4][2], bb[2];
#pragma unroll
    for (int j = 0; j < 4; ++j) { w[j][0] = *(const f32x4*)(cw + j * LRUW + c8); w[j][1] = *(const f32x4*)(cw + j * LRUW + c8 + 4); }
    bb[0] = *(const f32x4*)(cbias + c8); bb[1] = *(const f32x4*)(cbias + c8 + 4);
#pragma unroll 2
    for (int p = 0; p < 8; ++p) { const int rl = p * 32 + (tid >> 4), s = s0 + rl; const unsigned grow = (unsigned)(row0 + rl);
        f32x4 a0 = bb[0], a1 = bb[1];
#pragma unroll
        for (int j = 0; j < 4; ++j) { if (s - 3 + j >= 0) { const v4u uw = *(const v4u*)((const char*)U + ((grow - 3 + j) * LRUW + c8) * 2u);
            a0 += w[j][0] * (f32x4){bflo(uw.x), bfhi(uw.x), bflo(uw.y), bfhi(uw.y)}; a1 += w[j][1] * (f32x4){bflo(uw.z), bfhi(uw.z), bflo(uw.w), bfhi(uw.w)}; } }
        v4u o; o.x = pk2(a0.x, a0.y); o.y = pk2(a0.z, a0.w); o.z = pk2(a1.x, a1.y); o.w = pk2(a1.z, a1.w);
        *(v4u*)((char*)UC + (grow * LRUW + c8) * 2u) = o; }
}

__global__ void __launch_bounds__(NTHR, LB2) hymba_fwd(Args a) {
    extern __shared__ __attribute__((aligned(16))) unsigned char lds_raw[];
    cg::grid_group grid = cg::this_grid();
    LAS unsigned char* lds = (LAS unsigned char*)lds_raw;
    { const int t0 = threadIdx.x; if ((t0 & 63) == 0) *(volatile LAS int*)(lds + WTAB_OFF + hw_slot() * 4) = t0 >> 6;
      if (t0 < 2) *(volatile LAS unsigned*)(lds + XBST_OFF + t0 * 4) = 0u; }
    __syncthreads();
    const XcdBarrier xbar = xcd_barrier_post((unsigned*)a.ws, (volatile LAS unsigned*)(lds + XBST_OFF));
    const int G = gridDim.x, c = blockIdx.x;
#define WIN ((bf16*)(a.ws + WS_WIN))
#define WOUT ((bf16*)(a.ws + WS_WOUT))
#define WCQ ((bf16*)(a.ws + WS_WCQ))
#define WCKV ((bf16*)(a.ws + WS_WCKV))
#define WCO ((bf16*)(a.ws + WS_WCO))
#define WGU ((bf16*)(a.ws + WS_WGU))
#define WDN ((bf16*)(a.ws + WS_WDN))
#define WLRU ((bf16*)(a.ws + WS_WLRU))
#define XN ((bf16*)(a.ws + WS_XN))
#define MN ((bf16*)(a.ws + WS_MN))
#define Qh ((bf16*)(a.ws + WS_Q))
#define Kh ((bf16*)(a.ws + WS_K))
#define Vh ((bf16*)(a.ws + WS_V))
#define U ((bf16*)(a.ws + WS_U))
#define GG ((bf16*)(a.ws + WS_GG))
#define UC ((bf16*)(a.ws + WS_UC))
#define LF ((float*)(a.ws + WS_LF))
#define CK ((bf16*)(a.ws + WS_CK))
#define CV ((bf16*)(a.ws + WS_CV))
#define MIX ((bf16*)(a.ws + WS_MIX))
#define SSQF ((float*)(a.ws + WS_SSQF))
#define SSQL ((float*)(a.ws + WS_SSQL))
#define X1 ((float*)(a.ws + WS_X1))
#define X1B ((bf16*)(a.ws + WS_X1B))
#define SSQ1 ((float*)(a.ws + WS_SSQ1))
#define CQ ((bf16*)(a.ws + WS_CQ))
#define OX ((bf16*)(a.ws + WS_OX))
#define X2B ((bf16*)(a.ws + WS_X2B))
#define SSQ2 ((float*)(a.ws + WS_SSQ2))
#define H ((bf16*)(a.ws + WS_H))
#define HL ((bf16*)(a.ws + WS_HL))
#define AC ((bf16*)(a.ws + WS_AC))
#define ENDH ((float*)(a.ws + WS_ENDH))
#define ENDA ((float*)(a.ws + WS_ENDA))
#define red ((PG8_LAS float*)(lds + RED_OFF))

    for (int rep = 0; rep < 1 + ((REP >> 0) & 1); ++rep) {
    if (PH & 1) { int tid = my_tid(); p0_prologue(a, lds, __builtin_amdgcn_readfirstlane(tid >> 6), tid & 63, G); }
    GSYNC();
    if (a.ws == nullptr) grid.sync();
    }

    for (int rep = 0; rep < 1 + ((REP >> 1) & 1); ++rep) {
    if (PH & 2) {
        pg8::Gemm g{XN, WIN, M, INWP, DM, DM, DM}; pg8::StaticOrder S; S.init(M, INWP, G, c);
        pg8::EpiIn E{0, Qh, Kh, Vh, U, GG, LF, a.in[I_GQ], a.in[I_GK], a.in[I_BF], red};
        pg8::gemm_phase<pg8::EpiIn, pg8::StaticOrder, true, true>(lds, g, S, E);
        pg8::Gemm g2{MN, WCKV, MMEM, 2 * XW, DM, DM, DM}; pg8::StaticOrder S2; S2.init(MMEM, 2 * XW, G, (c + 16) % G);
        pg8::EpiCkv E2{0, CK, CV, a.in[I_GCK], red};
        pg8::gemm_phase<pg8::EpiCkv, pg8::StaticOrder, true, true>(lds, g2, S2, E2);
        if (G == 256 && c >= 160 && c < 240) { const int t2 = my_tid(); late_range(a, lds, 0, N_LATE_P1, (c - 160) * NWAVES + (t2 >> 6), 80 * NWAVES, __builtin_amdgcn_readfirstlane(t2 >> 6), t2 & 63); }
    }
    GSYNC();
    }

    for (int rep = 0; rep < 1 + ((REP >> 2) & 1); ++rep) {
    if (PH & 4) { int cL = c, tid = my_tid(); asm volatile("" : "+s"(cL));
      const int nl = G > 128 ? G - 128 : G;
      if (G <= 128 || cL >= 128)
      for (int L = (G > 128 ? cL - 128 : cL); L < 256; L += nl) {
            const int pm = L >> 3, nblk = L & 7, row0 = pm * 256;
            conv_chunk(U, UC, a.in[I_CONVW], a.in[I_CONVB], row0, (pm & 7) * 256, nblk, tid);
            VM_WAIT(); __syncthreads(); __builtin_amdgcn_fence(__ATOMIC_ACQUIRE, "agent");
            pg8::Gemm g{UC + (size_t)row0 * LRUW + nblk * 128, WLRU + (size_t)nblk * 256 * 128, 256, 256, 128, LRUW, 128}; pg8::OneUnit S;
            pg8::EpiLru E{0, UC, HL, AC, ENDH + pm * 1024, ENDA + pm * 1024, a.in[I_BRA], a.in[I_BRI], a.in[I_LAM], row0, nblk};
            pg8::gemm_phase<pg8::EpiLru, pg8::OneUnit, false, true>(lds, g, S, E);
      }
      if (G == 256 && cL >= 128) {
        VM_WAIT(); __syncthreads();
        if (my_tid() == 0) { unsigned* cnt = (unsigned*)(a.ws + 15360);
            __builtin_amdgcn_fence(__ATOMIC_RELEASE, "agent"); asm volatile("s_waitcnt vmcnt(0)" ::: "memory");
            (void)__hip_atomic_fetch_add(cnt, 1u, __ATOMIC_RELAXED, __HIP_MEMORY_SCOPE_AGENT);
            unsigned sp = 0; while (__hip_atomic_load(cnt, __ATOMIC_RELAXED, __HIP_MEMORY_SCOPE_AGENT) < 128u && ++sp < (1u << 22)) __builtin_amdgcn_s_sleep(1);
            __builtin_amdgcn_fence(__ATOMIC_ACQUIRE, "agent"); asm volatile("s_waitcnt vmcnt(0)" ::: "memory"); }
        __syncthreads();
#define P2B_FIRST (cL - 128)
#define P2B_STRIDE 128
    { int tid = my_tid();
      for (int L = P2B_FIRST; L < 256; L += P2B_STRIDE) { const int pm = L >> 3, nblk = L & 7, j = pm & 7, c8 = nblk * 128 + (tid & 15) * 8;
        f32x4 hi0 = {0.f, 0.f, 0.f, 0.f}, hi1 = {0.f, 0.f, 0.f, 0.f};
        for (int i = 0; i < j; ++i) { const float* eh = ENDH + (pm - j + i) * 1024 + c8; const float* ea = ENDA + (pm - j + i) * 1024 + c8;
            hi0 = *(const f32x4*)ea * hi0 + *(const f32x4*)eh; hi1 = *(const f32x4*)(ea + 4) * hi1 + *(const f32x4*)(eh + 4); }
#pragma unroll 2
        for (int p = 0; p < 8; ++p) { const unsigned row = (unsigned)(pm * 256 + p * 32 + (tid >> 4)), o = (row * 1024u + c8) * 2u;
            const v4u hw = *(const v4u*)((const char*)HL + o), aw = *(const v4u*)((const char*)AC + o), gw = *(const v4u*)((const char*)GG + o);
            const f32x4 y0 = ((f32x4){bflo(hw.x), bfhi(hw.x), bflo(hw.y), bfhi(hw.y)} + (f32x4){bflo(aw.x), bfhi(aw.x), bflo(aw.y), bfhi(aw.y)} * hi0) * (f32x4){bflo(gw.x), bfhi(gw.x), bflo(gw.y), bfhi(gw.y)};
            const f32x4 y1 = ((f32x4){bflo(hw.z), bfhi(hw.z), bflo(hw.w), bfhi(hw.w)} + (f32x4){bflo(aw.z), bfhi(aw.z), bflo(aw.w), bfhi(aw.w)} * hi1) * (f32x4){bflo(gw.z), bfhi(gw.z), bflo(gw.w), bfhi(gw.w)};
            float ss = (y0.x * y0.x + y0.y * y0.y) + (y0.z * y0.z + y0.w * y0.w) + (y1.x * y1.x + y1.y * y1.y) + (y1.z * y1.z + y1.w * y1.w);
            v4u ow; ow.x = pk2(y0.x, y0.y); ow.y = pk2(y0.z, y0.w); ow.z = pk2(y1.x, y1.y); ow.w = pk2(y1.z, y1.w);
            *(v4u*)((char*)MIX + ((size_t)row * 2048 + 1024 + c8) * 2) = ow;
            ss += shx<1>(ss); ss += shx<2>(ss); ss += shx<4>(ss); ss += shx<8>(ss);
            if ((tid & 15) == 0) SSQL[row * 8 + nblk] = ss; } } }
#undef P2B_FIRST
#undef P2B_STRIDE
        { const int t2 = my_tid(); late_range(a, lds, N_LATE_P1, N_LATE_P2, (cL - 128) * NWAVES + (t2 >> 6), 128 * NWAVES, __builtin_amdgcn_readfirstlane(t2 >> 6), t2 & 63); } } }
    if (PH & 4) { int cF = c, tid = my_tid(); asm volatile("" : "+s"(cF)); const int lane = tid & 63, wave = __builtin_amdgcn_readfirstlane(tid >> 6);
      for (int L = cF; L < 128; L += G) {
        {
#if !defined(NO_FOX)
            const int it = L, bh = it >> 2, x = it & 3, b = bh >> 3, h = bh & 7;
            LAS float* cbl = (LAS float*)(lds + CB_OFF); LAS float* wsum = (LAS float*)(lds + WSUM_OFF);
            { const float* lf = LF + ((size_t)b * SEQ + tid * 4) * 8 + h;
              const float v0 = lf[0], v1 = lf[8], v2 = lf[16], v3 = lf[24]; const float t0 = v0, t1 = t0 + v1, t2 = t1 + v2, t3 = t2 + v3;
              wsum[tid] = t3; __syncthreads();
              for (int o = 1; o < 512; o <<= 1) { const float v = wsum[tid] + (tid >= o ? wsum[tid - o] : 0.f); __syncthreads(); wsum[tid] = v; __syncthreads(); }
              const float off = wsum[tid] - t3;
              const float ns = -1.0f / att::SCALE;
              *(LAS f32x4*)(cbl + tid * 4) = (f32x4){(off + t0) * ns, (off + t1) * ns, (off + t2) * ns, (off + t3) * ns};
              __syncthreads(); }
            typedef att::BlockRef<att::bf16, att::bf16> BR;
            BR cur, nxt;
            { const size_t hrow = (size_t)bh * SEQ;
              cur.Q = (const att::bf16*)Qh + (hrow + x * 256) * 128; cur.K = (const att::bf16*)Kh + hrow * 128; cur.V = (const att::bf16*)Vh + hrow * 128;
              cur.O = (att::bf16*)MIX + ((size_t)b * SEQ + x * 256) * 2048 + h * 128; cur.SS = FOX_SS; cur.P0 = x * 256;
              nxt = cur; const int d = (7 - 2 * x) * 256;
              nxt.Q += (size_t)d * 128; nxt.O += (size_t)d * 2048; nxt.SS += (size_t)d * 8; nxt.P0 += d; }
            att::Seam<att::bf16> S;
            att::causal_swa_prime<att::bf16, att::bf16>(cur, 1 << 20, (char*)lds_raw, S);
            for (int p = 0; p < 2; ++p) {
                att::causal_swa_block<att::bf16, att::bf16, 2048, FOX_HAS_SS>(cur, nxt, SEQ, 1 << 20, (char*)lds_raw, S, FOX_CB);
                cur = nxt; }
            VM_WAIT(); __syncthreads(); __builtin_amdgcn_fence(__ATOMIC_ACQUIRE, "agent");
            for (int p = 0; p < 16; ++p) { const int qb = (p < 8) ? x : 7 - x, rl = (p & 7) * 32 + (tid >> 4); const size_t trow = (size_t)b * SEQ + qb * 256 + rl;
                const v4u w = *(const v4u*)(MIX + trow * 2048 + h * 128 + (tid & 15) * 8);
                float ss = (bflo(w.x) * bflo(w.x) + bfhi(w.x) * bfhi(w.x)) + (bflo(w.y) * bflo(w.y) + bfhi(w.y) * bfhi(w.y)) + (bflo(w.z) * bflo(w.z) + bfhi(w.z) * bfhi(w.z)) + (bflo(w.w) * bflo(w.w) + bfhi(w.w) * bfhi(w.w));
                ss += shx<1>(ss); ss += shx<2>(ss); ss += shx<4>(ss); ss += shx<8>(ss);
                if ((tid & 15) == 0) SSQF[trow * 8 + h] = ss; }
            VM_WAIT(); __syncthreads();
#endif
        }
    } }
    GSYNC();
    }

    if (G != 256) {
#define P2B_FIRST c
#define P2B_STRIDE G
    { int tid = my_tid();
      for (int L = P2B_FIRST; L < 256; L += P2B_STRIDE) { const int pm = L >> 3, nblk = L & 7, j = pm & 7, c8 = nblk * 128 + (tid & 15) * 8;
        f32x4 hi0 = {0.f, 0.f, 0.f, 0.f}, hi1 = {0.f, 0.f, 0.f, 0.f};
        for (int i = 0; i < j; ++i) { const float* eh = ENDH + (pm - j + i) * 1024 + c8; const float* ea = ENDA + (pm - j + i) * 1024 + c8;
            hi0 = *(const f32x4*)ea * hi0 + *(const f32x4*)eh; hi1 = *(const f32x4*)(ea + 4) * hi1 + *(const f32x4*)(eh + 4); }
#pragma unroll 2
        for (int p = 0; p < 8; ++p) { const unsigned row = (unsigned)(pm * 256 + p * 32 + (tid >> 4)), o = (row * 1024u + c8) * 2u;
            const v4u hw = *(const v4u*)((const char*)HL + o), aw = *(const v4u*)((const char*)AC + o), gw = *(const v4u*)((const char*)GG + o);
            const f32x4 y0 = ((f32x4){bflo(hw.x), bfhi(hw.x), bflo(hw.y), bfhi(hw.y)} + (f32x4){bflo(aw.x), bfhi(aw.x), bflo(aw.y), bfhi(aw.y)} * hi0) * (f32x4){bflo(gw.x), bfhi(gw.x), bflo(gw.y), bfhi(gw.y)};
            const f32x4 y1 = ((f32x4){bflo(hw.z), bfhi(hw.z), bflo(hw.w), bfhi(hw.w)} + (f32x4){bflo(aw.z), bfhi(aw.z), bflo(aw.w), bfhi(aw.w)} * hi1) * (f32x4){bflo(gw.z), bfhi(gw.z), bflo(gw.w), bfhi(gw.w)};
            float ss = (y0.x * y0.x + y0.y * y0.y) + (y0.z * y0.z + y0.w * y0.w) + (y1.x * y1.x + y1.y * y1.y) + (y1.z * y1.z + y1.w * y1.w);
            v4u ow; ow.x = pk2(y0.x, y0.y); ow.y = pk2(y0.z, y0.w); ow.z = pk2(y1.x, y1.y); ow.w = pk2(y1.z, y1.w);
            *(v4u*)((char*)MIX + ((size_t)row * 2048 + 1024 + c8) * 2) = ow;
            ss += shx<1>(ss); ss += shx<2>(ss); ss += shx<4>(ss); ss += shx<8>(ss);
            if ((tid & 15) == 0) SSQL[row * 8 + nblk] = ss; } } }
#undef P2B_FIRST
#undef P2B_STRIDE
    GSYNC(); }

    for (int rep = 0; rep < 1 + ((REP >> 3) & 1); ++rep) {
    if (PH & 8) {
        pg8::Gemm g{MIX, WOUT, M, DM, DM, DM, DM}; pg8::StaticOrder S; S.init(M, DM, G, c);
        pg8::EpiRes<true> E{16, a.in[I_X], nullptr, nullptr, X1B, SSQ1, SSQF, SSQL};
        pg8::gemm_phase<pg8::EpiRes<true>, pg8::StaticOrder, true, true>(lds, g, S, E);
    }
    GSYNC();
    }

    for (int rep = 0; rep < 1 + ((REP >> 4) & 1); ++rep) {
    if (PH & 16) {
        pg8::Gemm g{X1B, WCQ, M, XW, DM, DM, DM}; pg8::StaticOrder S; S.init(M, XW, G, c);
        pg8::EpiCq E{0, CQ, a.in[I_GCQ], SSQ1, red};
        pg8::gemm_phase<pg8::EpiCq, pg8::StaticOrder, true, true>(lds, g, S, E);
        if (G == 256 && c >= 64) { const int t2 = my_tid(); late_range(a, lds, N_LATE_P2, N_LATE, (c - 64) * NWAVES + (t2 >> 6), 192 * NWAVES, __builtin_amdgcn_readfirstlane(t2 >> 6), t2 & 63); }
    }
    GSYNC();
    }

    for (int rep = 0; rep < 1 + ((REP >> 5) & 1); ++rep) {
    if (PH & 32) for (int L = c; L < 128; L += G) {
        const int bh = L >> 3, qb = L & 7, b = bh >> 2, h = bh & 3;
        att::BlockRef<att::bf16, att::bf16> r;
        r.Q = (const att::bf16*)CQ + ((size_t)bh * SEQ + qb * 256) * 128; r.K = (const att::bf16*)CK + (size_t)bh * NMEM * 128; r.V = (const att::bf16*)CV + (size_t)bh * NMEM * 128;
        r.O = (att::bf16*)OX + ((size_t)b * SEQ + qb * 256) * XW + h * 128; r.SS = nullptr; r.P0 = 1 << 16;
        att::Seam<att::bf16> S;
        att::causal_swa_prime<att::bf16, att::bf16>(r, 1 << 20, (char*)lds_raw, S);
        att::causal_swa_block<att::bf16, att::bf16, XW, false>(r, r, NMEM, 1 << 20, (char*)lds_raw, S, -1);
        VM_WAIT(); __syncthreads();
    }
    GSYNC();
    }

    for (int rep = 0; rep < 1 + ((REP >> 6) & 1); ++rep) {
    if (PH & 64) {
        pg8::Gemm g{OX, WCO, M, DM, XW, XW, XW}; pg8::StaticOrder S; S.init(M, DM, G, c);
        pg8::EpiRes<false> E{0, nullptr, X1B, nullptr, X2B, SSQ2, nullptr, nullptr};
        pg8::gemm_phase<pg8::EpiRes<false>, pg8::StaticOrder, true, true>(lds, g, S, E);
    }
    GSYNC();
    }

    for (int rep = 0; rep < 1 + ((REP >> 7) & 1); ++rep) {
    if (PH & 128) {
        pg8::Gemm g{X2B, WGU, M, 2 * FFN, DM, DM, DM}; pg8::StaticOrder S; S.init(M, 2 * FFN, G, c);
        pg8::EpiGu E{0, H, SSQ2, red};
        pg8::gemm_phase<pg8::EpiGu, pg8::StaticOrder, true, true>(lds, g, S, E);
    }
    GSYNC();
    }

    if (PH & 256) {
        pg8::Gemm g{H, WDN, M, DM, FFN, FFN, FFN}; pg8::StaticOrder S; S.init(M, DM, G, c);
        pg8::EpiRes<false> E{0, nullptr, X2B, a.out, nullptr, nullptr, nullptr, nullptr};
        pg8::gemm_phase<pg8::EpiRes<false>, pg8::StaticOrder, true, true>(lds, g, S, E);
    }
}

#undef WIN
#undef WOUT
#undef WCQ
#undef WCKV
#undef WCO
#undef WGU
#undef WDN
#undef WLRU
#undef XN
#undef MN
#undef Qh
#undef Kh
#undef Vh
#undef U
#undef GG
#undef UC
#undef LF
#undef CK
#undef CV
#undef MIX
#undef SSQF
#undef SSQL
#undef X1
#undef X1B
#undef SSQ1
#undef CQ
#undef OX
#undef X2B
#undef SSQ2
#undef H
#undef HL
#undef AC
#undef ENDH
#undef ENDA
#undef red
extern "C" void kernel_launch(void* const* d_in, const int* in_sizes, int n_in, void* d_out, int out_size, void* d_ws, size_t ws_size, hipStream_t stream) {
    static int grid = 0;
    if (grid == 0) {
        if (n_in != 27 || in_sizes[0] != M * DM || out_size != M * DM || ws_size < WS_END) { fprintf(stderr, "kernel_launch: unexpected shapes (n_in %d, in0 %d, out %d, ws %zu)\n", n_in, n_in > 0 ? in_sizes[0] : -1, out_size, ws_size); grid = -1; return; }
        int dev = 0, cus = 0, per_cu = 0;
        (void)hipGetDevice(&dev); (void)hipDeviceGetAttribute(&cus, hipDeviceAttributeMultiprocessorCount, dev);
        if (hipFuncSetAttribute((const void*)hymba_fwd, hipFuncAttributeMaxDynamicSharedMemorySize, LDS_BYTES) != hipSuccess) { fprintf(stderr, "kernel_launch: hipFuncSetAttribute failed\n"); grid = -1; return; }
        if (hipOccupancyMaxActiveBlocksPerMultiprocessor(&per_cu, (const void*)hymba_fwd, NTHR, LDS_BYTES) != hipSuccess || per_cu < 1) { fprintf(stderr, "kernel_launch: occupancy query says %d\n", per_cu); per_cu = 1; }
        (void)hipGetLastError();
        grid = cus * per_cu;
    }
    if (grid < 0) return;
    Args a{};
    for (int i = 0; i < 27; ++i) a.in[i] = (const float*)d_in[i];
    a.out = (float*)d_out; a.ws = (unsigned char*)d_ws;
    if (hipMemsetAsync(d_ws, 0, 16384, stream) != hipSuccess) { fprintf(stderr, "kernel_launch: memset of the barrier words failed\n"); return; }
    void* args[] = {&a};
    hipError_t e = hipLaunchCooperativeKernel((const void*)hymba_fwd, dim3(grid), dim3(NTHR), args, LDS_BYTES, stream);
    if (e != hipSuccess) fprintf(stderr, "cooperative launch failed: %s (grid %d)\n", hipGetErrorString(e), grid);
}
```

```cpp
#include <hip/hip_runtime.h>
#include <hip/hip_bf16.h>
#include <hip/hip_cooperative_groups.h>
#include <cstdio>
#include <cstdint>
namespace cg = cooperative_groups;


template <int K> __device__ __forceinline__ float shx(float v) { static_assert(K < 32, "use sum32"); return __int_as_float(__builtin_amdgcn_ds_swizzle(__float_as_int(v), (K << 10) | 0x1f)); }
__device__ __forceinline__ float sum32(float v) { auto rr = __builtin_amdgcn_permlane32_swap(__float_as_uint(v), __float_as_uint(v), false, false); return __uint_as_float(rr[0]) + __uint_as_float(rr[1]); }
constexpr int WTAB_OFF = 147456 - 256, XBST_OFF = 147456 - 512;
__device__ __forceinline__ int hw_slot() { return (int)(__builtin_amdgcn_s_getreg((5 << 11) | 4) & 63u); }
__device__ __forceinline__ int my_tid() {
    const int slot = hw_slot();
    const int wave = __builtin_amdgcn_readfirstlane(*(volatile __attribute__((address_space(3))) int*)(unsigned)(WTAB_OFF + slot * 4));
    int l; asm volatile("v_mbcnt_lo_u32_b32 %0, -1, 0\n\tv_mbcnt_hi_u32_b32 %0, -1, %0" : "=v"(l));
    return wave * 64 + l;
}
namespace pg8 {
#define PG8_LAS __attribute__((address_space(3)))
typedef unsigned short bf16_t;
typedef short bf16x8 __attribute__((ext_vector_type(8)));
typedef float f32x4 __attribute__((ext_vector_type(4)));
typedef unsigned u32x4 __attribute__((ext_vector_type(4)));
constexpr int BM = 256, BK = 64, HALF = 128, HTB = HALF * BK * 2  , STAGE_BYTES = 8 * HTB, NXCD = 8, WGM = 8;

__host__ __device__ __forceinline__ int lds_byte(int r, int c) { const int st = (r >> 4) * 2 + (c >> 5), rr = r & 15, cc = c & 31, ob = rr * 64 + cc * 2; return st * 1024 + (ob ^ (((ob >> 9) & 1) << 5)); }
__host__ __device__ __forceinline__ void stage_rc(int b, int& R, int& C) { const int st = b / 1024, sb = b % 1024, swz = sb ^ (((sb >> 9) & 1) << 5); R = (st >> 1) * 16 + swz / 64; C = (st & 1) * 32 + (swz % 64) / 2; }
__host__ __device__ __forceinline__ int perm32(int rho) { const int n = rho >> 4, i = rho & 15; return 8 * (i >> 2) + 4 * n + (i & 3); }

struct Unit { int pm, pn; };
struct Gemm { const bf16_t* A; const bf16_t* Bt; int M, N, K, lda, ldb; };

struct StaticOrder {
    int nM, nN, nwg, G, c;
    __host__ __device__ __forceinline__ void init(int M, int N, int G_, int c_) { nM = M / BM; nN = N / BM; nwg = nM * nN; G = G_; c = c_; }
    __host__ __device__ __forceinline__ bool next(int i, Unit& u) const {
        const long L = (long)i * G + c; if (L >= nwg) return false;
        int wgid = (int)L; { const int q = nwg / NXCD, r = nwg % NXCD, xcd = wgid % NXCD, off = wgid / NXCD; wgid = (xcd < r ? xcd * (q + 1) : r * (q + 1) + (xcd - r) * q) + off; }
        const int nig = WGM * nN, gid = wgid / nig, fm = gid * WGM, gsz = (nM - fm) < WGM ? (nM - fm) : WGM;
        u.pm = fm + ((wgid % nig) % gsz); u.pn = (wgid % nig) / gsz; return true;
    }
    __device__ __forceinline__ void a_ready(const Unit&) const {}
    __device__ __forceinline__ void done(const Unit&) const {}
};

__device__ __forceinline__ unsigned cvt_pk_bf16(float lo, float hi) { unsigned r; asm volatile("v_cvt_pk_bf16_f32 %0, %1, %2" : "=v"(r) : "v"(lo), "v"(hi)); return r; }

typedef float f32x2 __attribute__((ext_vector_type(2)));
constexpr float RMS_EPS = 1e-6f;
struct OneUnit {
    __device__ __forceinline__ bool next(int i, Unit& u) const { if (i != 0) return false; u.pm = 0; u.pn = 0; return true; }
    __device__ __forceinline__ void a_ready(const Unit&) const {}
    __device__ __forceinline__ void done(const Unit&) const {}
};
struct OffsetOrder {
    StaticOrder S;
    __device__ __forceinline__ bool next(int i, Unit& u) const { return S.next(i, u); }
    __device__ __forceinline__ void a_ready(const Unit&) const {}
    __device__ __forceinline__ void done(const Unit&) const {}
};
__device__ __forceinline__ float fast_log1p(float x) { const float sr = x * (1.0f - x * (0.5f - x * (0.33333334f - x * (0.25f - x * (0.2f - x * 0.16666667f))))); return x < 0.0625f ? sr : __logf(1.0f + x); }
__device__ __forceinline__ float sigmoidf_(float x) { return __builtin_amdgcn_rcpf(1.0f + __expf(-x)); }
__device__ __forceinline__ float gelu_tanh(float x) { const float u = 0.7978845608028654f * (x + 0.044715f * x * x * x); return x * sigmoidf_(2.0f * u); }
__device__ __forceinline__ float sum_f(const float* p, int n4) { float s = 0.f; for (int i = 0; i < n4; ++i) { const f32x4 v = *(const f32x4*)(p + 4 * i); s += (v[0] + v[1]) + (v[2] + v[3]); } return s; }
__device__ __forceinline__ u32x4 pack8(const f32x4& a, const f32x4& b) { u32x4 w; w.x = cvt_pk_bf16(a[0], a[1]); w.y = cvt_pk_bf16(a[2], a[3]); w.z = cvt_pk_bf16(b[0], b[1]); w.w = cvt_pk_bf16(b[2], b[3]); return w; }

template <int ACT  >
__device__ __forceinline__ void store_tile(const f32x4 (&acc)[2][2][4][2], bf16_t* d0, bf16_t* d1, size_t ld, int wr, int wc, int fr, int fq) {
#pragma unroll
    for (int ai = 0; ai < 2; ++ai)
#pragma unroll
        for (int m = 0; m < 4; ++m) { const size_t ro = (size_t)(ai * HALF + wr * 64 + m * 16 + fr) * ld + wc * 32 + fq * 8;
#pragma unroll
            for (int bj = 0; bj < 2; ++bj) { f32x4 v0 = acc[ai][bj][m][0], v1 = acc[ai][bj][m][1];
                if (ACT == 1) {
#pragma unroll
                    for (int j = 0; j < 4; ++j) { v0[j] = gelu_tanh(v0[j]); v1[j] = gelu_tanh(v1[j]); } }
                *(u32x4*)((bj ? d1 : d0) + ro) = pack8(v0, v1); } }
}
template <bool ROWSCALE>
__device__ __forceinline__ void head_norm_store(const f32x4 (&acc)[2][2][4][2], const float (&rs)[2][4], const float* gain, bf16_t* d0, bf16_t* d1, PG8_LAS float* red, int wr, int wc, int fr, int fq) {
#pragma unroll
    for (int ai = 0; ai < 2; ++ai)
#pragma unroll
        for (int m = 0; m < 4; ++m)
#pragma unroll
            for (int bj = 0; bj < 2; ++bj) { float s = 0.f;
#pragma unroll
                for (int n = 0; n < 2; ++n) { f32x4 v = acc[ai][bj][m][n]; if (ROWSCALE) v = v * rs[ai][m]; s += (v[0] * v[0] + v[1] * v[1]) + (v[2] * v[2] + v[3] * v[3]); }
                s += shx<16>(s); s = sum32(s);
                if (fq == 0) red[((ai * HALF + wr * 64 + m * 16 + fr) * 2 + bj) * 4 + wc] = s; }
    asm volatile("s_waitcnt lgkmcnt(0)" ::: "memory"); __builtin_amdgcn_s_barrier(); asm volatile("" ::: "memory");
    const f32x4 g0 = *(const f32x4*)(gain + wc * 32 + fq * 8), g1 = *(const f32x4*)(gain + wc * 32 + fq * 8 + 4);
#pragma unroll
    for (int ai = 0; ai < 2; ++ai)
#pragma unroll
        for (int m = 0; m < 4; ++m) { const int rl = ai * HALF + wr * 64 + m * 16 + fr;
#pragma unroll
            for (int bj = 0; bj < 2; ++bj) { const PG8_LAS float* rp = red + (rl * 2 + bj) * 4;
                const float ss = (rp[0] + rp[1]) + (rp[2] + rp[3]);
                float sc = __builtin_amdgcn_rsqf(ss * (1.0f / 128.0f) + RMS_EPS); if (ROWSCALE) sc *= rs[ai][m];
                const f32x4 v0 = acc[ai][bj][m][0] * sc * g0, v1 = acc[ai][bj][m][1] * sc * g1;
                *(u32x4*)((bj ? d1 : d0) + (size_t)rl * 128 + wc * 32 + fq * 8) = pack8(v0, v1); } }
}

struct EpiIn {
    static constexpr bool PERM = true, AFTER_DRAIN = false, HAS_MID = false; int mid_t;
    bf16_t *Q, *Kh, *V, *U, *GG; float* LF; const float *g_q, *g_k, *b_f; PG8_LAS float* red;
    __device__ __forceinline__ void operator()(const f32x4 (&acc)[2][2][4][2], const Unit& u, int wr, int wc, int fr, int fq) const {
        asm volatile("" : "+v"(fr), "+v"(fq));
        const int pn = u.pn, row0 = u.pm * BM, b = row0 >> 11, s0 = row0 & 2047;
        if (pn < 12) {
            const int h0 = (pn & 3) * 2; bf16_t* const q_ = Q; bf16_t* const k_ = Kh; bf16_t* const v_ = V; const float* const gq_ = g_q; const float* const gk_ = g_k;
            bf16_t* base = pn < 4 ? q_ : (pn < 8 ? k_ : v_);
            bf16_t* d0 = base + ((size_t)(b * 8 + h0) * 2048 + s0) * 128; bf16_t* d1 = d0 + (size_t)2048 * 128;
            if (pn < 8) { float rs[2][4]; head_norm_store<false>(acc, rs, pn < 4 ? gq_ : gk_, d0, d1, red, wr, wc, fr, fq); }
            else store_tile<0>(acc, d0, d1, 128, wr, wc, fr, fq);
        } else if (pn < 16) { bf16_t* const u_ = U; bf16_t* d0 = u_ + (size_t)row0 * 1024 + (pn - 12) * 256; store_tile<0>(acc, d0, d0 + 128, 1024, wr, wc, fr, fq); }
        else if (pn < 20) { bf16_t* const g_ = GG; bf16_t* d0 = g_ + (size_t)row0 * 1024 + (pn - 16) * 256; store_tile<1>(acc, d0, d0 + 128, 1024, wr, wc, fr, fq); }
        else if (wc == 0 && fq == 0) {
            const f32x4 b0 = *(const f32x4*)b_f, b1 = *(const f32x4*)(b_f + 4);
#pragma unroll
            for (int ai = 0; ai < 2; ++ai)
#pragma unroll
                for (int m = 0; m < 4; ++m) { const int row = row0 + ai * HALF + wr * 64 + m * 16 + fr; f32x4 z0 = acc[ai][0][m][0] + b0, z1 = acc[ai][0][m][1] + b1;
#pragma unroll
                    for (int j = 0; j < 4; ++j) { z0[j] = fminf(z0[j], 0.f) - fast_log1p(__expf(-fabsf(z0[j]))); z1[j] = fminf(z1[j], 0.f) - fast_log1p(__expf(-fabsf(z1[j]))); }
                    *(f32x4*)(LF + (size_t)row * 8) = z0; *(f32x4*)(LF + (size_t)row * 8 + 4) = z1; }
        }
    }
};
struct EpiCkv {
    static constexpr bool PERM = true, AFTER_DRAIN = false, HAS_MID = false; int mid_t;
    bf16_t *CK, *CV; const float* g_ck; PG8_LAS float* red;
    __device__ __forceinline__ void operator()(const f32x4 (&acc)[2][2][4][2], const Unit& u, int wr, int wc, int fr, int fq) const {
        asm volatile("" : "+v"(fr), "+v"(fq));
        const int pn = u.pn, b = u.pm, h0 = (pn & 1) * 2;
        bf16_t* const ck_ = CK; bf16_t* const cv_ = CV; bf16_t* d0 = (pn < 2 ? ck_ : cv_) + ((size_t)(b * 4 + h0) * 256) * 128; bf16_t* d1 = d0 + (size_t)256 * 128;
        if (pn < 2) { float rs[2][4]; head_norm_store<false>(acc, rs, g_ck, d0, d1, red, wr, wc, fr, fq); }
        else store_tile<0>(acc, d0, d1, 128, wr, wc, fr, fq);
    }
};
struct EpiCq {
    static constexpr bool PERM = true, AFTER_DRAIN = false, HAS_MID = false; int mid_t;
    bf16_t* CQ; const float* g_cq; const float* SSQ; PG8_LAS float* red;
    __device__ __forceinline__ void operator()(const f32x4 (&acc)[2][2][4][2], const Unit& u, int wr, int wc, int fr, int fq) const {
        asm volatile("" : "+v"(fr), "+v"(fq));
        const int pn = u.pn, row0 = u.pm * BM, b = row0 >> 11, s0 = row0 & 2047, h0 = pn * 2, tid = (wr * 4 + wc) * 64 + fq * 16 + fr;
        PG8_LAS float* tab = red + 2048;
        if (tid < 256) tab[tid] = __builtin_amdgcn_rsqf(sum_f(SSQ + (size_t)(row0 + tid) * 32, 8) * (1.0f / 2048.0f) + RMS_EPS);
        asm volatile("s_waitcnt lgkmcnt(0)" ::: "memory"); __builtin_amdgcn_s_barrier(); asm volatile("" ::: "memory");
        float rs[2][4];
#pragma unroll
        for (int ai = 0; ai < 2; ++ai)
#pragma unroll
            for (int m = 0; m < 4; ++m) rs[ai][m] = tab[ai * HALF + wr * 64 + m * 16 + fr];
        bf16_t* d0 = CQ + ((size_t)(b * 4 + h0) * 2048 + s0) * 128; bf16_t* d1 = d0 + (size_t)2048 * 128;
        head_norm_store<true>(acc, rs, g_cq, d0, d1, red, wr, wc, fr, fq);
    }
};
template <bool MID> struct EpiRes {
    static constexpr bool PERM = true, AFTER_DRAIN = false, HAS_MID = MID; int mid_t;
    const float* resid; const bf16_t* residb; float* outf; bf16_t* outb; float* ssq_out; const float *ssqf, *ssql;
    __device__ __forceinline__ void mid(f32x4 (&acc)[2][2][4][2], const Unit& u, int wr, int wc, int fr, int fq) const {
        asm volatile("" : "+v"(fr), "+v"(fq));
#pragma unroll
        for (int ai = 0; ai < 2; ++ai)
#pragma unroll
            for (int m = 0; m < 4; ++m) { const size_t row = (size_t)u.pm * BM + ai * HALF + wr * 64 + m * 16 + fr;
                const float rf = __builtin_amdgcn_rsqf(sum_f(ssqf + row * 8, 2) * (1.0f / 1024.0f) + RMS_EPS), rl = __builtin_amdgcn_rsqf(sum_f(ssql + row * 8, 2) * (1.0f / 1024.0f) + RMS_EPS);
                const float ratio = rf / rl;
#pragma unroll
                for (int bj = 0; bj < 2; ++bj)
#pragma unroll
                    for (int n = 0; n < 2; ++n) acc[ai][bj][m][n] = acc[ai][bj][m][n] * ratio;
                __builtin_amdgcn_sched_barrier(0); }
    }
    __device__ __forceinline__ void operator()(const f32x4 (&acc)[2][2][4][2], const Unit& u, int wr, int wc, int fr, int fq) const {
        asm volatile("" : "+v"(fr), "+v"(fq));
#pragma unroll
        for (int ai = 0; ai < 2; ++ai)
#pragma unroll
            for (int m = 0; m < 4; ++m) { const size_t row = (size_t)u.pm * BM + ai * HALF + wr * 64 + m * 16 + fr;
                float sc = 1.f; if (MID) sc = __builtin_amdgcn_rsqf(sum_f(ssql + row * 8, 2) * (1.0f / 1024.0f) + RMS_EPS);
                float ss = 0.f;
#pragma unroll
                for (int bj = 0; bj < 2; ++bj) { const size_t o = row * 2048 + u.pn * BM + bj * HALF + wc * 32 + fq * 8;
                    f32x4 r0, r1;
                    if (residb) { const u32x4 w = *(const u32x4*)(residb + o); r0 = (f32x4){__uint_as_float(w.x << 16), __uint_as_float(w.x & 0xffff0000u), __uint_as_float(w.y << 16), __uint_as_float(w.y & 0xffff0000u)};
                                  r1 = (f32x4){__uint_as_float(w.z << 16), __uint_as_float(w.z & 0xffff0000u), __uint_as_float(w.w << 16), __uint_as_float(w.w & 0xffff0000u)}; }
                    else { r0 = *(const f32x4*)(resid + o); r1 = *(const f32x4*)(resid + o + 4); }
                    const f32x4 v0 = r0 + acc[ai][bj][m][0] * sc, v1 = r1 + acc[ai][bj][m][1] * sc;
                    if (outf) { *(f32x4*)(outf + o) = v0; *(f32x4*)(outf + o + 4) = v1; }
                    ss += (v0[0] * v0[0] + v0[1] * v0[1]) + (v0[2] * v0[2] + v0[3] * v0[3]) + (v1[0] * v1[0] + v1[1] * v1[1]) + (v1[2] * v1[2] + v1[3] * v1[3]);
                    if (outb) *(u32x4*)(outb + o) = pack8(v0, v1); }
                if (ssq_out) { ss += shx<16>(ss); ss = sum32(ss); if (fq == 0) ssq_out[row * 32 + u.pn * 4 + wc] = ss; }
                __builtin_amdgcn_sched_barrier(0); }
    }
};
struct EpiGu {
    static constexpr bool PERM = true, AFTER_DRAIN = false, HAS_MID = false; int mid_t;
    bf16_t* H; const float* SSQ; PG8_LAS float* red;
    __device__ __forceinline__ void operator()(const f32x4 (&acc)[2][2][4][2], const Unit& u, int wr, int wc, int fr, int fq) const {
        asm volatile("" : "+v"(fr), "+v"(fq));
        const int tid = (wr * 4 + wc) * 64 + fq * 16 + fr; PG8_LAS float* tab = red + 2048;
        if (tid < 256) tab[tid] = __builtin_amdgcn_rsqf(sum_f(SSQ + ((size_t)u.pm * BM + tid) * 32, 8) * (1.0f / 2048.0f) + RMS_EPS);
        asm volatile("s_waitcnt lgkmcnt(0)" ::: "memory"); __builtin_amdgcn_s_barrier(); asm volatile("" ::: "memory");
#pragma unroll
        for (int ai = 0; ai < 2; ++ai)
#pragma unroll
            for (int m = 0; m < 4; ++m) { const size_t row = (size_t)u.pm * BM + ai * HALF + wr * 64 + m * 16 + fr;
                const float rs = tab[ai * HALF + wr * 64 + m * 16 + fr];
                f32x4 h[2];
#pragma unroll
                for (int n = 0; n < 2; ++n) { const f32x4 g = acc[ai][0][m][n] * rs, up = acc[ai][1][m][n] * rs;
#pragma unroll
                    for (int j = 0; j < 4; ++j) h[n][j] = g[j] * sigmoidf_(g[j]) * up[j]; }
                *(u32x4*)(H + row * 5632 + u.pn * HALF + wc * 32 + fq * 8) = pack8(h[0], h[1]); }
    }
};
struct EpiLru {
    static constexpr bool PERM = true, AFTER_DRAIN = true, HAS_MID = false; int mid_t;
    const bf16_t* UC; bf16_t* HL; bf16_t* AC; float* ENDH; float* ENDA; const float *b_ra, *b_ri, *lam; int row0, nblk;
    __device__ __forceinline__ void fused(f32x4 (&acc)[2][2][4][2], const Unit&, int wr, int wc, int fr, int fq, PG8_LAS unsigned char* lds, int wid, int lane) const {
        asm volatile("" : "+v"(fr), "+v"(fq));
        PG8_LAS float* LA = (PG8_LAS float*)lds; PG8_LAS float* LB = LA + 128 * 132;
        const int tid = wid * 64 + lane, ch0 = nblk * 128 + wc * 32 + fq * 8;
        float hc = 0.f, ac = 1.f;
#pragma unroll
        for (int ai = 0; ai < 2; ++ai) {
#pragma unroll
            for (int n = 0; n < 2; ++n) {
                const f32x4 bra = *(const f32x4*)(b_ra + ch0 + 4 * n), bri = *(const f32x4*)(b_ri + ch0 + 4 * n), lm = *(const f32x4*)(lam + ch0 + 4 * n); f32x4 sp;
#pragma unroll
                for (int j = 0; j < 4; ++j) sp[j] = -8.0f * fast_log1p(__expf(-lm[j]));
#pragma unroll
                for (int m = 0; m < 4; ++m) { const int rl = wr * 64 + m * 16 + fr; const unsigned grow = (unsigned)(row0 + ai * HALF + rl);
                    const f32x2 ucw = *(const f32x2*)((const char*)UC + (grow * 1024u + ch0 + 4 * n) * 2u); f32x4 av, bv;
#pragma unroll
                    for (int j = 0; j < 4; ++j) { const unsigned w = __float_as_uint(ucw[j >> 1]); const float uc = __uint_as_float((j & 1) ? (w & 0xffff0000u) : (w << 16));
                        const float r = sigmoidf_(acc[ai][0][m][n][j] + bra[j]), ig = sigmoidf_(acc[ai][1][m][n][j] + bri[j]);
                        const float la = r * sp[j], a_ = __expf(la); av[j] = a_; bv[j] = __builtin_amdgcn_sqrtf(fmaxf(fmaf(-a_, a_, 1.0f), 0.f)) * ig * uc; }
                    *(PG8_LAS f32x4*)(LA + rl * 132 + wc * 32 + fq * 8 + 4 * n) = av; *(PG8_LAS f32x4*)(LB + rl * 132 + wc * 32 + fq * 8 + 4 * n) = bv;
                    __builtin_amdgcn_sched_barrier(0); } }
            asm volatile("s_waitcnt lgkmcnt(0)" ::: "memory"); __builtin_amdgcn_s_barrier(); asm volatile("" ::: "memory");
            if (tid < 128) {
#pragma unroll 8
                for (int rl = 0; rl < 128; ++rl) { const float a_ = LA[rl * 132 + tid]; hc = a_ * hc + LB[rl * 132 + tid]; ac *= a_; LB[rl * 132 + tid] = hc; LA[rl * 132 + tid] = ac; }
                if (ai == 1) { ENDH[nblk * 128 + tid] = hc; ENDA[nblk * 128 + tid] = ac; } }
            asm volatile("s_waitcnt lgkmcnt(0)" ::: "memory"); __builtin_amdgcn_s_barrier(); asm volatile("" ::: "memory");
            const int c8 = (tid & 15) * 8;
#pragma unroll
            for (int p = 0; p < 4; ++p) { const int rl = p * 32 + (tid >> 4); const unsigned o = ((unsigned)(row0 + ai * HALF + rl) * 1024u + nblk * 128 + c8) * 2u;
                const f32x4 h0 = *(const PG8_LAS f32x4*)(LB + rl * 132 + c8), h1 = *(const PG8_LAS f32x4*)(LB + rl * 132 + c8 + 4);
                const f32x4 a0 = *(const PG8_LAS f32x4*)(LA + rl * 132 + c8), a1 = *(const PG8_LAS f32x4*)(LA + rl * 132 + c8 + 4);
                *(u32x4*)((char*)HL + o) = pack8(h0, h1); *(u32x4*)((char*)AC + o) = pack8(a0, a1); }
            asm volatile("s_waitcnt lgkmcnt(0)" ::: "memory"); __builtin_amdgcn_s_barrier(); asm volatile("" ::: "memory");
        }
    }
};
template <class Epi, class Sched, bool ALIGN_EPI = false, bool SP2 = false>
__device__ __forceinline__ void gemm_phase(PG8_LAS unsigned char* lds, const Gemm g, const Sched& S, const Epi& E) {
    int tid_ = my_tid();
    const int tid = tid_, wid = __builtin_amdgcn_readfirstlane(tid >> 6), lane = tid & 63, wr = wid >> 2, wc = wid & 3, fr = lane & 15, fq = lane >> 4;
    const int K = g.K, nt = K / BK;
    unsigned voffA[2], voffB[2];
#pragma unroll
    for (int i = 0; i < 2; ++i) { int R, C; stage_rc(tid * 16 + i * 8192, R, C); const int Rb = Epi::PERM ? ((R & ~31) + perm32(R & 31)) : R;
        voffA[i] = (unsigned)(R * g.lda + C) * 2u; voffB[i] = (unsigned)(Rb * g.ldb + C) * 2u; }
    const size_t kstep = (size_t)(BK * 2);
    const size_t hstepA = (size_t)HALF * g.lda * 2, hstepB = (size_t)HALF * g.ldb * 2;
    const size_t tstepA = 2 * hstepA, tstepB = 2 * hstepB;
    const unsigned ldsw = (unsigned)wid * 1024u;
    const int aoff = lds_byte(wr * 64 + fr, fq * 8), boff = lds_byte(wc * 32 + fr, fq * 8);
#define PG8_SA(b, h) (((b) * 2 + (h)) * HTB)
#define PG8_SB(b, h) ((4 + (b) * 2 + (h)) * HTB)
#define PG8_STAGE(bufoff, gbase, voff) do { _Pragma("unroll") for (int _i = 0; _i < 2; ++_i) \
        __builtin_amdgcn_global_load_lds((const unsigned*)((const char*)(gbase) + (voff)[_i]), (PG8_LAS unsigned*)(lds + (bufoff) + ldsw + _i * 8192), 16, 0, 0); } while (0)
#define PG8_LDA(dst, b, h) do { _Pragma("unroll") for (int m = 0; m < 4; ++m) _Pragma("unroll") for (int k = 0; k < 2; ++k) dst[m][k] = *(const PG8_LAS bf16x8*)(lds + PG8_SA(b, h) + aoff + m * 2048 + k * 1024); } while (0)
#define PG8_LDB(dst, b, h) do { _Pragma("unroll") for (int n = 0; n < 2; ++n) _Pragma("unroll") for (int k = 0; k < 2; ++k) dst[n][k] = *(const PG8_LAS bf16x8*)(lds + PG8_SB(b, h) + boff + n * 2048 + k * 1024); } while (0)
#define PG8_MMA(ai, bj, At, Bt) do { __builtin_amdgcn_s_setprio(1); _Pragma("unroll") for (int m = 0; m < 4; ++m) _Pragma("unroll") for (int n = 0; n < 2; ++n) _Pragma("unroll") for (int k = 0; k < 2; ++k) \
        acc[ai][bj][m][n] = __builtin_amdgcn_mfma_f32_16x16x32_bf16(Bt[n][k], At[m][k], acc[ai][bj][m][n], 0, 0, 0); __builtin_amdgcn_s_setprio(0); } while (0)
#define PG8_WAIT_V(n) asm volatile("s_waitcnt vmcnt(" #n ")" ::: "memory")
#define PG8_WAIT_L(n) asm volatile("s_waitcnt lgkmcnt(" #n ")" ::: "memory")
#define PG8_BAR __builtin_amdgcn_s_barrier()
#define PG8_SCHED __builtin_amdgcn_sched_barrier(0)
    Unit cur, nxt; int ui = 0;
    if (!S.next(0, cur)) return;
    f32x4 acc[2][2][4][2];
#pragma unroll
    for (int a = 0; a < 2; ++a)
#pragma unroll
        for (int b = 0; b < 2; ++b)
#pragma unroll
            for (int m = 0; m < 4; ++m)
#pragma unroll
                for (int n = 0; n < 2; ++n) acc[a][b][m][n] = (f32x4){0.f, 0.f, 0.f, 0.f};
    bf16x8 At[4][2], B0[2][2], B1[2][2];
    const char* cA = (const char*)g.A + (size_t)cur.pm * tstepA; const char* cB = (const char*)g.Bt + (size_t)cur.pn * tstepB;
    S.a_ready(cur);
    if constexpr (SP2) {
        PG8_STAGE(PG8_SB(0, 0), cB, voffB); PG8_STAGE(PG8_SB(0, 1), cB + hstepB, voffB); PG8_STAGE(PG8_SA(0, 0), cA, voffA); PG8_STAGE(PG8_SA(0, 1), cA + hstepA, voffA);
        if (wr == 1) PG8_BAR;
        PG8_WAIT_V(2); PG8_BAR;
        PG8_STAGE(PG8_SB(1, 0), cB + kstep, voffB); PG8_STAGE(PG8_SA(1, 0), cA + kstep, voffA); PG8_STAGE(PG8_SB(1, 1), cB + hstepB + kstep, voffB);
        PG8_WAIT_V(6); PG8_BAR;
    } else {
        PG8_STAGE(PG8_SB(0, 0), cB, voffB); PG8_STAGE(PG8_SA(0, 0), cA, voffA); PG8_STAGE(PG8_SB(0, 1), cB + hstepB, voffB); PG8_STAGE(PG8_SA(0, 1), cA + hstepA, voffA);
        if (wr == 1) PG8_BAR;
        PG8_WAIT_V(4); PG8_BAR;
        PG8_STAGE(PG8_SB(1, 0), cB + kstep, voffB); PG8_STAGE(PG8_SA(1, 0), cA + kstep, voffA); PG8_STAGE(PG8_SB(1, 1), cB + hstepB + kstep, voffB);
        PG8_WAIT_V(6); PG8_BAR;
    }
    for (;;) {
        const bool has_next = S.next(ui + 1, nxt);
        const char* nA = has_next ? (const char*)g.A + (size_t)nxt.pm * tstepA : cA; const char* nB = has_next ? (const char*)g.Bt + (size_t)nxt.pn * tstepB : cB;
        for (int t = 0; t < nt; t += 2) {
            const bool last = (t == nt - 2);
            if constexpr (Epi::HAS_MID) { if (t == E.mid_t) E.mid(acc, cur, wr, wc, fr, fq); }
            const char* a1 = cA + (size_t)(t + 1) * kstep;
            const char* a2 = last ? nA : cA + (size_t)(t + 2) * kstep; const char* b2 = last ? nB : cB + (size_t)(t + 2) * kstep;
            const char* a3 = a2 + kstep; const char* b3 = b2 + kstep;
            if (last && has_next) S.a_ready(nxt);
            if constexpr (SP2) {
            PG8_LDB(B0, 0, 0); PG8_LDB(B1, 0, 1); PG8_SCHED; PG8_LDA(At, 0, 0); PG8_STAGE(PG8_SA(1, 1), a1 + hstepA, voffA);
            PG8_WAIT_V(8); PG8_WAIT_L(0); PG8_BAR; PG8_MMA(0, 0, At, B0); PG8_MMA(0, 1, At, B1); PG8_BAR; PG8_SCHED;
            PG8_LDA(At, 0, 1); PG8_STAGE(PG8_SB(0, 0), b2, voffB); PG8_STAGE(PG8_SB(0, 1), b2 + hstepB, voffB); PG8_STAGE(PG8_SA(0, 0), a2, voffA);
            PG8_WAIT_V(8); PG8_WAIT_L(0); PG8_BAR; PG8_MMA(1, 0, At, B0); PG8_MMA(1, 1, At, B1); PG8_BAR; PG8_SCHED;
            PG8_LDB(B0, 1, 0); PG8_LDB(B1, 1, 1); PG8_SCHED; PG8_LDA(At, 1, 0); PG8_STAGE(PG8_SA(0, 1), a2 + hstepA, voffA);
            PG8_WAIT_V(8); PG8_WAIT_L(0); PG8_BAR; PG8_MMA(0, 0, At, B0); PG8_MMA(0, 1, At, B1); PG8_BAR; PG8_SCHED;
            PG8_LDA(At, 1, 1); PG8_STAGE(PG8_SB(1, 0), b3, voffB); PG8_STAGE(PG8_SB(1, 1), b3 + hstepB, voffB); PG8_STAGE(PG8_SA(1, 0), a3, voffA);
            PG8_WAIT_V(8); PG8_WAIT_L(0); PG8_BAR; PG8_MMA(1, 0, At, B0); PG8_MMA(1, 1, At, B1); PG8_BAR; PG8_SCHED;
            } else {
            PG8_LDB(B0, 0, 0); PG8_SCHED; PG8_LDA(At, 0, 0); PG8_STAGE(PG8_SA(1, 1), a1 + hstepA, voffA);
            PG8_WAIT_L(8); PG8_BAR; PG8_WAIT_L(0); PG8_MMA(0, 0, At, B0); PG8_BAR; PG8_SCHED;
            PG8_LDB(B1, 0, 1); PG8_STAGE(PG8_SB(0, 0), b2, voffB);
            PG8_BAR; PG8_WAIT_L(0); PG8_MMA(0, 1, At, B1); PG8_BAR;
            PG8_LDA(At, 0, 1); PG8_STAGE(PG8_SA(0, 0), a2, voffA);
            PG8_BAR; PG8_WAIT_L(0); PG8_MMA(1, 0, At, B0); PG8_BAR; PG8_SCHED;
            PG8_STAGE(PG8_SB(0, 1), b2 + hstepB, voffB);
            PG8_WAIT_V(6); PG8_BAR; PG8_MMA(1, 1, At, B1); PG8_BAR;
            PG8_LDB(B0, 1, 0); PG8_SCHED; PG8_LDA(At, 1, 0); PG8_STAGE(PG8_SA(0, 1), a2 + hstepA, voffA);
            PG8_WAIT_L(8); PG8_BAR; PG8_WAIT_L(0); PG8_MMA(0, 0, At, B0); PG8_BAR; PG8_SCHED;
            PG8_LDB(B1, 1, 1); PG8_STAGE(PG8_SB(1, 0), b3, voffB);
            PG8_BAR; PG8_WAIT_L(0); PG8_MMA(0, 1, At, B1); PG8_BAR;
            PG8_LDA(At, 1, 1); PG8_STAGE(PG8_SA(1, 0), a3, voffA);
            PG8_BAR; PG8_WAIT_L(0); PG8_MMA(1, 0, At, B0); PG8_BAR; PG8_SCHED;
            PG8_STAGE(PG8_SB(1, 1), b3 + hstepB, voffB);
            PG8_WAIT_V(6); PG8_BAR; PG8_MMA(1, 1, At, B1); PG8_BAR;
            }
        }
        if constexpr (ALIGN_EPI) { if (wr == 0) PG8_BAR; }
        if constexpr (!Epi::AFTER_DRAIN) { E(acc, cur, wr, wc, fr, fq); S.done(cur); }
        if (!has_next) break;
#pragma unroll
        for (int a = 0; a < 2; ++a)
#pragma unroll
            for (int b = 0; b < 2; ++b)
#pragma unroll
                for (int m = 0; m < 4; ++m)
#pragma unroll
                    for (int n = 0; n < 2; ++n) acc[a][b][m][n] = (f32x4){0.f, 0.f, 0.f, 0.f};
        cur = nxt; cA = nA; cB = nB; ++ui;
        if constexpr (ALIGN_EPI) { if (wr == 1) PG8_BAR; }
    }
    PG8_WAIT_V(0);
    if constexpr (!ALIGN_EPI) { if (wr == 0) PG8_BAR; }
    PG8_BAR;
    if constexpr (Epi::AFTER_DRAIN) { E.fused(acc, cur, wr, wc, fr, fq, lds, wid, lane); S.done(cur); }
#undef PG8_SA
#undef PG8_SB
#undef PG8_STAGE
#undef PG8_LDA
#undef PG8_LDB
#undef PG8_MMA
#undef PG8_WAIT_V
#undef PG8_WAIT_L
#undef PG8_BAR
#undef PG8_SCHED
}
}
namespace att {
constexpr int D = 128;
constexpr float THR = 8.f;
constexpr bool WSKIP = false;
constexpr float SCALE = 0.08838834764831845f;
constexpr int NW = 8, QBLK = 32, KVBLK = 64, QB = NW * QBLK;
constexpr int SHM_V = KVBLK * D * 2, SHM_K = KVBLK * D * 2;
constexpr int LDS_BYTES = 2 * SHM_V + 2 * SHM_K + NW * 64 * 4;
using bf16 = __hip_bfloat16;
typedef short bf16x8 __attribute__((ext_vector_type(8)));
typedef short s16x4 __attribute__((ext_vector_type(4)));
typedef float f32x16 __attribute__((ext_vector_type(16)));
typedef float f32x4 __attribute__((ext_vector_type(4)));
typedef unsigned u32x4 __attribute__((ext_vector_type(4)));
template <class A, class Bt> struct same_t { static constexpr bool v = false; };
template <class A> struct same_t<A, A> { static constexpr bool v = true; };

#define KSWZ(row, colB) ((row) * 256 + ((colB) ^ (((row) & 7) << 4)))
#define SBAR() __builtin_amdgcn_sched_barrier(0)
__device__ __forceinline__ int v_st(int k, int c) { const int kk = (k & ~0xC) | ((k & 4) << 1) | ((k & 8) >> 1); return ((kk >> 3) * 4 + (c >> 5)) * 512 + ((kk & 7) * 32 + (c & 31)) * 2; }
__device__ __forceinline__ int v_rd_base(int lane) { return ((lane & 3) << 3) | (((lane >> 2) & 3) << 6) | (((lane >> 4) & 1) << 5) | (((lane >> 5) & 1) << 8); }
constexpr int v_rd_off(int d0, int ks, int half) { return d0 * 512 + ks * 4096 + half * 2048; }
__device__ __forceinline__ int crow(int r, int hi) { return (r & 3) + 8 * (r >> 2) + 4 * hi; }
__device__ __forceinline__ unsigned cvtpk(float lo, float hi) {
    unsigned r; asm volatile("v_cvt_pk_bf16_f32 %0, %1, %2" : "=v"(r) : "v"(lo), "v"(hi)); return r;
}
__device__ __forceinline__ bf16x8 pack8(f32x4 a, f32x4 b) {
    u32x4 w = {cvtpk(a[0], a[1]), cvtpk(a[2], a[3]), cvtpk(b[0], b[1]), cvtpk(b[2], b[3])};
    return *reinterpret_cast<bf16x8*>(&w);
}
template <class T> __device__ __forceinline__ bf16x8 load8(const T* p) {
    if constexpr (same_t<T, float>::v) { return pack8(*(const f32x4*)p, *(const f32x4*)(p + 4)); }
    else { return *reinterpret_cast<const bf16x8*>(p); }
}
__device__ __forceinline__ void mask_tile(f32x16& p0, f32x16& p1, int dq, unsigned W) {
    const float NEG = -__builtin_inff();
#pragma unroll
    for (int r = 0; r < 16; ++r) {
        const int c = (r & 3) + 8 * (r >> 2);
        if ((unsigned)(dq - c) >= W) p0[r] = NEG;
        if ((unsigned)(dq - c - 32) >= W) p1[r] = NEG;
    }
}
__device__ __forceinline__ void partialSM(f32x16& p0, f32x16& p1, float& m_reg, float& mn, float& alpha) {
    float pmax = p0[0]; for (int r = 1; r < 16; ++r) pmax = fmaxf(pmax, p0[r]); for (int r = 0; r < 16; ++r) pmax = fmaxf(pmax, p1[r]);
    { auto rr = __builtin_amdgcn_permlane32_swap(__float_as_uint(pmax), __float_as_uint(pmax), false, false);
      pmax = fmaxf(__uint_as_float(rr[0]), __uint_as_float(rr[1])); }
    constexpr float C2 = 1.4426950408889634f * SCALE;
    if (__builtin_expect(__all((pmax - m_reg) * SCALE <= THR), 1)) { mn = m_reg; alpha = 1.f; }
    else { mn = fmaxf(m_reg, pmax); alpha = __builtin_amdgcn_exp2f((m_reg - mn) * C2); m_reg = mn; }
    const float mnL = -mn * C2;
    for (int r = 0; r < 16; ++r) p0[r] = fmaf(p0[r], C2, mnL); for (int r = 0; r < 16; ++r) p1[r] = fmaf(p1[r], C2, mnL);
    for (int r = 0; r < 16; ++r) p0[r] = __builtin_amdgcn_exp2f(p0[r]);
}
__device__ __forceinline__ void finishSM(f32x16& p0, f32x16& p1, float alpha, float& l_reg, bf16x8& pa0, bf16x8& pa1, bf16x8& pa2, bf16x8& pa3) {
    for (int r = 0; r < 16; ++r) p1[r] = __builtin_amdgcn_exp2f(p1[r]);
    float ps = 0; for (int r = 0; r < 16; ++r) ps += p0[r]; for (int r = 0; r < 16; ++r) ps += p1[r];
    { auto rr = __builtin_amdgcn_permlane32_swap(__float_as_uint(ps), __float_as_uint(ps), false, false);
      ps = __uint_as_float(rr[0]) + __uint_as_float(rr[1]); }
    l_reg = l_reg * alpha + ps;
#define PK4(P, B_, OUT) do { unsigned a0 = cvtpk(P[B_+0], P[B_+1]), a1 = cvtpk(P[B_+2], P[B_+3]);                          \
        unsigned b0 = cvtpk(P[B_+4], P[B_+5]), b1 = cvtpk(P[B_+6], P[B_+7]);                                             \
        auto r0 = __builtin_amdgcn_permlane32_swap(a0, b0, false, false); auto r1 = __builtin_amdgcn_permlane32_swap(a1, b1, false, false); \
        u32x4 w = {r0[0], r1[0], r0[1], r1[1]}; OUT = *reinterpret_cast<bf16x8*>(&w); } while (0)
    PK4(p0, 0, pa0); PK4(p0, 8, pa1); PK4(p1, 0, pa2); PK4(p1, 8, pa3);
#undef PK4
}
template <int KB, bool SK>
__device__ __forceinline__ void qkt(f32x16& p0, f32x16& p1, const char* K_lds, int r32, int hi, const bf16x8* qr, bool act, int cbo  ) {
    if (SK && !act) { const float NEG = -__builtin_inff();
#pragma unroll
        for (int r = 0; r < 16; ++r) { p0[r] = NEG; p1[r] = NEG; } return; }
    if (cbo >= 0) { int a_ = cbo + hi * 16; asm volatile("" : "+v"(a_)); const __attribute__((address_space(3))) float* cb = (const __attribute__((address_space(3))) float*)(unsigned)a_;
#pragma unroll
        for (int q_ = 0; q_ < 4; ++q_) { const f32x4 v0_ = *(const __attribute__((address_space(3))) f32x4*)(cb + 8 * q_), v1_ = *(const __attribute__((address_space(3))) f32x4*)(cb + 32 + 8 * q_);
#pragma unroll
            for (int j_ = 0; j_ < 4; ++j_) { p0[4 * q_ + j_] = v0_[j_]; p1[4 * q_ + j_] = v1_[j_]; } }
    } else { p0 = f32x16{}; p1 = f32x16{}; }
    const char* kb[4];
#pragma unroll
    for (int dd = 0; dd < 4; ++dd) kb[dd] = K_lds + KB * SHM_K + KSWZ(r32, (dd * 16 + hi * 8) * 2);
#pragma unroll
    for (int d0 = 0; d0 < 8; ++d0) { const char* a = kb[d0 & 3] + (d0 >> 2) * 128;
        bf16x8 b0 = *reinterpret_cast<const bf16x8*>(a);
        bf16x8 b1 = *reinterpret_cast<const bf16x8*>(a + 32 * 256);
        p0 = __builtin_amdgcn_mfma_f32_32x32x16_bf16(b0, qr[d0], p0, 0, 0, 0);
        p1 = __builtin_amdgcn_mfma_f32_32x32x16_bf16(b1, qr[d0], p1, 0, 0, 0); }
}
template <int VB, bool SK>
__device__ __forceinline__ void pv_tile(f32x16* o, int vb0, bf16x8 pa0, bf16x8 pa1, bf16x8 pa2, bf16x8 pa3, bool act) {
    if (SK && !act) return;
#define TRRD(dst, off) asm volatile("ds_read_b64_tr_b16 %0, %1 offset:%2" : "=&v"(dst) : "v"(vb0), "i"(off) : "memory")
#define PV_D0(d0) do { s16x4 l0, l1, l2, l3, h0, h1, h2, h3; constexpr int b_ = VB * SHM_V + v_rd_off(d0, 0, 0);     \
        TRRD(l0, b_); TRRD(h0, b_ + 2048); TRRD(l1, b_ + 4096); TRRD(h1, b_ + 6144); TRRD(l2, b_ + 8192); TRRD(h2, b_ + 10240); TRRD(l3, b_ + 12288); TRRD(h3, b_ + 14336); \
        asm volatile("s_waitcnt lgkmcnt(0)" ::: "memory"); SBAR();                 \
        o[d0] = __builtin_amdgcn_mfma_f32_32x32x16_bf16(pa0, (bf16x8){l0[0], l0[1], l0[2], l0[3], h0[0], h0[1], h0[2], h0[3]}, o[d0], 0, 0, 0);   \
        o[d0] = __builtin_amdgcn_mfma_f32_32x32x16_bf16(pa1, (bf16x8){l1[0], l1[1], l1[2], l1[3], h1[0], h1[1], h1[2], h1[3]}, o[d0], 0, 0, 0);   \
        o[d0] = __builtin_amdgcn_mfma_f32_32x32x16_bf16(pa2, (bf16x8){l2[0], l2[1], l2[2], l2[3], h2[0], h2[1], h2[2], h2[3]}, o[d0], 0, 0, 0);   \
        o[d0] = __builtin_amdgcn_mfma_f32_32x32x16_bf16(pa3, (bf16x8){l3[0], l3[1], l3[2], l3[3], h3[0], h3[1], h3[2], h3[3]}, o[d0], 0, 0, 0); } while (0)
    PV_D0(0); PV_D0(1); PV_D0(2); PV_D0(3);
#undef PV_D0
#undef TRRD
}

template <class T> __device__ __forceinline__ T* uptr(T* p) { const unsigned long long v = (unsigned long long)p; const unsigned lo = __builtin_amdgcn_readfirstlane((unsigned)v), hi = __builtin_amdgcn_readfirstlane((unsigned)(v >> 32)); return (T*)(((unsigned long long)hi << 32) | lo); }
template <class TIn, class TOut> struct BlockRef { const TIn* Q; const TIn* K; const TIn* V; TOut* O; float* SS; int P0; };
template <class TIn> struct Seam {
    bf16x8 qr[8];
    bf16x8 st_v0, st_v1, st_k0, st_k1; f32x4 sf0, sf1, sf2, sf3;
    f32x4 tq[16];
};
__device__ __forceinline__ int swa_jlo(int P0, int W) { const int lowk = P0 - W + 1; return lowk > 0 ? lowk / KVBLK : 0; }
#define ROW(p, k0, rr) ((decltype(p))((const char*)(p) + (unsigned)(((k0) + (rr)) * D + sc) * (unsigned)sizeof(*(p))))
#define VMW() asm volatile("s_waitcnt vmcnt(0)" ::: "memory")
#define VMWN(n) asm volatile("s_waitcnt vmcnt(%0)" :: "i"(n) : "memory")
#define SLOAD_H(Kp, Vp, k0) do { S.st_v0 = load8<TIn>(ROW(Vp, k0, sr)); S.st_v1 = load8<TIn>(ROW(Vp, k0, 32 + sr));              \
                         S.st_k0 = load8<TIn>(ROW(Kp, k0, sr)); S.st_k1 = load8<TIn>(ROW(Kp, k0, 32 + sr)); } while (0)
#define SWRITE_HK(bf) do { *(bf16x8*)(K_lds + (bf) * SHM_K + kws) = S.st_k0; *(bf16x8*)(K_lds + (bf) * SHM_K + kws + 32 * 256) = S.st_k1; } while (0)
#define SWRITE_HV(bf) do { *(bf16x8*)(V_lds + (bf) * SHM_V + vst0) = S.st_v0; *(bf16x8*)(V_lds + (bf) * SHM_V + vst1) = S.st_v1; } while (0)
#define SWRITE_H(bf) do { SWRITE_HV(bf); SWRITE_HK(bf); } while (0)
#define SLOAD_F(p, k0) do { S.sf0 = *(const f32x4*)ROW(p, k0, sr); S.sf1 = *(const f32x4*)(ROW(p, k0, sr) + 4);                \
                            S.sf2 = *(const f32x4*)ROW(p, k0, 32 + sr); S.sf3 = *(const f32x4*)(ROW(p, k0, 32 + sr) + 4); } while (0)
#define SWRITE_KF(bf) do { *(bf16x8*)(K_lds + (bf) * SHM_K + kws) = pack8(S.sf0, S.sf1); *(bf16x8*)(K_lds + (bf) * SHM_K + kws + 32 * 256) = pack8(S.sf2, S.sf3); } while (0)
#define SWRITE_VF(bf) do { *(bf16x8*)(V_lds + (bf) * SHM_V + vst0) = pack8(S.sf0, S.sf1); *(bf16x8*)(V_lds + (bf) * SHM_V + vst1) = pack8(S.sf2, S.sf3); } while (0)
template <class TIn, class TOut>
__device__ __forceinline__ void causal_swa_prime(const BlockRef<TIn, TOut>& cur_, int W, char* lds, Seam<TIn>& S) {
    BlockRef<TIn, TOut> cur; cur.Q = uptr(cur_.Q); cur.K = uptr(cur_.K); cur.V = uptr(cur_.V); cur.O = nullptr; cur.SS = nullptr; cur.P0 = __builtin_amdgcn_readfirstlane(cur_.P0);
    constexpr bool F32 = same_t<TIn, float>::v;
    int tid_ = my_tid();
    const int tid = tid_, wid = __builtin_amdgcn_readfirstlane(tid >> 6), lane = tid & 63, r32 = lane & 31, hi = lane >> 5;
    const int sr = tid >> 4, sc = (tid & 15) * 8, kws = KSWZ(sr, sc * 2); char* K_lds = lds + 2 * SHM_V;
    const int kb0 = swa_jlo(cur.P0, W) * KVBLK;
    for (int d0 = 0; d0 < 8; ++d0) S.qr[d0] = load8<TIn>((const TIn*)((const char*)cur.Q + (unsigned)((wid * QBLK + r32) * D + d0 * 16 + hi * 8) * (unsigned)sizeof(TIn)));
    if constexpr (F32) { SLOAD_F((const float*)cur.K, kb0); VMW(); SWRITE_KF(0); SBAR(); SLOAD_F((const float*)cur.V, kb0); }
    else { SLOAD_H(cur.K, cur.V, kb0); VMW(); SWRITE_HK(0); }
    __syncthreads();
}
template <class TIn, class TOut, int ost, bool HAS_SS>
__device__ __forceinline__ void causal_swa_block(const BlockRef<TIn, TOut>& cur_, const BlockRef<TIn, TOut>& nxt_, int skv, int W, char* lds, Seam<TIn>& S, int cbl  ) {
    constexpr bool F32 = same_t<TIn, float>::v;
    BlockRef<TIn, TOut> cur, nxt; cur.Q = uptr(cur_.Q); cur.K = uptr(cur_.K); cur.V = uptr(cur_.V); cur.O = uptr(cur_.O); cur.SS = uptr(cur_.SS); cur.P0 = __builtin_amdgcn_readfirstlane(cur_.P0);
    nxt.Q = uptr(nxt_.Q); nxt.K = uptr(nxt_.K); nxt.V = uptr(nxt_.V); nxt.O = nullptr; nxt.SS = nullptr; nxt.P0 = __builtin_amdgcn_readfirstlane(nxt_.P0);
    int tid_ = my_tid();
    const int tid = tid_, wid = __builtin_amdgcn_readfirstlane(tid >> 6), lane = tid & 63, r32 = lane & 31, hi = lane >> 5;
    const int j_lo = swa_jlo(cur.P0, W);
    int j_hi = (cur.P0 + QB - 1) / KVBLK + 1; if (j_hi > skv / KVBLK) j_hi = skv / KVBLK;
    const int NT = j_hi - j_lo;
    const int kbn = swa_jlo(nxt.P0, W) * KVBLK;
    const int qlo = cur.P0 + wid * QBLK, qm = qlo + r32 - 4 * hi;
    char* V_lds = lds; char* K_lds = lds + 2 * SHM_V;
    float* ws = (float*)(lds + 2 * SHM_V + 2 * SHM_K) + wid * 64; float* li_l = ws, * al_l = ws + 32;
    float m_reg = -1e30f, l_reg = 0; f32x16 o[4] = {};
    const int sr = tid >> 4, sc = (tid & 15) * 8, vst0 = v_st(sr, sc), vst1 = v_st(32 + sr, sc), kws = KSWZ(sr, sc * 2);
    const int vb0 = (int)(uintptr_t)V_lds + v_rd_base(lane);
    const TIn* Kh = cur.K; const TIn* Vh = cur.V;
#define RESC(a) do { if (__any((a) < 1.f)) { if (hi == 0) al_l[r32] = (a); asm volatile("s_waitcnt lgkmcnt(0)" ::: "memory");              \
                     for (int d_ = 0; d_ < 4; ++d_) for (int r = 0; r < 16; ++r) o[d_][r] *= al_l[crow(r, hi)]; } } while (0)
#define KBASE(t) ((j_lo + (t)) * KVBLK)
#define CBT(t) (cbl >= 0 ? cbl + KBASE(t) * 4 : -1)
#define ACT(t) (KBASE(t) <= qlo + QBLK - 1 && KBASE(t) + KVBLK - 1 >= qlo - W + 1)
#define MASKT(P0_, P1_, t) do { const int kb_ = KBASE(t); if ((!SK || ACT(t)) && (kb_ + KVBLK - 1 > qlo || kb_ <= qlo + QBLK - 1 - W)) mask_tile(P0_, P1_, qm - kb_, (unsigned)W); } while (0)
    constexpr int NQL = F32 ? 16 : 8;
    constexpr bool SK = WSKIP && !F32;
#define SEAM_K0() do { VMWN(NQL); if constexpr (F32) { SWRITE_KF(0); SBAR(); SLOAD_F((const float*)nxt.V, kbn); } else { SWRITE_HK(0); } SBAR(); } while (0)
    f32x16 pA0, pA1, pB0, pB1; float mnA, mnB, alA, alB; bf16x8 pa0, pa1, pa2, pa3;
    if constexpr (F32) { VMW(); SWRITE_VF(0); SBAR(); } else { SWRITE_HV(0); SBAR(); }
    if (NT > 1) { if constexpr (F32) SLOAD_F((const float*)Kh, KBASE(1)); else SLOAD_H(Kh, Vh, KBASE(1)); }
    SBAR(); qkt<0, SK>(pA0, pA1, K_lds, r32, hi, S.qr, ACT(0), CBT(0));
    if constexpr (F32) { if (NT > 1) { VMW(); SWRITE_KF(1); SBAR(); SLOAD_F((const float*)Vh, KBASE(1)); } }
    MASKT(pA0, pA1, 0); partialSM(pA0, pA1, m_reg, mnA, alA);
    if (NT > 1) { VMW(); if constexpr (F32) { SWRITE_VF(1); SBAR(); if (NT > 2) SLOAD_F((const float*)Kh, KBASE(2)); } else SWRITE_H(1); }
    __syncthreads();
#define HALF_STEP(PX0, PX1, mnX, alX, PY0, PY1, alY, t, KB, VB, SB) do {                                                      \
        SBAR(); qkt<KB, SK>(PX0, PX1, K_lds, r32, hi, S.qr, ACT(t), CBT(t));                                             \
        finishSM(PY0, PY1, alY, l_reg, pa0, pa1, pa2, pa3); SBAR();                                                           \
        if ((t) + 1 < NT) { if constexpr (F32) { VMW(); SWRITE_KF(SB); SBAR(); SLOAD_F((const float*)Vh, KBASE((t) + 1)); }  \
                            else { SLOAD_H(Kh, Vh, KBASE((t) + 1)); } SBAR(); }                                               \
        pv_tile<VB, SK>(o, vb0, pa0, pa1, pa2, pa3, ACT((t) - 1)); MASKT(PX0, PX1, (t)); partialSM(PX0, PX1, m_reg, mnX, alX);                                        \
        __syncthreads();                                                                                                      \
        if ((t) + 1 < NT) { VMW(); if constexpr (F32) { SWRITE_VF(SB); SBAR(); if ((t) + 2 < NT) SLOAD_F((const float*)Kh, KBASE((t) + 2)); } \
                            else { SWRITE_H(SB); } }                                                                          \
        RESC(alX); __syncthreads(); } while (0)
    for (int t = 1; t + 1 < NT; t += 2) {
        HALF_STEP(pB0, pB1, mnB, alB, pA0, pA1, alA, t, 1, 0, 0);
        HALF_STEP(pA0, pA1, mnA, alA, pB0, pB1, alB, t + 1, 0, 1, 1);
    }
    const bool even = (NT & 1) == 0;
    if (even) { SBAR(); qkt<1, SK>(pB0, pB1, K_lds, r32, hi, S.qr, ACT(NT - 1), CBT(NT - 1)); SBAR(); }
#define QROW(e) (nxt.Q + (size_t)(wid * QBLK + r32) * D + ((e) >> 1) * 16 + hi * 8 + ((e) & 1) * 4)
    if constexpr (F32) { SLOAD_F((const float*)nxt.K, kbn); SBAR();
#pragma unroll
        for (int e = 0; e < 8; ++e) S.tq[e] = *(const f32x4*)QROW(e); }
    else { SLOAD_H(nxt.K, nxt.V, kbn); SBAR();
#pragma unroll
        for (int d0 = 0; d0 < 8; ++d0) S.qr[d0] = load8<TIn>((const TIn*)((const char*)nxt.Q + (unsigned)((wid * QBLK + r32) * D + d0 * 16 + hi * 8) * (unsigned)sizeof(TIn))); }
    SBAR();
    finishSM(pA0, pA1, alA, l_reg, pa0, pa1, pa2, pa3); SBAR();
    if constexpr (F32) {
#pragma unroll
        for (int e = 8; e < 16; ++e) S.tq[e] = *(const f32x4*)QROW(e); SBAR(); }
#undef QROW
    pv_tile<0, SK>(o, vb0, pa0, pa1, pa2, pa3, ACT(even ? NT - 2 : NT - 1));
    if (even) { MASKT(pB0, pB1, NT - 1); partialSM(pB0, pB1, m_reg, mnB, alB); __syncthreads(); RESC(alB);
        finishSM(pB0, pB1, alB, l_reg, pa0, pa1, pa2, pa3); SBAR(); pv_tile<1, SK>(o, vb0, pa0, pa1, pa2, pa3, ACT(NT - 1)); }
    SBAR(); SEAM_K0();
    if (hi == 0) li_l[r32] = l_reg; asm volatile("s_waitcnt lgkmcnt(0)" ::: "memory");
    float rli[16];
#pragma unroll
    for (int r = 0; r < 16; ++r) rli[r] = __builtin_amdgcn_rcpf(li_l[crow(r, hi)]);
    int r32e = r32, hie = hi; asm volatile("" : "+v"(r32e), "+v"(hie));
    char* Ob = (char*)cur.O; const unsigned ob0 = (unsigned)((wid * QBLK + 4 * hie) * ost + r32e) * 2u;
#pragma unroll
    for (int r = 0; r < 16; ++r) { const unsigned rowoff = ob0 + (unsigned)(((r & 3) + 8 * (r >> 2)) * ost * 2); float ss_ = 0.f;
#pragma unroll
        for (int d0 = 0; d0 < 4; ++d0) { const float v = o[d0][r] * rli[r]; ss_ += v * v;
            const float vn = shx<1>(v);
            if ((r32e & 1) == 0) *(unsigned*)(Ob + rowoff + d0 * 64) = cvtpk(v, vn); }
        if (HAS_SS) { ss_ += shx<1>(ss_); ss_ += shx<2>(ss_); ss_ += shx<4>(ss_); ss_ += shx<8>(ss_); ss_ += shx<16>(ss_);
            if (r32e == 0) *(float*)((char*)cur.SS + (unsigned)(wid * QBLK + 4 * hie + (r & 3) + 8 * (r >> 2)) * 32u) = ss_; }
        SBAR(); }
    if constexpr (F32) {
#pragma unroll
        for (int d0 = 0; d0 < 8; ++d0) S.qr[d0] = pack8(S.tq[2 * d0], S.tq[2 * d0 + 1]); }
    __syncthreads();
#undef RESC
#undef KBASE
#undef CBT
#undef ACT
#undef MASKT
#undef SEAM_K0
#undef HALF_STEP
}
#undef ROW
}

#define GAS __attribute__((address_space(1)))
#define LAS __attribute__((address_space(3)))
typedef unsigned short bf16;
typedef unsigned v4u __attribute__((ext_vector_type(4)));
typedef float f32x4 __attribute__((ext_vector_type(4)));
#define LDS_WAIT() asm volatile("s_waitcnt lgkmcnt(0)" ::: "memory")
#define VM_WAIT() asm volatile("s_waitcnt vmcnt(0)" ::: "memory")
__device__ __forceinline__ unsigned f2bf(float f) { unsigned u = __builtin_bit_cast(unsigned, f); return (u + 0x7fffu + ((u >> 16) & 1u)) >> 16; }
__device__ __forceinline__ unsigned pk2(float lo, float hi) { return f2bf(lo) | (f2bf(hi) << 16); }
__device__ __forceinline__ float bflo(unsigned w) { return __uint_as_float(w << 16); }
__device__ __forceinline__ float bfhi(unsigned w) { return __uint_as_float(w & 0xffff0000u); }

#ifndef LB2
#define LB2 2
#endif
#ifndef FOX_HAS_SS
#define FOX_HAS_SS false
#endif
#ifndef FOX_SS
#define FOX_SS (SSQF + ((size_t)b * SEQ + x * 256) * 8 + h)
#endif
#ifndef FOX_CB
#define FOX_CB CB_OFF
#endif
#ifndef USE_XB
#define USE_XB 1
#endif
#if USE_XB
#define GSYNC() xcd_barrier(xbar)
#else
#define GSYNC() grid.sync()
#endif
#ifndef REP
#define REP 0
#endif
#ifndef PH
#define PH 0x1ff
#endif
constexpr int NWAVES = 8, NTHR = 512;
constexpr int BATCH = 4, SEQ = 2048, DM = 2048, M = BATCH * SEQ, NMEM = 256, MMEM = BATCH * NMEM;
constexpr int FOXW = 1024, LRUW = 1024, INW = 5128, INWP = 5376, XW = 512, FFN = 5632;
constexpr float EPS = 1e-6f;
constexpr size_t MiB = 1u << 20;
constexpr size_t WS_WIN = 1 * MiB, WS_WOUT = 22 * MiB, WS_WCQ = 30 * MiB, WS_WCKV = 32 * MiB, WS_WCO = 36 * MiB, WS_WGU = 38 * MiB, WS_WDN = 82 * MiB, WS_WLRU = 104 * MiB;
constexpr size_t WS_XN = 105 * MiB, WS_MN = 137 * MiB, WS_Q = 141 * MiB, WS_K = 157 * MiB, WS_V = 173 * MiB, WS_U = 189 * MiB, WS_GG = 205 * MiB, WS_UC = 221 * MiB;
constexpr size_t WS_LF = 237 * MiB, WS_CK = 238 * MiB, WS_CV = 239 * MiB, WS_MIX = 240 * MiB, WS_SSQF = 272 * MiB, WS_SSQL = 273 * MiB, WS_X1 = 274 * MiB;
constexpr size_t WS_SSQ1 = 338 * MiB, WS_CQ = 339 * MiB, WS_SSQ2 = 347 * MiB, WS_END = 348 * MiB;
constexpr size_t WS_HL = WS_X1, WS_AC = WS_X1 + 16 * MiB, WS_ENDH = WS_SSQ2, WS_ENDA = WS_SSQ2 + 256 * 1024;
constexpr size_t WS_X1B = WS_XN  , WS_OX = WS_Q  , WS_X2B = WS_MIX  , WS_H = WS_Q  ;
constexpr int LDS_BYTES = 147456, RED_OFF = 131072, CB_OFF = 69632, WSUM_OFF = 77824;

__device__ __forceinline__ float wave_sum(float v) { v += shx<1>(v); v += shx<2>(v); v += shx<4>(v); v += shx<8>(v); v += shx<16>(v); return sum32(v); }
__device__ __forceinline__ void transpose_item(const float* W, int ldw, int k0, int srcn0, int nvalid, const float* ks, bf16* WT, int ldt, int drow0, LAS float* scr, int lane) {
    f32x4 v[8];
#pragma unroll
    for (int i = 0; i < 8; ++i) { const int kk = 8 * i + (lane >> 3), n4 = (lane & 7) * 4;
        v[i] = (n4 < nvalid) ? *(const GAS f32x4*)(W + (size_t)(k0 + kk) * ldw + srcn0 + n4) : (f32x4){0.f, 0.f, 0.f, 0.f}; }
#pragma unroll
    for (int i = 0; i < 8; ++i) { const int kk = 8 * i + (lane >> 3), n4 = (lane & 7) * 4; f32x4 x = v[i]; if (ks) x = x * ks[k0 + kk];
        LAS float* d = scr + kk * 33 + n4; d[0] = x.x; d[1] = x.y; d[2] = x.z; d[3] = x.w; }
    LDS_WAIT(); asm volatile("" ::: "memory");
    const int c = lane & 7;
#pragma unroll
    for (int j = 0; j < 4; ++j) { const int n = (lane >> 3) + 8 * j; const LAS float* s = scr + (8 * c) * 33 + n;
        v4u o; o.x = pk2(s[0 * 33], s[1 * 33]); o.y = pk2(s[2 * 33], s[3 * 33]); o.z = pk2(s[4 * 33], s[5 * 33]); o.w = pk2(s[6 * 33], s[7 * 33]);
        *(GAS v4u*)(WT + (size_t)(drow0 + n) * ldt + k0 + 8 * c) = o; }
    LDS_WAIT(); asm volatile("" ::: "memory");
}
__device__ __forceinline__ void rms_row_to_bf16(const float* xrow, const float* g, bf16* orow, int lane) {
    const GAS f32x4* xr = (const GAS f32x4*)xrow + lane; const GAS f32x4* gr = (const GAS f32x4*)g + lane;
    f32x4 v[8]; float s = 0.f;
#pragma unroll
    for (int j = 0; j < 8; ++j) { v[j] = xr[64 * j]; s += (v[j].x * v[j].x + v[j].y * v[j].y) + (v[j].z * v[j].z + v[j].w * v[j].w); }
    const float rstd = 1.0f / sqrtf(wave_sum(s) * (1.f / DM) + EPS);
    GAS unsigned long long* o8 = (GAS unsigned long long*)orow + lane;
#pragma unroll
    for (int j = 0; j < 8; ++j) { const f32x4 gg = gr[64 * j]; o8[64 * j] = (unsigned long long)pk2(v[j].x * rstd * gg.x, v[j].y * rstd * gg.y) | ((unsigned long long)pk2(v[j].z * rstd * gg.z, v[j].w * rstd * gg.w) << 32); }
}

#define XB_TMO      128
#define XB_XCNT(j)  (256  + 64 * (j))
#define XB_XSUB(j)  (1280 + 64 * (j))
#define XB_XGEN(j)  (2304 + 64 * (j))
#define XB_TOP      3328
#define XB_TOPGEN   3392
#define XCD_BAR_WORDS 3456
#define XB_SPIN_CAP (1u << 18)

__device__ __forceinline__ unsigned xb_ld(unsigned* p)              { return __hip_atomic_load(p, __ATOMIC_RELAXED, __HIP_MEMORY_SCOPE_AGENT); }
__device__ __forceinline__ unsigned xb_add(unsigned* p, unsigned v) { return __hip_atomic_fetch_add(p, v, __ATOMIC_RELAXED, __HIP_MEMORY_SCOPE_AGENT); }
__device__ __forceinline__ unsigned xb_xcc_id() { return (unsigned)__builtin_amdgcn_s_getreg((3 << 11) | 20) & 0xFu; }
#define XB_SPIN(cond, bar) do { unsigned _sp = 0; while (cond) { __builtin_amdgcn_s_sleep(1); \
    if ((++_sp & 255u) == 0u) { if (xb_ld(&(bar)[XB_TMO])) break; if (_sp > XB_SPIN_CAP) { atomicAdd(&(bar)[XB_TMO], 1u); break; } } } } while (0)

struct XcdBarrier {
    unsigned* bar; unsigned x;
    volatile LAS unsigned* st;
};

__device__ __forceinline__ XcdBarrier xcd_barrier_post(unsigned* bar, volatile LAS unsigned* st) {
    XcdBarrier b; b.bar = bar; b.x = xb_xcc_id(); b.st = st;
    if (my_tid() == 0) (void)xb_add(&bar[XB_XCNT(b.x)], 1u);
    return b;
}
__device__ __forceinline__ void xcd_barrier_complete(unsigned* bar, unsigned x, unsigned& nloc, unsigned& nx) {
    const unsigned G = gridDim.x * gridDim.y * gridDim.z;
    unsigned sum, cnt, mine, sp = 0u;
    for (;;) {
        sum = 0u; cnt = 0u; mine = 0u;
#pragma unroll
        for (unsigned j = 0; j < 16; ++j) { const unsigned c = xb_ld(&bar[XB_XCNT(j)]); sum += c; cnt += (c > 0u) ? 1u : 0u; mine = (j == x) ? c : mine; }
        if (sum == G) break;
        __builtin_amdgcn_s_sleep(1);
        if ((++sp & 255u) == 0u) { if (xb_ld(&bar[XB_TMO])) break; if (sp > XB_SPIN_CAP) { atomicAdd(&bar[XB_TMO], 1u); break; } }
    }
    nloc = mine > 0u ? mine : 1u; nx = cnt > 0u ? cnt : 1u;
}

__device__ __forceinline__ void xcd_barrier(const XcdBarrier& b) {
    asm volatile("s_waitcnt vmcnt(0)" ::: "memory");
    __syncthreads();
    if (my_tid() == 0) {
        unsigned* bar = b.bar;
        __builtin_amdgcn_s_waitcnt(0);
        unsigned nloc = b.st[0], nx = b.st[1];
        if (nloc == 0u) { xcd_barrier_complete(bar, b.x, nloc, nx); b.st[0] = nloc; b.st[1] = nx; }
        const unsigned old = xb_add(&bar[XB_XSUB(b.x)], 1u);
        const unsigned gen = old / nloc;
        if (old + 1u == (gen + 1u) * nloc) {
            __builtin_amdgcn_fence(__ATOMIC_RELEASE, "agent");
            asm volatile("s_waitcnt vmcnt(0)" ::: "memory");
            const unsigned og = xb_add(&bar[XB_TOP], 1u);
            const unsigned tg = og / nx;
            if (og + 1u == (tg + 1u) * nx) xb_add(&bar[XB_TOPGEN], 1u);
            else XB_SPIN(xb_ld(&bar[XB_TOPGEN]) == tg, bar);
            __builtin_amdgcn_fence(__ATOMIC_ACQUIRE, "agent");
            xb_add(&bar[XB_XGEN(b.x)], 1u);
            asm volatile("s_waitcnt vmcnt(0)" ::: "memory");
        } else {
            XB_SPIN(xb_ld(&bar[XB_XGEN(b.x)]) == gen, bar);
            __builtin_amdgcn_fence(__ATOMIC_ACQUIRE, "agent");
            asm volatile("s_waitcnt vmcnt(0)" ::: "memory");
        }
    }
    __syncthreads();
}

struct Args { const float* in[27]; float* out; unsigned char* ws; };
enum { I_X = 0, I_MEM, I_GMIX, I_WIN, I_BF, I_GQ, I_GK, I_CONVW, I_CONVB, I_WRA, I_BRA, I_WRI, I_BRI, I_LAM, I_GFOX, I_GLRU, I_WOUT, I_GXATTN, I_GMEM, I_WCQ, I_WCKV, I_GCQ, I_GCK, I_WCO, I_GFFN, I_WGU, I_WDN };

constexpr int KB_D = DM / 64;
constexpr int I0 = (INWP / 32) * KB_D, I3 = (2 * XW / 32) * KB_D, I7 = 16 * 4 * 2, N_EARLY = I0 + I3 + I7;
constexpr int I1 = (DM / 32) * KB_D, I2 = (XW / 32) * KB_D, I4 = (DM / 32) * (XW / 64), I5 = (2 * FFN / 32) * KB_D, I6 = (DM / 32) * (FFN / 64), N_LATE = I1 + I2 + I4 + I5 + I6;
constexpr int N_LATE_P1 = I1 + I2 + I4 + 2560;
constexpr int N_LATE_P2 = N_LATE_P1 + 2440;
constexpr int N_LATE_P4A = N_LATE_P2 + 9000;
__device__ __forceinline__ void early_item(const Args& a, int r, LAS float* scr, int lane) {
    unsigned char* ws = a.ws;
    if (r < I0) { const int rg = r / KB_D, kb = r % KB_D, d = rg * 32; int src = d, nv = 32;
        if (d >= 3072 && d < 5120) src = d + 8; else if (d == 5120) { src = 3072; nv = 8; } else if (d > 5120) { src = 0; nv = 0; }
        transpose_item(a.in[I_WIN], INW, kb * 64, src, nv, nullptr, (bf16*)(ws + WS_WIN), DM, d, scr, lane); return; } r -= I0;
    if (r < I3) { const int rg = r / KB_D, kb = r % KB_D;
        transpose_item(a.in[I_WCKV], 2 * XW, kb * 64, rg * 32, 32, nullptr, (bf16*)(ws + WS_WCKV), DM, rg * 32, scr, lane); return; } r -= I3;
    { const int mtx = r >> 3, sub = r & 7, rg = sub >> 1, kb = sub & 1, n = mtx >> 1, which = mtx & 1;
        transpose_item((which ? a.in[I_WRI] : a.in[I_WRA]) + (size_t)n * 128 * 128, 128, kb * 64, rg * 32, 32, nullptr, (bf16*)(ws + WS_WLRU) + (size_t)(n * 256 + which * 128) * 128, 128, rg * 32, scr, lane); }
}
__device__ __forceinline__ void late_item(const Args& a, int r, LAS float* scr, int lane) {
    unsigned char* ws = a.ws;
    if (r < I1) { const int rg = r / KB_D, kb = r % KB_D; const float* ks = kb < 16 ? a.in[I_GFOX] : a.in[I_GLRU] - 1024;
        transpose_item(a.in[I_WOUT], DM, kb * 64, rg * 32, 32, ks, (bf16*)(ws + WS_WOUT), DM, rg * 32, scr, lane); return; } r -= I1;
    if (r < I2) { const int rg = r / KB_D, kb = r % KB_D;
        transpose_item(a.in[I_WCQ], XW, kb * 64, rg * 32, 32, a.in[I_GXATTN], (bf16*)(ws + WS_WCQ), DM, rg * 32, scr, lane); return; } r -= I2;
    if (r < I4) { const int rg = r / (XW / 64), kb = r % (XW / 64);
        transpose_item(a.in[I_WCO], DM, kb * 64, rg * 32, 32, nullptr, (bf16*)(ws + WS_WCO), XW, rg * 32, scr, lane); return; } r -= I4;
    if (r < I5) { const int rg = r / KB_D, kb = r % KB_D, d = rg * 32, tile = d >> 8, w = d & 255; const int src = w < 128 ? tile * 128 + w : FFN + tile * 128 + (w - 128);
        transpose_item(a.in[I_WGU], 2 * FFN, kb * 64, src, 32, a.in[I_GFFN], (bf16*)(ws + WS_WGU), DM, d, scr, lane); return; } r -= I5;
    { const int rg = r / (FFN / 64), kb = r % (FFN / 64);
        transpose_item(a.in[I_WDN], DM, kb * 64, rg * 32, 32, nullptr, (bf16*)(ws + WS_WDN), FFN, rg * 32, scr, lane); }
}
__device__ __forceinline__ void late_range(const Args& a, LAS unsigned char* lds, int lo, int hi, int w, int nw, int wave, int lane) {
    LAS float* scr = (LAS float*)(lds + wave * 16384);
    for (int it = lo + w; it < hi; it += nw) late_item(a, it, scr, lane);
}
__device__ __forceinline__ void p0_prologue(const Args& a, LAS unsigned char* lds, int wave, int lane, int G) {
    unsigned char* ws = a.ws;
    LAS float* scr = (LAS float*)(lds + wave * 16384);
    const int gw = blockIdx.x * NWAVES + wave, NGW = G * NWAVES;
    for (int it = gw; it < N_EARLY; it += NGW) early_item(a, it, scr, lane);
    if (G != 256) for (int it = gw; it < N_LATE; it += NGW) late_item(a, it, scr, lane);
    for (int m = gw; m < M + MMEM; m += NGW) {
        if (m < M) rms_row_to_bf16(a.in[I_X] + (size_t)m * DM, a.in[I_GMIX], (bf16*)(ws + WS_XN) + (size_t)m * DM, lane);
        else rms_row_to_bf16(a.in[I_MEM] + (size_t)(m - M) * DM, a.in[I_GMEM], (bf16*)(ws + WS_MN) + (size_t)(m - M) * DM, lane);
    }
}

__device__ __forceinline__ void conv_chunk(const bf16* U, bf16* UC, const float* cw, const float* cbias, int row0, int s0, int nblk, int tid) {
    asm volatile("" : "+v"(tid));
    const int c8 = nblk * 128 + (tid & 15) * 8;
    f32x4 w[4][2], bb[2];
#pragma unroll
    for (int j = 0; j < 4; ++j) { w[j][0] = *(const f32x4*)(cw + j * LRUW + c8); w[j][1] = *(const f32x4*)(cw + j * LRUW + c8 + 4); }
    bb[0] = *(const f32x4*)(cbias + c8); bb[1] = *(const f32x4*)(cbias + c8 + 4);
#pragma unroll 2
    for (int p = 0; p < 8; ++p) { const int rl = p * 32 + (tid >> 4), s = s0 + rl; const unsigned grow = (unsigned)(row0 + rl);
        f32x4 a0 = bb[0], a1 = bb[1];
#pragma unroll
        for (int j = 0; j < 4; ++j) { if (s - 3 + j >= 0) { const v4u uw = *(const v4u*)((const char*)U + ((grow - 3 + j) * LRUW + c8) * 2u);
            a0 += w[j][0] * (f32x4){bflo(uw.x), bfhi(uw.x), bflo(uw.y), bfhi(uw.y)}; a1 += w[j][1] * (f32x4){bflo(uw.z), bfhi(uw.z), bflo(uw.w), bfhi(uw.w)}; } }
        v4u o; o.x = pk2(a0.x, a0.y); o.y = pk2(a0.z, a0.w); o.z = pk2(a1.x, a1.y); o.w = pk2(a1.z, a1.w);
        *(v4u*)((char*)UC + (grow * LRUW + c8) * 2u) = o; }
}

__global__ void __launch_bounds__(NTHR, LB2) hymba_fwd(Args a) {
    extern __shared__ __attribute__((aligned(16))) unsigned char lds_raw[];
    cg::grid_group grid = cg::this_grid();
    LAS unsigned char* lds = (LAS unsigned char*)lds_raw;
    { const int t0 = threadIdx.x; if ((t0 & 63) == 0) *(volatile LAS int*)(lds + WTAB_OFF + hw_slot() * 4) = t0 >> 6;
      if (t0 < 2) *(volatile LAS unsigned*)(lds + XBST_OFF + t0 * 4) = 0u; }
    __syncthreads();
    const XcdBarrier xbar = xcd_barrier_post((unsigned*)a.ws, (volatile LAS unsigned*)(lds + XBST_OFF));
    const int G = gridDim.x, c = blockIdx.x;
#define WIN ((bf16*)(a.ws + WS_WIN))
#define WOUT ((bf16*)(a.ws + WS_WOUT))
#define WCQ ((bf16*)(a.ws + WS_WCQ))
#define WCKV ((bf16*)(a.ws + WS_WCKV))
#define WCO ((bf16*)(a.ws + WS_WCO))
#define WGU ((bf16*)(a.ws + WS_WGU))
#define WDN ((bf16*)(a.ws + WS_WDN))
#define WLRU ((bf16*)(a.ws + WS_WLRU))
#define XN ((bf16*)(a.ws + WS_XN))
#define MN ((bf16*)(a.ws + WS_MN))
#define Qh ((bf16*)(a.ws + WS_Q))
#define Kh ((bf16*)(a.ws + WS_K))
#define Vh ((bf16*)(a.ws + WS_V))
#define U ((bf16*)(a.ws + WS_U))
#define GG ((bf16*)(a.ws + WS_GG))
#define UC ((bf16*)(a.ws + WS_UC))
#define LF ((float*)(a.ws + WS_LF))
#define CK ((bf16*)(a.ws + WS_CK))
#define CV ((bf16*)(a.ws + WS_CV))
#define MIX ((bf16*)(a.ws + WS_MIX))
#define SSQF ((float*)(a.ws + WS_SSQF))
#define SSQL ((float*)(a.ws + WS_SSQL))
#define X1 ((float*)(a.ws + WS_X1))
#define X1B ((bf16*)(a.ws + WS_X1B))
#define SSQ1 ((float*)(a.ws + WS_SSQ1))
#define CQ ((bf16*)(a.ws + WS_CQ))
#define OX ((bf16*)(a.ws + WS_OX))
#define X2B ((bf16*)(a.ws + WS_X2B))
#define SSQ2 ((float*)(a.ws + WS_SSQ2))
#define H ((bf16*)(a.ws + WS_H))
#define HL ((bf16*)(a.ws + WS_HL))
#define AC ((bf16*)(a.ws + WS_AC))
#define ENDH ((float*)(a.ws + WS_ENDH))
#define ENDA ((float*)(a.ws + WS_ENDA))
#define red ((PG8_LAS float*)(lds + RED_OFF))

    for (int rep = 0; rep < 1 + ((REP >> 0) & 1); ++rep) {
    if (PH & 1) { int tid = my_tid(); p0_prologue(a, lds, __builtin_amdgcn_readfirstlane(tid >> 6), tid & 63, G); }
    GSYNC();
    if (a.ws == nullptr) grid.sync();
    }

    for (int rep = 0; rep < 1 + ((REP >> 1) & 1); ++rep) {
    if (PH & 2) {
        pg8::Gemm g{XN, WIN, M, INWP, DM, DM, DM}; pg8::StaticOrder S; S.init(M, INWP, G, c);
        pg8::EpiIn E{0, Qh, Kh, Vh, U, GG, LF, a.in[I_GQ], a.in[I_GK], a.in[I_BF], red};
        pg8::gemm_phase<pg8::EpiIn, pg8::StaticOrder, true, true>(lds, g, S, E);
        pg8::Gemm g2{MN, WCKV, MMEM, 2 * XW, DM, DM, DM}; pg8::StaticOrder S2; S2.init(MMEM, 2 * XW, G, (c + 16) % G);
        pg8::EpiCkv E2{0, CK, CV, a.in[I_GCK], red};
        pg8::gemm_phase<pg8::EpiCkv, pg8::StaticOrder, true, true>(lds, g2, S2, E2);
        if (G == 256 && c >= 160 && c < 240) { const int t2 = my_tid(); late_range(a, lds, 0, N_LATE_P1, (c - 160) * NWAVES + (t2 >> 6), 80 * NWAVES, __builtin_amdgcn_readfirstlane(t2 >> 6), t2 & 63); }
    }
    GSYNC();
    }

    for (int rep = 0; rep < 1 + ((REP >> 2) & 1); ++rep) {
    if (PH & 4) { int cL = c, tid = my_tid(); asm volatile("" : "+s"(cL));
      const int nl = G > 128 ? G - 128 : G;
      if (G <= 128 || cL >= 128)
      for (int L = (G > 128 ? cL - 128 : cL); L < 256; L += nl) {
            const int pm = L >> 3, nblk = L & 7, row0 = pm * 256;
            conv_chunk(U, UC, a.in[I_CONVW], a.in[I_CONVB], row0, (pm & 7) * 256, nblk, tid);
            VM_WAIT(); __syncthreads(); __builtin_amdgcn_fence(__ATOMIC_ACQUIRE, "agent");
            pg8::Gemm g{UC + (size_t)row0 * LRUW + nblk * 128, WLRU + (size_t)nblk * 256 * 128, 256, 256, 128, LRUW, 128}; pg8::OneUnit S;
            pg8::EpiLru E{0, UC, HL, AC, ENDH + pm * 1024, ENDA + pm * 1024, a.in[I_BRA], a.in[I_BRI], a.in[I_LAM], row0, nblk};
            pg8::gemm_phase<pg8::EpiLru, pg8::OneUnit, false, true>(lds, g, S, E);
      }
      if (G == 256 && cL >= 128) {
        VM_WAIT(); __syncthreads();
        if (my_tid() == 0) { unsigned* cnt = (unsigned*)(a.ws + 15360);
            __builtin_amdgcn_fence(__ATOMIC_RELEASE, "agent"); asm volatile("s_waitcnt vmcnt(0)" ::: "memory");
            (void)__hip_atomic_fetch_add(cnt, 1u, __ATOMIC_RELAXED, __HIP_MEMORY_SCOPE_AGENT);
            unsigned sp = 0; while (__hip_atomic_load(cnt, __ATOMIC_RELAXED, __HIP_MEMORY_SCOPE_AGENT) < 128u && ++sp < (1u << 22)) __builtin_amdgcn_s_sleep(1);
            __builtin_amdgcn_fence(__ATOMIC_ACQUIRE, "agent"); asm volatile("s_waitcnt vmcnt(0)" ::: "memory"); }
        __syncthreads();
#define P2B_FIRST (cL - 128)
#define P2B_STRIDE 128
    { int tid = my_tid();
      for (int L = P2B_FIRST; L < 256; L += P2B_STRIDE) { const int pm = L >> 3, nblk = L & 7, j = pm & 7, c8 = nblk * 128 + (tid & 15) * 8;
        f32x4 hi0 = {0.f, 0.f, 0.f, 0.f}, hi1 = {0.f, 0.f, 0.f, 0.f};
        for (int i = 0; i < j; ++i) { const float* eh = ENDH + (pm - j + i) * 1024 + c8; const float* ea = ENDA + (pm - j + i) * 1024 + c8;
            hi0 = *(const f32x4*)ea * hi0 + *(const f32x4*)eh; hi1 = *(const f32x4*)(ea + 4) * hi1 + *(const f32x4*)(eh + 4); }
#pragma unroll 2
        for (int p = 0; p < 8; ++p) { const unsigned row = (unsigned)(pm * 256 + p * 32 + (tid >> 4)), o = (row * 1024u + c8) * 2u;
            const v4u hw = *(const v4u*)((const char*)HL + o), aw = *(const v4u*)((const char*)AC + o), gw = *(const v4u*)((const char*)GG + o);
            const f32x4 y0 = ((f32x4){bflo(hw.x), bfhi(hw.x), bflo(hw.y), bfhi(hw.y)} + (f32x4){bflo(aw.x), bfhi(aw.x), bflo(aw.y), bfhi(aw.y)} * hi0) * (f32x4){bflo(gw.x), bfhi(gw.x), bflo(gw.y), bfhi(gw.y)};
            const f32x4 y1 = ((f32x4){bflo(hw.z), bfhi(hw.z), bflo(hw.w), bfhi(hw.w)} + (f32x4){bflo(aw.z), bfhi(aw.z), bflo(aw.w), bfhi(aw.w)} * hi1) * (f32x4){bflo(gw.z), bfhi(gw.z), bflo(gw.w), bfhi(gw.w)};
            float ss = (y0.x * y0.x + y0.y * y0.y) + (y0.z * y0.z + y0.w * y0.w) + (y1.x * y1.x + y1.y * y1.y) + (y1.z * y1.z + y1.w * y1.w);
            v4u ow; ow.x = pk2(y0.x, y0.y); ow.y = pk2(y0.z, y0.w); ow.z = pk2(y1.x, y1.y); ow.w = pk2(y1.z, y1.w);
            *(v4u*)((char*)MIX + ((size_t)row * 2048 + 1024 + c8) * 2) = ow;
            ss += shx<1>(ss); ss += shx<2>(ss); ss += shx<4>(ss); ss += shx<8>(ss);
            if ((tid & 15) == 0) SSQL[row * 8 + nblk] = ss; } } }
#undef P2B_FIRST
#undef P2B_STRIDE
        { const int t2 = my_tid(); late_range(a, lds, N_LATE_P1, N_LATE_P2, (cL - 128) * NWAVES + (t2 >> 6), 128 * NWAVES, __builtin_amdgcn_readfirstlane(t2 >> 6), t2 & 63); } } }
    if (PH & 4) { int cF = c, tid = my_tid(); asm volatile("" : "+s"(cF)); const int lane = tid & 63, wave = __builtin_amdgcn_readfirstlane(tid >> 6);
      for (int L = cF; L < 128; L += G) {
        {
#if !defined(NO_FOX)
            const int it = L, bh = it >> 2, x = it & 3, b = bh >> 3, h = bh & 7;
            LAS float* cbl = (LAS float*)(lds + CB_OFF); LAS float* wsum = (LAS float*)(lds + WSUM_OFF);
            { const float* lf = LF + ((size_t)b * SEQ + tid * 4) * 8 + h;
              const float v0 = lf[0], v1 = lf[8], v2 = lf[16], v3 = lf[24]; const float t0 = v0, t1 = t0 + v1, t2 = t1 + v2, t3 = t2 + v3;
              wsum[tid] = t3; __syncthreads();
              for (int o = 1; o < 512; o <<= 1) { const float v = wsum[tid] + (tid >= o ? wsum[tid - o] : 0.f); __syncthreads(); wsum[tid] = v; __syncthreads(); }
              const float off = wsum[tid] - t3;
              const float ns = -1.0f / att::SCALE;
              *(LAS f32x4*)(cbl + tid * 4) = (f32x4){(off + t0) * ns, (off + t1) * ns, (off + t2) * ns, (off + t3) * ns};
              __syncthreads(); }
            typedef att::BlockRef<att::bf16, att::bf16> BR;
            BR cur, nxt;
            { const size_t hrow = (size_t)bh * SEQ;
              cur.Q = (const att::bf16*)Qh + (hrow + x * 256) * 128; cur.K = (const att::bf16*)Kh + hrow * 128; cur.V = (const att::bf16*)Vh + hrow * 128;
              cur.O = (att::bf16*)MIX + ((size_t)b * SEQ + x * 256) * 2048 + h * 128; cur.SS = FOX_SS; cur.P0 = x * 256;
              nxt = cur; const int d = (7 - 2 * x) * 256;
              nxt.Q += (size_t)d * 128; nxt.O += (size_t)d * 2048; nxt.SS += (size_t)d * 8; nxt.P0 += d; }
            att::Seam<att::bf16> S;
            att::causal_swa_prime<att::bf16, att::bf16>(cur, 1 << 20, (char*)lds_raw, S);
            for (int p = 0; p < 2; ++p) {
                att::causal_swa_block<att::bf16, att::bf16, 2048, FOX_HAS_SS>(cur, nxt, SEQ, 1 << 20, (char*)lds_raw, S, FOX_CB);
                cur = nxt; }
            VM_WAIT(); __syncthreads(); __builtin_amdgcn_fence(__ATOMIC_ACQUIRE, "agent");
            for (int p = 0; p < 16; ++p) { const int qb = (p < 8) ? x : 7 - x, rl = (p & 7) * 32 + (tid >> 4); const size_t trow = (size_t)b * SEQ + qb * 256 + rl;
                const v4u w = *(const v4u*)(MIX + trow * 2048 + h * 128 + (tid & 15) * 8);
                float ss = (bflo(w.x) * bflo(w.x) + bfhi(w.x) * bfhi(w.x)) + (bflo(w.y) * bflo(w.y) + bfhi(w.y) * bfhi(w.y)) + (bflo(w.z) * bflo(w.z) + bfhi(w.z) * bfhi(w.z)) + (bflo(w.w) * bflo(w.w) + bfhi(w.w) * bfhi(w.w));
                ss += shx<1>(ss); ss += shx<2>(ss); ss += shx<4>(ss); ss += shx<8>(ss);
                if ((tid & 15) == 0) SSQF[trow * 8 + h] = ss; }
            VM_WAIT(); __syncthreads();
#endif
        }
    } }
    GSYNC();
    }

    if (G != 256) {
#define P2B_FIRST c
#define P2B_STRIDE G
    { int tid = my_tid();
      for (int L = P2B_FIRST; L < 256; L += P2B_STRIDE) { const int pm = L >> 3, nblk = L & 7, j = pm & 7, c8 = nblk * 128 + (tid & 15) * 8;
        f32x4 hi0 = {0.f, 0.f, 0.f, 0.f}, hi1 = {0.f, 0.f, 0.f, 0.f};
        for (int i = 0; i < j; ++i) { const float* eh = ENDH + (pm - j + i) * 1024 + c8; const float* ea = ENDA + (pm - j + i) * 1024 + c8;
            hi0 = *(const f32x4*)ea * hi0 + *(const f32x4*)eh; hi1 = *(const f32x4*)(ea + 4) * hi1 + *(const f32x4*)(eh + 4); }
#pragma unroll 2
        for (int p = 0; p < 8; ++p) { const unsigned row = (unsigned)(pm * 256 + p * 32 + (tid >> 4)), o = (row * 1024u + c8) * 2u;
            const v4u hw = *(const v4u*)((const char*)HL + o), aw = *(const v4u*)((const char*)AC + o), gw = *(const v4u*)((const char*)GG + o);
            const f32x4 y0 = ((f32x4){bflo(hw.x), bfhi(hw.x), bflo(hw.y), bfhi(hw.y)} + (f32x4){bflo(aw.x), bfhi(aw.x), bflo(aw.y), bfhi(aw.y)} * hi0) * (f32x4){bflo(gw.x), bfhi(gw.x), bflo(gw.y), bfhi(gw.y)};
            const f32x4 y1 = ((f32x4){bflo(hw.z), bfhi(hw.z), bflo(hw.w), bfhi(hw.w)} + (f32x4){bflo(aw.z), bfhi(aw.z), bflo(aw.w), bfhi(aw.w)} * hi1) * (f32x4){bflo(gw.z), bfhi(gw.z), bflo(gw.w), bfhi(gw.w)};
            float ss = (y0.x * y0.x + y0.y * y0.y) + (y0.z * y0.z + y0.w * y0.w) + (y1.x * y1.x + y1.y * y1.y) + (y1.z * y1.z + y1.w * y1.w);
            v4u ow; ow.x = pk2(y0.x, y0.y); ow.y = pk2(y0.z, y0.w); ow.z = pk2(y1.x, y1.y); ow.w = pk2(y1.z, y1.w);
            *(v4u*)((char*)MIX + ((size_t)row * 2048 + 1024 + c8) * 2) = ow;
            ss += shx<1>(ss); ss += shx<2>(ss); ss += shx<4>(ss); ss += shx<8>(ss);
            if ((tid & 15) == 0) SSQL[row * 8 + nblk] = ss; } } }
#undef P2B_FIRST
#undef P2B_STRIDE
    GSYNC(); }

    for (int rep = 0; rep < 1 + ((REP >> 3) & 1); ++rep) {
    if (PH & 8) {
        pg8::Gemm g{MIX, WOUT, M, DM, DM, DM, DM}; pg8::StaticOrder S; S.init(M, DM, G, c);
        pg8::EpiRes<true> E{16, a.in[I_X], nullptr, nullptr, X1B, SSQ1, SSQF, SSQL};
        pg8::gemm_phase<pg8::EpiRes<true>, pg8::StaticOrder, true, true>(lds, g, S, E);
    }
    GSYNC();
    }

    if (PH & 16) {
        pg8::Gemm g{X1B, WCQ, M, XW, DM, DM, DM}; pg8::StaticOrder S; S.init(M, XW, G, c);
        pg8::EpiCq E{0, CQ, a.in[I_GCQ], SSQ1, red};
        pg8::gemm_phase<pg8::EpiCq, pg8::StaticOrder, true, true>(lds, g, S, E);
        const bool fast = (G == 256);
        if (fast && c >= 128) { const int t2 = my_tid(); late_range(a, lds, N_LATE_P2, N_LATE_P4A, (c - 128) * NWAVES + (t2 >> 6), 128 * NWAVES, __builtin_amdgcn_readfirstlane(t2 >> 6), t2 & 63); }
        else if (fast && c >= 64) { const int t2 = my_tid(); late_range(a, lds, N_LATE_P4A, N_LATE, (c - 64) * NWAVES + (t2 >> 6), 64 * NWAVES, __builtin_amdgcn_readfirstlane(t2 >> 6), t2 & 63); }
        pg8::StaticOrder Sx; Sx.init(M, XW, G, fast ? (c & 63) : c);
        for (int i = 0; ; ++i) {
            if (fast && (i > 0 || c >= 128)) break;
            pg8::Unit u; if (!Sx.next(i, u)) break;
            const int hfirst = 2 * u.pn + ((fast && c >= 64) ? 1 : 0), nh = fast ? 1 : 2;
            VM_WAIT(); __syncthreads();
            if (fast && my_tid() == 0) { unsigned* f = (unsigned*)(a.ws + 15616) + (c & 63);
                if (c < 64) { __builtin_amdgcn_fence(__ATOMIC_RELEASE, "agent"); asm volatile("s_waitcnt vmcnt(0)" ::: "memory"); __hip_atomic_store(f, 1u, __ATOMIC_RELAXED, __HIP_MEMORY_SCOPE_AGENT); }
                else { unsigned sp = 0; while (__hip_atomic_load(f, __ATOMIC_RELAXED, __HIP_MEMORY_SCOPE_AGENT) == 0u && ++sp < (1u << 22)) __builtin_amdgcn_s_sleep(1); } }
            __syncthreads(); __builtin_amdgcn_fence(__ATOMIC_ACQUIRE, "agent"); asm volatile("s_waitcnt vmcnt(0)" ::: "memory");
            const int b = u.pm >> 3, qb = u.pm & 7;
            for (int hh = 0; hh < nh; ++hh) { const int h = hfirst + hh, bh = b * 4 + h;
                att::BlockRef<att::bf16, att::bf16> r;
                r.Q = (const att::bf16*)CQ + ((size_t)bh * SEQ + qb * 256) * 128; r.K = (const att::bf16*)CK + (size_t)bh * NMEM * 128; r.V = (const att::bf16*)CV + (size_t)bh * NMEM * 128;
                r.O = (att::bf16*)OX + ((size_t)b * SEQ + qb * 256) * XW + h * 128; r.SS = nullptr; r.P0 = 1 << 16;
                att::Seam<att::bf16> Sm;
                att::causal_swa_prime<att::bf16, att::bf16>(r, 1 << 20, (char*)lds_raw, Sm);
                att::causal_swa_block<att::bf16, att::bf16, XW, false>(r, r, NMEM, 1 << 20, (char*)lds_raw, Sm, -1);
                VM_WAIT(); __syncthreads(); }
        }
    }
    GSYNC();

    for (int rep = 0; rep < 1 + ((REP >> 6) & 1); ++rep) {
    if (PH & 64) {
        pg8::Gemm g{OX, WCO, M, DM, XW, XW, XW}; pg8::StaticOrder S; S.init(M, DM, G, c);
        pg8::EpiRes<false> E{0, nullptr, X1B, nullptr, X2B, SSQ2, nullptr, nullptr};
        pg8::gemm_phase<pg8::EpiRes<false>, pg8::StaticOrder, true, true>(lds, g, S, E);
    }
    GSYNC();
    }

    for (int rep = 0; rep < 1 + ((REP >> 7) & 1); ++rep) {
    if (PH & 128) {
        pg8::Gemm g{X2B, WGU, M, 2 * FFN, DM, DM, DM}; pg8::StaticOrder S; S.init(M, 2 * FFN, G, c);
        pg8::EpiGu E{0, H, SSQ2, red};
        pg8::gemm_phase<pg8::EpiGu, pg8::StaticOrder, true, true>(lds, g, S, E);
    }
    GSYNC();
    }

    if (PH & 256) {
        pg8::Gemm g{H, WDN, M, DM, FFN, FFN, FFN}; pg8::StaticOrder S; S.init(M, DM, G, c);
        pg8::EpiRes<false> E{0, nullptr, X2B, a.out, nullptr, nullptr, nullptr, nullptr};
        pg8::gemm_phase<pg8::EpiRes<false>, pg8::StaticOrder, true, true>(lds, g, S, E);
    }
}

#undef WIN
#undef WOUT
#undef WCQ
#undef WCKV
#undef WCO
#undef WGU
#undef WDN
#undef WLRU
#undef XN
#undef MN
#undef Qh
#undef Kh
#undef Vh
#undef U
#undef GG
#undef UC
#undef LF
#undef CK
#undef CV
#undef MIX
#undef SSQF
#undef SSQL
#undef X1
#undef X1B
#undef SSQ1
#undef CQ
#undef OX
#undef X2B
#undef SSQ2
#undef H
#undef HL
#undef AC
#undef ENDH
#undef ENDA
#undef red
extern "C" void kernel_launch(void* const* d_in, const int* in_sizes, int n_in, void* d_out, int out_size, void* d_ws, size_t ws_size, hipStream_t stream) {
    static int grid = 0;
    if (grid == 0) {
        if (n_in != 27 || in_sizes[0] != M * DM || out_size != M * DM || ws_size < WS_END) { fprintf(stderr, "kernel_launch: unexpected shapes (n_in %d, in0 %d, out %d, ws %zu)\n", n_in, n_in > 0 ? in_sizes[0] : -1, out_size, ws_size); grid = -1; return; }
        int dev = 0, cus = 0, per_cu = 0;
        (void)hipGetDevice(&dev); (void)hipDeviceGetAttribute(&cus, hipDeviceAttributeMultiprocessorCount, dev);
        if (hipFuncSetAttribute((const void*)hymba_fwd, hipFuncAttributeMaxDynamicSharedMemorySize, LDS_BYTES) != hipSuccess) { fprintf(stderr, "kernel_launch: hipFuncSetAttribute failed\n"); grid = -1; return; }
        if (hipOccupancyMaxActiveBlocksPerMultiprocessor(&per_cu, (const void*)hymba_fwd, NTHR, LDS_BYTES) != hipSuccess || per_cu < 1) { fprintf(stderr, "kernel_launch: occupancy query says %d\n", per_cu); per_cu = 1; }
        (void)hipGetLastError();
        grid = cus * per_cu;
    }
    if (grid < 0) return;
    Args a{};
    for (int i = 0; i < 27; ++i) a.in[i] = (const float*)d_in[i];
    a.out = (float*)d_out; a.ws = (unsigned char*)d_ws;
    if (hipMemsetAsync(d_ws, 0, 16384, stream) != hipSuccess) { fprintf(stderr, "kernel_launch: memset of the barrier words failed\n"); return; }
    void* args[] = {&a};
    hipError_t e = hipLaunchCooperativeKernel((const void*)hymba_fwd, dim3(grid), dim3(NTHR), args, LDS_BYTES, stream);
    if (e != hipSuccess) fprintf(stderr, "cooperative launch failed: %s (grid %d)\n", hipGetErrorString(e), grid);
}
```

```cpp
#include <hip/hip_runtime.h>
#include <hip/hip_bf16.h>
#include <hip/hip_cooperative_groups.h>
#include <cstdio>
#include <cstdint>
namespace cg = cooperative_groups;


template <int K> __device__ __forceinline__ float shx(float v) { static_assert(K < 32, "use sum32"); return __int_as_float(__builtin_amdgcn_ds_swizzle(__float_as_int(v), (K << 10) | 0x1f)); }
__device__ __forceinline__ float sum32(float v) { auto rr = __builtin_amdgcn_permlane32_swap(__float_as_uint(v), __float_as_uint(v), false, false); return __uint_as_float(rr[0]) + __uint_as_float(rr[1]); }
constexpr int WTAB_OFF = 147456 - 256, XBST_OFF = 147456 - 512;
__device__ __forceinline__ int hw_slot() { return (int)(__builtin_amdgcn_s_getreg((5 << 11) | 4) & 63u); }
__device__ __forceinline__ int my_tid() {
    const int slot = hw_slot();
    const int wave = __builtin_amdgcn_readfirstlane(*(volatile __attribute__((address_space(3))) int*)(unsigned)(WTAB_OFF + slot * 4));
    int l; asm volatile("v_mbcnt_lo_u32_b32 %0, -1, 0\n\tv_mbcnt_hi_u32_b32 %0, -1, %0" : "=v"(l));
    return wave * 64 + l;
}
namespace pg8 {
#define PG8_LAS __attribute__((address_space(3)))
typedef unsigned short bf16_t;
typedef short bf16x8 __attribute__((ext_vector_type(8)));
typedef float f32x4 __attribute__((ext_vector_type(4)));
typedef unsigned u32x4 __attribute__((ext_vector_type(4)));
constexpr int BM = 256, BK = 64, HALF = 128, HTB = HALF * BK * 2  , STAGE_BYTES = 8 * HTB, NXCD = 8, WGM = 8;

__host__ __device__ __forceinline__ int lds_byte(int r, int c) { const int st = (r >> 4) * 2 + (c >> 5), rr = r & 15, cc = c & 31, ob = rr * 64 + cc * 2; return st * 1024 + (ob ^ (((ob >> 9) & 1) << 5)); }
__host__ __device__ __forceinline__ void stage_rc(int b, int& R, int& C) { const int st = b / 1024, sb = b % 1024, swz = sb ^ (((sb >> 9) & 1) << 5); R = (st >> 1) * 16 + swz / 64; C = (st & 1) * 32 + (swz % 64) / 2; }
__host__ __device__ __forceinline__ int perm32(int rho) { const int n = rho >> 4, i = rho & 15; return 8 * (i >> 2) + 4 * n + (i & 3); }

struct Unit { int pm, pn; };
struct Gemm { const bf16_t* A; const bf16_t* Bt; int M, N, K, lda, ldb; };

struct StaticOrder {
    int nM, nN, nwg, G, c;
    __host__ __device__ void init(int M, int N, int G_, int c_) { nM = M / BM; nN = N / BM; nwg = nM * nN; G = G_; c = c_; }
    __host__ __device__ bool next(int i, Unit& u) const {
        const long L = (long)i * G + c; if (L >= nwg) return false;
        int wgid = (int)L; { const int q = nwg / NXCD, r = nwg % NXCD, xcd = wgid % NXCD, off = wgid / NXCD; wgid = (xcd < r ? xcd * (q + 1) : r * (q + 1) + (xcd - r) * q) + off; }
        const int nig = WGM * nN, gid = wgid / nig, fm = gid * WGM, gsz = (nM - fm) < WGM ? (nM - fm) : WGM;
        u.pm = fm + ((wgid % nig) % gsz); u.pn = (wgid % nig) / gsz; return true;
    }
    __device__ __forceinline__ void a_ready(const Unit&) const {}
    __device__ __forceinline__ void done(const Unit&) const {}
};

__device__ __forceinline__ unsigned cvt_pk_bf16(float lo, float hi) { unsigned r; asm volatile("v_cvt_pk_bf16_f32 %0, %1, %2" : "=v"(r) : "v"(lo), "v"(hi)); return r; }

typedef float f32x2 __attribute__((ext_vector_type(2)));
constexpr float RMS_EPS = 1e-6f;
struct OneUnit {
    __device__ __forceinline__ bool next(int i, Unit& u) const { if (i != 0) return false; u.pm = 0; u.pn = 0; return true; }
    __device__ __forceinline__ void a_ready(const Unit&) const {}
    __device__ __forceinline__ void done(const Unit&) const {}
};
struct OffsetOrder {
    StaticOrder S;
    __device__ __forceinline__ bool next(int i, Unit& u) const { return S.next(i, u); }
    __device__ __forceinline__ void a_ready(const Unit&) const {}
    __device__ __forceinline__ void done(const Unit&) const {}
};
__device__ __forceinline__ float fast_log1p(float x) { const float sr = x * (1.0f - x * (0.5f - x * (0.33333334f - x * (0.25f - x * (0.2f - x * 0.16666667f))))); return x < 0.0625f ? sr : __logf(1.0f + x); }
__device__ __forceinline__ float sigmoidf_(float x) { return __builtin_amdgcn_rcpf(1.0f + __expf(-x)); }
__device__ __forceinline__ float gelu_tanh(float x) { const float u = 0.7978845608028654f * (x + 0.044715f * x * x * x); return x * sigmoidf_(2.0f * u); }
__device__ __forceinline__ float sum_f(const float* p, int n4) { float s = 0.f; for (int i = 0; i < n4; ++i) { const f32x4 v = *(const f32x4*)(p + 4 * i); s += (v[0] + v[1]) + (v[2] + v[3]); } return s; }
__device__ __forceinline__ u32x4 pack8(const f32x4& a, const f32x4& b) { u32x4 w; w.x = cvt_pk_bf16(a[0], a[1]); w.y = cvt_pk_bf16(a[2], a[3]); w.z = cvt_pk_bf16(b[0], b[1]); w.w = cvt_pk_bf16(b[2], b[3]); return w; }

template <int ACT  >
__device__ __forceinline__ void store_tile(const f32x4 (&acc)[2][2][4][2], bf16_t* d0, bf16_t* d1, size_t ld, int wr, int wc, int fr, int fq) {
#pragma unroll
    for (int ai = 0; ai < 2; ++ai)
#pragma unroll
        for (int m = 0; m < 4; ++m) { const size_t ro = (size_t)(ai * HALF + wr * 64 + m * 16 + fr) * ld + wc * 32 + fq * 8;
#pragma unroll
            for (int bj = 0; bj < 2; ++bj) { f32x4 v0 = acc[ai][bj][m][0], v1 = acc[ai][bj][m][1];
                if (ACT == 1) {
#pragma unroll
                    for (int j = 0; j < 4; ++j) { v0[j] = gelu_tanh(v0[j]); v1[j] = gelu_tanh(v1[j]); } }
                *(u32x4*)((bj ? d1 : d0) + ro) = pack8(v0, v1); } }
}
template <bool ROWSCALE>
__device__ __forceinline__ void head_norm_store(const f32x4 (&acc)[2][2][4][2], const float (&rs)[2][4], const float* gain, bf16_t* d0, bf16_t* d1, PG8_LAS float* red, int wr, int wc, int fr, int fq) {
#pragma unroll
    for (int ai = 0; ai < 2; ++ai)
#pragma unroll
        for (int m = 0; m < 4; ++m)
#pragma unroll
            for (int bj = 0; bj < 2; ++bj) { float s = 0.f;
#pragma unroll
                for (int n = 0; n < 2; ++n) { f32x4 v = acc[ai][bj][m][n]; if (ROWSCALE) v = v * rs[ai][m]; s += (v[0] * v[0] + v[1] * v[1]) + (v[2] * v[2] + v[3] * v[3]); }
                s += shx<16>(s); s = sum32(s);
                if (fq == 0) red[((ai * HALF + wr * 64 + m * 16 + fr) * 2 + bj) * 4 + wc] = s; }
    asm volatile("s_waitcnt lgkmcnt(0)" ::: "memory"); __builtin_amdgcn_s_barrier(); asm volatile("" ::: "memory");
    const f32x4 g0 = *(const f32x4*)(gain + wc * 32 + fq * 8), g1 = *(const f32x4*)(gain + wc * 32 + fq * 8 + 4);
#pragma unroll
    for (int ai = 0; ai < 2; ++ai)
#pragma unroll
        for (int m = 0; m < 4; ++m) { const int rl = ai * HALF + wr * 64 + m * 16 + fr;
#pragma unroll
            for (int bj = 0; bj < 2; ++bj) { const PG8_LAS float* rp = red + (rl * 2 + bj) * 4;
                const float ss = (rp[0] + rp[1]) + (rp[2] + rp[3]);
                float sc = __builtin_amdgcn_rsqf(ss * (1.0f / 128.0f) + RMS_EPS); if (ROWSCALE) sc *= rs[ai][m];
                const f32x4 v0 = acc[ai][bj][m][0] * sc * g0, v1 = acc[ai][bj][m][1] * sc * g1;
                *(u32x4*)((bj ? d1 : d0) + (size_t)rl * 128 + wc * 32 + fq * 8) = pack8(v0, v1); } }
}

struct EpiIn {
    static constexpr bool PERM = true, AFTER_DRAIN = false, HAS_MID = false; int mid_t;
    bf16_t *Q, *Kh, *V, *U, *GG; float* LF; const float *g_q, *g_k, *b_f; PG8_LAS float* red;
    __device__ __forceinline__ void operator()(const f32x4 (&acc)[2][2][4][2], const Unit& u, int wr, int wc, int fr, int fq) const {
        asm volatile("" : "+v"(fr), "+v"(fq));
        const int pn = u.pn, row0 = u.pm * BM, b = row0 >> 11, s0 = row0 & 2047;
        if (pn < 12) {
            const int h0 = (pn & 3) * 2; bf16_t* const q_ = Q; bf16_t* const k_ = Kh; bf16_t* const v_ = V; const float* const gq_ = g_q; const float* const gk_ = g_k;
            bf16_t* base = pn < 4 ? q_ : (pn < 8 ? k_ : v_);
            bf16_t* d0 = base + ((size_t)(b * 8 + h0) * 2048 + s0) * 128; bf16_t* d1 = d0 + (size_t)2048 * 128;
            if (pn < 8) { float rs[2][4]; head_norm_store<false>(acc, rs, pn < 4 ? gq_ : gk_, d0, d1, red, wr, wc, fr, fq); }
            else store_tile<0>(acc, d0, d1, 128, wr, wc, fr, fq);
        } else if (pn < 16) { bf16_t* const u_ = U; bf16_t* d0 = u_ + (size_t)row0 * 1024 + (pn - 12) * 256; store_tile<0>(acc, d0, d0 + 128, 1024, wr, wc, fr, fq); }
        else if (pn < 20) { bf16_t* const g_ = GG; bf16_t* d0 = g_ + (size_t)row0 * 1024 + (pn - 16) * 256; store_tile<1>(acc, d0, d0 + 128, 1024, wr, wc, fr, fq); }
        else if (wc == 0 && fq == 0) {
            const f32x4 b0 = *(const f32x4*)b_f, b1 = *(const f32x4*)(b_f + 4);
#pragma unroll
            for (int ai = 0; ai < 2; ++ai)
#pragma unroll
                for (int m = 0; m < 4; ++m) { const int row = row0 + ai * HALF + wr * 64 + m * 16 + fr; f32x4 z0 = acc[ai][0][m][0] + b0, z1 = acc[ai][0][m][1] + b1;
#pragma unroll
                    for (int j = 0; j < 4; ++j) { z0[j] = fminf(z0[j], 0.f) - fast_log1p(__expf(-fabsf(z0[j]))); z1[j] = fminf(z1[j], 0.f) - fast_log1p(__expf(-fabsf(z1[j]))); }
                    *(f32x4*)(LF + (size_t)row * 8) = z0; *(f32x4*)(LF + (size_t)row * 8 + 4) = z1; }
        }
    }
};
struct EpiCkv {
    static constexpr bool PERM = true, AFTER_DRAIN = false, HAS_MID = false; int mid_t;
    bf16_t *CK, *CV; const float* g_ck; PG8_LAS float* red;
    __device__ __forceinline__ void operator()(const f32x4 (&acc)[2][2][4][2], const Unit& u, int wr, int wc, int fr, int fq) const {
        asm volatile("" : "+v"(fr), "+v"(fq));
        const int pn = u.pn, b = u.pm, h0 = (pn & 1) * 2;
        bf16_t* const ck_ = CK; bf16_t* const cv_ = CV; bf16_t* d0 = (pn < 2 ? ck_ : cv_) + ((size_t)(b * 4 + h0) * 256) * 128; bf16_t* d1 = d0 + (size_t)256 * 128;
        if (pn < 2) { float rs[2][4]; head_norm_store<false>(acc, rs, g_ck, d0, d1, red, wr, wc, fr, fq); }
        else store_tile<0>(acc, d0, d1, 128, wr, wc, fr, fq);
    }
};
struct EpiCq {
    static constexpr bool PERM = true, AFTER_DRAIN = false, HAS_MID = false; int mid_t;
    bf16_t* CQ; const float* g_cq; const float* SSQ; PG8_LAS float* red;
    __device__ __forceinline__ void operator()(const f32x4 (&acc)[2][2][4][2], const Unit& u, int wr, int wc, int fr, int fq) const {
        asm volatile("" : "+v"(fr), "+v"(fq));
        const int pn = u.pn, row0 = u.pm * BM, b = row0 >> 11, s0 = row0 & 2047, h0 = pn * 2, tid = (wr * 4 + wc) * 64 + fq * 16 + fr;
        PG8_LAS float* tab = red + 2048;
        if (tid < 256) tab[tid] = __builtin_amdgcn_rsqf(sum_f(SSQ + (size_t)(row0 + tid) * 32, 8) * (1.0f / 2048.0f) + RMS_EPS);
        asm volatile("s_waitcnt lgkmcnt(0)" ::: "memory"); __builtin_amdgcn_s_barrier(); asm volatile("" ::: "memory");
        float rs[2][4];
#pragma unroll
        for (int ai = 0; ai < 2; ++ai)
#pragma unroll
            for (int m = 0; m < 4; ++m) rs[ai][m] = tab[ai * HALF + wr * 64 + m * 16 + fr];
        bf16_t* d0 = CQ + ((size_t)(b * 4 + h0) * 2048 + s0) * 128; bf16_t* d1 = d0 + (size_t)2048 * 128;
        head_norm_store<true>(acc, rs, g_cq, d0, d1, red, wr, wc, fr, fq);
    }
};
template <bool MID> struct EpiRes {
    static constexpr bool PERM = true, AFTER_DRAIN = false, HAS_MID = MID; int mid_t;
    const float* resid; const bf16_t* residb; float* outf; bf16_t* outb; float* ssq_out; const float *ssqf, *ssql;
    __device__ __forceinline__ void mid(f32x4 (&acc)[2][2][4][2], const Unit& u, int wr, int wc, int fr, int fq) const {
        asm volatile("" : "+v"(fr), "+v"(fq));
#pragma unroll
        for (int ai = 0; ai < 2; ++ai)
#pragma unroll
            for (int m = 0; m < 4; ++m) { const size_t row = (size_t)u.pm * BM + ai * HALF + wr * 64 + m * 16 + fr;
                const float rf = __builtin_amdgcn_rsqf(sum_f(ssqf + row * 8, 2) * (1.0f / 1024.0f) + RMS_EPS), rl = __builtin_amdgcn_rsqf(sum_f(ssql + row * 8, 2) * (1.0f / 1024.0f) + RMS_EPS);
                const float ratio = rf / rl;
#pragma unroll
                for (int bj = 0; bj < 2; ++bj)
#pragma unroll
                    for (int n = 0; n < 2; ++n) acc[ai][bj][m][n] = acc[ai][bj][m][n] * ratio;
                __builtin_amdgcn_sched_barrier(0); }
    }
    __device__ __forceinline__ void operator()(const f32x4 (&acc)[2][2][4][2], const Unit& u, int wr, int wc, int fr, int fq) const {
        asm volatile("" : "+v"(fr), "+v"(fq));
#pragma unroll
        for (int ai = 0; ai < 2; ++ai)
#pragma unroll
            for (int m = 0; m < 4; ++m) { const size_t row = (size_t)u.pm * BM + ai * HALF + wr * 64 + m * 16 + fr;
                float sc = 1.f; if (MID) sc = __builtin_amdgcn_rsqf(sum_f(ssql + row * 8, 2) * (1.0f / 1024.0f) + RMS_EPS);
                float ss = 0.f;
#pragma unroll
                for (int bj = 0; bj < 2; ++bj) { const size_t o = row * 2048 + u.pn * BM + bj * HALF + wc * 32 + fq * 8;
                    f32x4 r0, r1;
                    if (residb) { const u32x4 w = *(const u32x4*)(residb + o); r0 = (f32x4){__uint_as_float(w.x << 16), __uint_as_float(w.x & 0xffff0000u), __uint_as_float(w.y << 16), __uint_as_float(w.y & 0xffff0000u)};
                                  r1 = (f32x4){__uint_as_float(w.z << 16), __uint_as_float(w.z & 0xffff0000u), __uint_as_float(w.w << 16), __uint_as_float(w.w & 0xffff0000u)}; }
                    else { r0 = *(const f32x4*)(resid + o); r1 = *(const f32x4*)(resid + o + 4); }
                    const f32x4 v0 = r0 + acc[ai][bj][m][0] * sc, v1 = r1 + acc[ai][bj][m][1] * sc;
                    if (outf) { __builtin_nontemporal_store(v0, (f32x4*)(outf + o)); __builtin_nontemporal_store(v1, (f32x4*)(outf + o + 4)); }
                    ss += (v0[0] * v0[0] + v0[1] * v0[1]) + (v0[2] * v0[2] + v0[3] * v0[3]) + (v1[0] * v1[0] + v1[1] * v1[1]) + (v1[2] * v1[2] + v1[3] * v1[3]);
                    if (outb) *(u32x4*)(outb + o) = pack8(v0, v1); }
                if (ssq_out) { ss += shx<16>(ss); ss = sum32(ss); if (fq == 0) ssq_out[row * 32 + u.pn * 4 + wc] = ss; }
                __builtin_amdgcn_sched_barrier(0); }
    }
};
struct EpiGu {
    static constexpr bool PERM = true, AFTER_DRAIN = false, HAS_MID = false; int mid_t;
    bf16_t* H; const float* SSQ; PG8_LAS float* red;
    __device__ __forceinline__ void operator()(const f32x4 (&acc)[2][2][4][2], const Unit& u, int wr, int wc, int fr, int fq) const {
        asm volatile("" : "+v"(fr), "+v"(fq));
        const int tid = (wr * 4 + wc) * 64 + fq * 16 + fr; PG8_LAS float* tab = red + 2048;
        if (tid < 256) tab[tid] = __builtin_amdgcn_rsqf(sum_f(SSQ + ((size_t)u.pm * BM + tid) * 32, 8) * (1.0f / 2048.0f) + RMS_EPS);
        asm volatile("s_waitcnt lgkmcnt(0)" ::: "memory"); __builtin_amdgcn_s_barrier(); asm volatile("" ::: "memory");
#pragma unroll
        for (int ai = 0; ai < 2; ++ai)
#pragma unroll
            for (int m = 0; m < 4; ++m) { const size_t row = (size_t)u.pm * BM + ai * HALF + wr * 64 + m * 16 + fr;
                const float rs = tab[ai * HALF + wr * 64 + m * 16 + fr];
                f32x4 h[2];
#pragma unroll
                for (int n = 0; n < 2; ++n) { const f32x4 g = acc[ai][0][m][n] * rs, up = acc[ai][1][m][n] * rs;
#pragma unroll
                    for (int j = 0; j < 4; ++j) h[n][j] = g[j] * sigmoidf_(g[j]) * up[j]; }
                *(u32x4*)(H + row * 5632 + u.pn * HALF + wc * 32 + fq * 8) = pack8(h[0], h[1]); }
    }
};
struct EpiLru {
    static constexpr bool PERM = true, AFTER_DRAIN = true, HAS_MID = false; int mid_t;
    const bf16_t* UC; bf16_t* HL; bf16_t* AC; float* ENDH; float* ENDA; const float *b_ra, *b_ri, *lam; int row0, nblk;
    __device__ __forceinline__ void fused(f32x4 (&acc)[2][2][4][2], const Unit&, int wr, int wc, int fr, int fq, PG8_LAS unsigned char* lds, int wid, int lane) const {
        asm volatile("" : "+v"(fr), "+v"(fq));
        PG8_LAS float* LA = (PG8_LAS float*)lds; PG8_LAS float* LB = LA + 128 * 132;
        const int tid = wid * 64 + lane, ch0 = nblk * 128 + wc * 32 + fq * 8;
        float hc = 0.f, ac = 1.f;
#pragma unroll
        for (int ai = 0; ai < 2; ++ai) {
#pragma unroll
            for (int n = 0; n < 2; ++n) {
                const f32x4 bra = *(const f32x4*)(b_ra + ch0 + 4 * n), bri = *(const f32x4*)(b_ri + ch0 + 4 * n), lm = *(const f32x4*)(lam + ch0 + 4 * n); f32x4 sp;
#pragma unroll
                for (int j = 0; j < 4; ++j) sp[j] = -8.0f * fast_log1p(__expf(-lm[j]));
#pragma unroll
                for (int m = 0; m < 4; ++m) { const int rl = wr * 64 + m * 16 + fr; const unsigned grow = (unsigned)(row0 + ai * HALF + rl);
                    const f32x2 ucw = *(const f32x2*)((const char*)UC + (grow * 1024u + ch0 + 4 * n) * 2u); f32x4 av, bv;
#pragma unroll
                    for (int j = 0; j < 4; ++j) { const unsigned w = __float_as_uint(ucw[j >> 1]); const float uc = __uint_as_float((j & 1) ? (w & 0xffff0000u) : (w << 16));
                        const float r = sigmoidf_(acc[ai][0][m][n][j] + bra[j]), ig = sigmoidf_(acc[ai][1][m][n][j] + bri[j]);
                        const float la = r * sp[j], a_ = __expf(la); av[j] = a_; bv[j] = __builtin_amdgcn_sqrtf(fmaxf(fmaf(-a_, a_, 1.0f), 0.f)) * ig * uc; }
                    *(PG8_LAS f32x4*)(LA + rl * 132 + wc * 32 + fq * 8 + 4 * n) = av; *(PG8_LAS f32x4*)(LB + rl * 132 + wc * 32 + fq * 8 + 4 * n) = bv;
                    __builtin_amdgcn_sched_barrier(0); } }
            asm volatile("s_waitcnt lgkmcnt(0)" ::: "memory"); __builtin_amdgcn_s_barrier(); asm volatile("" ::: "memory");
            if (tid < 128) {
#pragma unroll 8
                for (int rl = 0; rl < 128; ++rl) { const float a_ = LA[rl * 132 + tid]; hc = a_ * hc + LB[rl * 132 + tid]; ac *= a_; LB[rl * 132 + tid] = hc; LA[rl * 132 + tid] = ac; }
                if (ai == 1) { ENDH[nblk * 128 + tid] = hc; ENDA[nblk * 128 + tid] = ac; } }
            asm volatile("s_waitcnt lgkmcnt(0)" ::: "memory"); __builtin_amdgcn_s_barrier(); asm volatile("" ::: "memory");
            const int c8 = (tid & 15) * 8;
#pragma unroll
            for (int p = 0; p < 4; ++p) { const int rl = p * 32 + (tid >> 4); const unsigned o = ((unsigned)(row0 + ai * HALF + rl) * 1024u + nblk * 128 + c8) * 2u;
                const f32x4 h0 = *(const PG8_LAS f32x4*)(LB + rl * 132 + c8), h1 = *(const PG8_LAS f32x4*)(LB + rl * 132 + c8 + 4);
                const f32x4 a0 = *(const PG8_LAS f32x4*)(LA + rl * 132 + c8), a1 = *(const PG8_LAS f32x4*)(LA + rl * 132 + c8 + 4);
                *(u32x4*)((char*)HL + o) = pack8(h0, h1); *(u32x4*)((char*)AC + o) = pack8(a0, a1); }
            asm volatile("s_waitcnt lgkmcnt(0)" ::: "memory"); __builtin_amdgcn_s_barrier(); asm volatile("" ::: "memory");
        }
    }
};
template <class Epi, class Sched, bool ALIGN_EPI = false, bool SP2 = false>
__device__ __forceinline__ void gemm_phase(PG8_LAS unsigned char* lds, const Gemm g, const Sched& S, const Epi& E) {
    int tid_ = my_tid();
    const int tid = tid_, wid = __builtin_amdgcn_readfirstlane(tid >> 6), lane = tid & 63, wr = wid >> 2, wc = wid & 3, fr = lane & 15, fq = lane >> 4;
    const int K = g.K, nt = K / BK;
    unsigned voffA[2], voffB[2];
#pragma unroll
    for (int i = 0; i < 2; ++i) { int R, C; stage_rc(tid * 16 + i * 8192, R, C); const int Rb = Epi::PERM ? ((R & ~31) + perm32(R & 31)) : R;
        voffA[i] = (unsigned)(R * g.lda + C) * 2u; voffB[i] = (unsigned)(Rb * g.ldb + C) * 2u; }
    const size_t kstep = (size_t)(BK * 2);
    const size_t hstepA = (size_t)HALF * g.lda * 2, hstepB = (size_t)HALF * g.ldb * 2;
    const size_t tstepA = 2 * hstepA, tstepB = 2 * hstepB;
    const unsigned ldsw = (unsigned)wid * 1024u;
    const int aoff = lds_byte(wr * 64 + fr, fq * 8), boff = lds_byte(wc * 32 + fr, fq * 8);
#define PG8_SA(b, h) (((b) * 2 + (h)) * HTB)
#define PG8_SB(b, h) ((4 + (b) * 2 + (h)) * HTB)
#define PG8_STAGE(bufoff, gbase, voff) do { _Pragma("unroll") for (int _i = 0; _i < 2; ++_i) \
        __builtin_amdgcn_global_load_lds((const unsigned*)((const char*)(gbase) + (voff)[_i]), (PG8_LAS unsigned*)(lds + (bufoff) + ldsw + _i * 8192), 16, 0, 0); } while (0)
#define PG8_LDA(dst, b, h) do { _Pragma("unroll") for (int m = 0; m < 4; ++m) _Pragma("unroll") for (int k = 0; k < 2; ++k) dst[m][k] = *(const PG8_LAS bf16x8*)(lds + PG8_SA(b, h) + aoff + m * 2048 + k * 1024); } while (0)
#define PG8_LDB(dst, b, h) do { _Pragma("unroll") for (int n = 0; n < 2; ++n) _Pragma("unroll") for (int k = 0; k < 2; ++k) dst[n][k] = *(const PG8_LAS bf16x8*)(lds + PG8_SB(b, h) + boff + n * 2048 + k * 1024); } while (0)
#define PG8_MMA(ai, bj, At, Bt) do { __builtin_amdgcn_s_setprio(1); _Pragma("unroll") for (int m = 0; m < 4; ++m) _Pragma("unroll") for (int n = 0; n < 2; ++n) _Pragma("unroll") for (int k = 0; k < 2; ++k) \
        acc[ai][bj][m][n] = __builtin_amdgcn_mfma_f32_16x16x32_bf16(Bt[n][k], At[m][k], acc[ai][bj][m][n], 0, 0, 0); __builtin_amdgcn_s_setprio(0); } while (0)
#define PG8_WAIT_V(n) asm volatile("s_waitcnt vmcnt(" #n ")" ::: "memory")
#define PG8_WAIT_L(n) asm volatile("s_waitcnt lgkmcnt(" #n ")" ::: "memory")
#define PG8_BAR __builtin_amdgcn_s_barrier()
#define PG8_SCHED __builtin_amdgcn_sched_barrier(0)
    Unit cur, nxt; int ui = 0;
    if (!S.next(0, cur)) return;
    f32x4 acc[2][2][4][2];
#pragma unroll
    for (int a = 0; a < 2; ++a)
#pragma unroll
        for (int b = 0; b < 2; ++b)
#pragma unroll
            for (int m = 0; m < 4; ++m)
#pragma unroll
                for (int n = 0; n < 2; ++n) acc[a][b][m][n] = (f32x4){0.f, 0.f, 0.f, 0.f};
    bf16x8 At[4][2], B0[2][2], B1[2][2];
    const char* cA = (const char*)g.A + (size_t)cur.pm * tstepA; const char* cB = (const char*)g.Bt + (size_t)cur.pn * tstepB;
    S.a_ready(cur);
    if constexpr (SP2) {
        PG8_STAGE(PG8_SB(0, 0), cB, voffB); PG8_STAGE(PG8_SB(0, 1), cB + hstepB, voffB); PG8_STAGE(PG8_SA(0, 0), cA, voffA); PG8_STAGE(PG8_SA(0, 1), cA + hstepA, voffA);
        if (wr == 1) PG8_BAR;
        PG8_WAIT_V(2); PG8_BAR;
        PG8_STAGE(PG8_SB(1, 0), cB + kstep, voffB); PG8_STAGE(PG8_SA(1, 0), cA + kstep, voffA); PG8_STAGE(PG8_SB(1, 1), cB + hstepB + kstep, voffB);
        PG8_WAIT_V(6); PG8_BAR;
    } else {
        PG8_STAGE(PG8_SB(0, 0), cB, voffB); PG8_STAGE(PG8_SA(0, 0), cA, voffA); PG8_STAGE(PG8_SB(0, 1), cB + hstepB, voffB); PG8_STAGE(PG8_SA(0, 1), cA + hstepA, voffA);
        if (wr == 1) PG8_BAR;
        PG8_WAIT_V(4); PG8_BAR;
        PG8_STAGE(PG8_SB(1, 0), cB + kstep, voffB); PG8_STAGE(PG8_SA(1, 0), cA + kstep, voffA); PG8_STAGE(PG8_SB(1, 1), cB + hstepB + kstep, voffB);
        PG8_WAIT_V(6); PG8_BAR;
    }
    for (;;) {
        const bool has_next = S.next(ui + 1, nxt);
        const char* nA = has_next ? (const char*)g.A + (size_t)nxt.pm * tstepA : cA; const char* nB = has_next ? (const char*)g.Bt + (size_t)nxt.pn * tstepB : cB;
        for (int t = 0; t < nt; t += 2) {
            const bool last = (t == nt - 2);
            if constexpr (Epi::HAS_MID) { if (t == E.mid_t) E.mid(acc, cur, wr, wc, fr, fq); }
            const char* a1 = cA + (size_t)(t + 1) * kstep;
            const char* a2 = last ? nA : cA + (size_t)(t + 2) * kstep; const char* b2 = last ? nB : cB + (size_t)(t + 2) * kstep;
            const char* a3 = a2 + kstep; const char* b3 = b2 + kstep;
            if (last && has_next) S.a_ready(nxt);
            if constexpr (SP2) {
            PG8_LDB(B0, 0, 0); PG8_LDB(B1, 0, 1); PG8_SCHED; PG8_LDA(At, 0, 0); PG8_STAGE(PG8_SA(1, 1), a1 + hstepA, voffA);
            PG8_WAIT_V(8); PG8_WAIT_L(0); PG8_BAR; PG8_MMA(0, 0, At, B0); PG8_MMA(0, 1, At, B1); PG8_BAR; PG8_SCHED;
            PG8_LDA(At, 0, 1); PG8_STAGE(PG8_SB(0, 0), b2, voffB); PG8_STAGE(PG8_SB(0, 1), b2 + hstepB, voffB); PG8_STAGE(PG8_SA(0, 0), a2, voffA);
            PG8_WAIT_V(8); PG8_WAIT_L(0); PG8_BAR; PG8_MMA(1, 0, At, B0); PG8_MMA(1, 1, At, B1); PG8_BAR; PG8_SCHED;
            PG8_LDB(B0, 1, 0); PG8_LDB(B1, 1, 1); PG8_SCHED; PG8_LDA(At, 1, 0); PG8_STAGE(PG8_SA(0, 1), a2 + hstepA, voffA);
            PG8_WAIT_V(8); PG8_WAIT_L(0); PG8_BAR; PG8_MMA(0, 0, At, B0); PG8_MMA(0, 1, At, B1); PG8_BAR; PG8_SCHED;
            PG8_LDA(At, 1, 1); PG8_STAGE(PG8_SB(1, 0), b3, voffB); PG8_STAGE(PG8_SB(1, 1), b3 + hstepB, voffB); PG8_STAGE(PG8_SA(1, 0), a3, voffA);
            PG8_WAIT_V(8); PG8_WAIT_L(0); PG8_BAR; PG8_MMA(1, 0, At, B0); PG8_MMA(1, 1, At, B1); PG8_BAR; PG8_SCHED;
            } else {
            PG8_LDB(B0, 0, 0); PG8_SCHED; PG8_LDA(At, 0, 0); PG8_STAGE(PG8_SA(1, 1), a1 + hstepA, voffA);
            PG8_WAIT_L(8); PG8_BAR; PG8_WAIT_L(0); PG8_MMA(0, 0, At, B0); PG8_BAR; PG8_SCHED;
            PG8_LDB(B1, 0, 1); PG8_STAGE(PG8_SB(0, 0), b2, voffB);
            PG8_BAR; PG8_WAIT_L(0); PG8_MMA(0, 1, At, B1); PG8_BAR;
            PG8_LDA(At, 0, 1); PG8_STAGE(PG8_SA(0, 0), a2, voffA);
            PG8_BAR; PG8_WAIT_L(0); PG8_MMA(1, 0, At, B0); PG8_BAR; PG8_SCHED;
            PG8_STAGE(PG8_SB(0, 1), b2 + hstepB, voffB);
            PG8_WAIT_V(6); PG8_BAR; PG8_MMA(1, 1, At, B1); PG8_BAR;
            PG8_LDB(B0, 1, 0); PG8_SCHED; PG8_LDA(At, 1, 0); PG8_STAGE(PG8_SA(0, 1), a2 + hstepA, voffA);
            PG8_WAIT_L(8); PG8_BAR; PG8_WAIT_L(0); PG8_MMA(0, 0, At, B0); PG8_BAR; PG8_SCHED;
            PG8_LDB(B1, 1, 1); PG8_STAGE(PG8_SB(1, 0), b3, voffB);
            PG8_BAR; PG8_WAIT_L(0); PG8_MMA(0, 1, At, B1); PG8_BAR;
            PG8_LDA(At, 1, 1); PG8_STAGE(PG8_SA(1, 0), a3, voffA);
            PG8_BAR; PG8_WAIT_L(0); PG8_MMA(1, 0, At, B0); PG8_BAR; PG8_SCHED;
            PG8_STAGE(PG8_SB(1, 1), b3 + hstepB, voffB);
            PG8_WAIT_V(6); PG8_BAR; PG8_MMA(1, 1, At, B1); PG8_BAR;
            }
        }
        if constexpr (ALIGN_EPI) { if (wr == 0) PG8_BAR; }
        if constexpr (!Epi::AFTER_DRAIN) { E(acc, cur, wr, wc, fr, fq); S.done(cur); }
        if (!has_next) break;
#pragma unroll
        for (int a = 0; a < 2; ++a)
#pragma unroll
            for (int b = 0; b < 2; ++b)
#pragma unroll
                for (int m = 0; m < 4; ++m)
#pragma unroll
                    for (int n = 0; n < 2; ++n) acc[a][b][m][n] = (f32x4){0.f, 0.f, 0.f, 0.f};
        cur = nxt; cA = nA; cB = nB; ++ui;
        if constexpr (ALIGN_EPI) { if (wr == 1) PG8_BAR; }
    }
    PG8_WAIT_V(0);
    if constexpr (!ALIGN_EPI) { if (wr == 0) PG8_BAR; }
    PG8_BAR;
    if constexpr (Epi::AFTER_DRAIN) { E.fused(acc, cur, wr, wc, fr, fq, lds, wid, lane); S.done(cur); }
#undef PG8_SA
#undef PG8_SB
#undef PG8_STAGE
#undef PG8_LDA
#undef PG8_LDB
#undef PG8_MMA
#undef PG8_WAIT_V
#undef PG8_WAIT_L
#undef PG8_BAR
#undef PG8_SCHED
}
}
namespace att {
constexpr int D = 128;
constexpr float THR = 8.f;
constexpr bool WSKIP = false;
constexpr float SCALE = 0.08838834764831845f;
constexpr int NW = 8, QBLK = 32, KVBLK = 64, QB = NW * QBLK;
constexpr int SHM_V = KVBLK * D * 2, SHM_K = KVBLK * D * 2;
constexpr int LDS_BYTES = 2 * SHM_V + 2 * SHM_K + NW * 64 * 4;
using bf16 = __hip_bfloat16;
typedef short bf16x8 __attribute__((ext_vector_type(8)));
typedef short s16x4 __attribute__((ext_vector_type(4)));
typedef float f32x16 __attribute__((ext_vector_type(16)));
typedef float f32x4 __attribute__((ext_vector_type(4)));
typedef unsigned u32x4 __attribute__((ext_vector_type(4)));
template <class A, class Bt> struct same_t { static constexpr bool v = false; };
template <class A> struct same_t<A, A> { static constexpr bool v = true; };

#define KSWZ(row, colB) ((row) * 256 + ((colB) ^ (((row) & 7) << 4)))
#define SBAR() __builtin_amdgcn_sched_barrier(0)
__device__ __forceinline__ int v_st(int k, int c) { const int kk = (k & ~0xC) | ((k & 4) << 1) | ((k & 8) >> 1); return ((kk >> 3) * 4 + (c >> 5)) * 512 + ((kk & 7) * 32 + (c & 31)) * 2; }
__device__ __forceinline__ int v_rd_base(int lane) { return ((lane & 3) << 3) | (((lane >> 2) & 3) << 6) | (((lane >> 4) & 1) << 5) | (((lane >> 5) & 1) << 8); }
constexpr int v_rd_off(int d0, int ks, int half) { return d0 * 512 + ks * 4096 + half * 2048; }
__device__ __forceinline__ int crow(int r, int hi) { return (r & 3) + 8 * (r >> 2) + 4 * hi; }
__device__ __forceinline__ unsigned cvtpk(float lo, float hi) {
    unsigned r; asm volatile("v_cvt_pk_bf16_f32 %0, %1, %2" : "=v"(r) : "v"(lo), "v"(hi)); return r;
}
__device__ __forceinline__ bf16x8 pack8(f32x4 a, f32x4 b) {
    u32x4 w = {cvtpk(a[0], a[1]), cvtpk(a[2], a[3]), cvtpk(b[0], b[1]), cvtpk(b[2], b[3])};
    return *reinterpret_cast<bf16x8*>(&w);
}
template <class T> __device__ __forceinline__ bf16x8 load8(const T* p) {
    if constexpr (same_t<T, float>::v) { return pack8(*(const f32x4*)p, *(const f32x4*)(p + 4)); }
    else { return *reinterpret_cast<const bf16x8*>(p); }
}
__device__ __forceinline__ void mask_tile(f32x16& p0, f32x16& p1, int dq, unsigned W) {
    const float NEG = -__builtin_inff();
#pragma unroll
    for (int r = 0; r < 16; ++r) {
        const int c = (r & 3) + 8 * (r >> 2);
        if ((unsigned)(dq - c) >= W) p0[r] = NEG;
        if ((unsigned)(dq - c - 32) >= W) p1[r] = NEG;
    }
}
__device__ __forceinline__ void partialSM(f32x16& p0, f32x16& p1, float& m_reg, float& mn, float& alpha) {
    float pmax = p0[0]; for (int r = 1; r < 16; ++r) pmax = fmaxf(pmax, p0[r]); for (int r = 0; r < 16; ++r) pmax = fmaxf(pmax, p1[r]);
    { auto rr = __builtin_amdgcn_permlane32_swap(__float_as_uint(pmax), __float_as_uint(pmax), false, false);
      pmax = fmaxf(__uint_as_float(rr[0]), __uint_as_float(rr[1])); }
    constexpr float C2 = 1.4426950408889634f * SCALE;
    if (__builtin_expect(__all((pmax - m_reg) * SCALE <= THR), 1)) { mn = m_reg; alpha = 1.f; }
    else { mn = fmaxf(m_reg, pmax); alpha = __builtin_amdgcn_exp2f((m_reg - mn) * C2); m_reg = mn; }
    const float mnL = -mn * C2;
    for (int r = 0; r < 16; ++r) p0[r] = fmaf(p0[r], C2, mnL); for (int r = 0; r < 16; ++r) p1[r] = fmaf(p1[r], C2, mnL);
    for (int r = 0; r < 16; ++r) p0[r] = __builtin_amdgcn_exp2f(p0[r]);
}
__device__ __forceinline__ void finishSM(f32x16& p0, f32x16& p1, float alpha, float& l_reg, bf16x8& pa0, bf16x8& pa1, bf16x8& pa2, bf16x8& pa3) {
    for (int r = 0; r < 16; ++r) p1[r] = __builtin_amdgcn_exp2f(p1[r]);
    float ps = 0; for (int r = 0; r < 16; ++r) ps += p0[r]; for (int r = 0; r < 16; ++r) ps += p1[r];
    { auto rr = __builtin_amdgcn_permlane32_swap(__float_as_uint(ps), __float_as_uint(ps), false, false);
      ps = __uint_as_float(rr[0]) + __uint_as_float(rr[1]); }
    l_reg = l_reg * alpha + ps;
#define PK4(P, B_, OUT) do { unsigned a0 = cvtpk(P[B_+0], P[B_+1]), a1 = cvtpk(P[B_+2], P[B_+3]);                          \
        unsigned b0 = cvtpk(P[B_+4], P[B_+5]), b1 = cvtpk(P[B_+6], P[B_+7]);                                             \
        auto r0 = __builtin_amdgcn_permlane32_swap(a0, b0, false, false); auto r1 = __builtin_amdgcn_permlane32_swap(a1, b1, false, false); \
        u32x4 w = {r0[0], r1[0], r0[1], r1[1]}; OUT = *reinterpret_cast<bf16x8*>(&w); } while (0)
    PK4(p0, 0, pa0); PK4(p0, 8, pa1); PK4(p1, 0, pa2); PK4(p1, 8, pa3);
#undef PK4
}
template <int KB, bool SK>
__device__ __forceinline__ void qkt(f32x16& p0, f32x16& p1, const char* K_lds, int r32, int hi, const bf16x8* qr, bool act, int cbo  ) {
    if (SK && !act) { const float NEG = -__builtin_inff();
#pragma unroll
        for (int r = 0; r < 16; ++r) { p0[r] = NEG; p1[r] = NEG; } return; }
    if (cbo >= 0) { int a_ = cbo + hi * 16; asm volatile("" : "+v"(a_)); const __attribute__((address_space(3))) float* cb = (const __attribute__((address_space(3))) float*)(unsigned)a_;
#pragma unroll
        for (int q_ = 0; q_ < 4; ++q_) { const f32x4 v0_ = *(const __attribute__((address_space(3))) f32x4*)(cb + 8 * q_), v1_ = *(const __attribute__((address_space(3))) f32x4*)(cb + 32 + 8 * q_);
#pragma unroll
            for (int j_ = 0; j_ < 4; ++j_) { p0[4 * q_ + j_] = v0_[j_]; p1[4 * q_ + j_] = v1_[j_]; } }
    } else { p0 = f32x16{}; p1 = f32x16{}; }
    const char* kb[4];
#pragma unroll
    for (int dd = 0; dd < 4; ++dd) kb[dd] = K_lds + KB * SHM_K + KSWZ(r32, (dd * 16 + hi * 8) * 2);
#pragma unroll
    for (int d0 = 0; d0 < 8; ++d0) { const char* a = kb[d0 & 3] + (d0 >> 2) * 128;
        bf16x8 b0 = *reinterpret_cast<const bf16x8*>(a);
        bf16x8 b1 = *reinterpret_cast<const bf16x8*>(a + 32 * 256);
        p0 = __builtin_amdgcn_mfma_f32_32x32x16_bf16(b0, qr[d0], p0, 0, 0, 0);
        p1 = __builtin_amdgcn_mfma_f32_32x32x16_bf16(b1, qr[d0], p1, 0, 0, 0); }
}
template <int VB, bool SK>
__device__ __forceinline__ void pv_tile(f32x16* o, int vb0, bf16x8 pa0, bf16x8 pa1, bf16x8 pa2, bf16x8 pa3, bool act) {
    if (SK && !act) return;
#define TRRD(dst, off) asm volatile("ds_read_b64_tr_b16 %0, %1 offset:%2" : "=&v"(dst) : "v"(vb0), "i"(off) : "memory")
#define PV_D0(d0) do { s16x4 l0, l1, l2, l3, h0, h1, h2, h3; constexpr int b_ = VB * SHM_V + v_rd_off(d0, 0, 0);     \
        TRRD(l0, b_); TRRD(h0, b_ + 2048); TRRD(l1, b_ + 4096); TRRD(h1, b_ + 6144); TRRD(l2, b_ + 8192); TRRD(h2, b_ + 10240); TRRD(l3, b_ + 12288); TRRD(h3, b_ + 14336); \
        asm volatile("s_waitcnt lgkmcnt(0)" ::: "memory"); SBAR();                 \
        o[d0] = __builtin_amdgcn_mfma_f32_32x32x16_bf16(pa0, (bf16x8){l0[0], l0[1], l0[2], l0[3], h0[0], h0[1], h0[2], h0[3]}, o[d0], 0, 0, 0);   \
        o[d0] = __builtin_amdgcn_mfma_f32_32x32x16_bf16(pa1, (bf16x8){l1[0], l1[1], l1[2], l1[3], h1[0], h1[1], h1[2], h1[3]}, o[d0], 0, 0, 0);   \
        o[d0] = __builtin_amdgcn_mfma_f32_32x32x16_bf16(pa2, (bf16x8){l2[0], l2[1], l2[2], l2[3], h2[0], h2[1], h2[2], h2[3]}, o[d0], 0, 0, 0);   \
        o[d0] = __builtin_amdgcn_mfma_f32_32x32x16_bf16(pa3, (bf16x8){l3[0], l3[1], l3[2], l3[3], h3[0], h3[1], h3[2], h3[3]}, o[d0], 0, 0, 0); } while (0)
    PV_D0(0); PV_D0(1); PV_D0(2); PV_D0(3);
#undef PV_D0
#undef TRRD
}

template <class T> __device__ __forceinline__ T* uptr(T* p) { const unsigned long long v = (unsigned long long)p; const unsigned lo = __builtin_amdgcn_readfirstlane((unsigned)v), hi = __builtin_amdgcn_readfirstlane((unsigned)(v >> 32)); return (T*)(((unsigned long long)hi << 32) | lo); }
template <class TIn, class TOut> struct BlockRef { const TIn* Q; const TIn* K; const TIn* V; TOut* O; float* SS; int P0; };
template <class TIn> struct Seam {
    bf16x8 qr[8];
    bf16x8 st_v0, st_v1, st_k0, st_k1; f32x4 sf0, sf1, sf2, sf3;
    f32x4 tq[16];
};
__device__ __forceinline__ int swa_jlo(int P0, int W) { const int lowk = P0 - W + 1; return lowk > 0 ? lowk / KVBLK : 0; }
#define ROW(p, k0, rr) ((decltype(p))((const char*)(p) + (unsigned)(((k0) + (rr)) * D + sc) * (unsigned)sizeof(*(p))))
#define VMW() asm volatile("s_waitcnt vmcnt(0)" ::: "memory")
#define VMWN(n) asm volatile("s_waitcnt vmcnt(%0)" :: "i"(n) : "memory")
#define SLOAD_H(Kp, Vp, k0) do { S.st_v0 = load8<TIn>(ROW(Vp, k0, sr)); S.st_v1 = load8<TIn>(ROW(Vp, k0, 32 + sr));              \
                         S.st_k0 = load8<TIn>(ROW(Kp, k0, sr)); S.st_k1 = load8<TIn>(ROW(Kp, k0, 32 + sr)); } while (0)
#define SWRITE_HK(bf) do { *(bf16x8*)(K_lds + (bf) * SHM_K + kws) = S.st_k0; *(bf16x8*)(K_lds + (bf) * SHM_K + kws + 32 * 256) = S.st_k1; } while (0)
#define SWRITE_HV(bf) do { *(bf16x8*)(V_lds + (bf) * SHM_V + vst0) = S.st_v0; *(bf16x8*)(V_lds + (bf) * SHM_V + vst1) = S.st_v1; } while (0)
#define SWRITE_H(bf) do { SWRITE_HV(bf); SWRITE_HK(bf); } while (0)
#define SLOAD_F(p, k0) do { S.sf0 = *(const f32x4*)ROW(p, k0, sr); S.sf1 = *(const f32x4*)(ROW(p, k0, sr) + 4);                \
                            S.sf2 = *(const f32x4*)ROW(p, k0, 32 + sr); S.sf3 = *(const f32x4*)(ROW(p, k0, 32 + sr) + 4); } while (0)
#define SWRITE_KF(bf) do { *(bf16x8*)(K_lds + (bf) * SHM_K + kws) = pack8(S.sf0, S.sf1); *(bf16x8*)(K_lds + (bf) * SHM_K + kws + 32 * 256) = pack8(S.sf2, S.sf3); } while (0)
#define SWRITE_VF(bf) do { *(bf16x8*)(V_lds + (bf) * SHM_V + vst0) = pack8(S.sf0, S.sf1); *(bf16x8*)(V_lds + (bf) * SHM_V + vst1) = pack8(S.sf2, S.sf3); } while (0)
template <class TIn, class TOut>
__device__ __forceinline__ void causal_swa_prime(const BlockRef<TIn, TOut>& cur_, int W, char* lds, Seam<TIn>& S) {
    BlockRef<TIn, TOut> cur; cur.Q = uptr(cur_.Q); cur.K = uptr(cur_.K); cur.V = uptr(cur_.V); cur.O = nullptr; cur.SS = nullptr; cur.P0 = __builtin_amdgcn_readfirstlane(cur_.P0);
    constexpr bool F32 = same_t<TIn, float>::v;
    int tid_ = my_tid();
    const int tid = tid_, wid = __builtin_amdgcn_readfirstlane(tid >> 6), lane = tid & 63, r32 = lane & 31, hi = lane >> 5;
    const int sr = tid >> 4, sc = (tid & 15) * 8, kws = KSWZ(sr, sc * 2); char* K_lds = lds + 2 * SHM_V;
    const int kb0 = swa_jlo(cur.P0, W) * KVBLK;
    for (int d0 = 0; d0 < 8; ++d0) S.qr[d0] = load8<TIn>((const TIn*)((const char*)cur.Q + (unsigned)((wid * QBLK + r32) * D + d0 * 16 + hi * 8) * (unsigned)sizeof(TIn)));
    if constexpr (F32) { SLOAD_F((const float*)cur.K, kb0); VMW(); SWRITE_KF(0); SBAR(); SLOAD_F((const float*)cur.V, kb0); }
    else { SLOAD_H(cur.K, cur.V, kb0); VMW(); SWRITE_HK(0); }
    __syncthreads();
}
template <class TIn, class TOut, int ost, bool HAS_SS>
__device__ __forceinline__ void causal_swa_block(const BlockRef<TIn, TOut>& cur_, const BlockRef<TIn, TOut>& nxt_, int skv, int W, char* lds, Seam<TIn>& S, int cbl  ) {
    constexpr bool F32 = same_t<TIn, float>::v;
    BlockRef<TIn, TOut> cur, nxt; cur.Q = uptr(cur_.Q); cur.K = uptr(cur_.K); cur.V = uptr(cur_.V); cur.O = uptr(cur_.O); cur.SS = uptr(cur_.SS); cur.P0 = __builtin_amdgcn_readfirstlane(cur_.P0);
    nxt.Q = uptr(nxt_.Q); nxt.K = uptr(nxt_.K); nxt.V = uptr(nxt_.V); nxt.O = nullptr; nxt.SS = nullptr; nxt.P0 = __builtin_amdgcn_readfirstlane(nxt_.P0);
    int tid_ = my_tid();
    const int tid = tid_, wid = __builtin_amdgcn_readfirstlane(tid >> 6), lane = tid & 63, r32 = lane & 31, hi = lane >> 5;
    const int j_lo = swa_jlo(cur.P0, W);
    int j_hi = (cur.P0 + QB - 1) / KVBLK + 1; if (j_hi > skv / KVBLK) j_hi = skv / KVBLK;
    const int NT = j_hi - j_lo;
    const int kbn = swa_jlo(nxt.P0, W) * KVBLK;
    const int qlo = cur.P0 + wid * QBLK, qm = qlo + r32 - 4 * hi;
    char* V_lds = lds; char* K_lds = lds + 2 * SHM_V;
    float* ws = (float*)(lds + 2 * SHM_V + 2 * SHM_K) + wid * 64; float* li_l = ws, * al_l = ws + 32;
    float m_reg = -1e30f, l_reg = 0; f32x16 o[4] = {};
    const int sr = tid >> 4, sc = (tid & 15) * 8, vst0 = v_st(sr, sc), vst1 = v_st(32 + sr, sc), kws = KSWZ(sr, sc * 2);
    const int vb0 = (int)(uintptr_t)V_lds + v_rd_base(lane);
    const TIn* Kh = cur.K; const TIn* Vh = cur.V;
#define RESC(a) do { if (__any((a) < 1.f)) { if (hi == 0) al_l[r32] = (a); asm volatile("s_waitcnt lgkmcnt(0)" ::: "memory");              \
                     for (int d_ = 0; d_ < 4; ++d_) for (int r = 0; r < 16; ++r) o[d_][r] *= al_l[crow(r, hi)]; } } while (0)
#define KBASE(t) ((j_lo + (t)) * KVBLK)
#define CBT(t) (cbl >= 0 ? cbl + KBASE(t) * 4 : -1)
#define ACT(t) (KBASE(t) <= qlo + QBLK - 1 && KBASE(t) + KVBLK - 1 >= qlo - W + 1)
#define MASKT(P0_, P1_, t) do { const int kb_ = KBASE(t); if ((!SK || ACT(t)) && (kb_ + KVBLK - 1 > qlo || kb_ <= qlo + QBLK - 1 - W)) mask_tile(P0_, P1_, qm - kb_, (unsigned)W); } while (0)
    constexpr int NQL = F32 ? 16 : 8;
    constexpr bool SK = WSKIP && !F32;
#define SEAM_K0() do { VMWN(NQL); if constexpr (F32) { SWRITE_KF(0); SBAR(); SLOAD_F((const float*)nxt.V, kbn); } else { SWRITE_HK(0); } SBAR(); } while (0)
    f32x16 pA0, pA1, pB0, pB1; float mnA, mnB, alA, alB; bf16x8 pa0, pa1, pa2, pa3;
    if constexpr (F32) { VMW(); SWRITE_VF(0); SBAR(); } else { SWRITE_HV(0); SBAR(); }
    if (NT > 1) { if constexpr (F32) SLOAD_F((const float*)Kh, KBASE(1)); else SLOAD_H(Kh, Vh, KBASE(1)); }
    SBAR(); qkt<0, SK>(pA0, pA1, K_lds, r32, hi, S.qr, ACT(0), CBT(0));
    if constexpr (F32) { if (NT > 1) { VMW(); SWRITE_KF(1); SBAR(); SLOAD_F((const float*)Vh, KBASE(1)); } }
    MASKT(pA0, pA1, 0); partialSM(pA0, pA1, m_reg, mnA, alA);
    if (NT > 1) { VMW(); if constexpr (F32) { SWRITE_VF(1); SBAR(); if (NT > 2) SLOAD_F((const float*)Kh, KBASE(2)); } else SWRITE_H(1); }
    __syncthreads();
#define HALF_STEP(PX0, PX1, mnX, alX, PY0, PY1, alY, t, KB, VB, SB) do {                                                      \
        SBAR(); qkt<KB, SK>(PX0, PX1, K_lds, r32, hi, S.qr, ACT(t), CBT(t));                                             \
        finishSM(PY0, PY1, alY, l_reg, pa0, pa1, pa2, pa3); SBAR();                                                           \
        if ((t) + 1 < NT) { if constexpr (F32) { VMW(); SWRITE_KF(SB); SBAR(); SLOAD_F((const float*)Vh, KBASE((t) + 1)); }  \
                            else { SLOAD_H(Kh, Vh, KBASE((t) + 1)); } SBAR(); }                                               \
        pv_tile<VB, SK>(o, vb0, pa0, pa1, pa2, pa3, ACT((t) - 1)); MASKT(PX0, PX1, (t)); partialSM(PX0, PX1, m_reg, mnX, alX);                                        \
        __syncthreads();                                                                                                      \
        if ((t) + 1 < NT) { VMW(); if constexpr (F32) { SWRITE_VF(SB); SBAR(); if ((t) + 2 < NT) SLOAD_F((const float*)Kh, KBASE((t) + 2)); } \
                            else { SWRITE_H(SB); } }                                                                          \
        RESC(alX); __syncthreads(); } while (0)
    for (int t = 1; t + 1 < NT; t += 2) {
        HALF_STEP(pB0, pB1, mnB, alB, pA0, pA1, alA, t, 1, 0, 0);
        HALF_STEP(pA0, pA1, mnA, alA, pB0, pB1, alB, t + 1, 0, 1, 1);
    }
    const bool even = (NT & 1) == 0;
    if (even) { SBAR(); qkt<1, SK>(pB0, pB1, K_lds, r32, hi, S.qr, ACT(NT - 1), CBT(NT - 1)); SBAR(); }
#define QROW(e) (nxt.Q + (size_t)(wid * QBLK + r32) * D + ((e) >> 1) * 16 + hi * 8 + ((e) & 1) * 4)
    if constexpr (F32) { SLOAD_F((const float*)nxt.K, kbn); SBAR();
#pragma unroll
        for (int e = 0; e < 8; ++e) S.tq[e] = *(const f32x4*)QROW(e); }
    else { SLOAD_H(nxt.K, nxt.V, kbn); SBAR();
#pragma unroll
        for (int d0 = 0; d0 < 8; ++d0) S.qr[d0] = load8<TIn>((const TIn*)((const char*)nxt.Q + (unsigned)((wid * QBLK + r32) * D + d0 * 16 + hi * 8) * (unsigned)sizeof(TIn))); }
    SBAR();
    finishSM(pA0, pA1, alA, l_reg, pa0, pa1, pa2, pa3); SBAR();
    if constexpr (F32) {
#pragma unroll
        for (int e = 8; e < 16; ++e) S.tq[e] = *(const f32x4*)QROW(e); SBAR(); }
#undef QROW
    pv_tile<0, SK>(o, vb0, pa0, pa1, pa2, pa3, ACT(even ? NT - 2 : NT - 1));
    if (even) { MASKT(pB0, pB1, NT - 1); partialSM(pB0, pB1, m_reg, mnB, alB); __syncthreads(); RESC(alB);
        finishSM(pB0, pB1, alB, l_reg, pa0, pa1, pa2, pa3); SBAR(); pv_tile<1, SK>(o, vb0, pa0, pa1, pa2, pa3, ACT(NT - 1)); }
    SBAR(); SEAM_K0();
    if (hi == 0) li_l[r32] = l_reg; asm volatile("s_waitcnt lgkmcnt(0)" ::: "memory");
    float rli[16];
#pragma unroll
    for (int r = 0; r < 16; ++r) rli[r] = __builtin_amdgcn_rcpf(li_l[crow(r, hi)]);
    int r32e = r32, hie = hi; asm volatile("" : "+v"(r32e), "+v"(hie));
    char* Ob = (char*)cur.O; const unsigned ob0 = (unsigned)((wid * QBLK + 4 * hie) * ost + r32e) * 2u;
#pragma unroll
    for (int r = 0; r < 16; ++r) { const unsigned rowoff = ob0 + (unsigned)(((r & 3) + 8 * (r >> 2)) * ost * 2); float ss_ = 0.f;
#pragma unroll
        for (int d0 = 0; d0 < 4; ++d0) { const float v = o[d0][r] * rli[r]; ss_ += v * v;
            const float vn = shx<1>(v);
            if ((r32e & 1) == 0) *(unsigned*)(Ob + rowoff + d0 * 64) = cvtpk(v, vn); }
        if (HAS_SS) { ss_ += shx<1>(ss_); ss_ += shx<2>(ss_); ss_ += shx<4>(ss_); ss_ += shx<8>(ss_); ss_ += shx<16>(ss_);
            if (r32e == 0) *(float*)((char*)cur.SS + (unsigned)(wid * QBLK + 4 * hie + (r & 3) + 8 * (r >> 2)) * 32u) = ss_; }
        SBAR(); }
    if constexpr (F32) {
#pragma unroll
        for (int d0 = 0; d0 < 8; ++d0) S.qr[d0] = pack8(S.tq[2 * d0], S.tq[2 * d0 + 1]); }
    __syncthreads();
#undef RESC
#undef KBASE
#undef CBT
#undef ACT
#undef MASKT
#undef SEAM_K0
#undef HALF_STEP
}
#undef ROW
}

#define GAS __attribute__((address_space(1)))
#define LAS __attribute__((address_space(3)))
typedef unsigned short bf16;
typedef unsigned v4u __attribute__((ext_vector_type(4)));
typedef float f32x4 __attribute__((ext_vector_type(4)));
#define LDS_WAIT() asm volatile("s_waitcnt lgkmcnt(0)" ::: "memory")
#define VM_WAIT() asm volatile("s_waitcnt vmcnt(0)" ::: "memory")
__device__ __forceinline__ unsigned f2bf(float f) { unsigned u = __builtin_bit_cast(unsigned, f); return (u + 0x7fffu + ((u >> 16) & 1u)) >> 16; }
__device__ __forceinline__ unsigned pk2(float lo, float hi) { return f2bf(lo) | (f2bf(hi) << 16); }
__device__ __forceinline__ float bflo(unsigned w) { return __uint_as_float(w << 16); }
__device__ __forceinline__ float bfhi(unsigned w) { return __uint_as_float(w & 0xffff0000u); }

#ifndef LB2
#define LB2 2
#endif
#ifndef FOX_HAS_SS
#define FOX_HAS_SS false
#endif
#ifndef FOX_SS
#define FOX_SS (SSQF + ((size_t)b * SEQ + x * 256) * 8 + h)
#endif
#ifndef FOX_CB
#define FOX_CB CB_OFF
#endif
#ifndef USE_XB
#define USE_XB 1
#endif
#if USE_XB
#define GSYNC() xcd_barrier(xbar)
#else
#define GSYNC() grid.sync()
#endif
#ifndef REP
#define REP 0
#endif
#ifndef PH
#define PH 0x1ff
#endif
constexpr int NWAVES = 8, NTHR = 512;
constexpr int BATCH = 4, SEQ = 2048, DM = 2048, M = BATCH * SEQ, NMEM = 256, MMEM = BATCH * NMEM;
constexpr int FOXW = 1024, LRUW = 1024, INW = 5128, INWP = 5376, XW = 512, FFN = 5632;
constexpr float EPS = 1e-6f;
constexpr size_t MiB = 1u << 20;
constexpr size_t WS_WIN = 1 * MiB, WS_WOUT = 22 * MiB, WS_WCQ = 30 * MiB, WS_WCKV = 32 * MiB, WS_WCO = 36 * MiB, WS_WGU = 38 * MiB, WS_WDN = 82 * MiB, WS_WLRU = 104 * MiB;
constexpr size_t WS_XN = 105 * MiB, WS_MN = 137 * MiB, WS_Q = 141 * MiB, WS_K = 157 * MiB, WS_V = 173 * MiB, WS_U = 189 * MiB, WS_GG = 205 * MiB, WS_UC = 221 * MiB;
constexpr size_t WS_LF = 237 * MiB, WS_CK = 238 * MiB, WS_CV = 239 * MiB, WS_MIX = 240 * MiB, WS_SSQF = 272 * MiB, WS_SSQL = 273 * MiB, WS_X1 = 274 * MiB;
constexpr size_t WS_SSQ1 = 338 * MiB, WS_CQ = 339 * MiB, WS_SSQ2 = 347 * MiB, WS_END = 348 * MiB;
constexpr size_t WS_HL = WS_X1, WS_AC = WS_X1 + 16 * MiB, WS_ENDH = WS_SSQ2, WS_ENDA = WS_SSQ2 + 256 * 1024;
constexpr size_t WS_X1B = WS_XN  , WS_OX = WS_Q  , WS_X2B = WS_MIX  , WS_H = WS_Q  ;
constexpr int LDS_BYTES = 147456, RED_OFF = 131072, CB_OFF = 69632, WSUM_OFF = 77824;

__device__ __forceinline__ float wave_sum(float v) { v += shx<1>(v); v += shx<2>(v); v += shx<4>(v); v += shx<8>(v); v += shx<16>(v); return sum32(v); }
__device__ __forceinline__ void transpose_item(const float* W, int ldw, int k0, int srcn0, int nvalid, const float* ks, bf16* WT, int ldt, int drow0, LAS float* scr, int lane) {
    f32x4 v[8];
#pragma unroll
    for (int i = 0; i < 8; ++i) { const int kk = 8 * i + (lane >> 3), n4 = (lane & 7) * 4;
        v[i] = (n4 < nvalid) ? __builtin_nontemporal_load((const GAS f32x4*)(W + (size_t)(k0 + kk) * ldw + srcn0 + n4)) : (f32x4){0.f, 0.f, 0.f, 0.f}; }
#pragma unroll
    for (int i = 0; i < 8; ++i) { const int kk = 8 * i + (lane >> 3), n4 = (lane & 7) * 4; f32x4 x = v[i]; if (ks) x = x * ks[k0 + kk];
        LAS float* d = scr + kk * 33 + n4; d[0] = x.x; d[1] = x.y; d[2] = x.z; d[3] = x.w; }
    LDS_WAIT(); asm volatile("" ::: "memory");
    const int c = lane & 7;
#pragma unroll
    for (int j = 0; j < 4; ++j) { const int n = (lane >> 3) + 8 * j; const LAS float* s = scr + (8 * c) * 33 + n;
        v4u o; o.x = pk2(s[0 * 33], s[1 * 33]); o.y = pk2(s[2 * 33], s[3 * 33]); o.z = pk2(s[4 * 33], s[5 * 33]); o.w = pk2(s[6 * 33], s[7 * 33]);
        *(GAS v4u*)(WT + (size_t)(drow0 + n) * ldt + k0 + 8 * c) = o; }
    LDS_WAIT(); asm volatile("" ::: "memory");
}
__device__ __forceinline__ void rms_row_to_bf16(const float* xrow, const float* g, bf16* orow, int lane) {
    const GAS f32x4* xr = (const GAS f32x4*)xrow + lane; const GAS f32x4* gr = (const GAS f32x4*)g + lane;
    f32x4 v[8]; float s = 0.f;
#pragma unroll
    for (int j = 0; j < 8; ++j) { v[j] = xr[64 * j]; s += (v[j].x * v[j].x + v[j].y * v[j].y) + (v[j].z * v[j].z + v[j].w * v[j].w); }
    const float rstd = 1.0f / sqrtf(wave_sum(s) * (1.f / DM) + EPS);
    GAS unsigned long long* o8 = (GAS unsigned long long*)orow + lane;
#pragma unroll
    for (int j = 0; j < 8; ++j) { const f32x4 gg = gr[64 * j]; o8[64 * j] = (unsigned long long)pk2(v[j].x * rstd * gg.x, v[j].y * rstd * gg.y) | ((unsigned long long)pk2(v[j].z * rstd * gg.z, v[j].w * rstd * gg.w) << 32); }
}

#define XB_TMO      128
#define XB_XCNT(j)  (256  + 64 * (j))
#define XB_XSUB(j)  (1280 + 64 * (j))
#define XB_XGEN(j)  (2304 + 64 * (j))
#define XB_TOP      3328
#define XB_TOPGEN   3392
#define XCD_BAR_WORDS 3456
#define XB_SPIN_CAP (1u << 18)

__device__ __forceinline__ unsigned xb_ld(unsigned* p)              { return __hip_atomic_load(p, __ATOMIC_RELAXED, __HIP_MEMORY_SCOPE_AGENT); }
__device__ __forceinline__ unsigned xb_add(unsigned* p, unsigned v) { return __hip_atomic_fetch_add(p, v, __ATOMIC_RELAXED, __HIP_MEMORY_SCOPE_AGENT); }
__device__ __forceinline__ unsigned xb_xcc_id() { return (unsigned)__builtin_amdgcn_s_getreg((3 << 11) | 20) & 0xFu; }
#define XB_SPIN(cond, bar) do { unsigned _sp = 0; while (cond) { __builtin_amdgcn_s_sleep(1); \
    if ((++_sp & 255u) == 0u) { if (xb_ld(&(bar)[XB_TMO])) break; if (_sp > XB_SPIN_CAP) { atomicAdd(&(bar)[XB_TMO], 1u); break; } } } } while (0)

struct XcdBarrier {
    unsigned* bar; unsigned x;
    volatile LAS unsigned* st;
};

__device__ __forceinline__ XcdBarrier xcd_barrier_post(unsigned* bar, volatile LAS unsigned* st) {
    XcdBarrier b; b.bar = bar; b.x = xb_xcc_id(); b.st = st;
    if (my_tid() == 0) (void)xb_add(&bar[XB_XCNT(b.x)], 1u);
    return b;
}
__device__ __forceinline__ void xcd_barrier_complete(unsigned* bar, unsigned x, unsigned& nloc, unsigned& nx) {
    const unsigned G = gridDim.x * gridDim.y * gridDim.z;
    unsigned sum, cnt, mine, sp = 0u;
    for (;;) {
        sum = 0u; cnt = 0u; mine = 0u;
#pragma unroll
        for (unsigned j = 0; j < 16; ++j) { const unsigned c = xb_ld(&bar[XB_XCNT(j)]); sum += c; cnt += (c > 0u) ? 1u : 0u; mine = (j == x) ? c : mine; }
        if (sum == G) break;
        __builtin_amdgcn_s_sleep(1);
        if ((++sp & 255u) == 0u) { if (xb_ld(&bar[XB_TMO])) break; if (sp > XB_SPIN_CAP) { atomicAdd(&bar[XB_TMO], 1u); break; } }
    }
    nloc = mine > 0u ? mine : 1u; nx = cnt > 0u ? cnt : 1u;
}

__device__ __forceinline__ void xcd_barrier(const XcdBarrier& b) {
    asm volatile("s_waitcnt vmcnt(0)" ::: "memory");
    __syncthreads();
    if (my_tid() == 0) {
        unsigned* bar = b.bar;
        __builtin_amdgcn_s_waitcnt(0);
        unsigned nloc = b.st[0], nx = b.st[1];
        if (nloc == 0u) { xcd_barrier_complete(bar, b.x, nloc, nx); b.st[0] = nloc; b.st[1] = nx; }
        const unsigned old = xb_add(&bar[XB_XSUB(b.x)], 1u);
        const unsigned gen = old / nloc;
        if (old + 1u == (gen + 1u) * nloc) {
            __builtin_amdgcn_fence(__ATOMIC_RELEASE, "agent");
            asm volatile("s_waitcnt vmcnt(0)" ::: "memory");
            const unsigned og = xb_add(&bar[XB_TOP], 1u);
            const unsigned tg = og / nx;
            if (og + 1u == (tg + 1u) * nx) xb_add(&bar[XB_TOPGEN], 1u);
            else XB_SPIN(xb_ld(&bar[XB_TOPGEN]) == tg, bar);
            __builtin_amdgcn_fence(__ATOMIC_ACQUIRE, "agent");
            xb_add(&bar[XB_XGEN(b.x)], 1u);
            asm volatile("s_waitcnt vmcnt(0)" ::: "memory");
        } else {
            XB_SPIN(xb_ld(&bar[XB_XGEN(b.x)]) == gen, bar);
            __builtin_amdgcn_fence(__ATOMIC_ACQUIRE, "agent");
            asm volatile("s_waitcnt vmcnt(0)" ::: "memory");
        }
    }
    __syncthreads();
}

struct Args { const float* in[27]; float* out; unsigned char* ws; };
enum { I_X = 0, I_MEM, I_GMIX, I_WIN, I_BF, I_GQ, I_GK, I_CONVW, I_CONVB, I_WRA, I_BRA, I_WRI, I_BRI, I_LAM, I_GFOX, I_GLRU, I_WOUT, I_GXATTN, I_GMEM, I_WCQ, I_WCKV, I_GCQ, I_GCK, I_WCO, I_GFFN, I_WGU, I_WDN };

constexpr int KB_D = DM / 64;
constexpr int I0 = (INWP / 32) * KB_D, I3 = (2 * XW / 32) * KB_D, I7 = 16 * 4 * 2, N_EARLY = I0 + I3 + I7;
constexpr int I1 = (DM / 32) * KB_D, I2 = (XW / 32) * KB_D, I4 = (DM / 32) * (XW / 64), I5 = (2 * FFN / 32) * KB_D, I6 = (DM / 32) * (FFN / 64), N_LATE = I1 + I2 + I4 + I5 + I6;
constexpr int N_LATE_P1 = I1 + I2 + I4 + 2560;
constexpr int N_LATE_P2 = N_LATE_P1 + 2440;
__device__ __forceinline__ void early_item(const Args& a, int r, LAS float* scr, int lane) {
    unsigned char* ws = a.ws;
    if (r < I0) { const int rg = r / KB_D, kb = r % KB_D, d = rg * 32; int src = d, nv = 32;
        if (d >= 3072 && d < 5120) src = d + 8; else if (d == 5120) { src = 3072; nv = 8; } else if (d > 5120) { src = 0; nv = 0; }
        transpose_item(a.in[I_WIN], INW, kb * 64, src, nv, nullptr, (bf16*)(ws + WS_WIN), DM, d, scr, lane); return; } r -= I0;
    if (r < I3) { const int rg = r / KB_D, kb = r % KB_D;
        transpose_item(a.in[I_WCKV], 2 * XW, kb * 64, rg * 32, 32, nullptr, (bf16*)(ws + WS_WCKV), DM, rg * 32, scr, lane); return; } r -= I3;
    { const int mtx = r >> 3, sub = r & 7, rg = sub >> 1, kb = sub & 1, n = mtx >> 1, which = mtx & 1;
        transpose_item((which ? a.in[I_WRI] : a.in[I_WRA]) + (size_t)n * 128 * 128, 128, kb * 64, rg * 32, 32, nullptr, (bf16*)(ws + WS_WLRU) + (size_t)(n * 256 + which * 128) * 128, 128, rg * 32, scr, lane); }
}
__device__ __forceinline__ void late_item(const Args& a, int r, LAS float* scr, int lane) {
    unsigned char* ws = a.ws;
    if (r < I1) { const int rg = r / KB_D, kb = r % KB_D; const float* ks = kb < 16 ? a.in[I_GFOX] : a.in[I_GLRU] - 1024;
        transpose_item(a.in[I_WOUT], DM, kb * 64, rg * 32, 32, ks, (bf16*)(ws + WS_WOUT), DM, rg * 32, scr, lane); return; } r -= I1;
    if (r < I2) { const int rg = r / KB_D, kb = r % KB_D;
        transpose_item(a.in[I_WCQ], XW, kb * 64, rg * 32, 32, a.in[I_GXATTN], (bf16*)(ws + WS_WCQ), DM, rg * 32, scr, lane); return; } r -= I2;
    if (r < I4) { const int rg = r / (XW / 64), kb = r % (XW / 64);
        transpose_item(a.in[I_WCO], DM, kb * 64, rg * 32, 32, nullptr, (bf16*)(ws + WS_WCO), XW, rg * 32, scr, lane); return; } r -= I4;
    if (r < I5) { const int rg = r / KB_D, kb = r % KB_D, d = rg * 32, tile = d >> 8, w = d & 255; const int src = w < 128 ? tile * 128 + w : FFN + tile * 128 + (w - 128);
        transpose_item(a.in[I_WGU], 2 * FFN, kb * 64, src, 32, a.in[I_GFFN], (bf16*)(ws + WS_WGU), DM, d, scr, lane); return; } r -= I5;
    { const int rg = r / (FFN / 64), kb = r % (FFN / 64);
        transpose_item(a.in[I_WDN], DM, kb * 64, rg * 32, 32, nullptr, (bf16*)(ws + WS_WDN), FFN, rg * 32, scr, lane); }
}
__device__ __forceinline__ void late_range(const Args& a, LAS unsigned char* lds, int lo, int hi, int w, int nw, int wave, int lane) {
    LAS float* scr = (LAS float*)(lds + wave * 16384);
    for (int it = lo + w; it < hi; it += nw) late_item(a, it, scr, lane);
}
__device__ __forceinline__ void p0_prologue(const Args& a, LAS unsigned char* lds, int wave, int lane, int G) {
    unsigned char* ws = a.ws;
    LAS float* scr = (LAS float*)(lds + wave * 16384);
    const int gw = blockIdx.x * NWAVES + wave, NGW = G * NWAVES;
    for (int it = gw; it < N_EARLY; it += NGW) early_item(a, it, scr, lane);
    if (G != 256) for (int it = gw; it < N_LATE; it += NGW) late_item(a, it, scr, lane);
    for (int m = gw; m < M + MMEM; m += NGW) {
        if (m < M) rms_row_to_bf16(a.in[I_X] + (size_t)m * DM, a.in[I_GMIX], (bf16*)(ws + WS_XN) + (size_t)m * DM, lane);
        else rms_row_to_bf16(a.in[I_MEM] + (size_t)(m - M) * DM, a.in[I_GMEM], (bf16*)(ws + WS_MN) + (size_t)(m - M) * DM, lane);
    }
}

__device__ __forceinline__ void conv_chunk(const bf16* U, bf16* UC, const float* cw, const float* cbias, int row0, int s0, int nblk, int tid) {
    asm volatile("" : "+v"(tid));
    const int c8 = nblk * 128 + (tid & 15) * 8;
    f32x4 w[4][2], bb[2];
#pragma unroll
    for (int j = 0; j < 4; ++j) { w[j][0] = *(const f32x4*)(cw + j * LRUW + c8); w[j][1] = *(const f32x4*)(cw + j * LRUW + c8 + 4); }
    bb[0] = *(const f32x4*)(cbias + c8); bb[1] = *(const f32x4*)(cbias + c8 + 4);
#pragma unroll 2
    for (int p = 0; p < 8; ++p) { const int rl = p * 32 + (tid >> 4), s = s0 + rl; const unsigned grow = (unsigned)(row0 + rl);
        f32x4 a0 = bb[0], a1 = bb[1];
#pragma unroll
        for (int j = 0; j < 4; ++j) { if (s - 3 + j >= 0) { const v4u uw = *(const v4u*)((const char*)U + ((grow - 3 + j) * LRUW + c8) * 2u);
            a0 += w[j][0] * (f32x4){bflo(uw.x), bfhi(uw.x), bflo(uw.y), bfhi(uw.y)}; a1 += w[j][1] * (f32x4){bflo(uw.z), bfhi(uw.z), bflo(uw.w), bfhi(uw.w)}; } }
        v4u o; o.x = pk2(a0.x, a0.y); o.y = pk2(a0.z, a0.w); o.z = pk2(a1.x, a1.y); o.w = pk2(a1.z, a1.w);
        *(v4u*)((char*)UC + (grow * LRUW + c8) * 2u) = o; }
}

__global__ void __launch_bounds__(NTHR, LB2) hymba_fwd(Args a) {
    extern __shared__ __attribute__((aligned(16))) unsigned char lds_raw[];
    cg::grid_group grid = cg::this_grid();
    LAS unsigned char* lds = (LAS unsigned char*)lds_raw;
    { const int t0 = threadIdx.x; if ((t0 & 63) == 0) *(volatile LAS int*)(lds + WTAB_OFF + hw_slot() * 4) = t0 >> 6;
      if (t0 < 2) *(volatile LAS unsigned*)(lds + XBST_OFF + t0 * 4) = 0u; }
    __syncthreads();
    const XcdBarrier xbar = xcd_barrier_post((unsigned*)a.ws, (volatile LAS unsigned*)(lds + XBST_OFF));
    const int G = gridDim.x, c = blockIdx.x;
#define WIN ((bf16*)(a.ws + WS_WIN))
#define WOUT ((bf16*)(a.ws + WS_WOUT))
#define WCQ ((bf16*)(a.ws + WS_WCQ))
#define WCKV ((bf16*)(a.ws + WS_WCKV))
#define WCO ((bf16*)(a.ws + WS_WCO))
#define WGU ((bf16*)(a.ws + WS_WGU))
#define WDN ((bf16*)(a.ws + WS_WDN))
#define WLRU ((bf16*)(a.ws + WS_WLRU))
#define XN ((bf16*)(a.ws + WS_XN))
#define MN ((bf16*)(a.ws + WS_MN))
#define Qh ((bf16*)(a.ws + WS_Q))
#define Kh ((bf16*)(a.ws + WS_K))
#define Vh ((bf16*)(a.ws + WS_V))
#define U ((bf16*)(a.ws + WS_U))
#define GG ((bf16*)(a.ws + WS_GG))
#define UC ((bf16*)(a.ws + WS_UC))
#define LF ((float*)(a.ws + WS_LF))
#define CK ((bf16*)(a.ws + WS_CK))
#define CV ((bf16*)(a.ws + WS_CV))
#define MIX ((bf16*)(a.ws + WS_MIX))
#define SSQF ((float*)(a.ws + WS_SSQF))
#define SSQL ((float*)(a.ws + WS_SSQL))
#define X1 ((float*)(a.ws + WS_X1))
#define X1B ((bf16*)(a.ws + WS_X1B))
#define SSQ1 ((float*)(a.ws + WS_SSQ1))
#define CQ ((bf16*)(a.ws + WS_CQ))
#define OX ((bf16*)(a.ws + WS_OX))
#define X2B ((bf16*)(a.ws + WS_X2B))
#define SSQ2 ((float*)(a.ws + WS_SSQ2))
#define H ((bf16*)(a.ws + WS_H))
#define HL ((bf16*)(a.ws + WS_HL))
#define AC ((bf16*)(a.ws + WS_AC))
#define ENDH ((float*)(a.ws + WS_ENDH))
#define ENDA ((float*)(a.ws + WS_ENDA))
#define red ((PG8_LAS float*)(lds + RED_OFF))

    for (int rep = 0; rep < 1 + ((REP >> 0) & 1); ++rep) {
    if (PH & 1) { int tid = my_tid(); p0_prologue(a, lds, __builtin_amdgcn_readfirstlane(tid >> 6), tid & 63, G); }
    GSYNC();
    if (a.ws == nullptr) grid.sync();
    }

    for (int rep = 0; rep < 1 + ((REP >> 1) & 1); ++rep) {
    if (PH & 2) {
        pg8::Gemm g{XN, WIN, M, INWP, DM, DM, DM}; pg8::StaticOrder S; S.init(M, INWP, G, c);
        pg8::EpiIn E{0, Qh, Kh, Vh, U, GG, LF, a.in[I_GQ], a.in[I_GK], a.in[I_BF], red};
        pg8::gemm_phase<pg8::EpiIn, pg8::StaticOrder, true, true>(lds, g, S, E);
        pg8::Gemm g2{MN, WCKV, MMEM, 2 * XW, DM, DM, DM}; pg8::StaticOrder S2; S2.init(MMEM, 2 * XW, G, (c + 16) % G);
        pg8::EpiCkv E2{0, CK, CV, a.in[I_GCK], red};
        pg8::gemm_phase<pg8::EpiCkv, pg8::StaticOrder, true, true>(lds, g2, S2, E2);
        if (G == 256 && c >= 160 && c < 240) { const int t2 = my_tid(); late_range(a, lds, 0, N_LATE_P1, (c - 160) * NWAVES + (t2 >> 6), 80 * NWAVES, __builtin_amdgcn_readfirstlane(t2 >> 6), t2 & 63); }
    }
    GSYNC();
    }

    for (int rep = 0; rep < 1 + ((REP >> 2) & 1); ++rep) {
    if (PH & 4) { int cL = c, tid = my_tid(); asm volatile("" : "+s"(cL));
      const int nl = G > 128 ? G - 128 : G;
      if (G <= 128 || cL >= 128)
      for (int L = (G > 128 ? cL - 128 : cL); L < 256; L += nl) {
            const int pm = L >> 3, nblk = L & 7, row0 = pm * 256;
            conv_chunk(U, UC, a.in[I_CONVW], a.in[I_CONVB], row0, (pm & 7) * 256, nblk, tid);
            VM_WAIT(); __syncthreads(); __builtin_amdgcn_fence(__ATOMIC_ACQUIRE, "agent");
            pg8::Gemm g{UC + (size_t)row0 * LRUW + nblk * 128, WLRU + (size_t)nblk * 256 * 128, 256, 256, 128, LRUW, 128}; pg8::OneUnit S;
            pg8::EpiLru E{0, UC, HL, AC, ENDH + pm * 1024, ENDA + pm * 1024, a.in[I_BRA], a.in[I_BRI], a.in[I_LAM], row0, nblk};
            pg8::gemm_phase<pg8::EpiLru, pg8::OneUnit, false, true>(lds, g, S, E);
      }
      if (G == 256 && cL >= 128) {
        VM_WAIT(); __syncthreads();
        if (my_tid() == 0) { unsigned* cnt = (unsigned*)(a.ws + 15360);
            __builtin_amdgcn_fence(__ATOMIC_RELEASE, "agent"); asm volatile("s_waitcnt vmcnt(0)" ::: "memory");
            (void)__hip_atomic_fetch_add(cnt, 1u, __ATOMIC_RELAXED, __HIP_MEMORY_SCOPE_AGENT);
            unsigned sp = 0; while (__hip_atomic_load(cnt, __ATOMIC_RELAXED, __HIP_MEMORY_SCOPE_AGENT) < 128u && ++sp < (1u << 22)) __builtin_amdgcn_s_sleep(1);
            __builtin_amdgcn_fence(__ATOMIC_ACQUIRE, "agent"); asm volatile("s_waitcnt vmcnt(0)" ::: "memory"); }
        __syncthreads();
#define P2B_FIRST (cL - 128)
#define P2B_STRIDE 128
    { int tid = my_tid();
      for (int L = P2B_FIRST; L < 256; L += P2B_STRIDE) { const int pm = L >> 3, nblk = L & 7, j = pm & 7, c8 = nblk * 128 + (tid & 15) * 8;
        f32x4 hi0 = {0.f, 0.f, 0.f, 0.f}, hi1 = {0.f, 0.f, 0.f, 0.f};
        for (int i = 0; i < j; ++i) { const float* eh = ENDH + (pm - j + i) * 1024 + c8; const float* ea = ENDA + (pm - j + i) * 1024 + c8;
            hi0 = *(const f32x4*)ea * hi0 + *(const f32x4*)eh; hi1 = *(const f32x4*)(ea + 4) * hi1 + *(const f32x4*)(eh + 4); }
#pragma unroll 2
        for (int p = 0; p < 8; ++p) { const unsigned row = (unsigned)(pm * 256 + p * 32 + (tid >> 4)), o = (row * 1024u + c8) * 2u;
            const v4u hw = *(const v4u*)((const char*)HL + o), aw = *(const v4u*)((const char*)AC + o), gw = *(const v4u*)((const char*)GG + o);
            const f32x4 y0 = ((f32x4){bflo(hw.x), bfhi(hw.x), bflo(hw.y), bfhi(hw.y)} + (f32x4){bflo(aw.x), bfhi(aw.x), bflo(aw.y), bfhi(aw.y)} * hi0) * (f32x4){bflo(gw.x), bfhi(gw.x), bflo(gw.y), bfhi(gw.y)};
            const f32x4 y1 = ((f32x4){bflo(hw.z), bfhi(hw.z), bflo(hw.w), bfhi(hw.w)} + (f32x4){bflo(aw.z), bfhi(aw.z), bflo(aw.w), bfhi(aw.w)} * hi1) * (f32x4){bflo(gw.z), bfhi(gw.z), bflo(gw.w), bfhi(gw.w)};
            float ss = (y0.x * y0.x + y0.y * y0.y) + (y0.z * y0.z + y0.w * y0.w) + (y1.x * y1.x + y1.y * y1.y) + (y1.z * y1.z + y1.w * y1.w);
            v4u ow; ow.x = pk2(y0.x, y0.y); ow.y = pk2(y0.z, y0.w); ow.z = pk2(y1.x, y1.y); ow.w = pk2(y1.z, y1.w);
            *(v4u*)((char*)MIX + ((size_t)row * 2048 + 1024 + c8) * 2) = ow;
            ss += shx<1>(ss); ss += shx<2>(ss); ss += shx<4>(ss); ss += shx<8>(ss);
            if ((tid & 15) == 0) SSQL[row * 8 + nblk] = ss; } } }
#undef P2B_FIRST
#undef P2B_STRIDE
        { const int t2 = my_tid(); late_range(a, lds, N_LATE_P1, N_LATE_P2, (cL - 128) * NWAVES + (t2 >> 6), 128 * NWAVES, __builtin_amdgcn_readfirstlane(t2 >> 6), t2 & 63); } } }
    if (PH & 4) { int cF = c, tid = my_tid(); asm volatile("" : "+s"(cF)); const int lane = tid & 63, wave = __builtin_amdgcn_readfirstlane(tid >> 6);
      for (int L = cF; L < 128; L += G) {
        {
#if !defined(NO_FOX)
            const int it = L, bh = it >> 2, x = it & 3, b = bh >> 3, h = bh & 7;
            LAS float* cbl = (LAS float*)(lds + CB_OFF); LAS float* wsum = (LAS float*)(lds + WSUM_OFF);
            { const float* lf = LF + ((size_t)b * SEQ + tid * 4) * 8 + h;
              const float v0 = lf[0], v1 = lf[8], v2 = lf[16], v3 = lf[24]; const float t0 = v0, t1 = t0 + v1, t2 = t1 + v2, t3 = t2 + v3;
              wsum[tid] = t3; __syncthreads();
              for (int o = 1; o < 512; o <<= 1) { const float v = wsum[tid] + (tid >= o ? wsum[tid - o] : 0.f); __syncthreads(); wsum[tid] = v; __syncthreads(); }
              const float off = wsum[tid] - t3;
              const float ns = -1.0f / att::SCALE;
              *(LAS f32x4*)(cbl + tid * 4) = (f32x4){(off + t0) * ns, (off + t1) * ns, (off + t2) * ns, (off + t3) * ns};
              __syncthreads(); }
            typedef att::BlockRef<att::bf16, att::bf16> BR;
            BR cur, nxt;
            { const size_t hrow = (size_t)bh * SEQ;
              cur.Q = (const att::bf16*)Qh + (hrow + x * 256) * 128; cur.K = (const att::bf16*)Kh + hrow * 128; cur.V = (const att::bf16*)Vh + hrow * 128;
              cur.O = (att::bf16*)MIX + ((size_t)b * SEQ + x * 256) * 2048 + h * 128; cur.SS = FOX_SS; cur.P0 = x * 256;
              nxt = cur; const int d = (7 - 2 * x) * 256;
              nxt.Q += (size_t)d * 128; nxt.O += (size_t)d * 2048; nxt.SS += (size_t)d * 8; nxt.P0 += d; }
            att::Seam<att::bf16> S;
            att::causal_swa_prime<att::bf16, att::bf16>(cur, 1 << 20, (char*)lds_raw, S);
            for (int p = 0; p < 2; ++p) {
                att::causal_swa_block<att::bf16, att::bf16, 2048, FOX_HAS_SS>(cur, nxt, SEQ, 1 << 20, (char*)lds_raw, S, FOX_CB);
                cur = nxt; }
            VM_WAIT(); __syncthreads(); __builtin_amdgcn_fence(__ATOMIC_ACQUIRE, "agent");
            for (int p = 0; p < 16; ++p) { const int qb = (p < 8) ? x : 7 - x, rl = (p & 7) * 32 + (tid >> 4); const size_t trow = (size_t)b * SEQ + qb * 256 + rl;
                const v4u w = *(const v4u*)(MIX + trow * 2048 + h * 128 + (tid & 15) * 8);
                float ss = (bflo(w.x) * bflo(w.x) + bfhi(w.x) * bfhi(w.x)) + (bflo(w.y) * bflo(w.y) + bfhi(w.y) * bfhi(w.y)) + (bflo(w.z) * bflo(w.z) + bfhi(w.z) * bfhi(w.z)) + (bflo(w.w) * bflo(w.w) + bfhi(w.w) * bfhi(w.w));
                ss += shx<1>(ss); ss += shx<2>(ss); ss += shx<4>(ss); ss += shx<8>(ss);
                if ((tid & 15) == 0) SSQF[trow * 8 + h] = ss; }
            VM_WAIT(); __syncthreads();
#endif
        }
    } }
    GSYNC();
    }

    if (G != 256) {
#define P2B_FIRST c
#define P2B_STRIDE G
    { int tid = my_tid();
      for (int L = P2B_FIRST; L < 256; L += P2B_STRIDE) { const int pm = L >> 3, nblk = L & 7, j = pm & 7, c8 = nblk * 128 + (tid & 15) * 8;
        f32x4 hi0 = {0.f, 0.f, 0.f, 0.f}, hi1 = {0.f, 0.f, 0.f, 0.f};
        for (int i = 0; i < j; ++i) { const float* eh = ENDH + (pm - j + i) * 1024 + c8; const float* ea = ENDA + (pm - j + i) * 1024 + c8;
            hi0 = *(const f32x4*)ea * hi0 + *(const f32x4*)eh; hi1 = *(const f32x4*)(ea + 4) * hi1 + *(const f32x4*)(eh + 4); }
#pragma unroll 2
        for (int p = 0; p < 8; ++p) { const unsigned row = (unsigned)(pm * 256 + p * 32 + (tid >> 4)), o = (row * 1024u + c8) * 2u;
            const v4u hw = *(const v4u*)((const char*)HL + o), aw = *(const v4u*)((const char*)AC + o), gw = *(const v4u*)((const char*)GG + o);
            const f32x4 y0 = ((f32x4){bflo(hw.x), bfhi(hw.x), bflo(hw.y), bfhi(hw.y)} + (f32x4){bflo(aw.x), bfhi(aw.x), bflo(aw.y), bfhi(aw.y)} * hi0) * (f32x4){bflo(gw.x), bfhi(gw.x), bflo(gw.y), bfhi(gw.y)};
            const f32x4 y1 = ((f32x4){bflo(hw.z), bfhi(hw.z), bflo(hw.w), bfhi(hw.w)} + (f32x4){bflo(aw.z), bfhi(aw.z), bflo(aw.w), bfhi(aw.w)} * hi1) * (f32x4){bflo(gw.z), bfhi(gw.z), bflo(gw.w), bfhi(gw.w)};
            float ss = (y0.x * y0.x + y0.y * y0.y) + (y0.z * y0.z + y0.w * y0.w) + (y1.x * y1.x + y1.y * y1.y) + (y1.z * y1.z + y1.w * y1.w);
            v4u ow; ow.x = pk2(y0.x, y0.y); ow.y = pk2(y0.z, y0.w); ow.z = pk2(y1.x, y1.y); ow.w = pk2(y1.z, y1.w);
            *(v4u*)((char*)MIX + ((size_t)row * 2048 + 1024 + c8) * 2) = ow;
            ss += shx<1>(ss); ss += shx<2>(ss); ss += shx<4>(ss); ss += shx<8>(ss);
            if ((tid & 15) == 0) SSQL[row * 8 + nblk] = ss; } } }
#undef P2B_FIRST
#undef P2B_STRIDE
    GSYNC(); }

    for (int rep = 0; rep < 1 + ((REP >> 3) & 1); ++rep) {
    if (PH & 8) {
        pg8::Gemm g{MIX, WOUT, M, DM, DM, DM, DM}; pg8::StaticOrder S; S.init(M, DM, G, c);
        pg8::EpiRes<true> E{16, a.in[I_X], nullptr, nullptr, X1B, SSQ1, SSQF, SSQL};
        pg8::gemm_phase<pg8::EpiRes<true>, pg8::StaticOrder, true, true>(lds, g, S, E);
    }
    GSYNC();
    }

    for (int rep = 0; rep < 1 + ((REP >> 4) & 1); ++rep) {
    if (PH & 16) {
        pg8::Gemm g{X1B, WCQ, M, XW, DM, DM, DM}; pg8::StaticOrder S; S.init(M, XW, G, c);
        pg8::EpiCq E{0, CQ, a.in[I_GCQ], SSQ1, red};
        pg8::gemm_phase<pg8::EpiCq, pg8::StaticOrder, true, true>(lds, g, S, E);
        if (G == 256 && c >= 64) { const int t2 = my_tid(); late_range(a, lds, N_LATE_P2, N_LATE, (c - 64) * NWAVES + (t2 >> 6), 192 * NWAVES, __builtin_amdgcn_readfirstlane(t2 >> 6), t2 & 63); }
    }
    GSYNC();
    }

    for (int rep = 0; rep < 1 + ((REP >> 5) & 1); ++rep) {
    if (PH & 32) for (int L = c; L < 128; L += G) {
        const int bh = L >> 3, qb = L & 7, b = bh >> 2, h = bh & 3;
        att::BlockRef<att::bf16, att::bf16> r;
        r.Q = (const att::bf16*)CQ + ((size_t)bh * SEQ + qb * 256) * 128; r.K = (const att::bf16*)CK + (size_t)bh * NMEM * 128; r.V = (const att::bf16*)CV + (size_t)bh * NMEM * 128;
        r.O = (att::bf16*)OX + ((size_t)b * SEQ + qb * 256) * XW + h * 128; r.SS = nullptr; r.P0 = 1 << 16;
        att::Seam<att::bf16> S;
        att::causal_swa_prime<att::bf16, att::bf16>(r, 1 << 20, (char*)lds_raw, S);
        att::causal_swa_block<att::bf16, att::bf16, XW, false>(r, r, NMEM, 1 << 20, (char*)lds_raw, S, -1);
        VM_WAIT(); __syncthreads();
    }
    GSYNC();
    }

    for (int rep = 0; rep < 1 + ((REP >> 6) & 1); ++rep) {
    if (PH & 64) {
        pg8::Gemm g{OX, WCO, M, DM, XW, XW, XW}; pg8::StaticOrder S; S.init(M, DM, G, c);
        pg8::EpiRes<false> E{0, nullptr, X1B, nullptr, X2B, SSQ2, nullptr, nullptr};
        pg8::gemm_phase<pg8::EpiRes<false>, pg8::StaticOrder, true, true>(lds, g, S, E);
    }
    GSYNC();
    }

    for (int rep = 0; rep < 1 + ((REP >> 7) & 1); ++rep) {
    if (PH & 128) {
        pg8::Gemm g{X2B, WGU, M, 2 * FFN, DM, DM, DM}; pg8::StaticOrder S; S.init(M, 2 * FFN, G, c);
        pg8::EpiGu E{0, H, SSQ2, red};
        pg8::gemm_phase<pg8::EpiGu, pg8::StaticOrder, true, true>(lds, g, S, E);
    }
    GSYNC();
    }

    if (PH & 256) {
        pg8::Gemm g{H, WDN, M, DM, FFN, FFN, FFN}; pg8::StaticOrder S; S.init(M, DM, G, c);
        pg8::EpiRes<false> E{0, nullptr, X2B, a.out, nullptr, nullptr, nullptr, nullptr};
        pg8::gemm_phase<pg8::EpiRes<false>, pg8::StaticOrder, true, true>(lds, g, S, E);
    }
}

#undef WIN
#undef WOUT
#undef WCQ
#undef WCKV
#undef WCO
#undef WGU
#undef WDN
#undef WLRU
#undef XN
#undef MN
#undef Qh
#undef Kh
#undef Vh
#undef U
#undef GG
#undef UC
#undef LF
#undef CK
#undef CV
#undef MIX
#undef SSQF
#undef SSQL
#undef X1
#undef X1B
#undef SSQ1
#undef CQ
#undef OX
#undef X2B
#undef SSQ2
#undef H
#undef HL
#undef AC
#undef ENDH
#undef ENDA
#undef red
extern "C" void kernel_launch(void* const* d_in, const int* in_sizes, int n_in, void* d_out, int out_size, void* d_ws, size_t ws_size, hipStream_t stream) {
    static int grid = 0;
    if (grid == 0) {
        if (n_in != 27 || in_sizes[0] != M * DM || out_size != M * DM || ws_size < WS_END) { fprintf(stderr, "kernel_launch: unexpected shapes (n_in %d, in0 %d, out %d, ws %zu)\n", n_in, n_in > 0 ? in_sizes[0] : -1, out_size, ws_size); grid = -1; return; }
        int dev = 0, cus = 0, per_cu = 0;
        (void)hipGetDevice(&dev); (void)hipDeviceGetAttribute(&cus, hipDeviceAttributeMultiprocessorCount, dev);
        if (hipFuncSetAttribute((const void*)hymba_fwd, hipFuncAttributeMaxDynamicSharedMemorySize, LDS_BYTES) != hipSuccess) { fprintf(stderr, "kernel_launch: hipFuncSetAttribute failed\n"); grid = -1; return; }
        if (hipOccupancyMaxActiveBlocksPerMultiprocessor(&per_cu, (const void*)hymba_fwd, NTHR, LDS_BYTES) != hipSuccess || per_cu < 1) { fprintf(stderr, "kernel_launch: occupancy query says %d\n", per_cu); per_cu = 1; }
        (void)hipGetLastError();
        grid = cus * per_cu;
    }
    if (grid < 0) return;
    Args a{};
    for (int i = 0; i < 27; ++i) a.in[i] = (const float*)d_in[i];
    a.out = (float*)d_out; a.ws = (unsigned char*)d_ws;
    if (hipMemsetAsync(d_ws, 0, 16384, stream) != hipSuccess) { fprintf(stderr, "kernel_launch: memset of the barrier words failed\n"); return; }
    void* args[] = {&a};
    hipError_t e = hipLaunchCooperativeKernel((const void*)hymba_fwd, dim3(grid), dim3(NTHR), args, LDS_BYTES, stream);
    if (e != hipSuccess) fprintf(stderr, "cooperative launch failed: %s (grid %d)\n", hipGetErrorString(e), grid);
}
```

```cpp
#include <hip/hip_runtime.h>
#include <hip/hip_bf16.h>
#include <hip/hip_cooperative_groups.h>
#include <cstdio>
#include <cstdint>
namespace cg = cooperative_groups;


template <int K> __device__ __forceinline__ float shx(float v) { static_assert(K < 32, "use sum32"); return __int_as_float(__builtin_amdgcn_ds_swizzle(__float_as_int(v), (K << 10) | 0x1f)); }
__device__ __forceinline__ float sum32(float v) { auto rr = __builtin_amdgcn_permlane32_swap(__float_as_uint(v), __float_as_uint(v), false, false); return __uint_as_float(rr[0]) + __uint_as_float(rr[1]); }
constexpr int WTAB_OFF = 147456 - 256, XBST_OFF = 147456 - 512;
__device__ __forceinline__ int hw_slot() { return (int)(__builtin_amdgcn_s_getreg((5 << 11) | 4) & 63u); }
__device__ __forceinline__ int my_tid() {
    const int slot = hw_slot();
    const int wave = __builtin_amdgcn_readfirstlane(*(volatile __attribute__((address_space(3))) int*)(unsigned)(WTAB_OFF + slot * 4));
    int l; asm volatile("v_mbcnt_lo_u32_b32 %0, -1, 0\n\tv_mbcnt_hi_u32_b32 %0, -1, %0" : "=v"(l));
    return wave * 64 + l;
}
namespace pg8 {
#define PG8_LAS __attribute__((address_space(3)))
typedef unsigned short bf16_t;
typedef short bf16x8 __attribute__((ext_vector_type(8)));
typedef float f32x4 __attribute__((ext_vector_type(4)));
typedef unsigned u32x4 __attribute__((ext_vector_type(4)));
constexpr int BM = 256, BK = 64, HALF = 128, HTB = HALF * BK * 2  , STAGE_BYTES = 8 * HTB, NXCD = 8, WGM = 8;

__host__ __device__ __forceinline__ int lds_byte(int r, int c) { const int st = (r >> 4) * 2 + (c >> 5), rr = r & 15, cc = c & 31, ob = rr * 64 + cc * 2; return st * 1024 + (ob ^ (((ob >> 9) & 1) << 5)); }
__host__ __device__ __forceinline__ void stage_rc(int b, int& R, int& C) { const int st = b / 1024, sb = b % 1024, swz = sb ^ (((sb >> 9) & 1) << 5); R = (st >> 1) * 16 + swz / 64; C = (st & 1) * 32 + (swz % 64) / 2; }
__host__ __device__ __forceinline__ int perm32(int rho) { const int n = rho >> 4, i = rho & 15; return 8 * (i >> 2) + 4 * n + (i & 3); }

struct Unit { int pm, pn; };
struct Gemm { const bf16_t* A; const bf16_t* Bt; int M, N, K, lda, ldb; };

struct StaticOrder {
    int nM, nN, nwg, G, c;
    __host__ __device__ void init(int M, int N, int G_, int c_) { nM = M / BM; nN = N / BM; nwg = nM * nN; G = G_; c = c_; }
    __host__ __device__ bool next(int i, Unit& u) const {
        const long L = (long)i * G + c; if (L >= nwg) return false;
        int wgid = (int)L; { const int q = nwg / NXCD, r = nwg % NXCD, xcd = wgid % NXCD, off = wgid / NXCD; wgid = (xcd < r ? xcd * (q + 1) : r * (q + 1) + (xcd - r) * q) + off; }
        const int nig = WGM * nN, gid = wgid / nig, fm = gid * WGM, gsz = (nM - fm) < WGM ? (nM - fm) : WGM;
        u.pm = fm + ((wgid % nig) % gsz); u.pn = (wgid % nig) / gsz; return true;
    }
    __device__ __forceinline__ void a_ready(const Unit&) const {}
    __device__ __forceinline__ void done(const Unit&) const {}
};

__device__ __forceinline__ unsigned cvt_pk_bf16(float lo, float hi) { unsigned r; asm volatile("v_cvt_pk_bf16_f32 %0, %1, %2" : "=v"(r) : "v"(lo), "v"(hi)); return r; }

typedef float f32x2 __attribute__((ext_vector_type(2)));
constexpr float RMS_EPS = 1e-6f;
struct OneUnit {
    __device__ __forceinline__ bool next(int i, Unit& u) const { if (i != 0) return false; u.pm = 0; u.pn = 0; return true; }
    __device__ __forceinline__ void a_ready(const Unit&) const {}
    __device__ __forceinline__ void done(const Unit&) const {}
};
struct OffsetOrder {
    StaticOrder S;
    __device__ __forceinline__ bool next(int i, Unit& u) const { return S.next(i, u); }
    __device__ __forceinline__ void a_ready(const Unit&) const {}
    __device__ __forceinline__ void done(const Unit&) const {}
};
__device__ __forceinline__ float fast_log1p(float x) { const float sr = x * (1.0f - x * (0.5f - x * (0.33333334f - x * (0.25f - x * (0.2f - x * 0.16666667f))))); return x < 0.0625f ? sr : __logf(1.0f + x); }
__device__ __forceinline__ float sigmoidf_(float x) { return __builtin_amdgcn_rcpf(1.0f + __expf(-x)); }
__device__ __forceinline__ float gelu_tanh(float x) { const float u = 0.7978845608028654f * (x + 0.044715f * x * x * x); return x * sigmoidf_(2.0f * u); }
__device__ __forceinline__ float sum_f(const float* p, int n4) { float s = 0.f; for (int i = 0; i < n4; ++i) { const f32x4 v = *(const f32x4*)(p + 4 * i); s += (v[0] + v[1]) + (v[2] + v[3]); } return s; }
__device__ __forceinline__ u32x4 pack8(const f32x4& a, const f32x4& b) { u32x4 w; w.x = cvt_pk_bf16(a[0], a[1]); w.y = cvt_pk_bf16(a[2], a[3]); w.z = cvt_pk_bf16(b[0], b[1]); w.w = cvt_pk_bf16(b[2], b[3]); return w; }

template <int ACT  >
__device__ __forceinline__ void store_tile(const f32x4 (&acc)[2][2][4][2], bf16_t* d0, bf16_t* d1, size_t ld, int wr, int wc, int fr, int fq) {
#pragma unroll
    for (int ai = 0; ai < 2; ++ai)
#pragma unroll
        for (int m = 0; m < 4; ++m) { const size_t ro = (size_t)(ai * HALF + wr * 64 + m * 16 + fr) * ld + wc * 32 + fq * 8;
#pragma unroll
            for (int bj = 0; bj < 2; ++bj) { f32x4 v0 = acc[ai][bj][m][0], v1 = acc[ai][bj][m][1];
                if (ACT == 1) {
#pragma unroll
                    for (int j = 0; j < 4; ++j) { v0[j] = gelu_tanh(v0[j]); v1[j] = gelu_tanh(v1[j]); } }
                *(u32x4*)((bj ? d1 : d0) + ro) = pack8(v0, v1); } }
}
template <bool ROWSCALE>
__device__ __forceinline__ void head_norm_store(const f32x4 (&acc)[2][2][4][2], const float (&rs)[2][4], const float* gain, bf16_t* d0, bf16_t* d1, PG8_LAS float* red, int wr, int wc, int fr, int fq) {
#pragma unroll
    for (int ai = 0; ai < 2; ++ai)
#pragma unroll
        for (int m = 0; m < 4; ++m)
#pragma unroll
            for (int bj = 0; bj < 2; ++bj) { float s = 0.f;
#pragma unroll
                for (int n = 0; n < 2; ++n) { f32x4 v = acc[ai][bj][m][n]; if (ROWSCALE) v = v * rs[ai][m]; s += (v[0] * v[0] + v[1] * v[1]) + (v[2] * v[2] + v[3] * v[3]); }
                s += shx<16>(s); s = sum32(s);
                if (fq == 0) red[((ai * HALF + wr * 64 + m * 16 + fr) * 2 + bj) * 4 + wc] = s; }
    asm volatile("s_waitcnt lgkmcnt(0)" ::: "memory"); __builtin_amdgcn_s_barrier(); asm volatile("" ::: "memory");
    const f32x4 g0 = *(const f32x4*)(gain + wc * 32 + fq * 8), g1 = *(const f32x4*)(gain + wc * 32 + fq * 8 + 4);
#pragma unroll
    for (int ai = 0; ai < 2; ++ai)
#pragma unroll
        for (int m = 0; m < 4; ++m) { const int rl = ai * HALF + wr * 64 + m * 16 + fr;
#pragma unroll
            for (int bj = 0; bj < 2; ++bj) { const PG8_LAS float* rp = red + (rl * 2 + bj) * 4;
                const float ss = (rp[0] + rp[1]) + (rp[2] + rp[3]);
                float sc = __builtin_amdgcn_rsqf(ss * (1.0f / 128.0f) + RMS_EPS); if (ROWSCALE) sc *= rs[ai][m];
                const f32x4 v0 = acc[ai][bj][m][0] * sc * g0, v1 = acc[ai][bj][m][1] * sc * g1;
                *(u32x4*)((bj ? d1 : d0) + (size_t)rl * 128 + wc * 32 + fq * 8) = pack8(v0, v1); } }
}

struct EpiIn {
    static constexpr bool PERM = true, AFTER_DRAIN = false, HAS_MID = false; int mid_t;
    bf16_t *Q, *Kh, *V, *U, *GG; float* LF; const float *g_q, *g_k, *b_f; PG8_LAS float* red;
    __device__ __forceinline__ void operator()(const f32x4 (&acc)[2][2][4][2], const Unit& u, int wr, int wc, int fr, int fq) const {
        asm volatile("" : "+v"(fr), "+v"(fq));
        const int pn = u.pn, row0 = u.pm * BM, b = row0 >> 11, s0 = row0 & 2047;
        if (pn < 12) {
            const int h0 = (pn & 3) * 2; bf16_t* const q_ = Q; bf16_t* const k_ = Kh; bf16_t* const v_ = V; const float* const gq_ = g_q; const float* const gk_ = g_k;
            bf16_t* base = pn < 4 ? q_ : (pn < 8 ? k_ : v_);
            bf16_t* d0 = base + ((size_t)(b * 8 + h0) * 2048 + s0) * 128; bf16_t* d1 = d0 + (size_t)2048 * 128;
            if (pn < 8) { float rs[2][4]; head_norm_store<false>(acc, rs, pn < 4 ? gq_ : gk_, d0, d1, red, wr, wc, fr, fq); }
            else store_tile<0>(acc, d0, d1, 128, wr, wc, fr, fq);
        } else if (pn < 16) { bf16_t* const u_ = U; bf16_t* d0 = u_ + (size_t)row0 * 1024 + (pn - 12) * 256; store_tile<0>(acc, d0, d0 + 128, 1024, wr, wc, fr, fq); }
        else if (pn < 20) { bf16_t* const g_ = GG; bf16_t* d0 = g_ + (size_t)row0 * 1024 + (pn - 16) * 256; store_tile<1>(acc, d0, d0 + 128, 1024, wr, wc, fr, fq); }
        else if (wc == 0 && fq == 0) {
            const f32x4 b0 = *(const f32x4*)b_f, b1 = *(const f32x4*)(b_f + 4);
#pragma unroll
            for (int ai = 0; ai < 2; ++ai)
#pragma unroll
                for (int m = 0; m < 4; ++m) { const int row = row0 + ai * HALF + wr * 64 + m * 16 + fr; f32x4 z0 = acc[ai][0][m][0] + b0, z1 = acc[ai][0][m][1] + b1;
#pragma unroll
                    for (int j = 0; j < 4; ++j) { z0[j] = fminf(z0[j], 0.f) - fast_log1p(__expf(-fabsf(z0[j]))); z1[j] = fminf(z1[j], 0.f) - fast_log1p(__expf(-fabsf(z1[j]))); }
                    *(f32x4*)(LF + (size_t)row * 8) = z0; *(f32x4*)(LF + (size_t)row * 8 + 4) = z1; }
        }
    }
};
struct EpiCkv {
    static constexpr bool PERM = true, AFTER_DRAIN = false, HAS_MID = false; int mid_t;
    bf16_t *CK, *CV; const float* g_ck; PG8_LAS float* red;
    __device__ __forceinline__ void operator()(const f32x4 (&acc)[2][2][4][2], const Unit& u, int wr, int wc, int fr, int fq) const {
        asm volatile("" : "+v"(fr), "+v"(fq));
        const int pn = u.pn, b = u.pm, h0 = (pn & 1) * 2;
        bf16_t* const ck_ = CK; bf16_t* const cv_ = CV; bf16_t* d0 = (pn < 2 ? ck_ : cv_) + ((size_t)(b * 4 + h0) * 256) * 128; bf16_t* d1 = d0 + (size_t)256 * 128;
        if (pn < 2) { float rs[2][4]; head_norm_store<false>(acc, rs, g_ck, d0, d1, red, wr, wc, fr, fq); }
        else store_tile<0>(acc, d0, d1, 128, wr, wc, fr, fq);
    }
};
struct EpiCq {
    static constexpr bool PERM = true, AFTER_DRAIN = false, HAS_MID = false; int mid_t;
    bf16_t* CQ; const float* g_cq; const float* SSQ; PG8_LAS float* red;
    __device__ __forceinline__ void operator()(const f32x4 (&acc)[2][2][4][2], const Unit& u, int wr, int wc, int fr, int fq) const {
        asm volatile("" : "+v"(fr), "+v"(fq));
        const int pn = u.pn, row0 = u.pm * BM, b = row0 >> 11, s0 = row0 & 2047, h0 = pn * 2, tid = (wr * 4 + wc) * 64 + fq * 16 + fr;
        PG8_LAS float* tab = red + 2048;
        if (tid < 256) tab[tid] = __builtin_amdgcn_rsqf(sum_f(SSQ + (size_t)(row0 + tid) * 32, 8) * (1.0f / 2048.0f) + RMS_EPS);
        asm volatile("s_waitcnt lgkmcnt(0)" ::: "memory"); __builtin_amdgcn_s_barrier(); asm volatile("" ::: "memory");
        float rs[2][4];
#pragma unroll
        for (int ai = 0; ai < 2; ++ai)
#pragma unroll
            for (int m = 0; m < 4; ++m) rs[ai][m] = tab[ai * HALF + wr * 64 + m * 16 + fr];
        bf16_t* d0 = CQ + ((size_t)(b * 4 + h0) * 2048 + s0) * 128; bf16_t* d1 = d0 + (size_t)2048 * 128;
        head_norm_store<true>(acc, rs, g_cq, d0, d1, red, wr, wc, fr, fq);
    }
};
template <bool MID> struct EpiRes {
    static constexpr bool PERM = true, AFTER_DRAIN = false, HAS_MID = MID; int mid_t;
    const float* resid; const bf16_t* residb; float* outf; bf16_t* outb; float* ssq_out; const float *ssqf, *ssql;
    __device__ __forceinline__ void mid(f32x4 (&acc)[2][2][4][2], const Unit& u, int wr, int wc, int fr, int fq) const {
        asm volatile("" : "+v"(fr), "+v"(fq));
#pragma unroll
        for (int ai = 0; ai < 2; ++ai)
#pragma unroll
            for (int m = 0; m < 4; ++m) { const size_t row = (size_t)u.pm * BM + ai * HALF + wr * 64 + m * 16 + fr;
                const float rf = __builtin_amdgcn_rsqf(sum_f(ssqf + row * 8, 2) * (1.0f / 1024.0f) + RMS_EPS), rl = __builtin_amdgcn_rsqf(sum_f(ssql + row * 8, 2) * (1.0f / 1024.0f) + RMS_EPS);
                const float ratio = rf / rl;
#pragma unroll
                for (int bj = 0; bj < 2; ++bj)
#pragma unroll
                    for (int n = 0; n < 2; ++n) acc[ai][bj][m][n] = acc[ai][bj][m][n] * ratio;
                __builtin_amdgcn_sched_barrier(0); }
    }
    __device__ __forceinline__ void operator()(const f32x4 (&acc)[2][2][4][2], const Unit& u, int wr, int wc, int fr, int fq) const {
        asm volatile("" : "+v"(fr), "+v"(fq));
#pragma unroll
        for (int ai = 0; ai < 2; ++ai)
#pragma unroll
            for (int m = 0; m < 4; ++m) { const size_t row = (size_t)u.pm * BM + ai * HALF + wr * 64 + m * 16 + fr;
                float sc = 1.f; if (MID) sc = __builtin_amdgcn_rsqf(sum_f(ssql + row * 8, 2) * (1.0f / 1024.0f) + RMS_EPS);
                float ss = 0.f;
#pragma unroll
                for (int bj = 0; bj < 2; ++bj) { const size_t o = row * 2048 + u.pn * BM + bj * HALF + wc * 32 + fq * 8;
                    f32x4 r0, r1;
                    if (residb) { const u32x4 w = __builtin_nontemporal_load((const u32x4*)(residb + o));     r0 = (f32x4){__uint_as_float(w.x << 16), __uint_as_float(w.x & 0xffff0000u), __uint_as_float(w.y << 16), __uint_as_float(w.y & 0xffff0000u)};
                                  r1 = (f32x4){__uint_as_float(w.z << 16), __uint_as_float(w.z & 0xffff0000u), __uint_as_float(w.w << 16), __uint_as_float(w.w & 0xffff0000u)}; }
                    else { r0 = __builtin_nontemporal_load((const f32x4*)(resid + o)); r1 = __builtin_nontemporal_load((const f32x4*)(resid + o + 4)); }
                    const f32x4 v0 = r0 + acc[ai][bj][m][0] * sc, v1 = r1 + acc[ai][bj][m][1] * sc;
                    if (outf) { __builtin_nontemporal_store(v0, (f32x4*)(outf + o)); __builtin_nontemporal_store(v1, (f32x4*)(outf + o + 4)); }
                    ss += (v0[0] * v0[0] + v0[1] * v0[1]) + (v0[2] * v0[2] + v0[3] * v0[3]) + (v1[0] * v1[0] + v1[1] * v1[1]) + (v1[2] * v1[2] + v1[3] * v1[3]);
                    if (outb) *(u32x4*)(outb + o) = pack8(v0, v1); }
                if (ssq_out) { ss += shx<16>(ss); ss = sum32(ss); if (fq == 0) ssq_out[row * 32 + u.pn * 4 + wc] = ss; }
                __builtin_amdgcn_sched_barrier(0); }
    }
};
struct EpiGu {
    static constexpr bool PERM = true, AFTER_DRAIN = false, HAS_MID = false; int mid_t;
    bf16_t* H; const float* SSQ; PG8_LAS float* red;
    __device__ __forceinline__ void operator()(const f32x4 (&acc)[2][2][4][2], const Unit& u, int wr, int wc, int fr, int fq) const {
        asm volatile("" : "+v"(fr), "+v"(fq));
        const int tid = (wr * 4 + wc) * 64 + fq * 16 + fr; PG8_LAS float* tab = red + 2048;
        if (tid < 256) tab[tid] = __builtin_amdgcn_rsqf(sum_f(SSQ + ((size_t)u.pm * BM + tid) * 32, 8) * (1.0f / 2048.0f) + RMS_EPS);
        asm volatile("s_waitcnt lgkmcnt(0)" ::: "memory"); __builtin_amdgcn_s_barrier(); asm volatile("" ::: "memory");
#pragma unroll
        for (int ai = 0; ai < 2; ++ai)
#pragma unroll
            for (int m = 0; m < 4; ++m) { const size_t row = (size_t)u.pm * BM + ai * HALF + wr * 64 + m * 16 + fr;
                const float rs = tab[ai * HALF + wr * 64 + m * 16 + fr];
                f32x4 h[2];
#pragma unroll
                for (int n = 0; n < 2; ++n) { const f32x4 g = acc[ai][0][m][n] * rs, up = acc[ai][1][m][n] * rs;
#pragma unroll
                    for (int j = 0; j < 4; ++j) h[n][j] = g[j] * sigmoidf_(g[j]) * up[j]; }
                *(u32x4*)(H + row * 5632 + u.pn * HALF + wc * 32 + fq * 8) = pack8(h[0], h[1]); }
    }
};
struct EpiLru {
    static constexpr bool PERM = true, AFTER_DRAIN = true, HAS_MID = false; int mid_t;
    const bf16_t* UC; bf16_t* HL; bf16_t* AC; float* ENDH; float* ENDA; const float *b_ra, *b_ri, *lam; int row0, nblk;
    __device__ __forceinline__ void fused(f32x4 (&acc)[2][2][4][2], const Unit&, int wr, int wc, int fr, int fq, PG8_LAS unsigned char* lds, int wid, int lane) const {
        asm volatile("" : "+v"(fr), "+v"(fq));
        PG8_LAS float* LA = (PG8_LAS float*)lds; PG8_LAS float* LB = LA + 128 * 132;
        const int tid = wid * 64 + lane, ch0 = nblk * 128 + wc * 32 + fq * 8;
        float hc = 0.f, ac = 1.f;
#pragma unroll
        for (int ai = 0; ai < 2; ++ai) {
#pragma unroll
            for (int n = 0; n < 2; ++n) {
                const f32x4 bra = *(const f32x4*)(b_ra + ch0 + 4 * n), bri = *(const f32x4*)(b_ri + ch0 + 4 * n), lm = *(const f32x4*)(lam + ch0 + 4 * n); f32x4 sp;
#pragma unroll
                for (int j = 0; j < 4; ++j) sp[j] = -8.0f * fast_log1p(__expf(-lm[j]));
#pragma unroll
                for (int m = 0; m < 4; ++m) { const int rl = wr * 64 + m * 16 + fr; const unsigned grow = (unsigned)(row0 + ai * HALF + rl);
                    const f32x2 ucw = *(const f32x2*)((const char*)UC + (grow * 1024u + ch0 + 4 * n) * 2u); f32x4 av, bv;
#pragma unroll
                    for (int j = 0; j < 4; ++j) { const unsigned w = __float_as_uint(ucw[j >> 1]); const float uc = __uint_as_float((j & 1) ? (w & 0xffff0000u) : (w << 16));
                        const float r = sigmoidf_(acc[ai][0][m][n][j] + bra[j]), ig = sigmoidf_(acc[ai][1][m][n][j] + bri[j]);
                        const float la = r * sp[j], a_ = __expf(la); av[j] = a_; bv[j] = __builtin_amdgcn_sqrtf(fmaxf(fmaf(-a_, a_, 1.0f), 0.f)) * ig * uc; }
                    *(PG8_LAS f32x4*)(LA + rl * 132 + wc * 32 + fq * 8 + 4 * n) = av; *(PG8_LAS f32x4*)(LB + rl * 132 + wc * 32 + fq * 8 + 4 * n) = bv;
                    __builtin_amdgcn_sched_barrier(0); } }
            asm volatile("s_waitcnt lgkmcnt(0)" ::: "memory"); __builtin_amdgcn_s_barrier(); asm volatile("" ::: "memory");
            if (tid < 128) {
#pragma unroll 8
                for (int rl = 0; rl < 128; ++rl) { const float a_ = LA[rl * 132 + tid]; hc = a_ * hc + LB[rl * 132 + tid]; ac *= a_; LB[rl * 132 + tid] = hc; LA[rl * 132 + tid] = ac; }
                if (ai == 1) { ENDH[nblk * 128 + tid] = hc; ENDA[nblk * 128 + tid] = ac; } }
            asm volatile("s_waitcnt lgkmcnt(0)" ::: "memory"); __builtin_amdgcn_s_barrier(); asm volatile("" ::: "memory");
            const int c8 = (tid & 15) * 8;
#pragma unroll
            for (int p = 0; p < 4; ++p) { const int rl = p * 32 + (tid >> 4); const unsigned o = ((unsigned)(row0 + ai * HALF + rl) * 1024u + nblk * 128 + c8) * 2u;
                const f32x4 h0 = *(const PG8_LAS f32x4*)(LB + rl * 132 + c8), h1 = *(const PG8_LAS f32x4*)(LB + rl * 132 + c8 + 4);
                const f32x4 a0 = *(const PG8_LAS f32x4*)(LA + rl * 132 + c8), a1 = *(const PG8_LAS f32x4*)(LA + rl * 132 + c8 + 4);
                *(u32x4*)((char*)HL + o) = pack8(h0, h1); *(u32x4*)((char*)AC + o) = pack8(a0, a1); }
            asm volatile("s_waitcnt lgkmcnt(0)" ::: "memory"); __builtin_amdgcn_s_barrier(); asm volatile("" ::: "memory");
        }
    }
};
template <class Epi, class Sched, bool ALIGN_EPI = false, bool SP2 = false>
__device__ __forceinline__ void gemm_phase(PG8_LAS unsigned char* lds, const Gemm g, const Sched& S, const Epi& E) {
    int tid_ = my_tid();
    const int tid = tid_, wid = __builtin_amdgcn_readfirstlane(tid >> 6), lane = tid & 63, wr = wid >> 2, wc = wid & 3, fr = lane & 15, fq = lane >> 4;
    const int K = g.K, nt = K / BK;
    unsigned voffA[2], voffB[2];
#pragma unroll
    for (int i = 0; i < 2; ++i) { int R, C; stage_rc(tid * 16 + i * 8192, R, C); const int Rb = Epi::PERM ? ((R & ~31) + perm32(R & 31)) : R;
        voffA[i] = (unsigned)(R * g.lda + C) * 2u; voffB[i] = (unsigned)(Rb * g.ldb + C) * 2u; }
    const size_t kstep = (size_t)(BK * 2);
    const size_t hstepA = (size_t)HALF * g.lda * 2, hstepB = (size_t)HALF * g.ldb * 2;
    const size_t tstepA = 2 * hstepA, tstepB = 2 * hstepB;
    const unsigned ldsw = (unsigned)wid * 1024u;
    const int aoff = lds_byte(wr * 64 + fr, fq * 8), boff = lds_byte(wc * 32 + fr, fq * 8);
#define PG8_SA(b, h) (((b) * 2 + (h)) * HTB)
#define PG8_SB(b, h) ((4 + (b) * 2 + (h)) * HTB)
#define PG8_STAGE(bufoff, gbase, voff) do { _Pragma("unroll") for (int _i = 0; _i < 2; ++_i) \
        __builtin_amdgcn_global_load_lds((const unsigned*)((const char*)(gbase) + (voff)[_i]), (PG8_LAS unsigned*)(lds + (bufoff) + ldsw + _i * 8192), 16, 0, 0); } while (0)
#define PG8_LDA(dst, b, h) do { _Pragma("unroll") for (int m = 0; m < 4; ++m) _Pragma("unroll") for (int k = 0; k < 2; ++k) dst[m][k] = *(const PG8_LAS bf16x8*)(lds + PG8_SA(b, h) + aoff + m * 2048 + k * 1024); } while (0)
#define PG8_LDB(dst, b, h) do { _Pragma("unroll") for (int n = 0; n < 2; ++n) _Pragma("unroll") for (int k = 0; k < 2; ++k) dst[n][k] = *(const PG8_LAS bf16x8*)(lds + PG8_SB(b, h) + boff + n * 2048 + k * 1024); } while (0)
#define PG8_MMA(ai, bj, At, Bt) do { __builtin_amdgcn_s_setprio(1); _Pragma("unroll") for (int m = 0; m < 4; ++m) _Pragma("unroll") for (int n = 0; n < 2; ++n) _Pragma("unroll") for (int k = 0; k < 2; ++k) \
        acc[ai][bj][m][n] = __builtin_amdgcn_mfma_f32_16x16x32_bf16(Bt[n][k], At[m][k], acc[ai][bj][m][n], 0, 0, 0); __builtin_amdgcn_s_setprio(0); } while (0)
#define PG8_WAIT_V(n) asm volatile("s_waitcnt vmcnt(" #n ")" ::: "memory")
#define PG8_WAIT_L(n) asm volatile("s_waitcnt lgkmcnt(" #n ")" ::: "memory")
#define PG8_BAR __builtin_amdgcn_s_barrier()
#define PG8_SCHED __builtin_amdgcn_sched_barrier(0)
    Unit cur, nxt; int ui = 0;
    if (!S.next(0, cur)) return;
    f32x4 acc[2][2][4][2];
#pragma unroll
    for (int a = 0; a < 2; ++a)
#pragma unroll
        for (int b = 0; b < 2; ++b)
#pragma unroll
            for (int m = 0; m < 4; ++m)
#pragma unroll
                for (int n = 0; n < 2; ++n) acc[a][b][m][n] = (f32x4){0.f, 0.f, 0.f, 0.f};
    bf16x8 At[4][2], B0[2][2], B1[2][2];
    const char* cA = (const char*)g.A + (size_t)cur.pm * tstepA; const char* cB = (const char*)g.Bt + (size_t)cur.pn * tstepB;
    S.a_ready(cur);
    if constexpr (SP2) {
        PG8_STAGE(PG8_SB(0, 0), cB, voffB); PG8_STAGE(PG8_SB(0, 1), cB + hstepB, voffB); PG8_STAGE(PG8_SA(0, 0), cA, voffA); PG8_STAGE(PG8_SA(0, 1), cA + hstepA, voffA);
        if (wr == 1) PG8_BAR;
        PG8_WAIT_V(2); PG8_BAR;
        PG8_STAGE(PG8_SB(1, 0), cB + kstep, voffB); PG8_STAGE(PG8_SA(1, 0), cA + kstep, voffA); PG8_STAGE(PG8_SB(1, 1), cB + hstepB + kstep, voffB);
        PG8_WAIT_V(6); PG8_BAR;
    } else {
        PG8_STAGE(PG8_SB(0, 0), cB, voffB); PG8_STAGE(PG8_SA(0, 0), cA, voffA); PG8_STAGE(PG8_SB(0, 1), cB + hstepB, voffB); PG8_STAGE(PG8_SA(0, 1), cA + hstepA, voffA);
        if (wr == 1) PG8_BAR;
        PG8_WAIT_V(4); PG8_BAR;
        PG8_STAGE(PG8_SB(1, 0), cB + kstep, voffB); PG8_STAGE(PG8_SA(1, 0), cA + kstep, voffA); PG8_STAGE(PG8_SB(1, 1), cB + hstepB + kstep, voffB);
        PG8_WAIT_V(6); PG8_BAR;
    }
    for (;;) {
        const bool has_next = S.next(ui + 1, nxt);
        const char* nA = has_next ? (const char*)g.A + (size_t)nxt.pm * tstepA : cA; const char* nB = has_next ? (const char*)g.Bt + (size_t)nxt.pn * tstepB : cB;
        for (int t = 0; t < nt; t += 2) {
            const bool last = (t == nt - 2);
            if constexpr (Epi::HAS_MID) { if (t == E.mid_t) E.mid(acc, cur, wr, wc, fr, fq); }
            const char* a1 = cA + (size_t)(t + 1) * kstep;
            const char* a2 = last ? nA : cA + (size_t)(t + 2) * kstep; const char* b2 = last ? nB : cB + (size_t)(t + 2) * kstep;
            const char* a3 = a2 + kstep; const char* b3 = b2 + kstep;
            if (last && has_next) S.a_ready(nxt);
            if constexpr (SP2) {
            PG8_LDB(B0, 0, 0); PG8_LDB(B1, 0, 1); PG8_SCHED; PG8_LDA(At, 0, 0); PG8_STAGE(PG8_SA(1, 1), a1 + hstepA, voffA);
            PG8_WAIT_V(8); PG8_WAIT_L(0); PG8_BAR; PG8_MMA(0, 0, At, B0); PG8_MMA(0, 1, At, B1); PG8_BAR; PG8_SCHED;
            PG8_LDA(At, 0, 1); PG8_STAGE(PG8_SB(0, 0), b2, voffB); PG8_STAGE(PG8_SB(0, 1), b2 + hstepB, voffB); PG8_STAGE(PG8_SA(0, 0), a2, voffA);
            PG8_WAIT_V(8); PG8_WAIT_L(0); PG8_BAR; PG8_MMA(1, 0, At, B0); PG8_MMA(1, 1, At, B1); PG8_BAR; PG8_SCHED;
            PG8_LDB(B0, 1, 0); PG8_LDB(B1, 1, 1); PG8_SCHED; PG8_LDA(At, 1, 0); PG8_STAGE(PG8_SA(0, 1), a2 + hstepA, voffA);
            PG8_WAIT_V(8); PG8_WAIT_L(0); PG8_BAR; PG8_MMA(0, 0, At, B0); PG8_MMA(0, 1, At, B1); PG8_BAR; PG8_SCHED;
            PG8_LDA(At, 1, 1); PG8_STAGE(PG8_SB(1, 0), b3, voffB); PG8_STAGE(PG8_SB(1, 1), b3 + hstepB, voffB); PG8_STAGE(PG8_SA(1, 0), a3, voffA);
            PG8_WAIT_V(8); PG8_WAIT_L(0); PG8_BAR; PG8_MMA(1, 0, At, B0); PG8_MMA(1, 1, At, B1); PG8_BAR; PG8_SCHED;
            } else {
            PG8_LDB(B0, 0, 0); PG8_SCHED; PG8_LDA(At, 0, 0); PG8_STAGE(PG8_SA(1, 1), a1 + hstepA, voffA);
            PG8_WAIT_L(8); PG8_BAR; PG8_WAIT_L(0); PG8_MMA(0, 0, At, B0); PG8_BAR; PG8_SCHED;
            PG8_LDB(B1, 0, 1); PG8_STAGE(PG8_SB(0, 0), b2, voffB);
            PG8_BAR; PG8_WAIT_L(0); PG8_MMA(0, 1, At, B1); PG8_BAR;
            PG8_LDA(At, 0, 1); PG8_STAGE(PG8_SA(0, 0), a2, voffA);
            PG8_BAR; PG8_WAIT_L(0); PG8_MMA(1, 0, At, B0); PG8_BAR; PG8_SCHED;
            PG8_STAGE(PG8_SB(0, 1), b2 + hstepB, voffB);
            PG8_WAIT_V(6); PG8_BAR; PG8_MMA(1, 1, At, B1); PG8_BAR;
            PG8_LDB(B0, 1, 0); PG8_SCHED; PG8_LDA(At, 1, 0); PG8_STAGE(PG8_SA(0, 1), a2 + hstepA, voffA);
            PG8_WAIT_L(8); PG8_BAR; PG8_WAIT_L(0); PG8_MMA(0, 0, At, B0); PG8_BAR; PG8_SCHED;
            PG8_LDB(B1, 1, 1); PG8_STAGE(PG8_SB(1, 0), b3, voffB);
            PG8_BAR; PG8_WAIT_L(0); PG8_MMA(0, 1, At, B1); PG8_BAR;
            PG8_LDA(At, 1, 1); PG8_STAGE(PG8_SA(1, 0), a3, voffA);
            PG8_BAR; PG8_WAIT_L(0); PG8_MMA(1, 0, At, B0); PG8_BAR; PG8_SCHED;
            PG8_STAGE(PG8_SB(1, 1), b3 + hstepB, voffB);
            PG8_WAIT_V(6); PG8_BAR; PG8_MMA(1, 1, At, B1); PG8_BAR;
            }
        }
        if constexpr (ALIGN_EPI) { if (wr == 0) PG8_BAR; }
        if constexpr (!Epi::AFTER_DRAIN) { E(acc, cur, wr, wc, fr, fq); S.done(cur); }
        if (!has_next) break;
#pragma unroll
        for (int a = 0; a < 2; ++a)
#pragma unroll
            for (int b = 0; b < 2; ++b)
#pragma unroll
                for (int m = 0; m < 4; ++m)
#pragma unroll
                    for (int n = 0; n < 2; ++n) acc[a][b][m][n] = (f32x4){0.f, 0.f, 0.f, 0.f};
        cur = nxt; cA = nA; cB = nB; ++ui;
        if constexpr (ALIGN_EPI) { if (wr == 1) PG8_BAR; }
    }
    PG8_WAIT_V(0);
    if constexpr (!ALIGN_EPI) { if (wr == 0) PG8_BAR; }
    PG8_BAR;
    if constexpr (Epi::AFTER_DRAIN) { E.fused(acc, cur, wr, wc, fr, fq, lds, wid, lane); S.done(cur); }
#undef PG8_SA
#undef PG8_SB
#undef PG8_STAGE
#undef PG8_LDA
#undef PG8_LDB
#undef PG8_MMA
#undef PG8_WAIT_V
#undef PG8_WAIT_L
#undef PG8_BAR
#undef PG8_SCHED
}
}
namespace att {
constexpr int D = 128;
constexpr float THR = 8.f;
constexpr bool WSKIP = false;
constexpr float SCALE = 0.08838834764831845f;
constexpr int NW = 8, QBLK = 32, KVBLK = 64, QB = NW * QBLK;
constexpr int SHM_V = KVBLK * D * 2, SHM_K = KVBLK * D * 2;
constexpr int LDS_BYTES = 2 * SHM_V + 2 * SHM_K + NW * 64 * 4;
using bf16 = __hip_bfloat16;
typedef short bf16x8 __attribute__((ext_vector_type(8)));
typedef short s16x4 __attribute__((ext_vector_type(4)));
typedef float f32x16 __attribute__((ext_vector_type(16)));
typedef float f32x4 __attribute__((ext_vector_type(4)));
typedef unsigned u32x4 __attribute__((ext_vector_type(4)));
template <class A, class Bt> struct same_t { static constexpr bool v = false; };
template <class A> struct same_t<A, A> { static constexpr bool v = true; };

#define KSWZ(row, colB) ((row) * 256 + ((colB) ^ (((row) & 7) << 4)))
#define SBAR() __builtin_amdgcn_sched_barrier(0)
__device__ __forceinline__ int v_st(int k, int c) { const int kk = (k & ~0xC) | ((k & 4) << 1) | ((k & 8) >> 1); return ((kk >> 3) * 4 + (c >> 5)) * 512 + ((kk & 7) * 32 + (c & 31)) * 2; }
__device__ __forceinline__ int v_rd_base(int lane) { return ((lane & 3) << 3) | (((lane >> 2) & 3) << 6) | (((lane >> 4) & 1) << 5) | (((lane >> 5) & 1) << 8); }
constexpr int v_rd_off(int d0, int ks, int half) { return d0 * 512 + ks * 4096 + half * 2048; }
__device__ __forceinline__ int crow(int r, int hi) { return (r & 3) + 8 * (r >> 2) + 4 * hi; }
__device__ __forceinline__ unsigned cvtpk(float lo, float hi) {
    unsigned r; asm volatile("v_cvt_pk_bf16_f32 %0, %1, %2" : "=v"(r) : "v"(lo), "v"(hi)); return r;
}
__device__ __forceinline__ bf16x8 pack8(f32x4 a, f32x4 b) {
    u32x4 w = {cvtpk(a[0], a[1]), cvtpk(a[2], a[3]), cvtpk(b[0], b[1]), cvtpk(b[2], b[3])};
    return *reinterpret_cast<bf16x8*>(&w);
}
template <class T> __device__ __forceinline__ bf16x8 load8(const T* p) {
    if constexpr (same_t<T, float>::v) { return pack8(*(const f32x4*)p, *(const f32x4*)(p + 4)); }
    else { return *reinterpret_cast<const bf16x8*>(p); }
}
__device__ __forceinline__ void mask_tile(f32x16& p0, f32x16& p1, int dq, unsigned W) {
    const float NEG = -__builtin_inff();
#pragma unroll
    for (int r = 0; r < 16; ++r) {
        const int c = (r & 3) + 8 * (r >> 2);
        if ((unsigned)(dq - c) >= W) p0[r] = NEG;
        if ((unsigned)(dq - c - 32) >= W) p1[r] = NEG;
    }
}
__device__ __forceinline__ void partialSM(f32x16& p0, f32x16& p1, float& m_reg, float& mn, float& alpha) {
    float pmax = p0[0]; for (int r = 1; r < 16; ++r) pmax = fmaxf(pmax, p0[r]); for (int r = 0; r < 16; ++r) pmax = fmaxf(pmax, p1[r]);
    { auto rr = __builtin_amdgcn_permlane32_swap(__float_as_uint(pmax), __float_as_uint(pmax), false, false);
      pmax = fmaxf(__uint_as_float(rr[0]), __uint_as_float(rr[1])); }
    constexpr float C2 = 1.4426950408889634f * SCALE;
    if (__builtin_expect(__all((pmax - m_reg) * SCALE <= THR), 1)) { mn = m_reg; alpha = 1.f; }
    else { mn = fmaxf(m_reg, pmax); alpha = __builtin_amdgcn_exp2f((m_reg - mn) * C2); m_reg = mn; }
    const float mnL = -mn * C2;
    for (int r = 0; r < 16; ++r) p0[r] = fmaf(p0[r], C2, mnL); for (int r = 0; r < 16; ++r) p1[r] = fmaf(p1[r], C2, mnL);
    for (int r = 0; r < 16; ++r) p0[r] = __builtin_amdgcn_exp2f(p0[r]);
}
__device__ __forceinline__ void finishSM(f32x16& p0, f32x16& p1, float alpha, float& l_reg, bf16x8& pa0, bf16x8& pa1, bf16x8& pa2, bf16x8& pa3) {
    for (int r = 0; r < 16; ++r) p1[r] = __builtin_amdgcn_exp2f(p1[r]);
    float ps = 0; for (int r = 0; r < 16; ++r) ps += p0[r]; for (int r = 0; r < 16; ++r) ps += p1[r];
    { auto rr = __builtin_amdgcn_permlane32_swap(__float_as_uint(ps), __float_as_uint(ps), false, false);
      ps = __uint_as_float(rr[0]) + __uint_as_float(rr[1]); }
    l_reg = l_reg * alpha + ps;
#define PK4(P, B_, OUT) do { unsigned a0 = cvtpk(P[B_+0], P[B_+1]), a1 = cvtpk(P[B_+2], P[B_+3]);                          \
        unsigned b0 = cvtpk(P[B_+4], P[B_+5]), b1 = cvtpk(P[B_+6], P[B_+7]);                                             \
        auto r0 = __builtin_amdgcn_permlane32_swap(a0, b0, false, false); auto r1 = __builtin_amdgcn_permlane32_swap(a1, b1, false, false); \
        u32x4 w = {r0[0], r1[0], r0[1], r1[1]}; OUT = *reinterpret_cast<bf16x8*>(&w); } while (0)
    PK4(p0, 0, pa0); PK4(p0, 8, pa1); PK4(p1, 0, pa2); PK4(p1, 8, pa3);
#undef PK4
}
template <int KB, bool SK>
__device__ __forceinline__ void qkt(f32x16& p0, f32x16& p1, const char* K_lds, int r32, int hi, const bf16x8* qr, bool act, int cbo  ) {
    if (SK && !act) { const float NEG = -__builtin_inff();
#pragma unroll
        for (int r = 0; r < 16; ++r) { p0[r] = NEG; p1[r] = NEG; } return; }
    if (cbo >= 0) { int a_ = cbo + hi * 16; asm volatile("" : "+v"(a_)); const __attribute__((address_space(3))) float* cb = (const __attribute__((address_space(3))) float*)(unsigned)a_;
#pragma unroll
        for (int q_ = 0; q_ < 4; ++q_) { const f32x4 v0_ = *(const __attribute__((address_space(3))) f32x4*)(cb + 8 * q_), v1_ = *(const __attribute__((address_space(3))) f32x4*)(cb + 32 + 8 * q_);
#pragma unroll
            for (int j_ = 0; j_ < 4; ++j_) { p0[4 * q_ + j_] = v0_[j_]; p1[4 * q_ + j_] = v1_[j_]; } }
    } else { p0 = f32x16{}; p1 = f32x16{}; }
    const char* kb[4];
#pragma unroll
    for (int dd = 0; dd < 4; ++dd) kb[dd] = K_lds + KB * SHM_K + KSWZ(r32, (dd * 16 + hi * 8) * 2);
#pragma unroll
    for (int d0 = 0; d0 < 8; ++d0) { const char* a = kb[d0 & 3] + (d0 >> 2) * 128;
        bf16x8 b0 = *reinterpret_cast<const bf16x8*>(a);
        bf16x8 b1 = *reinterpret_cast<const bf16x8*>(a + 32 * 256);
        p0 = __builtin_amdgcn_mfma_f32_32x32x16_bf16(b0, qr[d0], p0, 0, 0, 0);
        p1 = __builtin_amdgcn_mfma_f32_32x32x16_bf16(b1, qr[d0], p1, 0, 0, 0); }
}
template <int VB, bool SK>
__device__ __forceinline__ void pv_tile(f32x16* o, int vb0, bf16x8 pa0, bf16x8 pa1, bf16x8 pa2, bf16x8 pa3, bool act) {
    if (SK && !act) return;
#define TRRD(dst, off) asm volatile("ds_read_b64_tr_b16 %0, %1 offset:%2" : "=&v"(dst) : "v"(vb0), "i"(off) : "memory")
#define PV_D0(d0) do { s16x4 l0, l1, l2, l3, h0, h1, h2, h3; constexpr int b_ = VB * SHM_V + v_rd_off(d0, 0, 0);     \
        TRRD(l0, b_); TRRD(h0, b_ + 2048); TRRD(l1, b_ + 4096); TRRD(h1, b_ + 6144); TRRD(l2, b_ + 8192); TRRD(h2, b_ + 10240); TRRD(l3, b_ + 12288); TRRD(h3, b_ + 14336); \
        asm volatile("s_waitcnt lgkmcnt(0)" ::: "memory"); SBAR();                 \
        o[d0] = __builtin_amdgcn_mfma_f32_32x32x16_bf16(pa0, (bf16x8){l0[0], l0[1], l0[2], l0[3], h0[0], h0[1], h0[2], h0[3]}, o[d0], 0, 0, 0);   \
        o[d0] = __builtin_amdgcn_mfma_f32_32x32x16_bf16(pa1, (bf16x8){l1[0], l1[1], l1[2], l1[3], h1[0], h1[1], h1[2], h1[3]}, o[d0], 0, 0, 0);   \
        o[d0] = __builtin_amdgcn_mfma_f32_32x32x16_bf16(pa2, (bf16x8){l2[0], l2[1], l2[2], l2[3], h2[0], h2[1], h2[2], h2[3]}, o[d0], 0, 0, 0);   \
        o[d0] = __builtin_amdgcn_mfma_f32_32x32x16_bf16(pa3, (bf16x8){l3[0], l3[1], l3[2], l3[3], h3[0], h3[1], h3[2], h3[3]}, o[d0], 0, 0, 0); } while (0)
    PV_D0(0); PV_D0(1); PV_D0(2); PV_D0(3);
#undef PV_D0
#undef TRRD
}

template <class T> __device__ __forceinline__ T* uptr(T* p) { const unsigned long long v = (unsigned long long)p; const unsigned lo = __builtin_amdgcn_readfirstlane((unsigned)v), hi = __builtin_amdgcn_readfirstlane((unsigned)(v >> 32)); return (T*)(((unsigned long long)hi << 32) | lo); }
template <class TIn, class TOut> struct BlockRef { const TIn* Q; const TIn* K; const TIn* V; TOut* O; float* SS; int P0; };
template <class TIn> struct Seam {
    bf16x8 qr[8];
    bf16x8 st_v0, st_v1, st_k0, st_k1; f32x4 sf0, sf1, sf2, sf3;
    f32x4 tq[16];
};
__device__ __forceinline__ int swa_jlo(int P0, int W) { const int lowk = P0 - W + 1; return lowk > 0 ? lowk / KVBLK : 0; }
#define ROW(p, k0, rr) ((decltype(p))((const char*)(p) + (unsigned)(((k0) + (rr)) * D + sc) * (unsigned)sizeof(*(p))))
#define VMW() asm volatile("s_waitcnt vmcnt(0)" ::: "memory")
#define VMWN(n) asm volatile("s_waitcnt vmcnt(%0)" :: "i"(n) : "memory")
#define SLOAD_H(Kp, Vp, k0) do { S.st_v0 = load8<TIn>(ROW(Vp, k0, sr)); S.st_v1 = load8<TIn>(ROW(Vp, k0, 32 + sr));              \
                         S.st_k0 = load8<TIn>(ROW(Kp, k0, sr)); S.st_k1 = load8<TIn>(ROW(Kp, k0, 32 + sr)); } while (0)
#define SWRITE_HK(bf) do { *(bf16x8*)(K_lds + (bf) * SHM_K + kws) = S.st_k0; *(bf16x8*)(K_lds + (bf) * SHM_K + kws + 32 * 256) = S.st_k1; } while (0)
#define SWRITE_HV(bf) do { *(bf16x8*)(V_lds + (bf) * SHM_V + vst0) = S.st_v0; *(bf16x8*)(V_lds + (bf) * SHM_V + vst1) = S.st_v1; } while (0)
#define SWRITE_H(bf) do { SWRITE_HV(bf); SWRITE_HK(bf); } while (0)
#define SLOAD_F(p, k0) do { S.sf0 = *(const f32x4*)ROW(p, k0, sr); S.sf1 = *(const f32x4*)(ROW(p, k0, sr) + 4);                \
                            S.sf2 = *(const f32x4*)ROW(p, k0, 32 + sr); S.sf3 = *(const f32x4*)(ROW(p, k0, 32 + sr) + 4); } while (0)
#define SWRITE_KF(bf) do { *(bf16x8*)(K_lds + (bf) * SHM_K + kws) = pack8(S.sf0, S.sf1); *(bf16x8*)(K_lds + (bf) * SHM_K + kws + 32 * 256) = pack8(S.sf2, S.sf3); } while (0)
#define SWRITE_VF(bf) do { *(bf16x8*)(V_lds + (bf) * SHM_V + vst0) = pack8(S.sf0, S.sf1); *(bf16x8*)(V_lds + (bf) * SHM_V + vst1) = pack8(S.sf2, S.sf3); } while (0)
template <class TIn, class TOut>
__device__ __forceinline__ void causal_swa_prime(const BlockRef<TIn, TOut>& cur_, int W, char* lds, Seam<TIn>& S) {
    BlockRef<TIn, TOut> cur; cur.Q = uptr(cur_.Q); cur.K = uptr(cur_.K); cur.V = uptr(cur_.V); cur.O = nullptr; cur.SS = nullptr; cur.P0 = __builtin_amdgcn_readfirstlane(cur_.P0);
    constexpr bool F32 = same_t<TIn, float>::v;
    int tid_ = my_tid();
    const int tid = tid_, wid = __builtin_amdgcn_readfirstlane(tid >> 6), lane = tid & 63, r32 = lane & 31, hi = lane >> 5;
    const int sr = tid >> 4, sc = (tid & 15) * 8, kws = KSWZ(sr, sc * 2); char* K_lds = lds + 2 * SHM_V;
    const int kb0 = swa_jlo(cur.P0, W) * KVBLK;
    for (int d0 = 0; d0 < 8; ++d0) S.qr[d0] = load8<TIn>((const TIn*)((const char*)cur.Q + (unsigned)((wid * QBLK + r32) * D + d0 * 16 + hi * 8) * (unsigned)sizeof(TIn)));
    if constexpr (F32) { SLOAD_F((const float*)cur.K, kb0); VMW(); SWRITE_KF(0); SBAR(); SLOAD_F((const float*)cur.V, kb0); }
    else { SLOAD_H(cur.K, cur.V, kb0); VMW(); SWRITE_HK(0); }
    __syncthreads();
}
template <class TIn, class TOut, int ost, bool HAS_SS>
__device__ __forceinline__ void causal_swa_block(const BlockRef<TIn, TOut>& cur_, const BlockRef<TIn, TOut>& nxt_, int skv, int W, char* lds, Seam<TIn>& S, int cbl  ) {
    constexpr bool F32 = same_t<TIn, float>::v;
    BlockRef<TIn, TOut> cur, nxt; cur.Q = uptr(cur_.Q); cur.K = uptr(cur_.K); cur.V = uptr(cur_.V); cur.O = uptr(cur_.O); cur.SS = uptr(cur_.SS); cur.P0 = __builtin_amdgcn_readfirstlane(cur_.P0);
    nxt.Q = uptr(nxt_.Q); nxt.K = uptr(nxt_.K); nxt.V = uptr(nxt_.V); nxt.O = nullptr; nxt.SS = nullptr; nxt.P0 = __builtin_amdgcn_readfirstlane(nxt_.P0);
    int tid_ = my_tid();
    const int tid = tid_, wid = __builtin_amdgcn_readfirstlane(tid >> 6), lane = tid & 63, r32 = lane & 31, hi = lane >> 5;
    const int j_lo = swa_jlo(cur.P0, W);
    int j_hi = (cur.P0 + QB - 1) / KVBLK + 1; if (j_hi > skv / KVBLK) j_hi = skv / KVBLK;
    const int NT = j_hi - j_lo;
    const int kbn = swa_jlo(nxt.P0, W) * KVBLK;
    const int qlo = cur.P0 + wid * QBLK, qm = qlo + r32 - 4 * hi;
    char* V_lds = lds; char* K_lds = lds + 2 * SHM_V;
    float* ws = (float*)(lds + 2 * SHM_V + 2 * SHM_K) + wid * 64; float* li_l = ws, * al_l = ws + 32;
    float m_reg = -1e30f, l_reg = 0; f32x16 o[4] = {};
    const int sr = tid >> 4, sc = (tid & 15) * 8, vst0 = v_st(sr, sc), vst1 = v_st(32 + sr, sc), kws = KSWZ(sr, sc * 2);
    const int vb0 = (int)(uintptr_t)V_lds + v_rd_base(lane);
    const TIn* Kh = cur.K; const TIn* Vh = cur.V;
#define RESC(a) do { if (__any((a) < 1.f)) { if (hi == 0) al_l[r32] = (a); asm volatile("s_waitcnt lgkmcnt(0)" ::: "memory");              \
                     for (int d_ = 0; d_ < 4; ++d_) for (int r = 0; r < 16; ++r) o[d_][r] *= al_l[crow(r, hi)]; } } while (0)
#define KBASE(t) ((j_lo + (t)) * KVBLK)
#define CBT(t) (cbl >= 0 ? cbl + KBASE(t) * 4 : -1)
#define ACT(t) (KBASE(t) <= qlo + QBLK - 1 && KBASE(t) + KVBLK - 1 >= qlo - W + 1)
#define MASKT(P0_, P1_, t) do { const int kb_ = KBASE(t); if ((!SK || ACT(t)) && (kb_ + KVBLK - 1 > qlo || kb_ <= qlo + QBLK - 1 - W)) mask_tile(P0_, P1_, qm - kb_, (unsigned)W); } while (0)
    constexpr int NQL = F32 ? 16 : 8;
    constexpr bool SK = WSKIP && !F32;
#define SEAM_K0() do { VMWN(NQL); if constexpr (F32) { SWRITE_KF(0); SBAR(); SLOAD_F((const float*)nxt.V, kbn); } else { SWRITE_HK(0); } SBAR(); } while (0)
    f32x16 pA0, pA1, pB0, pB1; float mnA, mnB, alA, alB; bf16x8 pa0, pa1, pa2, pa3;
    if constexpr (F32) { VMW(); SWRITE_VF(0); SBAR(); } else { SWRITE_HV(0); SBAR(); }
    if (NT > 1) { if constexpr (F32) SLOAD_F((const float*)Kh, KBASE(1)); else SLOAD_H(Kh, Vh, KBASE(1)); }
    SBAR(); qkt<0, SK>(pA0, pA1, K_lds, r32, hi, S.qr, ACT(0), CBT(0));
    if constexpr (F32) { if (NT > 1) { VMW(); SWRITE_KF(1); SBAR(); SLOAD_F((const float*)Vh, KBASE(1)); } }
    MASKT(pA0, pA1, 0); partialSM(pA0, pA1, m_reg, mnA, alA);
    if (NT > 1) { VMW(); if constexpr (F32) { SWRITE_VF(1); SBAR(); if (NT > 2) SLOAD_F((const float*)Kh, KBASE(2)); } else SWRITE_H(1); }
    __syncthreads();
#define HALF_STEP(PX0, PX1, mnX, alX, PY0, PY1, alY, t, KB, VB, SB) do {                                                      \
        SBAR(); qkt<KB, SK>(PX0, PX1, K_lds, r32, hi, S.qr, ACT(t), CBT(t));                                             \
        finishSM(PY0, PY1, alY, l_reg, pa0, pa1, pa2, pa3); SBAR();                                                           \
        if ((t) + 1 < NT) { if constexpr (F32) { VMW(); SWRITE_KF(SB); SBAR(); SLOAD_F((const float*)Vh, KBASE((t) + 1)); }  \
                            else { SLOAD_H(Kh, Vh, KBASE((t) + 1)); } SBAR(); }                                               \
        pv_tile<VB, SK>(o, vb0, pa0, pa1, pa2, pa3, ACT((t) - 1)); MASKT(PX0, PX1, (t)); partialSM(PX0, PX1, m_reg, mnX, alX);                                        \
        __syncthreads();                                                                                                      \
        if ((t) + 1 < NT) { VMW(); if constexpr (F32) { SWRITE_VF(SB); SBAR(); if ((t) + 2 < NT) SLOAD_F((const float*)Kh, KBASE((t) + 2)); } \
                            else { SWRITE_H(SB); } }                                                                          \
        RESC(alX); __syncthreads(); } while (0)
    for (int t = 1; t + 1 < NT; t += 2) {
        HALF_STEP(pB0, pB1, mnB, alB, pA0, pA1, alA, t, 1, 0, 0);
        HALF_STEP(pA0, pA1, mnA, alA, pB0, pB1, alB, t + 1, 0, 1, 1);
    }
    const bool even = (NT & 1) == 0;
    if (even) { SBAR(); qkt<1, SK>(pB0, pB1, K_lds, r32, hi, S.qr, ACT(NT - 1), CBT(NT - 1)); SBAR(); }
#define QROW(e) (nxt.Q + (size_t)(wid * QBLK + r32) * D + ((e) >> 1) * 16 + hi * 8 + ((e) & 1) * 4)
    if constexpr (F32) { SLOAD_F((const float*)nxt.K, kbn); SBAR();
#pragma unroll
        for (int e = 0; e < 8; ++e) S.tq[e] = *(const f32x4*)QROW(e); }
    else { SLOAD_H(nxt.K, nxt.V, kbn); SBAR();
#pragma unroll
        for (int d0 = 0; d0 < 8; ++d0) S.qr[d0] = load8<TIn>((const TIn*)((const char*)nxt.Q + (unsigned)((wid * QBLK + r32) * D + d0 * 16 + hi * 8) * (unsigned)sizeof(TIn))); }
    SBAR();
    finishSM(pA0, pA1, alA, l_reg, pa0, pa1, pa2, pa3); SBAR();
    if constexpr (F32) {
#pragma unroll
        for (int e = 8; e < 16; ++e) S.tq[e] = *(const f32x4*)QROW(e); SBAR(); }
#undef QROW
    pv_tile<0, SK>(o, vb0, pa0, pa1, pa2, pa3, ACT(even ? NT - 2 : NT - 1));
    if (even) { MASKT(pB0, pB1, NT - 1); partialSM(pB0, pB1, m_reg, mnB, alB); __syncthreads(); RESC(alB);
        finishSM(pB0, pB1, alB, l_reg, pa0, pa1, pa2, pa3); SBAR(); pv_tile<1, SK>(o, vb0, pa0, pa1, pa2, pa3, ACT(NT - 1)); }
    SBAR(); SEAM_K0();
    if (hi == 0) li_l[r32] = l_reg; asm volatile("s_waitcnt lgkmcnt(0)" ::: "memory");
    float rli[16];
#pragma unroll
    for (int r = 0; r < 16; ++r) rli[r] = __builtin_amdgcn_rcpf(li_l[crow(r, hi)]);
    int r32e = r32, hie = hi; asm volatile("" : "+v"(r32e), "+v"(hie));
    char* Ob = (char*)cur.O; const unsigned ob0 = (unsigned)((wid * QBLK + 4 * hie) * ost + r32e) * 2u;
#pragma unroll
    for (int r = 0; r < 16; ++r) { const unsigned rowoff = ob0 + (unsigned)(((r & 3) + 8 * (r >> 2)) * ost * 2); float ss_ = 0.f;
#pragma unroll
        for (int d0 = 0; d0 < 4; ++d0) { const float v = o[d0][r] * rli[r]; ss_ += v * v;
            const float vn = shx<1>(v);
            if ((r32e & 1) == 0) *(unsigned*)(Ob + rowoff + d0 * 64) = cvtpk(v, vn); }
        if (HAS_SS) { ss_ += shx<1>(ss_); ss_ += shx<2>(ss_); ss_ += shx<4>(ss_); ss_ += shx<8>(ss_); ss_ += shx<16>(ss_);
            if (r32e == 0) *(float*)((char*)cur.SS + (unsigned)(wid * QBLK + 4 * hie + (r & 3) + 8 * (r >> 2)) * 32u) = ss_; }
        SBAR(); }
    if constexpr (F32) {
#pragma unroll
        for (int d0 = 0; d0 < 8; ++d0) S.qr[d0] = pack8(S.tq[2 * d0], S.tq[2 * d0 + 1]); }
    __syncthreads();
#undef RESC
#undef KBASE
#undef CBT
#undef ACT
#undef MASKT
#undef SEAM_K0
#undef HALF_STEP
}
#undef ROW
}

#define GAS __attribute__((address_space(1)))
#define LAS __attribute__((address_space(3)))
typedef unsigned short bf16;
typedef unsigned v4u __attribute__((ext_vector_type(4)));
typedef float f32x4 __attribute__((ext_vector_type(4)));
#define LDS_WAIT() asm volatile("s_waitcnt lgkmcnt(0)" ::: "memory")
#define VM_WAIT() asm volatile("s_waitcnt vmcnt(0)" ::: "memory")
__device__ __forceinline__ unsigned f2bf(float f) { unsigned u = __builtin_bit_cast(unsigned, f); return (u + 0x7fffu + ((u >> 16) & 1u)) >> 16; }
__device__ __forceinline__ unsigned pk2(float lo, float hi) { return f2bf(lo) | (f2bf(hi) << 16); }
__device__ __forceinline__ float bflo(unsigned w) { return __uint_as_float(w << 16); }
__device__ __forceinline__ float bfhi(unsigned w) { return __uint_as_float(w & 0xffff0000u); }

#ifndef LB2
#define LB2 2
#endif
#ifndef FOX_HAS_SS
#define FOX_HAS_SS false
#endif
#ifndef FOX_SS
#define FOX_SS (SSQF + ((size_t)b * SEQ + x * 256) * 8 + h)
#endif
#ifndef FOX_CB
#define FOX_CB CB_OFF
#endif
#ifndef USE_XB
#define USE_XB 1
#endif
#if USE_XB
#define GSYNC() xcd_barrier(xbar)
#else
#define GSYNC() grid.sync()
#endif
#ifndef REP
#define REP 0
#endif
#ifndef PH
#define PH 0x1ff
#endif
constexpr int NWAVES = 8, NTHR = 512;
constexpr int BATCH = 4, SEQ = 2048, DM = 2048, M = BATCH * SEQ, NMEM = 256, MMEM = BATCH * NMEM;
constexpr int FOXW = 1024, LRUW = 1024, INW = 5128, INWP = 5376, XW = 512, FFN = 5632;
constexpr float EPS = 1e-6f;
constexpr size_t MiB = 1u << 20;
constexpr size_t WS_WIN = 1 * MiB, WS_WOUT = 22 * MiB, WS_WCQ = 30 * MiB, WS_WCKV = 32 * MiB, WS_WCO = 36 * MiB, WS_WGU = 38 * MiB, WS_WDN = 82 * MiB, WS_WLRU = 104 * MiB;
constexpr size_t WS_XN = 105 * MiB, WS_MN = 137 * MiB, WS_Q = 141 * MiB, WS_K = 157 * MiB, WS_V = 173 * MiB, WS_U = 189 * MiB, WS_GG = 205 * MiB, WS_UC = 221 * MiB;
constexpr size_t WS_LF = 237 * MiB, WS_CK = 238 * MiB, WS_CV = 239 * MiB, WS_MIX = 240 * MiB, WS_SSQF = 272 * MiB, WS_SSQL = 273 * MiB, WS_X1 = 274 * MiB;
constexpr size_t WS_SSQ1 = 338 * MiB, WS_CQ = 339 * MiB, WS_SSQ2 = 347 * MiB, WS_END = 348 * MiB;
constexpr size_t WS_HL = WS_X1, WS_AC = WS_X1 + 16 * MiB, WS_ENDH = WS_SSQ2, WS_ENDA = WS_SSQ2 + 256 * 1024;
constexpr size_t WS_X1B = WS_XN  , WS_OX = WS_Q  , WS_X2B = WS_MIX  , WS_H = WS_Q  ;
constexpr int LDS_BYTES = 147456, RED_OFF = 131072, CB_OFF = 69632, WSUM_OFF = 77824;

__device__ __forceinline__ float wave_sum(float v) { v += shx<1>(v); v += shx<2>(v); v += shx<4>(v); v += shx<8>(v); v += shx<16>(v); return sum32(v); }
__device__ __forceinline__ void transpose_item(const float* W, int ldw, int k0, int srcn0, int nvalid, const float* ks, bf16* WT, int ldt, int drow0, LAS float* scr, int lane) {
    f32x4 v[8];
#pragma unroll
    for (int i = 0; i < 8; ++i) { const int kk = 8 * i + (lane >> 3), n4 = (lane & 7) * 4;
        v[i] = (n4 < nvalid) ? __builtin_nontemporal_load((const GAS f32x4*)(W + (size_t)(k0 + kk) * ldw + srcn0 + n4)) : (f32x4){0.f, 0.f, 0.f, 0.f}; }
#pragma unroll
    for (int i = 0; i < 8; ++i) { const int kk = 8 * i + (lane >> 3), n4 = (lane & 7) * 4; f32x4 x = v[i]; if (ks) x = x * ks[k0 + kk];
        LAS float* d = scr + kk * 33 + n4; d[0] = x.x; d[1] = x.y; d[2] = x.z; d[3] = x.w; }
    LDS_WAIT(); asm volatile("" ::: "memory");
    const int c = lane & 7;
#pragma unroll
    for (int j = 0; j < 4; ++j) { const int n = (lane >> 3) + 8 * j; const LAS float* s = scr + (8 * c) * 33 + n;
        v4u o; o.x = pk2(s[0 * 33], s[1 * 33]); o.y = pk2(s[2 * 33], s[3 * 33]); o.z = pk2(s[4 * 33], s[5 * 33]); o.w = pk2(s[6 * 33], s[7 * 33]);
        *(GAS v4u*)(WT + (size_t)(drow0 + n) * ldt + k0 + 8 * c) = o; }
    LDS_WAIT(); asm volatile("" ::: "memory");
}
__device__ __forceinline__ void rms_row_to_bf16(const float* xrow, const float* g, bf16* orow, int lane) {
    const GAS f32x4* xr = (const GAS f32x4*)xrow + lane; const GAS f32x4* gr = (const GAS f32x4*)g + lane;
    f32x4 v[8]; float s = 0.f;
#pragma unroll
    for (int j = 0; j < 8; ++j) { v[j] = xr[64 * j]; s += (v[j].x * v[j].x + v[j].y * v[j].y) + (v[j].z * v[j].z + v[j].w * v[j].w); }
    const float rstd = 1.0f / sqrtf(wave_sum(s) * (1.f / DM) + EPS);
    GAS unsigned long long* o8 = (GAS unsigned long long*)orow + lane;
#pragma unroll
    for (int j = 0; j < 8; ++j) { const f32x4 gg = gr[64 * j]; o8[64 * j] = (unsigned long long)pk2(v[j].x * rstd * gg.x, v[j].y * rstd * gg.y) | ((unsigned long long)pk2(v[j].z * rstd * gg.z, v[j].w * rstd * gg.w) << 32); }
}

#define XB_TMO      128
#define XB_XCNT(j)  (256  + 64 * (j))
#define XB_XSUB(j)  (1280 + 64 * (j))
#define XB_XGEN(j)  (2304 + 64 * (j))
#define XB_TOP      3328
#define XB_TOPGEN   3392
#define XCD_BAR_WORDS 3456
#define XB_SPIN_CAP (1u << 18)

__device__ __forceinline__ unsigned xb_ld(unsigned* p)              { return __hip_atomic_load(p, __ATOMIC_RELAXED, __HIP_MEMORY_SCOPE_AGENT); }
__device__ __forceinline__ unsigned xb_add(unsigned* p, unsigned v) { return __hip_atomic_fetch_add(p, v, __ATOMIC_RELAXED, __HIP_MEMORY_SCOPE_AGENT); }
__device__ __forceinline__ unsigned xb_xcc_id() { return (unsigned)__builtin_amdgcn_s_getreg((3 << 11) | 20) & 0xFu; }
#define XB_SPIN(cond, bar) do { unsigned _sp = 0; while (cond) { __builtin_amdgcn_s_sleep(1); \
    if ((++_sp & 255u) == 0u) { if (xb_ld(&(bar)[XB_TMO])) break; if (_sp > XB_SPIN_CAP) { atomicAdd(&(bar)[XB_TMO], 1u); break; } } } } while (0)

struct XcdBarrier {
    unsigned* bar; unsigned x;
    volatile LAS unsigned* st;
};

__device__ __forceinline__ XcdBarrier xcd_barrier_post(unsigned* bar, volatile LAS unsigned* st) {
    XcdBarrier b; b.bar = bar; b.x = xb_xcc_id(); b.st = st;
    if (my_tid() == 0) (void)xb_add(&bar[XB_XCNT(b.x)], 1u);
    return b;
}
__device__ __forceinline__ void xcd_barrier_complete(unsigned* bar, unsigned x, unsigned& nloc, unsigned& nx) {
    const unsigned G = gridDim.x * gridDim.y * gridDim.z;
    unsigned sum, cnt, mine, sp = 0u;
    for (;;) {
        sum = 0u; cnt = 0u; mine = 0u;
#pragma unroll
        for (unsigned j = 0; j < 16; ++j) { const unsigned c = xb_ld(&bar[XB_XCNT(j)]); sum += c; cnt += (c > 0u) ? 1u : 0u; mine = (j == x) ? c : mine; }
        if (sum == G) break;
        __builtin_amdgcn_s_sleep(1);
        if ((++sp & 255u) == 0u) { if (xb_ld(&bar[XB_TMO])) break; if (sp > XB_SPIN_CAP) { atomicAdd(&bar[XB_TMO], 1u); break; } }
    }
    nloc = mine > 0u ? mine : 1u; nx = cnt > 0u ? cnt : 1u;
}

__device__ __forceinline__ void xcd_barrier(const XcdBarrier& b) {
    asm volatile("s_waitcnt vmcnt(0)" ::: "memory");
    __syncthreads();
    if (my_tid() == 0) {
        unsigned* bar = b.bar;
        __builtin_amdgcn_s_waitcnt(0);
        unsigned nloc = b.st[0], nx = b.st[1];
        if (nloc == 0u) { xcd_barrier_complete(bar, b.x, nloc, nx); b.st[0] = nloc; b.st[1] = nx; }
        const unsigned old = xb_add(&bar[XB_XSUB(b.x)], 1u);
        const unsigned gen = old / nloc;
        if (old + 1u == (gen + 1u) * nloc) {
            __builtin_amdgcn_fence(__ATOMIC_RELEASE, "agent");
            asm volatile("s_waitcnt vmcnt(0)" ::: "memory");
            const unsigned og = xb_add(&bar[XB_TOP], 1u);
            const unsigned tg = og / nx;
            if (og + 1u == (tg + 1u) * nx) xb_add(&bar[XB_TOPGEN], 1u);
            else XB_SPIN(xb_ld(&bar[XB_TOPGEN]) == tg, bar);
            __builtin_amdgcn_fence(__ATOMIC_ACQUIRE, "agent");
            xb_add(&bar[XB_XGEN(b.x)], 1u);
            asm volatile("s_waitcnt vmcnt(0)" ::: "memory");
        } else {
            XB_SPIN(xb_ld(&bar[XB_XGEN(b.x)]) == gen, bar);
            __builtin_amdgcn_fence(__ATOMIC_ACQUIRE, "agent");
            asm volatile("s_waitcnt vmcnt(0)" ::: "memory");
        }
    }
    __syncthreads();
}

struct Args { const float* in[27]; float* out; unsigned char* ws; };
enum { I_X = 0, I_MEM, I_GMIX, I_WIN, I_BF, I_GQ, I_GK, I_CONVW, I_CONVB, I_WRA, I_BRA, I_WRI, I_BRI, I_LAM, I_GFOX, I_GLRU, I_WOUT, I_GXATTN, I_GMEM, I_WCQ, I_WCKV, I_GCQ, I_GCK, I_WCO, I_GFFN, I_WGU, I_WDN };

constexpr int KB_D = DM / 64;
constexpr int I0 = (INWP / 32) * KB_D, I3 = (2 * XW / 32) * KB_D, I7 = 16 * 4 * 2, N_EARLY = I0 + I3 + I7;
constexpr int I1 = (DM / 32) * KB_D, I2 = (XW / 32) * KB_D, I4 = (DM / 32) * (XW / 64), I5 = (2 * FFN / 32) * KB_D, I6 = (DM / 32) * (FFN / 64), N_LATE = I1 + I2 + I4 + I5 + I6;
constexpr int N_LATE_P1 = I1 + I2 + I4 + 2560;
constexpr int N_LATE_P2 = N_LATE_P1 + 2440;
__device__ __forceinline__ void early_item(const Args& a, int r, LAS float* scr, int lane) {
    unsigned char* ws = a.ws;
    if (r < I0) { const int rg = r / KB_D, kb = r % KB_D, d = rg * 32; int src = d, nv = 32;
        if (d >= 3072 && d < 5120) src = d + 8; else if (d == 5120) { src = 3072; nv = 8; } else if (d > 5120) { src = 0; nv = 0; }
        transpose_item(a.in[I_WIN], INW, kb * 64, src, nv, nullptr, (bf16*)(ws + WS_WIN), DM, d, scr, lane); return; } r -= I0;
    if (r < I3) { const int rg = r / KB_D, kb = r % KB_D;
        transpose_item(a.in[I_WCKV], 2 * XW, kb * 64, rg * 32, 32, nullptr, (bf16*)(ws + WS_WCKV), DM, rg * 32, scr, lane); return; } r -= I3;
    { const int mtx = r >> 3, sub = r & 7, rg = sub >> 1, kb = sub & 1, n = mtx >> 1, which = mtx & 1;
        transpose_item((which ? a.in[I_WRI] : a.in[I_WRA]) + (size_t)n * 128 * 128, 128, kb * 64, rg * 32, 32, nullptr, (bf16*)(ws + WS_WLRU) + (size_t)(n * 256 + which * 128) * 128, 128, rg * 32, scr, lane); }
}
__device__ __forceinline__ void late_item(const Args& a, int r, LAS float* scr, int lane) {
    unsigned char* ws = a.ws;
    if (r < I1) { const int rg = r / KB_D, kb = r % KB_D; const float* ks = kb < 16 ? a.in[I_GFOX] : a.in[I_GLRU] - 1024;
        transpose_item(a.in[I_WOUT], DM, kb * 64, rg * 32, 32, ks, (bf16*)(ws + WS_WOUT), DM, rg * 32, scr, lane); return; } r -= I1;
    if (r < I2) { const int rg = r / KB_D, kb = r % KB_D;
        transpose_item(a.in[I_WCQ], XW, kb * 64, rg * 32, 32, a.in[I_GXATTN], (bf16*)(ws + WS_WCQ), DM, rg * 32, scr, lane); return; } r -= I2;
    if (r < I4) { const int rg = r / (XW / 64), kb = r % (XW / 64);
        transpose_item(a.in[I_WCO], DM, kb * 64, rg * 32, 32, nullptr, (bf16*)(ws + WS_WCO), XW, rg * 32, scr, lane); return; } r -= I4;
    if (r < I5) { const int rg = r / KB_D, kb = r % KB_D, d = rg * 32, tile = d >> 8, w = d & 255; const int src = w < 128 ? tile * 128 + w : FFN + tile * 128 + (w - 128);
        transpose_item(a.in[I_WGU], 2 * FFN, kb * 64, src, 32, a.in[I_GFFN], (bf16*)(ws + WS_WGU), DM, d, scr, lane); return; } r -= I5;
    { const int rg = r / (FFN / 64), kb = r % (FFN / 64);
        transpose_item(a.in[I_WDN], DM, kb * 64, rg * 32, 32, nullptr, (bf16*)(ws + WS_WDN), FFN, rg * 32, scr, lane); }
}
__device__ __forceinline__ void late_range(const Args& a, LAS unsigned char* lds, int lo, int hi, int w, int nw, int wave, int lane) {
    LAS float* scr = (LAS float*)(lds + wave * 16384);
    for (int it = lo + w; it < hi; it += nw) late_item(a, it, scr, lane);
}
__device__ __forceinline__ void p0_prologue(const Args& a, LAS unsigned char* lds, int wave, int lane, int G) {
    unsigned char* ws = a.ws;
    LAS float* scr = (LAS float*)(lds + wave * 16384);
    const int gw = blockIdx.x * NWAVES + wave, NGW = G * NWAVES;
    for (int it = gw; it < N_EARLY; it += NGW) early_item(a, it, scr, lane);
    if (G != 256) for (int it = gw; it < N_LATE; it += NGW) late_item(a, it, scr, lane);
    for (int m = gw; m < M + MMEM; m += NGW) {
        if (m < M) rms_row_to_bf16(a.in[I_X] + (size_t)m * DM, a.in[I_GMIX], (bf16*)(ws + WS_XN) + (size_t)m * DM, lane);
        else rms_row_to_bf16(a.in[I_MEM] + (size_t)(m - M) * DM, a.in[I_GMEM], (bf16*)(ws + WS_MN) + (size_t)(m - M) * DM, lane);
    }
}

__device__ __forceinline__ void conv_chunk(const bf16* U, bf16* UC, const float* cw, const float* cbias, int row0, int s0, int nblk, int tid) {
    asm volatile("" : "+v"(tid));
    const int c8 = nblk * 128 + (tid & 15) * 8;
    f32x4 w[4][2], bb[2];
#pragma unroll
    for (int j = 0; j < 4; ++j) { w[j][0] = *(const f32x4*)(cw + j * LRUW + c8); w[j][1] = *(const f32x4*)(cw + j * LRUW + c8 + 4); }
    bb[0] = *(const f32x4*)(cbias + c8); bb[1] = *(const f32x4*)(cbias + c8 + 4);
#pragma unroll 2
    for (int p = 0; p < 8; ++p) { const int rl = p * 32 + (tid >> 4), s = s0 + rl; const unsigned grow = (unsigned)(row0 + rl);
        f32x4 a0 = bb[0], a1 = bb[1];
#pragma unroll
        for (int j = 0; j < 4; ++j) { if (s - 3 + j >= 0) { const v4u uw = *(const v4u*)((const char*)U + ((grow - 3 + j) * LRUW + c8) * 2u);
            a0 += w[j][0] * (f32x4){bflo(uw.x), bfhi(uw.x), bflo(uw.y), bfhi(uw.y)}; a1 += w[j][1] * (f32x4){bflo(uw.z), bfhi(uw.z), bflo(uw.w), bfhi(uw.w)}; } }
        v4u o; o.x = pk2(a0.x, a0.y); o.y = pk2(a0.z, a0.w); o.z = pk2(a1.x, a1.y); o.w = pk2(a1.z, a1.w);
        *(v4u*)((char*)UC + (grow * LRUW + c8) * 2u) = o; }
}

__global__ void __launch_bounds__(NTHR, LB2) hymba_fwd(Args a) {
    extern __shared__ __attribute__((aligned(16))) unsigned char lds_raw[];
    cg::grid_group grid = cg::this_grid();
    LAS unsigned char* lds = (LAS unsigned char*)lds_raw;
    { const int t0 = threadIdx.x; if ((t0 & 63) == 0) *(volatile LAS int*)(lds + WTAB_OFF + hw_slot() * 4) = t0 >> 6;
      if (t0 < 2) *(volatile LAS unsigned*)(lds + XBST_OFF + t0 * 4) = 0u; }
    __syncthreads();
    const XcdBarrier xbar = xcd_barrier_post((unsigned*)a.ws, (volatile LAS unsigned*)(lds + XBST_OFF));
    const int G = gridDim.x, c = blockIdx.x;
#define WIN ((bf16*)(a.ws + WS_WIN))
#define WOUT ((bf16*)(a.ws + WS_WOUT))
#define WCQ ((bf16*)(a.ws + WS_WCQ))
#define WCKV ((bf16*)(a.ws + WS_WCKV))
#define WCO ((bf16*)(a.ws + WS_WCO))
#define WGU ((bf16*)(a.ws + WS_WGU))
#define WDN ((bf16*)(a.ws + WS_WDN))
#define WLRU ((bf16*)(a.ws + WS_WLRU))
#define XN ((bf16*)(a.ws + WS_XN))
#define MN ((bf16*)(a.ws + WS_MN))
#define Qh ((bf16*)(a.ws + WS_Q))
#define Kh ((bf16*)(a.ws + WS_K))
#define Vh ((bf16*)(a.ws + WS_V))
#define U ((bf16*)(a.ws + WS_U))
#define GG ((bf16*)(a.ws + WS_GG))
#define UC ((bf16*)(a.ws + WS_UC))
#define LF ((float*)(a.ws + WS_LF))
#define CK ((bf16*)(a.ws + WS_CK))
#define CV ((bf16*)(a.ws + WS_CV))
#define MIX ((bf16*)(a.ws + WS_MIX))
#define SSQF ((float*)(a.ws + WS_SSQF))
#define SSQL ((float*)(a.ws + WS_SSQL))
#define X1 ((float*)(a.ws + WS_X1))
#define X1B ((bf16*)(a.ws + WS_X1B))
#define SSQ1 ((float*)(a.ws + WS_SSQ1))
#define CQ ((bf16*)(a.ws + WS_CQ))
#define OX ((bf16*)(a.ws + WS_OX))
#define X2B ((bf16*)(a.ws + WS_X2B))
#define SSQ2 ((float*)(a.ws + WS_SSQ2))
#define H ((bf16*)(a.ws + WS_H))
#define HL ((bf16*)(a.ws + WS_HL))
#define AC ((bf16*)(a.ws + WS_AC))
#define ENDH ((float*)(a.ws + WS_ENDH))
#define ENDA ((float*)(a.ws + WS_ENDA))
#define red ((PG8_LAS float*)(lds + RED_OFF))

    for (int rep = 0; rep < 1 + ((REP >> 0) & 1); ++rep) {
    if (PH & 1) { int tid = my_tid(); p0_prologue(a, lds, __builtin_amdgcn_readfirstlane(tid >> 6), tid & 63, G); }
    GSYNC();
    if (a.ws == nullptr) grid.sync();
    }

    for (int rep = 0; rep < 1 + ((REP >> 1) & 1); ++rep) {
    if (PH & 2) {
        pg8::Gemm g{XN, WIN, M, INWP, DM, DM, DM}; pg8::StaticOrder S; S.init(M, INWP, G, c);
        pg8::EpiIn E{0, Qh, Kh, Vh, U, GG, LF, a.in[I_GQ], a.in[I_GK], a.in[I_BF], red};
        pg8::gemm_phase<pg8::EpiIn, pg8::StaticOrder, true, true>(lds, g, S, E);
        pg8::Gemm g2{MN, WCKV, MMEM, 2 * XW, DM, DM, DM}; pg8::StaticOrder S2; S2.init(MMEM, 2 * XW, G, (c + 16) % G);
        pg8::EpiCkv E2{0, CK, CV, a.in[I_GCK], red};
        pg8::gemm_phase<pg8::EpiCkv, pg8::StaticOrder, true, true>(lds, g2, S2, E2);
        if (G == 256 && c >= 160 && c < 240) { const int t2 = my_tid(); late_range(a, lds, 0, N_LATE_P1, (c - 160) * NWAVES + (t2 >> 6), 80 * NWAVES, __builtin_amdgcn_readfirstlane(t2 >> 6), t2 & 63); }
    }
    GSYNC();
    }

    for (int rep = 0; rep < 1 + ((REP >> 2) & 1); ++rep) {
    if (PH & 4) { int cL = c, tid = my_tid(); asm volatile("" : "+s"(cL));
      const int nl = G > 128 ? G - 128 : G;
      if (G <= 128 || cL >= 128)
      for (int L = (G > 128 ? cL - 128 : cL); L < 256; L += nl) {
            const int pm = L >> 3, nblk = L & 7, row0 = pm * 256;
            conv_chunk(U, UC, a.in[I_CONVW], a.in[I_CONVB], row0, (pm & 7) * 256, nblk, tid);
            VM_WAIT(); __syncthreads(); __builtin_amdgcn_fence(__ATOMIC_ACQUIRE, "agent");
            pg8::Gemm g{UC + (size_t)row0 * LRUW + nblk * 128, WLRU + (size_t)nblk * 256 * 128, 256, 256, 128, LRUW, 128}; pg8::OneUnit S;
            pg8::EpiLru E{0, UC, HL, AC, ENDH + pm * 1024, ENDA + pm * 1024, a.in[I_BRA], a.in[I_BRI], a.in[I_LAM], row0, nblk};
            pg8::gemm_phase<pg8::EpiLru, pg8::OneUnit, false, true>(lds, g, S, E);
      }
      if (G == 256 && cL >= 128) {
        VM_WAIT(); __syncthreads();
        if (my_tid() == 0) { unsigned* cnt = (unsigned*)(a.ws + 15360);
            __builtin_amdgcn_fence(__ATOMIC_RELEASE, "agent"); asm volatile("s_waitcnt vmcnt(0)" ::: "memory");
            (void)__hip_atomic_fetch_add(cnt, 1u, __ATOMIC_RELAXED, __HIP_MEMORY_SCOPE_AGENT);
            unsigned sp = 0; while (__hip_atomic_load(cnt, __ATOMIC_RELAXED, __HIP_MEMORY_SCOPE_AGENT) < 128u && ++sp < (1u << 22)) __builtin_amdgcn_s_sleep(1);
            __builtin_amdgcn_fence(__ATOMIC_ACQUIRE, "agent"); asm volatile("s_waitcnt vmcnt(0)" ::: "memory"); }
        __syncthreads();
#define P2B_FIRST (cL - 128)
#define P2B_STRIDE 128
    { int tid = my_tid();
      for (int L = P2B_FIRST; L < 256; L += P2B_STRIDE) { const int pm = L >> 3, nblk = L & 7, j = pm & 7, c8 = nblk * 128 + (tid & 15) * 8;
        f32x4 hi0 = {0.f, 0.f, 0.f, 0.f}, hi1 = {0.f, 0.f, 0.f, 0.f};
        for (int i = 0; i < j; ++i) { const float* eh = ENDH + (pm - j + i) * 1024 + c8; const float* ea = ENDA + (pm - j + i) * 1024 + c8;
            hi0 = *(const f32x4*)ea * hi0 + *(const f32x4*)eh; hi1 = *(const f32x4*)(ea + 4) * hi1 + *(const f32x4*)(eh + 4); }
#pragma unroll 2
        for (int p = 0; p < 8; ++p) { const unsigned row = (unsigned)(pm * 256 + p * 32 + (tid >> 4)), o = (row * 1024u + c8) * 2u;
            const v4u hw = __builtin_nontemporal_load((const v4u*)((const char*)HL + o)), aw = __builtin_nontemporal_load((const v4u*)((const char*)AC + o)), gw = __builtin_nontemporal_load((const v4u*)((const char*)GG + o));
            const f32x4 y0 = ((f32x4){bflo(hw.x), bfhi(hw.x), bflo(hw.y), bfhi(hw.y)} + (f32x4){bflo(aw.x), bfhi(aw.x), bflo(aw.y), bfhi(aw.y)} * hi0) * (f32x4){bflo(gw.x), bfhi(gw.x), bflo(gw.y), bfhi(gw.y)};
            const f32x4 y1 = ((f32x4){bflo(hw.z), bfhi(hw.z), bflo(hw.w), bfhi(hw.w)} + (f32x4){bflo(aw.z), bfhi(aw.z), bflo(aw.w), bfhi(aw.w)} * hi1) * (f32x4){bflo(gw.z), bfhi(gw.z), bflo(gw.w), bfhi(gw.w)};
            float ss = (y0.x * y0.x + y0.y * y0.y) + (y0.z * y0.z + y0.w * y0.w) + (y1.x * y1.x + y1.y * y1.y) + (y1.z * y1.z + y1.w * y1.w);
            v4u ow; ow.x = pk2(y0.x, y0.y); ow.y = pk2(y0.z, y0.w); ow.z = pk2(y1.x, y1.y); ow.w = pk2(y1.z, y1.w);
            *(v4u*)((char*)MIX + ((size_t)row * 2048 + 1024 + c8) * 2) = ow;
            ss += shx<1>(ss); ss += shx<2>(ss); ss += shx<4>(ss); ss += shx<8>(ss);
            if ((tid & 15) == 0) SSQL[row * 8 + nblk] = ss; } } }
#undef P2B_FIRST
#undef P2B_STRIDE
        { const int t2 = my_tid(); late_range(a, lds, N_LATE_P1, N_LATE_P2, (cL - 128) * NWAVES + (t2 >> 6), 128 * NWAVES, __builtin_amdgcn_readfirstlane(t2 >> 6), t2 & 63); } } }
    if (PH & 4) { int cF = c, tid = my_tid(); asm volatile("" : "+s"(cF)); const int lane = tid & 63, wave = __builtin_amdgcn_readfirstlane(tid >> 6);
      for (int L = cF; L < 128; L += G) {
        {
#if !defined(NO_FOX)
            const int it = L, bh = it >> 2, x = it & 3, b = bh >> 3, h = bh & 7;
            LAS float* cbl = (LAS float*)(lds + CB_OFF); LAS float* wsum = (LAS float*)(lds + WSUM_OFF);
            { const float* lf = LF + ((size_t)b * SEQ + tid * 4) * 8 + h;
              const float v0 = lf[0], v1 = lf[8], v2 = lf[16], v3 = lf[24]; const float t0 = v0, t1 = t0 + v1, t2 = t1 + v2, t3 = t2 + v3;
              wsum[tid] = t3; __syncthreads();
              for (int o = 1; o < 512; o <<= 1) { const float v = wsum[tid] + (tid >= o ? wsum[tid - o] : 0.f); __syncthreads(); wsum[tid] = v; __syncthreads(); }
              const float off = wsum[tid] - t3;
              const float ns = -1.0f / att::SCALE;
              *(LAS f32x4*)(cbl + tid * 4) = (f32x4){(off + t0) * ns, (off + t1) * ns, (off + t2) * ns, (off + t3) * ns};
              __syncthreads(); }
            typedef att::BlockRef<att::bf16, att::bf16> BR;
            BR cur, nxt;
            { const size_t hrow = (size_t)bh * SEQ;
              cur.Q = (const att::bf16*)Qh + (hrow + x * 256) * 128; cur.K = (const att::bf16*)Kh + hrow * 128; cur.V = (const att::bf16*)Vh + hrow * 128;
              cur.O = (att::bf16*)MIX + ((size_t)b * SEQ + x * 256) * 2048 + h * 128; cur.SS = FOX_SS; cur.P0 = x * 256;
              nxt = cur; const int d = (7 - 2 * x) * 256;
              nxt.Q += (size_t)d * 128; nxt.O += (size_t)d * 2048; nxt.SS += (size_t)d * 8; nxt.P0 += d; }
            att::Seam<att::bf16> S;
            att::causal_swa_prime<att::bf16, att::bf16>(cur, 1 << 20, (char*)lds_raw, S);
            for (int p = 0; p < 2; ++p) {
                att::causal_swa_block<att::bf16, att::bf16, 2048, FOX_HAS_SS>(cur, nxt, SEQ, 1 << 20, (char*)lds_raw, S, FOX_CB);
                cur = nxt; }
            VM_WAIT(); __syncthreads(); __builtin_amdgcn_fence(__ATOMIC_ACQUIRE, "agent");
            for (int p = 0; p < 16; ++p) { const int qb = (p < 8) ? x : 7 - x, rl = (p & 7) * 32 + (tid >> 4); const size_t trow = (size_t)b * SEQ + qb * 256 + rl;
                const v4u w = *(const v4u*)(MIX + trow * 2048 + h * 128 + (tid & 15) * 8);
                float ss = (bflo(w.x) * bflo(w.x) + bfhi(w.x) * bfhi(w.x)) + (bflo(w.y) * bflo(w.y) + bfhi(w.y) * bfhi(w.y)) + (bflo(w.z) * bflo(w.z) + bfhi(w.z) * bfhi(w.z)) + (bflo(w.w) * bflo(w.w) + bfhi(w.w) * bfhi(w.w));
                ss += shx<1>(ss); ss += shx<2>(ss); ss += shx<4>(ss); ss += shx<8>(ss);
                if ((tid & 15) == 0) SSQF[trow * 8 + h] = ss; }
            VM_WAIT(); __syncthreads();
#endif
        }
    } }
    GSYNC();
    }

    if (G != 256) {
#define P2B_FIRST c
#define P2B_STRIDE G
    { int tid = my_tid();
      for (int L = P2B_FIRST; L < 256; L += P2B_STRIDE) { const int pm = L >> 3, nblk = L & 7, j = pm & 7, c8 = nblk * 128 + (tid & 15) * 8;
        f32x4 hi0 = {0.f, 0.f, 0.f, 0.f}, hi1 = {0.f, 0.f, 0.f, 0.f};
        for (int i = 0; i < j; ++i) { const float* eh = ENDH + (pm - j + i) * 1024 + c8; const float* ea = ENDA + (pm - j + i) * 1024 + c8;
            hi0 = *(const f32x4*)ea * hi0 + *(const f32x4*)eh; hi1 = *(const f32x4*)(ea + 4) * hi1 + *(const f32x4*)(eh + 4); }
#pragma unroll 2
        for (int p = 0; p < 8; ++p) { const unsigned row = (unsigned)(pm * 256 + p * 32 + (tid >> 4)), o = (row * 1024u + c8) * 2u;
            const v4u hw = __builtin_nontemporal_load((const v4u*)((const char*)HL + o)), aw = __builtin_nontemporal_load((const v4u*)((const char*)AC + o)), gw = __builtin_nontemporal_load((const v4u*)((const char*)GG + o));
            const f32x4 y0 = ((f32x4){bflo(hw.x), bfhi(hw.x), bflo(hw.y), bfhi(hw.y)} + (f32x4){bflo(aw.x), bfhi(aw.x), bflo(aw.y), bfhi(aw.y)} * hi0) * (f32x4){bflo(gw.x), bfhi(gw.x), bflo(gw.y), bfhi(gw.y)};
            const f32x4 y1 = ((f32x4){bflo(hw.z), bfhi(hw.z), bflo(hw.w), bfhi(hw.w)} + (f32x4){bflo(aw.z), bfhi(aw.z), bflo(aw.w), bfhi(aw.w)} * hi1) * (f32x4){bflo(gw.z), bfhi(gw.z), bflo(gw.w), bfhi(gw.w)};
            float ss = (y0.x * y0.x + y0.y * y0.y) + (y0.z * y0.z + y0.w * y0.w) + (y1.x * y1.x + y1.y * y1.y) + (y1.z * y1.z + y1.w * y1.w);
            v4u ow; ow.x = pk2(y0.x, y0.y); ow.y = pk2(y0.z, y0.w); ow.z = pk2(y1.x, y1.y); ow.w = pk2(y1.z, y1.w);
            *(v4u*)((char*)MIX + ((size_t)row * 2048 + 1024 + c8) * 2) = ow;
            ss += shx<1>(ss); ss += shx<2>(ss); ss += shx<4>(ss); ss += shx<8>(ss);
            if ((tid & 15) == 0) SSQL[row * 8 + nblk] = ss; } } }
#undef P2B_FIRST
#undef P2B_STRIDE
    GSYNC(); }

    for (int rep = 0; rep < 1 + ((REP >> 3) & 1); ++rep) {
    if (PH & 8) {
        pg8::Gemm g{MIX, WOUT, M, DM, DM, DM, DM}; pg8::StaticOrder S; S.init(M, DM, G, c);
        pg8::EpiRes<true> E{16, a.in[I_X], nullptr, nullptr, X1B, SSQ1, SSQF, SSQL};
        pg8::gemm_phase<pg8::EpiRes<true>, pg8::StaticOrder, true, true>(lds, g, S, E);
    }
    GSYNC();
    }

    for (int rep = 0; rep < 1 + ((REP >> 4) & 1); ++rep) {
    if (PH & 16) {
        pg8::Gemm g{X1B, WCQ, M, XW, DM, DM, DM}; pg8::StaticOrder S; S.init(M, XW, G, c);
        pg8::EpiCq E{0, CQ, a.in[I_GCQ], SSQ1, red};
        pg8::gemm_phase<pg8::EpiCq, pg8::StaticOrder, true, true>(lds, g, S, E);
        if (G == 256 && c >= 64) { const int t2 = my_tid(); late_range(a, lds, N_LATE_P2, N_LATE, (c - 64) * NWAVES + (t2 >> 6), 192 * NWAVES, __builtin_amdgcn_readfirstlane(t2 >> 6), t2 & 63); }
    }
    GSYNC();
    }

    for (int rep = 0; rep < 1 + ((REP >> 5) & 1); ++rep) {
    if (PH & 32) for (int L = c; L < 128; L += G) {
        const int bh = L >> 3, qb = L & 7, b = bh >> 2, h = bh & 3;
        att::BlockRef<att::bf16, att::bf16> r;
        r.Q = (const att::bf16*)CQ + ((size_t)bh * SEQ + qb * 256) * 128; r.K = (const att::bf16*)CK + (size_t)bh * NMEM * 128; r.V = (const att::bf16*)CV + (size_t)bh * NMEM * 128;
        r.O = (att::bf16*)OX + ((size_t)b * SEQ + qb * 256) * XW + h * 128; r.SS = nullptr; r.P0 = 1 << 16;
        att::Seam<att::bf16> S;
        att::causal_swa_prime<att::bf16, att::bf16>(r, 1 << 20, (char*)lds_raw, S);
        att::causal_swa_block<att::bf16, att::bf16, XW, false>(r, r, NMEM, 1 << 20, (char*)lds_raw, S, -1);
        VM_WAIT(); __syncthreads();
    }
    GSYNC();
    }

    for (int rep = 0; rep < 1 + ((REP >> 6) & 1); ++rep) {
    if (PH & 64) {
        pg8::Gemm g{OX, WCO, M, DM, XW, XW, XW}; pg8::StaticOrder S; S.init(M, DM, G, c);
        pg8::EpiRes<false> E{0, nullptr, X1B, nullptr, X2B, SSQ2, nullptr, nullptr};
        pg8::gemm_phase<pg8::EpiRes<false>, pg8::StaticOrder, true, true>(lds, g, S, E);
    }
    GSYNC();
    }

    for (int rep = 0; rep < 1 + ((REP >> 7) & 1); ++rep) {
    if (PH & 128) {
        pg8::Gemm g{X2B, WGU, M, 2 * FFN, DM, DM, DM}; pg8::StaticOrder S; S.init(M, 2 * FFN, G, c);
        pg8::EpiGu E{0, H, SSQ2, red};
        pg8::gemm_phase<pg8::EpiGu, pg8::StaticOrder, true, true>(lds, g, S, E);
    }
    GSYNC();
    }

    if (PH & 256) {
        pg8::Gemm g{H, WDN, M, DM, FFN, FFN, FFN}; pg8::StaticOrder S; S.init(M, DM, G, c);
        pg8::EpiRes<false> E{0, nullptr, X2B, a.out, nullptr, nullptr, nullptr, nullptr};
        pg8::gemm_phase<pg8::EpiRes<false>, pg8::StaticOrder, true, true>(lds, g, S, E);
    }
}

#undef WIN
#undef WOUT
#undef WCQ
#undef WCKV
#undef WCO
#undef WGU
#undef WDN
#undef WLRU
#undef XN
#undef MN
#undef Qh
#undef Kh
#undef Vh
#undef U
#undef GG
#undef UC
#undef LF
#undef CK
#undef CV
#undef MIX
#undef SSQF
#undef SSQL
#undef X1
#undef X1B
#undef SSQ1
#undef CQ
#undef OX
#undef X2B
#undef SSQ2
#undef H
#undef HL
#undef AC
#undef ENDH
#undef ENDA
#undef red
extern "C" void kernel_launch(void* const* d_in, const int* in_sizes, int n_in, void* d_out, int out_size, void* d_ws, size_t ws_size, hipStream_t stream) {
    static int grid = 0;
    if (grid == 0) {
        if (n_in != 27 || in_sizes[0] != M * DM || out_size != M * DM || ws_size < WS_END) { fprintf(stderr, "kernel_launch: unexpected shapes (n_in %d, in0 %d, out %d, ws %zu)\n", n_in, n_in > 0 ? in_sizes[0] : -1, out_size, ws_size); grid = -1; return; }
        int dev = 0, cus = 0, per_cu = 0;
        (void)hipGetDevice(&dev); (void)hipDeviceGetAttribute(&cus, hipDeviceAttributeMultiprocessorCount, dev);
        if (hipFuncSetAttribute((const void*)hymba_fwd, hipFuncAttributeMaxDynamicSharedMemorySize, LDS_BYTES) != hipSuccess) { fprintf(stderr, "kernel_launch: hipFuncSetAttribute failed\n"); grid = -1; return; }
        if (hipOccupancyMaxActiveBlocksPerMultiprocessor(&per_cu, (const void*)hymba_fwd, NTHR, LDS_BYTES) != hipSuccess || per_cu < 1) { fprintf(stderr, "kernel_launch: occupancy query says %d\n", per_cu); per_cu = 1; }
        (void)hipGetLastError();
        grid = cus * per_cu;
    }
    if (grid < 0) return;
    Args a{};
    for (int i = 0; i < 27; ++i) a.in[i] = (const float*)d_in[i];
    a.out = (float*)d_out; a.ws = (unsigned char*)d_ws;
    if (hipMemsetAsync(d_ws, 0, 16384, stream) != hipSuccess) { fprintf(stderr, "kernel_launch: memset of the barrier words failed\n"); return; }
    void* args[] = {&a};
    hipError_t e = hipLaunchCooperativeKernel((const void*)hymba_fwd, dim3(grid), dim3(NTHR), args, LDS_BYTES, stream);
    if (e != hipSuccess) fprintf(stderr, "cooperative launch failed: %s (grid %d)\n", hipGetErrorString(e), grid);
}
```

```cpp
#include <hip/hip_runtime.h>
#include <hip/hip_bf16.h>
#include <hip/hip_cooperative_groups.h>
#include <cstdio>
#include <cstdint>
namespace cg = cooperative_groups;


template <int K> __device__ __forceinline__ float shx(float v) { static_assert(K < 32, "use sum32"); return __int_as_float(__builtin_amdgcn_ds_swizzle(__float_as_int(v), (K << 10) | 0x1f)); }
__device__ __forceinline__ float sum32(float v) { auto rr = __builtin_amdgcn_permlane32_swap(__float_as_uint(v), __float_as_uint(v), false, false); return __uint_as_float(rr[0]) + __uint_as_float(rr[1]); }
constexpr int WTAB_OFF = 147456 - 256, XBST_OFF = 147456 - 512;
__device__ __forceinline__ int hw_slot() { return (int)(__builtin_amdgcn_s_getreg((5 << 11) | 4) & 63u); }
__device__ __forceinline__ int my_tid() {
    const int slot = hw_slot();
    const int wave = __builtin_amdgcn_readfirstlane(*(volatile __attribute__((address_space(3))) int*)(unsigned)(WTAB_OFF + slot * 4));
    int l; asm volatile("v_mbcnt_lo_u32_b32 %0, -1, 0\n\tv_mbcnt_hi_u32_b32 %0, -1, %0" : "=v"(l));
    return wave * 64 + l;
}
namespace pg8 {
#define PG8_LAS __attribute__((address_space(3)))
typedef unsigned short bf16_t;
typedef short bf16x8 __attribute__((ext_vector_type(8)));
typedef float f32x4 __attribute__((ext_vector_type(4)));
typedef unsigned u32x4 __attribute__((ext_vector_type(4)));
constexpr int BM = 256, BK = 64, HALF = 128, HTB = HALF * BK * 2  , STAGE_BYTES = 8 * HTB, NXCD = 8, WGM = 8;

__host__ __device__ __forceinline__ int lds_byte(int r, int c) { const int st = (r >> 4) * 2 + (c >> 5), rr = r & 15, cc = c & 31, ob = rr * 64 + cc * 2; return st * 1024 + (ob ^ (((ob >> 9) & 1) << 5)); }
__host__ __device__ __forceinline__ void stage_rc(int b, int& R, int& C) { const int st = b / 1024, sb = b % 1024, swz = sb ^ (((sb >> 9) & 1) << 5); R = (st >> 1) * 16 + swz / 64; C = (st & 1) * 32 + (swz % 64) / 2; }
__host__ __device__ __forceinline__ int perm32(int rho) { const int n = rho >> 4, i = rho & 15; return 8 * (i >> 2) + 4 * n + (i & 3); }

struct Unit { int pm, pn; };
struct Gemm { const bf16_t* A; const bf16_t* Bt; int M, N, K, lda, ldb; };

struct StaticOrder {
    int nM, nN, nwg, G, c;
    __host__ __device__ void init(int M, int N, int G_, int c_) { nM = M / BM; nN = N / BM; nwg = nM * nN; G = G_; c = c_; }
    __host__ __device__ bool next(int i, Unit& u) const {
        const long L = (long)i * G + c; if (L >= nwg) return false;
        int wgid = (int)L; { const int q = nwg / NXCD, r = nwg % NXCD, xcd = wgid % NXCD, off = wgid / NXCD; wgid = (xcd < r ? xcd * (q + 1) : r * (q + 1) + (xcd - r) * q) + off; }
        const int nig = WGM * nN, gid = wgid / nig, fm = gid * WGM, gsz = (nM - fm) < WGM ? (nM - fm) : WGM;
        u.pm = fm + ((wgid % nig) % gsz); u.pn = (wgid % nig) / gsz; return true;
    }
    __device__ __forceinline__ void a_ready(const Unit&) const {}
    __device__ __forceinline__ void done(const Unit&) const {}
};

__device__ __forceinline__ unsigned cvt_pk_bf16(float lo, float hi) { unsigned r; asm volatile("v_cvt_pk_bf16_f32 %0, %1, %2" : "=v"(r) : "v"(lo), "v"(hi)); return r; }

typedef float f32x2 __attribute__((ext_vector_type(2)));
constexpr float RMS_EPS = 1e-6f;
struct OneUnit {
    __device__ __forceinline__ bool next(int i, Unit& u) const { if (i != 0) return false; u.pm = 0; u.pn = 0; return true; }
    __device__ __forceinline__ void a_ready(const Unit&) const {}
    __device__ __forceinline__ void done(const Unit&) const {}
};
struct OffsetOrder {
    StaticOrder S;
    __device__ __forceinline__ bool next(int i, Unit& u) const { return S.next(i, u); }
    __device__ __forceinline__ void a_ready(const Unit&) const {}
    __device__ __forceinline__ void done(const Unit&) const {}
};
__device__ __forceinline__ float fast_log1p(float x) { const float sr = x * (1.0f - x * (0.5f - x * (0.33333334f - x * (0.25f - x * (0.2f - x * 0.16666667f))))); return x < 0.0625f ? sr : __logf(1.0f + x); }
__device__ __forceinline__ float sigmoidf_(float x) { return __builtin_amdgcn_rcpf(1.0f + __expf(-x)); }
__device__ __forceinline__ float gelu_tanh(float x) { const float u = 0.7978845608028654f * (x + 0.044715f * x * x * x); return x * sigmoidf_(2.0f * u); }
__device__ __forceinline__ float sum_f(const float* p, int n4) { float s = 0.f; for (int i = 0; i < n4; ++i) { const f32x4 v = *(const f32x4*)(p + 4 * i); s += (v[0] + v[1]) + (v[2] + v[3]); } return s; }
__device__ __forceinline__ u32x4 pack8(const f32x4& a, const f32x4& b) { u32x4 w; w.x = cvt_pk_bf16(a[0], a[1]); w.y = cvt_pk_bf16(a[2], a[3]); w.z = cvt_pk_bf16(b[0], b[1]); w.w = cvt_pk_bf16(b[2], b[3]); return w; }

template <int ACT  >
__device__ __forceinline__ void store_tile(const f32x4 (&acc)[2][2][4][2], bf16_t* d0, bf16_t* d1, size_t ld, int wr, int wc, int fr, int fq) {
#pragma unroll
    for (int ai = 0; ai < 2; ++ai)
#pragma unroll
        for (int m = 0; m < 4; ++m) { const size_t ro = (size_t)(ai * HALF + wr * 64 + m * 16 + fr) * ld + wc * 32 + fq * 8;
#pragma unroll
            for (int bj = 0; bj < 2; ++bj) { f32x4 v0 = acc[ai][bj][m][0], v1 = acc[ai][bj][m][1];
                if (ACT == 1) {
#pragma unroll
                    for (int j = 0; j < 4; ++j) { v0[j] = gelu_tanh(v0[j]); v1[j] = gelu_tanh(v1[j]); } }
                *(u32x4*)((bj ? d1 : d0) + ro) = pack8(v0, v1); } }
}
template <bool ROWSCALE>
__device__ __forceinline__ void head_norm_store(const f32x4 (&acc)[2][2][4][2], const float (&rs)[2][4], const float* gain, bf16_t* d0, bf16_t* d1, PG8_LAS float* red, int wr, int wc, int fr, int fq) {
#pragma unroll
    for (int ai = 0; ai < 2; ++ai)
#pragma unroll
        for (int m = 0; m < 4; ++m)
#pragma unroll
            for (int bj = 0; bj < 2; ++bj) { float s = 0.f;
#pragma unroll
                for (int n = 0; n < 2; ++n) { f32x4 v = acc[ai][bj][m][n]; if (ROWSCALE) v = v * rs[ai][m]; s += (v[0] * v[0] + v[1] * v[1]) + (v[2] * v[2] + v[3] * v[3]); }
                s += shx<16>(s); s = sum32(s);
                if (fq == 0) red[((ai * HALF + wr * 64 + m * 16 + fr) * 2 + bj) * 4 + wc] = s; }
    asm volatile("s_waitcnt lgkmcnt(0)" ::: "memory"); __builtin_amdgcn_s_barrier(); asm volatile("" ::: "memory");
    const f32x4 g0 = *(const f32x4*)(gain + wc * 32 + fq * 8), g1 = *(const f32x4*)(gain + wc * 32 + fq * 8 + 4);
#pragma unroll
    for (int ai = 0; ai < 2; ++ai)
#pragma unroll
        for (int m = 0; m < 4; ++m) { const int rl = ai * HALF + wr * 64 + m * 16 + fr;
#pragma unroll
            for (int bj = 0; bj < 2; ++bj) { const PG8_LAS float* rp = red + (rl * 2 + bj) * 4;
                const float ss = (rp[0] + rp[1]) + (rp[2] + rp[3]);
                float sc = __builtin_amdgcn_rsqf(ss * (1.0f / 128.0f) + RMS_EPS); if (ROWSCALE) sc *= rs[ai][m];
                const f32x4 v0 = acc[ai][bj][m][0] * sc * g0, v1 = acc[ai][bj][m][1] * sc * g1;
                *(u32x4*)((bj ? d1 : d0) + (size_t)rl * 128 + wc * 32 + fq * 8) = pack8(v0, v1); } }
}

struct EpiIn {
    static constexpr bool PERM = true, AFTER_DRAIN = false, HAS_MID = false; int mid_t;
    bf16_t *Q, *Kh, *V, *U, *GG; float* LF; const float *g_q, *g_k, *b_f; PG8_LAS float* red;
    __device__ __forceinline__ void operator()(const f32x4 (&acc)[2][2][4][2], const Unit& u, int wr, int wc, int fr, int fq) const {
        asm volatile("" : "+v"(fr), "+v"(fq));
        const int pn = u.pn, row0 = u.pm * BM, b = row0 >> 11, s0 = row0 & 2047;
        if (pn < 12) {
            const int h0 = (pn & 3) * 2; bf16_t* const q_ = Q; bf16_t* const k_ = Kh; bf16_t* const v_ = V; const float* const gq_ = g_q; const float* const gk_ = g_k;
            bf16_t* base = pn < 4 ? q_ : (pn < 8 ? k_ : v_);
            bf16_t* d0 = base + ((size_t)(b * 8 + h0) * 2048 + s0) * 128; bf16_t* d1 = d0 + (size_t)2048 * 128;
            if (pn < 8) { float rs[2][4]; head_norm_store<false>(acc, rs, pn < 4 ? gq_ : gk_, d0, d1, red, wr, wc, fr, fq); }
            else store_tile<0>(acc, d0, d1, 128, wr, wc, fr, fq);
        } else if (pn < 16) { bf16_t* const u_ = U; bf16_t* d0 = u_ + (size_t)row0 * 1024 + (pn - 12) * 256; store_tile<0>(acc, d0, d0 + 128, 1024, wr, wc, fr, fq); }
        else if (pn < 20) { bf16_t* const g_ = GG; bf16_t* d0 = g_ + (size_t)row0 * 1024 + (pn - 16) * 256; store_tile<1>(acc, d0, d0 + 128, 1024, wr, wc, fr, fq); }
        else if (wc == 0 && fq == 0) {
            const f32x4 b0 = *(const f32x4*)b_f, b1 = *(const f32x4*)(b_f + 4);
#pragma unroll
            for (int ai = 0; ai < 2; ++ai)
#pragma unroll
                for (int m = 0; m < 4; ++m) { const int row = row0 + ai * HALF + wr * 64 + m * 16 + fr; f32x4 z0 = acc[ai][0][m][0] + b0, z1 = acc[ai][0][m][1] + b1;
#pragma unroll
                    for (int j = 0; j < 4; ++j) { z0[j] = fminf(z0[j], 0.f) - fast_log1p(__expf(-fabsf(z0[j]))); z1[j] = fminf(z1[j], 0.f) - fast_log1p(__expf(-fabsf(z1[j]))); }
                    *(f32x4*)(LF + (size_t)row * 8) = z0; *(f32x4*)(LF + (size_t)row * 8 + 4) = z1; }
        }
    }
};
struct EpiCkv {
    static constexpr bool PERM = true, AFTER_DRAIN = false, HAS_MID = false; int mid_t;
    bf16_t *CK, *CV; const float* g_ck; PG8_LAS float* red;
    __device__ __forceinline__ void operator()(const f32x4 (&acc)[2][2][4][2], const Unit& u, int wr, int wc, int fr, int fq) const {
        asm volatile("" : "+v"(fr), "+v"(fq));
        const int pn = u.pn, b = u.pm, h0 = (pn & 1) * 2;
        bf16_t* const ck_ = CK; bf16_t* const cv_ = CV; bf16_t* d0 = (pn < 2 ? ck_ : cv_) + ((size_t)(b * 4 + h0) * 256) * 128; bf16_t* d1 = d0 + (size_t)256 * 128;
        if (pn < 2) { float rs[2][4]; head_norm_store<false>(acc, rs, g_ck, d0, d1, red, wr, wc, fr, fq); }
        else store_tile<0>(acc, d0, d1, 128, wr, wc, fr, fq);
    }
};
struct EpiCq {
    static constexpr bool PERM = true, AFTER_DRAIN = false, HAS_MID = false; int mid_t;
    bf16_t* CQ; const float* g_cq; const float* SSQ; PG8_LAS float* red;
    __device__ __forceinline__ void operator()(const f32x4 (&acc)[2][2][4][2], const Unit& u, int wr, int wc, int fr, int fq) const {
        asm volatile("" : "+v"(fr), "+v"(fq));
        const int pn = u.pn, row0 = u.pm * BM, b = row0 >> 11, s0 = row0 & 2047, h0 = pn * 2, tid = (wr * 4 + wc) * 64 + fq * 16 + fr;
        PG8_LAS float* tab = red + 2048;
        if (tid < 256) tab[tid] = __builtin_amdgcn_rsqf(sum_f(SSQ + (size_t)(row0 + tid) * 32, 8) * (1.0f / 2048.0f) + RMS_EPS);
        asm volatile("s_waitcnt lgkmcnt(0)" ::: "memory"); __builtin_amdgcn_s_barrier(); asm volatile("" ::: "memory");
        float rs[2][4];
#pragma unroll
        for (int ai = 0; ai < 2; ++ai)
#pragma unroll
            for (int m = 0; m < 4; ++m) rs[ai][m] = tab[ai * HALF + wr * 64 + m * 16 + fr];
        bf16_t* d0 = CQ + ((size_t)(b * 4 + h0) * 2048 + s0) * 128; bf16_t* d1 = d0 + (size_t)2048 * 128;
        head_norm_store<true>(acc, rs, g_cq, d0, d1, red, wr, wc, fr, fq);
    }
};
template <bool MID> struct EpiRes {
    static constexpr bool PERM = true, AFTER_DRAIN = false, HAS_MID = MID; int mid_t;
    const float* resid; const bf16_t* residb; float* outf; bf16_t* outb; float* ssq_out; const float *ssqf, *ssql;
    __device__ __forceinline__ void mid(f32x4 (&acc)[2][2][4][2], const Unit& u, int wr, int wc, int fr, int fq) const {
        asm volatile("" : "+v"(fr), "+v"(fq));
#pragma unroll
        for (int ai = 0; ai < 2; ++ai)
#pragma unroll
            for (int m = 0; m < 4; ++m) { const size_t row = (size_t)u.pm * BM + ai * HALF + wr * 64 + m * 16 + fr;
                const float rf = __builtin_amdgcn_rsqf(sum_f(ssqf + row * 8, 2) * (1.0f / 1024.0f) + RMS_EPS), rl = __builtin_amdgcn_rsqf(sum_f(ssql + row * 8, 2) * (1.0f / 1024.0f) + RMS_EPS);
                const float ratio = rf / rl;
#pragma unroll
                for (int bj = 0; bj < 2; ++bj)
#pragma unroll
                    for (int n = 0; n < 2; ++n) acc[ai][bj][m][n] = acc[ai][bj][m][n] * ratio;
                __builtin_amdgcn_sched_barrier(0); }
    }
    __device__ __forceinline__ void operator()(const f32x4 (&acc)[2][2][4][2], const Unit& u, int wr, int wc, int fr, int fq) const {
        asm volatile("" : "+v"(fr), "+v"(fq));
#pragma unroll
        for (int ai = 0; ai < 2; ++ai)
#pragma unroll
            for (int m = 0; m < 4; ++m) { const size_t row = (size_t)u.pm * BM + ai * HALF + wr * 64 + m * 16 + fr;
                float sc = 1.f; if (MID) sc = __builtin_amdgcn_rsqf(sum_f(ssql + row * 8, 2) * (1.0f / 1024.0f) + RMS_EPS);
                float ss = 0.f;
#pragma unroll
                for (int bj = 0; bj < 2; ++bj) { const size_t o = row * 2048 + u.pn * BM + bj * HALF + wc * 32 + fq * 8;
                    f32x4 r0, r1;
                    if (residb) { const u32x4 w = __builtin_nontemporal_load((const u32x4*)(residb + o));     r0 = (f32x4){__uint_as_float(w.x << 16), __uint_as_float(w.x & 0xffff0000u), __uint_as_float(w.y << 16), __uint_as_float(w.y & 0xffff0000u)};
                                  r1 = (f32x4){__uint_as_float(w.z << 16), __uint_as_float(w.z & 0xffff0000u), __uint_as_float(w.w << 16), __uint_as_float(w.w & 0xffff0000u)}; }
                    else { r0 = __builtin_nontemporal_load((const f32x4*)(resid + o)); r1 = __builtin_nontemporal_load((const f32x4*)(resid + o + 4)); }
                    const f32x4 v0 = r0 + acc[ai][bj][m][0] * sc, v1 = r1 + acc[ai][bj][m][1] * sc;
                    if (outf) { __builtin_nontemporal_store(v0, (f32x4*)(outf + o)); __builtin_nontemporal_store(v1, (f32x4*)(outf + o + 4)); }
                    ss += (v0[0] * v0[0] + v0[1] * v0[1]) + (v0[2] * v0[2] + v0[3] * v0[3]) + (v1[0] * v1[0] + v1[1] * v1[1]) + (v1[2] * v1[2] + v1[3] * v1[3]);
                    if (outb) *(u32x4*)(outb + o) = pack8(v0, v1); }
                if (ssq_out) { ss += shx<16>(ss); ss = sum32(ss); if (fq == 0) ssq_out[row * 32 + u.pn * 4 + wc] = ss; }
                __builtin_amdgcn_sched_barrier(0); }
    }
};
struct EpiGu {
    static constexpr bool PERM = true, AFTER_DRAIN = false, HAS_MID = false; int mid_t;
    bf16_t* H; const float* SSQ; PG8_LAS float* red;
    __device__ __forceinline__ void operator()(const f32x4 (&acc)[2][2][4][2], const Unit& u, int wr, int wc, int fr, int fq) const {
        asm volatile("" : "+v"(fr), "+v"(fq));
        const int tid = (wr * 4 + wc) * 64 + fq * 16 + fr; PG8_LAS float* tab = red + 2048;
        if (tid < 256) tab[tid] = __builtin_amdgcn_rsqf(sum_f(SSQ + ((size_t)u.pm * BM + tid) * 32, 8) * (1.0f / 2048.0f) + RMS_EPS);
        asm volatile("s_waitcnt lgkmcnt(0)" ::: "memory"); __builtin_amdgcn_s_barrier(); asm volatile("" ::: "memory");
#pragma unroll
        for (int ai = 0; ai < 2; ++ai)
#pragma unroll
            for (int m = 0; m < 4; ++m) { const size_t row = (size_t)u.pm * BM + ai * HALF + wr * 64 + m * 16 + fr;
                const float rs = tab[ai * HALF + wr * 64 + m * 16 + fr];
                f32x4 h[2];
#pragma unroll
                for (int n = 0; n < 2; ++n) { const f32x4 g = acc[ai][0][m][n] * rs, up = acc[ai][1][m][n] * rs;
#pragma unroll
                    for (int j = 0; j < 4; ++j) h[n][j] = g[j] * sigmoidf_(g[j]) * up[j]; }
                *(u32x4*)(H + row * 5632 + u.pn * HALF + wc * 32 + fq * 8) = pack8(h[0], h[1]); }
    }
};
struct EpiLru {
    static constexpr bool PERM = true, AFTER_DRAIN = true, HAS_MID = false; int mid_t;
    const bf16_t* UC; bf16_t* HL; bf16_t* AC; float* ENDH; float* ENDA; const float *b_ra, *b_ri, *lam; int row0, nblk;
    __device__ __forceinline__ void fused(f32x4 (&acc)[2][2][4][2], const Unit&, int wr, int wc, int fr, int fq, PG8_LAS unsigned char* lds, int wid, int lane) const {
        asm volatile("" : "+v"(fr), "+v"(fq));
        PG8_LAS float* LA = (PG8_LAS float*)lds; PG8_LAS float* LB = LA + 128 * 132;
        const int tid = wid * 64 + lane, ch0 = nblk * 128 + wc * 32 + fq * 8;
        float hc = 0.f, ac = 1.f;
#pragma unroll
        for (int ai = 0; ai < 2; ++ai) {
#pragma unroll
            for (int n = 0; n < 2; ++n) {
                const f32x4 bra = *(const f32x4*)(b_ra + ch0 + 4 * n), bri = *(const f32x4*)(b_ri + ch0 + 4 * n), lm = *(const f32x4*)(lam + ch0 + 4 * n); f32x4 sp;
#pragma unroll
                for (int j = 0; j < 4; ++j) sp[j] = -8.0f * fast_log1p(__expf(-lm[j]));
#pragma unroll
                for (int m = 0; m < 4; ++m) { const int rl = wr * 64 + m * 16 + fr; const unsigned grow = (unsigned)(row0 + ai * HALF + rl);
                    const f32x2 ucw = *(const f32x2*)((const char*)UC + (grow * 1024u + ch0 + 4 * n) * 2u); f32x4 av, bv;
#pragma unroll
                    for (int j = 0; j < 4; ++j) { const unsigned w = __float_as_uint(ucw[j >> 1]); const float uc = __uint_as_float((j & 1) ? (w & 0xffff0000u) : (w << 16));
                        const float r = sigmoidf_(acc[ai][0][m][n][j] + bra[j]), ig = sigmoidf_(acc[ai][1][m][n][j] + bri[j]);
                        const float la = r * sp[j], a_ = __expf(la); av[j] = a_; bv[j] = __builtin_amdgcn_sqrtf(fmaxf(fmaf(-a_, a_, 1.0f), 0.f)) * ig * uc; }
                    *(PG8_LAS f32x4*)(LA + rl * 132 + wc * 32 + fq * 8 + 4 * n) = av; *(PG8_LAS f32x4*)(LB + rl * 132 + wc * 32 + fq * 8 + 4 * n) = bv;
                    __builtin_amdgcn_sched_barrier(0); } }
            asm volatile("s_waitcnt lgkmcnt(0)" ::: "memory"); __builtin_amdgcn_s_barrier(); asm volatile("" ::: "memory");
            if (tid < 128) {
#pragma unroll 8
                for (int rl = 0; rl < 128; ++rl) { const float a_ = LA[rl * 132 + tid]; hc = a_ * hc + LB[rl * 132 + tid]; ac *= a_; LB[rl * 132 + tid] = hc; LA[rl * 132 + tid] = ac; }
                if (ai == 1) { ENDH[nblk * 128 + tid] = hc; ENDA[nblk * 128 + tid] = ac; } }
            asm volatile("s_waitcnt lgkmcnt(0)" ::: "memory"); __builtin_amdgcn_s_barrier(); asm volatile("" ::: "memory");
            const int c8 = (tid & 15) * 8;
#pragma unroll
            for (int p = 0; p < 4; ++p) { const int rl = p * 32 + (tid >> 4); const unsigned o = ((unsigned)(row0 + ai * HALF + rl) * 1024u + nblk * 128 + c8) * 2u;
                const f32x4 h0 = *(const PG8_LAS f32x4*)(LB + rl * 132 + c8), h1 = *(const PG8_LAS f32x4*)(LB + rl * 132 + c8 + 4);
                const f32x4 a0 = *(const PG8_LAS f32x4*)(LA + rl * 132 + c8), a1 = *(const PG8_LAS f32x4*)(LA + rl * 132 + c8 + 4);
                *(u32x4*)((char*)HL + o) = pack8(h0, h1); *(u32x4*)((char*)AC + o) = pack8(a0, a1); }
            asm volatile("s_waitcnt lgkmcnt(0)" ::: "memory"); __builtin_amdgcn_s_barrier(); asm volatile("" ::: "memory");
        }
    }
};
template <class Epi, class Sched, bool ALIGN_EPI = false, bool SP2 = false>
__device__ __forceinline__ void gemm_phase(PG8_LAS unsigned char* lds, const Gemm g, const Sched& S, const Epi& E) {
    int tid_ = my_tid();
    const int tid = tid_, wid = __builtin_amdgcn_readfirstlane(tid >> 6), lane = tid & 63, wr = wid >> 2, wc = wid & 3, fr = lane & 15, fq = lane >> 4;
    const int K = g.K, nt = K / BK;
    unsigned voffA[2], voffB[2];
#pragma unroll
    for (int i = 0; i < 2; ++i) { int R, C; stage_rc(tid * 16 + i * 8192, R, C); const int Rb = Epi::PERM ? ((R & ~31) + perm32(R & 31)) : R;
        voffA[i] = (unsigned)(R * g.lda + C) * 2u; voffB[i] = (unsigned)(Rb * g.ldb + C) * 2u; }
    const size_t kstep = (size_t)(BK * 2);
    const size_t hstepA = (size_t)HALF * g.lda * 2, hstepB = (size_t)HALF * g.ldb * 2;
    const size_t tstepA = 2 * hstepA, tstepB = 2 * hstepB;
    const unsigned ldsw = (unsigned)wid * 1024u;
    const int aoff = lds_byte(wr * 64 + fr, fq * 8), boff = lds_byte(wc * 32 + fr, fq * 8);
#define PG8_SA(b, h) (((b) * 2 + (h)) * HTB)
#define PG8_SB(b, h) ((4 + (b) * 2 + (h)) * HTB)
#define PG8_STAGE(bufoff, gbase, voff) do { _Pragma("unroll") for (int _i = 0; _i < 2; ++_i) \
        __builtin_amdgcn_global_load_lds((const unsigned*)((const char*)(gbase) + (voff)[_i]), (PG8_LAS unsigned*)(lds + (bufoff) + ldsw + _i * 8192), 16, 0, 0); } while (0)
#define PG8_LDA(dst, b, h) do { _Pragma("unroll") for (int m = 0; m < 4; ++m) _Pragma("unroll") for (int k = 0; k < 2; ++k) dst[m][k] = *(const PG8_LAS bf16x8*)(lds + PG8_SA(b, h) + aoff + m * 2048 + k * 1024); } while (0)
#define PG8_LDB(dst, b, h) do { _Pragma("unroll") for (int n = 0; n < 2; ++n) _Pragma("unroll") for (int k = 0; k < 2; ++k) dst[n][k] = *(const PG8_LAS bf16x8*)(lds + PG8_SB(b, h) + boff + n * 2048 + k * 1024); } while (0)
#define PG8_MMA(ai, bj, At, Bt) do { __builtin_amdgcn_s_setprio(1); _Pragma("unroll") for (int m = 0; m < 4; ++m) _Pragma("unroll") for (int n = 0; n < 2; ++n) _Pragma("unroll") for (int k = 0; k < 2; ++k) \
        acc[ai][bj][m][n] = __builtin_amdgcn_mfma_f32_16x16x32_bf16(Bt[n][k], At[m][k], acc[ai][bj][m][n], 0, 0, 0); __builtin_amdgcn_s_setprio(0); } while (0)
#define PG8_WAIT_V(n) asm volatile("s_waitcnt vmcnt(" #n ")" ::: "memory")
#define PG8_WAIT_L(n) asm volatile("s_waitcnt lgkmcnt(" #n ")" ::: "memory")
#define PG8_BAR __builtin_amdgcn_s_barrier()
#define PG8_SCHED __builtin_amdgcn_sched_barrier(0)
    Unit cur, nxt; int ui = 0;
    if (!S.next(0, cur)) return;
    f32x4 acc[2][2][4][2];
#pragma unroll
    for (int a = 0; a < 2; ++a)
#pragma unroll
        for (int b = 0; b < 2; ++b)
#pragma unroll
            for (int m = 0; m < 4; ++m)
#pragma unroll
                for (int n = 0; n < 2; ++n) acc[a][b][m][n] = (f32x4){0.f, 0.f, 0.f, 0.f};
    bf16x8 At[4][2], B0[2][2], B1[2][2];
    const char* cA = (const char*)g.A + (size_t)cur.pm * tstepA; const char* cB = (const char*)g.Bt + (size_t)cur.pn * tstepB;
    S.a_ready(cur);
    if constexpr (SP2) {
        PG8_STAGE(PG8_SB(0, 0), cB, voffB); PG8_STAGE(PG8_SB(0, 1), cB + hstepB, voffB); PG8_STAGE(PG8_SA(0, 0), cA, voffA); PG8_STAGE(PG8_SA(0, 1), cA + hstepA, voffA);
        if (wr == 1) PG8_BAR;
        PG8_WAIT_V(2); PG8_BAR;
        PG8_STAGE(PG8_SB(1, 0), cB + kstep, voffB); PG8_STAGE(PG8_SA(1, 0), cA + kstep, voffA); PG8_STAGE(PG8_SB(1, 1), cB + hstepB + kstep, voffB);
        PG8_WAIT_V(6); PG8_BAR;
    } else {
        PG8_STAGE(PG8_SB(0, 0), cB, voffB); PG8_STAGE(PG8_SA(0, 0), cA, voffA); PG8_STAGE(PG8_SB(0, 1), cB + hstepB, voffB); PG8_STAGE(PG8_SA(0, 1), cA + hstepA, voffA);
        if (wr == 1) PG8_BAR;
        PG8_WAIT_V(4); PG8_BAR;
        PG8_STAGE(PG8_SB(1, 0), cB + kstep, voffB); PG8_STAGE(PG8_SA(1, 0), cA + kstep, voffA); PG8_STAGE(PG8_SB(1, 1), cB + hstepB + kstep, voffB);
        PG8_WAIT_V(6); PG8_BAR;
    }
    for (;;) {
        const bool has_next = S.next(ui + 1, nxt);
        const char* nA = has_next ? (const char*)g.A + (size_t)nxt.pm * tstepA : cA; const char* nB = has_next ? (const char*)g.Bt + (size_t)nxt.pn * tstepB : cB;
        for (int t = 0; t < nt; t += 2) {
            const bool last = (t == nt - 2);
            if constexpr (Epi::HAS_MID) { if (t == E.mid_t) E.mid(acc, cur, wr, wc, fr, fq); }
            const char* a1 = cA + (size_t)(t + 1) * kstep;
            const char* a2 = last ? nA : cA + (size_t)(t + 2) * kstep; const char* b2 = last ? nB : cB + (size_t)(t + 2) * kstep;
            const char* a3 = a2 + kstep; const char* b3 = b2 + kstep;
            if (last && has_next) S.a_ready(nxt);
            if constexpr (SP2) {
            PG8_LDB(B0, 0, 0); PG8_LDB(B1, 0, 1); PG8_SCHED; PG8_LDA(At, 0, 0); PG8_STAGE(PG8_SA(1, 1), a1 + hstepA, voffA);
            PG8_WAIT_V(8); PG8_WAIT_L(0); PG8_BAR; PG8_MMA(0, 0, At, B0); PG8_MMA(0, 1, At, B1); PG8_BAR; PG8_SCHED;
            PG8_LDA(At, 0, 1); PG8_STAGE(PG8_SB(0, 0), b2, voffB); PG8_STAGE(PG8_SB(0, 1), b2 + hstepB, voffB); PG8_STAGE(PG8_SA(0, 0), a2, voffA);
            PG8_WAIT_V(8); PG8_WAIT_L(0); PG8_BAR; PG8_MMA(1, 0, At, B0); PG8_MMA(1, 1, At, B1); PG8_BAR; PG8_SCHED;
            PG8_LDB(B0, 1, 0); PG8_LDB(B1, 1, 1); PG8_SCHED; PG8_LDA(At, 1, 0); PG8_STAGE(PG8_SA(0, 1), a2 + hstepA, voffA);
            PG8_WAIT_V(8); PG8_WAIT_L(0); PG8_BAR; PG8_MMA(0, 0, At, B0); PG8_MMA(0, 1, At, B1); PG8_BAR; PG8_SCHED;
            PG8_LDA(At, 1, 1); PG8_STAGE(PG8_SB(1, 0), b3, voffB); PG8_STAGE(PG8_SB(1, 1), b3 + hstepB, voffB); PG8_STAGE(PG8_SA(1, 0), a3, voffA);
            PG8_WAIT_V(8); PG8_WAIT_L(0); PG8_BAR; PG8_MMA(1, 0, At, B0); PG8_MMA(1, 1, At, B1); PG8_BAR; PG8_SCHED;
            } else {
            PG8_LDB(B0, 0, 0); PG8_SCHED; PG8_LDA(At, 0, 0); PG8_STAGE(PG8_SA(1, 1), a1 + hstepA, voffA);
            PG8_WAIT_L(8); PG8_BAR; PG8_WAIT_L(0); PG8_MMA(0, 0, At, B0); PG8_BAR; PG8_SCHED;
            PG8_LDB(B1, 0, 1); PG8_STAGE(PG8_SB(0, 0), b2, voffB);
            PG8_BAR; PG8_WAIT_L(0); PG8_MMA(0, 1, At, B1); PG8_BAR;
            PG8_LDA(At, 0, 1); PG8_STAGE(PG8_SA(0, 0), a2, voffA);
            PG8_BAR; PG8_WAIT_L(0); PG8_MMA(1, 0, At, B0); PG8_BAR; PG8_SCHED;
            PG8_STAGE(PG8_SB(0, 1), b2 + hstepB, voffB);
            PG8_WAIT_V(6); PG8_BAR; PG8_MMA(1, 1, At, B1); PG8_BAR;
            PG8_LDB(B0, 1, 0); PG8_SCHED; PG8_LDA(At, 1, 0); PG8_STAGE(PG8_SA(0, 1), a2 + hstepA, voffA);
            PG8_WAIT_L(8); PG8_BAR; PG8_WAIT_L(0); PG8_MMA(0, 0, At, B0); PG8_BAR; PG8_SCHED;
            PG8_LDB(B1, 1, 1); PG8_STAGE(PG8_SB(1, 0), b3, voffB);
            PG8_BAR; PG8_WAIT_L(0); PG8_MMA(0, 1, At, B1); PG8_BAR;
            PG8_LDA(At, 1, 1); PG8_STAGE(PG8_SA(1, 0), a3, voffA);
            PG8_BAR; PG8_WAIT_L(0); PG8_MMA(1, 0, At, B0); PG8_BAR; PG8_SCHED;
            PG8_STAGE(PG8_SB(1, 1), b3 + hstepB, voffB);
            PG8_WAIT_V(6); PG8_BAR; PG8_MMA(1, 1, At, B1); PG8_BAR;
            }
        }
        if constexpr (ALIGN_EPI) { if (wr == 0) PG8_BAR; }
        if constexpr (!Epi::AFTER_DRAIN) { E(acc, cur, wr, wc, fr, fq); S.done(cur); }
        if (!has_next) break;
#pragma unroll
        for (int a = 0; a < 2; ++a)
#pragma unroll
            for (int b = 0; b < 2; ++b)
#pragma unroll
                for (int m = 0; m < 4; ++m)
#pragma unroll
                    for (int n = 0; n < 2; ++n) acc[a][b][m][n] = (f32x4){0.f, 0.f, 0.f, 0.f};
        cur = nxt; cA = nA; cB = nB; ++ui;
        if constexpr (ALIGN_EPI) { if (wr == 1) PG8_BAR; }
    }
    PG8_WAIT_V(0);
    if constexpr (!ALIGN_EPI) { if (wr == 0) PG8_BAR; }
    PG8_BAR;
    if constexpr (Epi::AFTER_DRAIN) { E.fused(acc, cur, wr, wc, fr, fq, lds, wid, lane); S.done(cur); }
#undef PG8_SA
#undef PG8_SB
#undef PG8_STAGE
#undef PG8_LDA
#undef PG8_LDB
#undef PG8_MMA
#undef PG8_WAIT_V
#undef PG8_WAIT_L
#undef PG8_BAR
#undef PG8_SCHED
}
}
namespace att {
constexpr int D = 128;
constexpr float THR = 8.f;
constexpr bool WSKIP = false;
constexpr float SCALE = 0.08838834764831845f;
constexpr int NW = 8, QBLK = 32, KVBLK = 64, QB = NW * QBLK;
constexpr int SHM_V = KVBLK * D * 2, SHM_K = KVBLK * D * 2;
constexpr int LDS_BYTES = 2 * SHM_V + 2 * SHM_K + NW * 64 * 4;
using bf16 = __hip_bfloat16;
typedef short bf16x8 __attribute__((ext_vector_type(8)));
typedef short s16x4 __attribute__((ext_vector_type(4)));
typedef float f32x16 __attribute__((ext_vector_type(16)));
typedef float f32x4 __attribute__((ext_vector_type(4)));
typedef unsigned u32x4 __attribute__((ext_vector_type(4)));
template <class A, class Bt> struct same_t { static constexpr bool v = false; };
template <class A> struct same_t<A, A> { static constexpr bool v = true; };

#define KSWZ(row, colB) ((row) * 256 + ((colB) ^ (((row) & 7) << 4)))
#define SBAR() __builtin_amdgcn_sched_barrier(0)
__device__ __forceinline__ int v_st(int k, int c) { const int kk = (k & ~0xC) | ((k & 4) << 1) | ((k & 8) >> 1); return ((kk >> 3) * 4 + (c >> 5)) * 512 + ((kk & 7) * 32 + (c & 31)) * 2; }
__device__ __forceinline__ int v_rd_base(int lane) { return ((lane & 3) << 3) | (((lane >> 2) & 3) << 6) | (((lane >> 4) & 1) << 5) | (((lane >> 5) & 1) << 8); }
constexpr int v_rd_off(int d0, int ks, int half) { return d0 * 512 + ks * 4096 + half * 2048; }
__device__ __forceinline__ int crow(int r, int hi) { return (r & 3) + 8 * (r >> 2) + 4 * hi; }
__device__ __forceinline__ unsigned cvtpk(float lo, float hi) {
    unsigned r; asm volatile("v_cvt_pk_bf16_f32 %0, %1, %2" : "=v"(r) : "v"(lo), "v"(hi)); return r;
}
__device__ __forceinline__ bf16x8 pack8(f32x4 a, f32x4 b) {
    u32x4 w = {cvtpk(a[0], a[1]), cvtpk(a[2], a[3]), cvtpk(b[0], b[1]), cvtpk(b[2], b[3])};
    return *reinterpret_cast<bf16x8*>(&w);
}
template <class T> __device__ __forceinline__ bf16x8 load8(const T* p) {
    if constexpr (same_t<T, float>::v) { return pack8(*(const f32x4*)p, *(const f32x4*)(p + 4)); }
    else { return *reinterpret_cast<const bf16x8*>(p); }
}
__device__ __forceinline__ void mask_tile(f32x16& p0, f32x16& p1, int dq, unsigned W) {
    const float NEG = -__builtin_inff();
#pragma unroll
    for (int r = 0; r < 16; ++r) {
        const int c = (r & 3) + 8 * (r >> 2);
        if ((unsigned)(dq - c) >= W) p0[r] = NEG;
        if ((unsigned)(dq - c - 32) >= W) p1[r] = NEG;
    }
}
__device__ __forceinline__ void partialSM(f32x16& p0, f32x16& p1, float& m_reg, float& mn, float& alpha) {
    float pmax = p0[0]; for (int r = 1; r < 16; ++r) pmax = fmaxf(pmax, p0[r]); for (int r = 0; r < 16; ++r) pmax = fmaxf(pmax, p1[r]);
    { auto rr = __builtin_amdgcn_permlane32_swap(__float_as_uint(pmax), __float_as_uint(pmax), false, false);
      pmax = fmaxf(__uint_as_float(rr[0]), __uint_as_float(rr[1])); }
    constexpr float C2 = 1.4426950408889634f * SCALE;
    if (__builtin_expect(__all((pmax - m_reg) * SCALE <= THR), 1)) { mn = m_reg; alpha = 1.f; }
    else { mn = fmaxf(m_reg, pmax); alpha = __builtin_amdgcn_exp2f((m_reg - mn) * C2); m_reg = mn; }
    const float mnL = -mn * C2;
    for (int r = 0; r < 16; ++r) p0[r] = fmaf(p0[r], C2, mnL); for (int r = 0; r < 16; ++r) p1[r] = fmaf(p1[r], C2, mnL);
    for (int r = 0; r < 16; ++r) p0[r] = __builtin_amdgcn_exp2f(p0[r]);
}
__device__ __forceinline__ void finishSM(f32x16& p0, f32x16& p1, float alpha, float& l_reg, bf16x8& pa0, bf16x8& pa1, bf16x8& pa2, bf16x8& pa3) {
    for (int r = 0; r < 16; ++r) p1[r] = __builtin_amdgcn_exp2f(p1[r]);
    float ps = 0; for (int r = 0; r < 16; ++r) ps += p0[r]; for (int r = 0; r < 16; ++r) ps += p1[r];
    { auto rr = __builtin_amdgcn_permlane32_swap(__float_as_uint(ps), __float_as_uint(ps), false, false);
      ps = __uint_as_float(rr[0]) + __uint_as_float(rr[1]); }
    l_reg = l_reg * alpha + ps;
#define PK4(P, B_, OUT) do { unsigned a0 = cvtpk(P[B_+0], P[B_+1]), a1 = cvtpk(P[B_+2], P[B_+3]);                          \
        unsigned b0 = cvtpk(P[B_+4], P[B_+5]), b1 = cvtpk(P[B_+6], P[B_+7]);                                             \
        auto r0 = __builtin_amdgcn_permlane32_swap(a0, b0, false, false); auto r1 = __builtin_amdgcn_permlane32_swap(a1, b1, false, false); \
        u32x4 w = {r0[0], r1[0], r0[1], r1[1]}; OUT = *reinterpret_cast<bf16x8*>(&w); } while (0)
    PK4(p0, 0, pa0); PK4(p0, 8, pa1); PK4(p1, 0, pa2); PK4(p1, 8, pa3);
#undef PK4
}
template <int KB, bool SK>
__device__ __forceinline__ void qkt(f32x16& p0, f32x16& p1, const char* K_lds, int r32, int hi, const bf16x8* qr, bool act, int cbo  ) {
    if (SK && !act) { const float NEG = -__builtin_inff();
#pragma unroll
        for (int r = 0; r < 16; ++r) { p0[r] = NEG; p1[r] = NEG; } return; }
    if (cbo >= 0) { int a_ = cbo + hi * 16; asm volatile("" : "+v"(a_)); const __attribute__((address_space(3))) float* cb = (const __attribute__((address_space(3))) float*)(unsigned)a_;
#pragma unroll
        for (int q_ = 0; q_ < 4; ++q_) { const f32x4 v0_ = *(const __attribute__((address_space(3))) f32x4*)(cb + 8 * q_), v1_ = *(const __attribute__((address_space(3))) f32x4*)(cb + 32 + 8 * q_);
#pragma unroll
            for (int j_ = 0; j_ < 4; ++j_) { p0[4 * q_ + j_] = v0_[j_]; p1[4 * q_ + j_] = v1_[j_]; } }
    } else { p0 = f32x16{}; p1 = f32x16{}; }
    const char* kb[4];
#pragma unroll
    for (int dd = 0; dd < 4; ++dd) kb[dd] = K_lds + KB * SHM_K + KSWZ(r32, (dd * 16 + hi * 8) * 2);
#pragma unroll
    for (int d0 = 0; d0 < 8; ++d0) { const char* a = kb[d0 & 3] + (d0 >> 2) * 128;
        bf16x8 b0 = *reinterpret_cast<const bf16x8*>(a);
        bf16x8 b1 = *reinterpret_cast<const bf16x8*>(a + 32 * 256);
        p0 = __builtin_amdgcn_mfma_f32_32x32x16_bf16(b0, qr[d0], p0, 0, 0, 0);
        p1 = __builtin_amdgcn_mfma_f32_32x32x16_bf16(b1, qr[d0], p1, 0, 0, 0); }
}
template <int VB, bool SK>
__device__ __forceinline__ void pv_tile(f32x16* o, int vb0, bf16x8 pa0, bf16x8 pa1, bf16x8 pa2, bf16x8 pa3, bool act) {
    if (SK && !act) return;
#define TRRD(dst, off) asm volatile("ds_read_b64_tr_b16 %0, %1 offset:%2" : "=&v"(dst) : "v"(vb0), "i"(off) : "memory")
#define PV_D0(d0) do { s16x4 l0, l1, l2, l3, h0, h1, h2, h3; constexpr int b_ = VB * SHM_V + v_rd_off(d0, 0, 0);     \
        TRRD(l0, b_); TRRD(h0, b_ + 2048); TRRD(l1, b_ + 4096); TRRD(h1, b_ + 6144); TRRD(l2, b_ + 8192); TRRD(h2, b_ + 10240); TRRD(l3, b_ + 12288); TRRD(h3, b_ + 14336); \
        asm volatile("s_waitcnt lgkmcnt(0)" ::: "memory"); SBAR();                 \
        o[d0] = __builtin_amdgcn_mfma_f32_32x32x16_bf16(pa0, (bf16x8){l0[0], l0[1], l0[2], l0[3], h0[0], h0[1], h0[2], h0[3]}, o[d0], 0, 0, 0);   \
        o[d0] = __builtin_amdgcn_mfma_f32_32x32x16_bf16(pa1, (bf16x8){l1[0], l1[1], l1[2], l1[3], h1[0], h1[1], h1[2], h1[3]}, o[d0], 0, 0, 0);   \
        o[d0] = __builtin_amdgcn_mfma_f32_32x32x16_bf16(pa2, (bf16x8){l2[0], l2[1], l2[2], l2[3], h2[0], h2[1], h2[2], h2[3]}, o[d0], 0, 0, 0);   \
        o[d0] = __builtin_amdgcn_mfma_f32_32x32x16_bf16(pa3, (bf16x8){l3[0], l3[1], l3[2], l3[3], h3[0], h3[1], h3[2], h3[3]}, o[d0], 0, 0, 0); } while (0)
    PV_D0(0); PV_D0(1); PV_D0(2); PV_D0(3);
#undef PV_D0
#undef TRRD
}

template <class T> __device__ __forceinline__ T* uptr(T* p) { const unsigned long long v = (unsigned long long)p; const unsigned lo = __builtin_amdgcn_readfirstlane((unsigned)v), hi = __builtin_amdgcn_readfirstlane((unsigned)(v >> 32)); return (T*)(((unsigned long long)hi << 32) | lo); }
template <class TIn, class TOut> struct BlockRef { const TIn* Q; const TIn* K; const TIn* V; TOut* O; float* SS; int P0; };
template <class TIn> struct Seam {
    bf16x8 qr[8];
    bf16x8 st_v0, st_v1, st_k0, st_k1; f32x4 sf0, sf1, sf2, sf3;
    f32x4 tq[16];
};
__device__ __forceinline__ int swa_jlo(int P0, int W) { const int lowk = P0 - W + 1; return lowk > 0 ? lowk / KVBLK : 0; }
#define ROW(p, k0, rr) ((decltype(p))((const char*)(p) + (unsigned)(((k0) + (rr)) * D + sc) * (unsigned)sizeof(*(p))))
#define VMW() asm volatile("s_waitcnt vmcnt(0)" ::: "memory")
#define VMWN(n) asm volatile("s_waitcnt vmcnt(%0)" :: "i"(n) : "memory")
#define SLOAD_H(Kp, Vp, k0) do { S.st_v0 = load8<TIn>(ROW(Vp, k0, sr)); S.st_v1 = load8<TIn>(ROW(Vp, k0, 32 + sr));              \
                         S.st_k0 = load8<TIn>(ROW(Kp, k0, sr)); S.st_k1 = load8<TIn>(ROW(Kp, k0, 32 + sr)); } while (0)
#define SWRITE_HK(bf) do { *(bf16x8*)(K_lds + (bf) * SHM_K + kws) = S.st_k0; *(bf16x8*)(K_lds + (bf) * SHM_K + kws + 32 * 256) = S.st_k1; } while (0)
#define SWRITE_HV(bf) do { *(bf16x8*)(V_lds + (bf) * SHM_V + vst0) = S.st_v0; *(bf16x8*)(V_lds + (bf) * SHM_V + vst1) = S.st_v1; } while (0)
#define SWRITE_H(bf) do { SWRITE_HV(bf); SWRITE_HK(bf); } while (0)
#define SLOAD_F(p, k0) do { S.sf0 = *(const f32x4*)ROW(p, k0, sr); S.sf1 = *(const f32x4*)(ROW(p, k0, sr) + 4);                \
                            S.sf2 = *(const f32x4*)ROW(p, k0, 32 + sr); S.sf3 = *(const f32x4*)(ROW(p, k0, 32 + sr) + 4); } while (0)
#define SWRITE_KF(bf) do { *(bf16x8*)(K_lds + (bf) * SHM_K + kws) = pack8(S.sf0, S.sf1); *(bf16x8*)(K_lds + (bf) * SHM_K + kws + 32 * 256) = pack8(S.sf2, S.sf3); } while (0)
#define SWRITE_VF(bf) do { *(bf16x8*)(V_lds + (bf) * SHM_V + vst0) = pack8(S.sf0, S.sf1); *(bf16x8*)(V_lds + (bf) * SHM_V + vst1) = pack8(S.sf2, S.sf3); } while (0)
template <class TIn, class TOut>
__device__ __forceinline__ void causal_swa_prime(const BlockRef<TIn, TOut>& cur_, int W, char* lds, Seam<TIn>& S) {
    BlockRef<TIn, TOut> cur; cur.Q = uptr(cur_.Q); cur.K = uptr(cur_.K); cur.V = uptr(cur_.V); cur.O = nullptr; cur.SS = nullptr; cur.P0 = __builtin_amdgcn_readfirstlane(cur_.P0);
    constexpr bool F32 = same_t<TIn, float>::v;
    int tid_ = my_tid();
    const int tid = tid_, wid = __builtin_amdgcn_readfirstlane(tid >> 6), lane = tid & 63, r32 = lane & 31, hi = lane >> 5;
    const int sr = tid >> 4, sc = (tid & 15) * 8, kws = KSWZ(sr, sc * 2); char* K_lds = lds + 2 * SHM_V;
    const int kb0 = swa_jlo(cur.P0, W) * KVBLK;
    for (int d0 = 0; d0 < 8; ++d0) S.qr[d0] = load8<TIn>((const TIn*)((const char*)cur.Q + (unsigned)((wid * QBLK + r32) * D + d0 * 16 + hi * 8) * (unsigned)sizeof(TIn)));
    if constexpr (F32) { SLOAD_F((const float*)cur.K, kb0); VMW(); SWRITE_KF(0); SBAR(); SLOAD_F((const float*)cur.V, kb0); }
    else { SLOAD_H(cur.K, cur.V, kb0); VMW(); SWRITE_HK(0); }
    __syncthreads();
}
template <class TIn, class TOut, int ost, bool HAS_SS>
__device__ __forceinline__ void causal_swa_block(const BlockRef<TIn, TOut>& cur_, const BlockRef<TIn, TOut>& nxt_, int skv, int W, char* lds, Seam<TIn>& S, int cbl  ) {
    constexpr bool F32 = same_t<TIn, float>::v;
    BlockRef<TIn, TOut> cur, nxt; cur.Q = uptr(cur_.Q); cur.K = uptr(cur_.K); cur.V = uptr(cur_.V); cur.O = uptr(cur_.O); cur.SS = uptr(cur_.SS); cur.P0 = __builtin_amdgcn_readfirstlane(cur_.P0);
    nxt.Q = uptr(nxt_.Q); nxt.K = uptr(nxt_.K); nxt.V = uptr(nxt_.V); nxt.O = nullptr; nxt.SS = nullptr; nxt.P0 = __builtin_amdgcn_readfirstlane(nxt_.P0);
    int tid_ = my_tid();
    const int tid = tid_, wid = __builtin_amdgcn_readfirstlane(tid >> 6), lane = tid & 63, r32 = lane & 31, hi = lane >> 5;
    const int j_lo = swa_jlo(cur.P0, W);
    int j_hi = (cur.P0 + QB - 1) / KVBLK + 1; if (j_hi > skv / KVBLK) j_hi = skv / KVBLK;
    const int NT = j_hi - j_lo;
    const int kbn = swa_jlo(nxt.P0, W) * KVBLK;
    const int qlo = cur.P0 + wid * QBLK, qm = qlo + r32 - 4 * hi;
    char* V_lds = lds; char* K_lds = lds + 2 * SHM_V;
    float* ws = (float*)(lds + 2 * SHM_V + 2 * SHM_K) + wid * 64; float* li_l = ws, * al_l = ws + 32;
    float m_reg = -1e30f, l_reg = 0; f32x16 o[4] = {};
    const int sr = tid >> 4, sc = (tid & 15) * 8, vst0 = v_st(sr, sc), vst1 = v_st(32 + sr, sc), kws = KSWZ(sr, sc * 2);
    const int vb0 = (int)(uintptr_t)V_lds + v_rd_base(lane);
    const TIn* Kh = cur.K; const TIn* Vh = cur.V;
#define RESC(a) do { if (__any((a) < 1.f)) { if (hi == 0) al_l[r32] = (a); asm volatile("s_waitcnt lgkmcnt(0)" ::: "memory");              \
                     for (int d_ = 0; d_ < 4; ++d_) for (int r = 0; r < 16; ++r) o[d_][r] *= al_l[crow(r, hi)]; } } while (0)
#define KBASE(t) ((j_lo + (t)) * KVBLK)
#define CBT(t) (cbl >= 0 ? cbl + KBASE(t) * 4 : -1)
#define ACT(t) (KBASE(t) <= qlo + QBLK - 1 && KBASE(t) + KVBLK - 1 >= qlo - W + 1)
#define MASKT(P0_, P1_, t) do { const int kb_ = KBASE(t); if ((!SK || ACT(t)) && (kb_ + KVBLK - 1 > qlo || kb_ <= qlo + QBLK - 1 - W)) mask_tile(P0_, P1_, qm - kb_, (unsigned)W); } while (0)
    constexpr int NQL = F32 ? 16 : 8;
    constexpr bool SK = WSKIP && !F32;
#define SEAM_K0() do { VMWN(NQL); if constexpr (F32) { SWRITE_KF(0); SBAR(); SLOAD_F((const float*)nxt.V, kbn); } else { SWRITE_HK(0); } SBAR(); } while (0)
    f32x16 pA0, pA1, pB0, pB1; float mnA, mnB, alA, alB; bf16x8 pa0, pa1, pa2, pa3;
    if constexpr (F32) { VMW(); SWRITE_VF(0); SBAR(); } else { SWRITE_HV(0); SBAR(); }
    if (NT > 1) { if constexpr (F32) SLOAD_F((const float*)Kh, KBASE(1)); else SLOAD_H(Kh, Vh, KBASE(1)); }
    SBAR(); qkt<0, SK>(pA0, pA1, K_lds, r32, hi, S.qr, ACT(0), CBT(0));
    if constexpr (F32) { if (NT > 1) { VMW(); SWRITE_KF(1); SBAR(); SLOAD_F((const float*)Vh, KBASE(1)); } }
    MASKT(pA0, pA1, 0); partialSM(pA0, pA1, m_reg, mnA, alA);
    if (NT > 1) { VMW(); if constexpr (F32) { SWRITE_VF(1); SBAR(); if (NT > 2) SLOAD_F((const float*)Kh, KBASE(2)); } else SWRITE_H(1); }
    __syncthreads();
#define HALF_STEP(PX0, PX1, mnX, alX, PY0, PY1, alY, t, KB, VB, SB) do {                                                      \
        SBAR(); qkt<KB, SK>(PX0, PX1, K_lds, r32, hi, S.qr, ACT(t), CBT(t));                                             \
        finishSM(PY0, PY1, alY, l_reg, pa0, pa1, pa2, pa3); SBAR();                                                           \
        if ((t) + 1 < NT) { if constexpr (F32) { VMW(); SWRITE_KF(SB); SBAR(); SLOAD_F((const float*)Vh, KBASE((t) + 1)); }  \
                            else { SLOAD_H(Kh, Vh, KBASE((t) + 1)); } SBAR(); }                                               \
        pv_tile<VB, SK>(o, vb0, pa0, pa1, pa2, pa3, ACT((t) - 1)); MASKT(PX0, PX1, (t)); partialSM(PX0, PX1, m_reg, mnX, alX);                                        \
        __syncthreads();                                                                                                      \
        if ((t) + 1 < NT) { VMW(); if constexpr (F32) { SWRITE_VF(SB); SBAR(); if ((t) + 2 < NT) SLOAD_F((const float*)Kh, KBASE((t) + 2)); } \
                            else { SWRITE_H(SB); } }                                                                          \
        RESC(alX); __syncthreads(); } while (0)
    for (int t = 1; t + 1 < NT; t += 2) {
        HALF_STEP(pB0, pB1, mnB, alB, pA0, pA1, alA, t, 1, 0, 0);
        HALF_STEP(pA0, pA1, mnA, alA, pB0, pB1, alB, t + 1, 0, 1, 1);
    }
    const bool even = (NT & 1) == 0;
    if (even) { SBAR(); qkt<1, SK>(pB0, pB1, K_lds, r32, hi, S.qr, ACT(NT - 1), CBT(NT - 1)); SBAR(); }
#define QROW(e) (nxt.Q + (size_t)(wid * QBLK + r32) * D + ((e) >> 1) * 16 + hi * 8 + ((e) & 1) * 4)
    if constexpr (F32) { SLOAD_F((const float*)nxt.K, kbn); SBAR();
#pragma unroll
        for (int e = 0; e < 8; ++e) S.tq[e] = *(const f32x4*)QROW(e); }
    else { SLOAD_H(nxt.K, nxt.V, kbn); SBAR();
#pragma unroll
        for (int d0 = 0; d0 < 8; ++d0) S.qr[d0] = load8<TIn>((const TIn*)((const char*)nxt.Q + (unsigned)((wid * QBLK + r32) * D + d0 * 16 + hi * 8) * (unsigned)sizeof(TIn))); }
    SBAR();
    finishSM(pA0, pA1, alA, l_reg, pa0, pa1, pa2, pa3); SBAR();
    if constexpr (F32) {
#pragma unroll
        for (int e = 8; e < 16; ++e) S.tq[e] = *(const f32x4*)QROW(e); SBAR(); }
#undef QROW
    pv_tile<0, SK>(o, vb0, pa0, pa1, pa2, pa3, ACT(even ? NT - 2 : NT - 1));
    if (even) { MASKT(pB0, pB1, NT - 1); partialSM(pB0, pB1, m_reg, mnB, alB); __syncthreads(); RESC(alB);
        finishSM(pB0, pB1, alB, l_reg, pa0, pa1, pa2, pa3); SBAR(); pv_tile<1, SK>(o, vb0, pa0, pa1, pa2, pa3, ACT(NT - 1)); }
    SBAR(); SEAM_K0();
    if (hi == 0) li_l[r32] = l_reg; asm volatile("s_waitcnt lgkmcnt(0)" ::: "memory");
    float rli[16];
#pragma unroll
    for (int r = 0; r < 16; ++r) rli[r] = __builtin_amdgcn_rcpf(li_l[crow(r, hi)]);
    int r32e = r32, hie = hi; asm volatile("" : "+v"(r32e), "+v"(hie));
    char* Ob = (char*)cur.O; const unsigned ob0 = (unsigned)((wid * QBLK + 4 * hie) * ost + r32e) * 2u;
#pragma unroll
    for (int r = 0; r < 16; ++r) { const unsigned rowoff = ob0 + (unsigned)(((r & 3) + 8 * (r >> 2)) * ost * 2); float ss_ = 0.f;
#pragma unroll
        for (int d0 = 0; d0 < 4; ++d0) { const float v = o[d0][r] * rli[r]; ss_ += v * v;
            const float vn = shx<1>(v);
            if ((r32e & 1) == 0) *(unsigned*)(Ob + rowoff + d0 * 64) = cvtpk(v, vn); }
        if (HAS_SS) { ss_ += shx<1>(ss_); ss_ += shx<2>(ss_); ss_ += shx<4>(ss_); ss_ += shx<8>(ss_); ss_ += shx<16>(ss_);
            if (r32e == 0) *(float*)((char*)cur.SS + (unsigned)(wid * QBLK + 4 * hie + (r & 3) + 8 * (r >> 2)) * 32u) = ss_; }
        SBAR(); }
    if constexpr (F32) {
#pragma unroll
        for (int d0 = 0; d0 < 8; ++d0) S.qr[d0] = pack8(S.tq[2 * d0], S.tq[2 * d0 + 1]); }
    __syncthreads();
#undef RESC
#undef KBASE
#undef CBT
#undef ACT
#undef MASKT
#undef SEAM_K0
#undef HALF_STEP
}
#undef ROW
}

#define GAS __attribute__((address_space(1)))
#define LAS __attribute__((address_space(3)))
typedef unsigned short bf16;
typedef unsigned v4u __attribute__((ext_vector_type(4)));
typedef float f32x4 __attribute__((ext_vector_type(4)));
#define LDS_WAIT() asm volatile("s_waitcnt lgkmcnt(0)" ::: "memory")
#define VM_WAIT() asm volatile("s_waitcnt vmcnt(0)" ::: "memory")
__device__ __forceinline__ unsigned f2bf(float f) { unsigned u = __builtin_bit_cast(unsigned, f); return (u + 0x7fffu + ((u >> 16) & 1u)) >> 16; }
__device__ __forceinline__ unsigned pk2(float lo, float hi) { return f2bf(lo) | (f2bf(hi) << 16); }
__device__ __forceinline__ float bflo(unsigned w) { return __uint_as_float(w << 16); }
__device__ __forceinline__ float bfhi(unsigned w) { return __uint_as_float(w & 0xffff0000u); }

#ifndef LB2
#define LB2 2
#endif
#ifndef FOX_HAS_SS
#define FOX_HAS_SS false
#endif
#ifndef FOX_SS
#define FOX_SS (SSQF + ((size_t)b * SEQ + x * 256) * 8 + h)
#endif
#ifndef FOX_CB
#define FOX_CB CB_OFF
#endif
#ifndef USE_XB
#define USE_XB 1
#endif
#if USE_XB
#define GSYNC() xcd_barrier(xbar)
#else
#define GSYNC() grid.sync()
#endif
#ifndef REP
#define REP 0
#endif
#ifndef PH
#define PH 0x1ff
#endif
constexpr int NWAVES = 8, NTHR = 512;
constexpr int BATCH = 4, SEQ = 2048, DM = 2048, M = BATCH * SEQ, NMEM = 256, MMEM = BATCH * NMEM;
constexpr int FOXW = 1024, LRUW = 1024, INW = 5128, INWP = 5376, XW = 512, FFN = 5632;
constexpr float EPS = 1e-6f;
constexpr size_t MiB = 1u << 20;
constexpr size_t WS_WIN = 1 * MiB, WS_WOUT = 22 * MiB, WS_WCQ = 30 * MiB, WS_WCKV = 32 * MiB, WS_WCO = 36 * MiB, WS_WGU = 38 * MiB, WS_WDN = 82 * MiB, WS_WLRU = 104 * MiB;
constexpr size_t WS_XN = 105 * MiB, WS_MN = 137 * MiB, WS_Q = 141 * MiB, WS_K = 157 * MiB, WS_V = 173 * MiB, WS_U = 189 * MiB, WS_GG = 205 * MiB, WS_UC = 221 * MiB;
constexpr size_t WS_LF = 237 * MiB, WS_CK = 238 * MiB, WS_CV = 239 * MiB, WS_MIX = 240 * MiB, WS_SSQF = 272 * MiB, WS_SSQL = 273 * MiB, WS_X1 = 274 * MiB;
constexpr size_t WS_SSQ1 = 338 * MiB, WS_CQ = 339 * MiB, WS_SSQ2 = 347 * MiB, WS_END = 348 * MiB;
constexpr size_t WS_HL = WS_X1, WS_AC = WS_X1 + 16 * MiB, WS_ENDH = WS_SSQ2, WS_ENDA = WS_SSQ2 + 256 * 1024;
constexpr size_t WS_X1B = WS_XN  , WS_OX = WS_Q  , WS_X2B = WS_MIX  , WS_H = WS_Q  ;
constexpr int LDS_BYTES = 147456, RED_OFF = 131072, CB_OFF = 69632, WSUM_OFF = 77824;

__device__ __forceinline__ float wave_sum(float v) { v += shx<1>(v); v += shx<2>(v); v += shx<4>(v); v += shx<8>(v); v += shx<16>(v); return sum32(v); }
template <bool NT_ST>
__device__ __forceinline__ void transpose_item(const float* W, int ldw, int k0, int srcn0, int nvalid, const float* ks, bf16* WT, int ldt, int drow0, LAS float* scr, int lane) {
    f32x4 v[8];
#pragma unroll
    for (int i = 0; i < 8; ++i) { const int kk = 8 * i + (lane >> 3), n4 = (lane & 7) * 4;
        v[i] = (n4 < nvalid) ? __builtin_nontemporal_load((const GAS f32x4*)(W + (size_t)(k0 + kk) * ldw + srcn0 + n4)) : (f32x4){0.f, 0.f, 0.f, 0.f}; }
#pragma unroll
    for (int i = 0; i < 8; ++i) { const int kk = 8 * i + (lane >> 3), n4 = (lane & 7) * 4; f32x4 x = v[i]; if (ks) x = x * ks[k0 + kk];
        LAS float* d = scr + kk * 33 + n4; d[0] = x.x; d[1] = x.y; d[2] = x.z; d[3] = x.w; }
    LDS_WAIT(); asm volatile("" ::: "memory");
    const int c = lane & 7;
#pragma unroll
    for (int j = 0; j < 4; ++j) { const int n = (lane >> 3) + 8 * j; const LAS float* s = scr + (8 * c) * 33 + n;
        v4u o; o.x = pk2(s[0 * 33], s[1 * 33]); o.y = pk2(s[2 * 33], s[3 * 33]); o.z = pk2(s[4 * 33], s[5 * 33]); o.w = pk2(s[6 * 33], s[7 * 33]);
        if (NT_ST) __builtin_nontemporal_store(o, (GAS v4u*)(WT + (size_t)(drow0 + n) * ldt + k0 + 8 * c)); else *(GAS v4u*)(WT + (size_t)(drow0 + n) * ldt + k0 + 8 * c) = o; }
    LDS_WAIT(); asm volatile("" ::: "memory");
}
__device__ __forceinline__ void rms_row_to_bf16(const float* xrow, const float* g, bf16* orow, int lane) {
    const GAS f32x4* xr = (const GAS f32x4*)xrow + lane; const GAS f32x4* gr = (const GAS f32x4*)g + lane;
    f32x4 v[8]; float s = 0.f;
#pragma unroll
    for (int j = 0; j < 8; ++j) { v[j] = __builtin_nontemporal_load(xr + 64 * j); s += (v[j].x * v[j].x + v[j].y * v[j].y) + (v[j].z * v[j].z + v[j].w * v[j].w); }
    const float rstd = 1.0f / sqrtf(wave_sum(s) * (1.f / DM) + EPS);
    GAS unsigned long long* o8 = (GAS unsigned long long*)orow + lane;
#pragma unroll
    for (int j = 0; j < 8; ++j) { const f32x4 gg = gr[64 * j]; o8[64 * j] = (unsigned long long)pk2(v[j].x * rstd * gg.x, v[j].y * rstd * gg.y) | ((unsigned long long)pk2(v[j].z * rstd * gg.z, v[j].w * rstd * gg.w) << 32); }
}

#define XB_TMO      128
#define XB_XCNT(j)  (256  + 64 * (j))
#define XB_XSUB(j)  (1280 + 64 * (j))
#define XB_XGEN(j)  (2304 + 64 * (j))
#define XB_TOP      3328
#define XB_TOPGEN   3392
#define XCD_BAR_WORDS 3456
#define XB_SPIN_CAP (1u << 18)

__device__ __forceinline__ unsigned xb_ld(unsigned* p)              { return __hip_atomic_load(p, __ATOMIC_RELAXED, __HIP_MEMORY_SCOPE_AGENT); }
__device__ __forceinline__ unsigned xb_add(unsigned* p, unsigned v) { return __hip_atomic_fetch_add(p, v, __ATOMIC_RELAXED, __HIP_MEMORY_SCOPE_AGENT); }
__device__ __forceinline__ unsigned xb_xcc_id() { return (unsigned)__builtin_amdgcn_s_getreg((3 << 11) | 20) & 0xFu; }
#define XB_SPIN(cond, bar) do { unsigned _sp = 0; while (cond) { __builtin_amdgcn_s_sleep(1); \
    if ((++_sp & 255u) == 0u) { if (xb_ld(&(bar)[XB_TMO])) break; if (_sp > XB_SPIN_CAP) { atomicAdd(&(bar)[XB_TMO], 1u); break; } } } } while (0)

struct XcdBarrier {
    unsigned* bar; unsigned x;
    volatile LAS unsigned* st;
};

__device__ __forceinline__ XcdBarrier xcd_barrier_post(unsigned* bar, volatile LAS unsigned* st) {
    XcdBarrier b; b.bar = bar; b.x = xb_xcc_id(); b.st = st;
    if (my_tid() == 0) (void)xb_add(&bar[XB_XCNT(b.x)], 1u);
    return b;
}
__device__ __forceinline__ void xcd_barrier_complete(unsigned* bar, unsigned x, unsigned& nloc, unsigned& nx) {
    const unsigned G = gridDim.x * gridDim.y * gridDim.z;
    unsigned sum, cnt, mine, sp = 0u;
    for (;;) {
        sum = 0u; cnt = 0u; mine = 0u;
#pragma unroll
        for (unsigned j = 0; j < 16; ++j) { const unsigned c = xb_ld(&bar[XB_XCNT(j)]); sum += c; cnt += (c > 0u) ? 1u : 0u; mine = (j == x) ? c : mine; }
        if (sum == G) break;
        __builtin_amdgcn_s_sleep(1);
        if ((++sp & 255u) == 0u) { if (xb_ld(&bar[XB_TMO])) break; if (sp > XB_SPIN_CAP) { atomicAdd(&bar[XB_TMO], 1u); break; } }
    }
    nloc = mine > 0u ? mine : 1u; nx = cnt > 0u ? cnt : 1u;
}

__device__ __forceinline__ void xcd_barrier(const XcdBarrier& b) {
    asm volatile("s_waitcnt vmcnt(0)" ::: "memory");
    __syncthreads();
    if (my_tid() == 0) {
        unsigned* bar = b.bar;
        __builtin_amdgcn_s_waitcnt(0);
        unsigned nloc = b.st[0], nx = b.st[1];
        if (nloc == 0u) { xcd_barrier_complete(bar, b.x, nloc, nx); b.st[0] = nloc; b.st[1] = nx; }
        const unsigned old = xb_add(&bar[XB_XSUB(b.x)], 1u);
        const unsigned gen = old / nloc;
        if (old + 1u == (gen + 1u) * nloc) {
            __builtin_amdgcn_fence(__ATOMIC_RELEASE, "agent");
            asm volatile("s_waitcnt vmcnt(0)" ::: "memory");
            const unsigned og = xb_add(&bar[XB_TOP], 1u);
            const unsigned tg = og / nx;
            if (og + 1u == (tg + 1u) * nx) xb_add(&bar[XB_TOPGEN], 1u);
            else XB_SPIN(xb_ld(&bar[XB_TOPGEN]) == tg, bar);
            __builtin_amdgcn_fence(__ATOMIC_ACQUIRE, "agent");
            xb_add(&bar[XB_XGEN(b.x)], 1u);
            asm volatile("s_waitcnt vmcnt(0)" ::: "memory");
        } else {
            XB_SPIN(xb_ld(&bar[XB_XGEN(b.x)]) == gen, bar);
            __builtin_amdgcn_fence(__ATOMIC_ACQUIRE, "agent");
            asm volatile("s_waitcnt vmcnt(0)" ::: "memory");
        }
    }
    __syncthreads();
}

struct Args { const float* in[27]; float* out; unsigned char* ws; };
enum { I_X = 0, I_MEM, I_GMIX, I_WIN, I_BF, I_GQ, I_GK, I_CONVW, I_CONVB, I_WRA, I_BRA, I_WRI, I_BRI, I_LAM, I_GFOX, I_GLRU, I_WOUT, I_GXATTN, I_GMEM, I_WCQ, I_WCKV, I_GCQ, I_GCK, I_WCO, I_GFFN, I_WGU, I_WDN };

constexpr int KB_D = DM / 64;
constexpr int I0 = (INWP / 32) * KB_D, I3 = (2 * XW / 32) * KB_D, I7 = 16 * 4 * 2, N_EARLY = I0 + I3 + I7;
constexpr int I1 = (DM / 32) * KB_D, I2 = (XW / 32) * KB_D, I4 = (DM / 32) * (XW / 64), I5 = (2 * FFN / 32) * KB_D, I6 = (DM / 32) * (FFN / 64), N_LATE = I1 + I2 + I4 + I5 + I6;
constexpr int N_LATE_P1 = I1 + I2 + I4 + 2560;
constexpr int N_LATE_P2 = N_LATE_P1 + 2440;
__device__ __forceinline__ void early_item(const Args& a, int r, LAS float* scr, int lane) {
    unsigned char* ws = a.ws;
    if (r < I0) { const int rg = r / KB_D, kb = r % KB_D, d = rg * 32; int src = d, nv = 32;
        if (d >= 3072 && d < 5120) src = d + 8; else if (d == 5120) { src = 3072; nv = 8; } else if (d > 5120) { src = 0; nv = 0; }
        transpose_item<false>(a.in[I_WIN], INW, kb * 64, src, nv, nullptr, (bf16*)(ws + WS_WIN), DM, d, scr, lane); return; } r -= I0;
    if (r < I3) { const int rg = r / KB_D, kb = r % KB_D;
        transpose_item<false>(a.in[I_WCKV], 2 * XW, kb * 64, rg * 32, 32, nullptr, (bf16*)(ws + WS_WCKV), DM, rg * 32, scr, lane); return; } r -= I3;
    { const int mtx = r >> 3, sub = r & 7, rg = sub >> 1, kb = sub & 1, n = mtx >> 1, which = mtx & 1;
        transpose_item<false>((which ? a.in[I_WRI] : a.in[I_WRA]) + (size_t)n * 128 * 128, 128, kb * 64, rg * 32, 32, nullptr, (bf16*)(ws + WS_WLRU) + (size_t)(n * 256 + which * 128) * 128, 128, rg * 32, scr, lane); }
}
__device__ __forceinline__ void late_item(const Args& a, int r, LAS float* scr, int lane) {
    unsigned char* ws = a.ws;
    if (r < I1) { const int rg = r / KB_D, kb = r % KB_D; const float* ks = kb < 16 ? a.in[I_GFOX] : a.in[I_GLRU] - 1024;
        transpose_item<true>(a.in[I_WOUT], DM, kb * 64, rg * 32, 32, ks, (bf16*)(ws + WS_WOUT), DM, rg * 32, scr, lane); return; } r -= I1;
    if (r < I2) { const int rg = r / KB_D, kb = r % KB_D;
        transpose_item<true>(a.in[I_WCQ], XW, kb * 64, rg * 32, 32, a.in[I_GXATTN], (bf16*)(ws + WS_WCQ), DM, rg * 32, scr, lane); return; } r -= I2;
    if (r < I4) { const int rg = r / (XW / 64), kb = r % (XW / 64);
        transpose_item<true>(a.in[I_WCO], DM, kb * 64, rg * 32, 32, nullptr, (bf16*)(ws + WS_WCO), XW, rg * 32, scr, lane); return; } r -= I4;
    if (r < I5) { const int rg = r / KB_D, kb = r % KB_D, d = rg * 32, tile = d >> 8, w = d & 255; const int src = w < 128 ? tile * 128 + w : FFN + tile * 128 + (w - 128);
        transpose_item<true>(a.in[I_WGU], 2 * FFN, kb * 64, src, 32, a.in[I_GFFN], (bf16*)(ws + WS_WGU), DM, d, scr, lane); return; } r -= I5;
    { const int rg = r / (FFN / 64), kb = r % (FFN / 64);
        transpose_item<true>(a.in[I_WDN], DM, kb * 64, rg * 32, 32, nullptr, (bf16*)(ws + WS_WDN), FFN, rg * 32, scr, lane); }
}
__device__ __forceinline__ void late_range(const Args& a, LAS unsigned char* lds, int lo, int hi, int w, int nw, int wave, int lane) {
    LAS float* scr = (LAS float*)(lds + wave * 16384);
    for (int it = lo + w; it < hi; it += nw) late_item(a, it, scr, lane);
}
__device__ __forceinline__ void p0_prologue(const Args& a, LAS unsigned char* lds, int wave, int lane, int G) {
    unsigned char* ws = a.ws;
    LAS float* scr = (LAS float*)(lds + wave * 16384);
    const int gw = blockIdx.x * NWAVES + wave, NGW = G * NWAVES;
    for (int it = gw; it < N_EARLY; it += NGW) early_item(a, it, scr, lane);
    if (G != 256) for (int it = gw; it < N_LATE; it += NGW) late_item(a, it, scr, lane);
    for (int m = gw; m < M + MMEM; m += NGW) {
        if (m < M) rms_row_to_bf16(a.in[I_X] + (size_t)m * DM, a.in[I_GMIX], (bf16*)(ws + WS_XN) + (size_t)m * DM, lane);
        else rms_row_to_bf16(a.in[I_MEM] + (size_t)(m - M) * DM, a.in[I_GMEM], (bf16*)(ws + WS_MN) + (size_t)(m - M) * DM, lane);
    }
}

__device__ __forceinline__ void conv_chunk(const bf16* U, bf16* UC, const float* cw, const float* cbias, int row0, int s0, int nblk, int tid) {
    asm volatile("" : "+v"(tid));
    const int c8 = nblk * 128 + (tid & 15) * 8;
    f32x4 w[4][2], bb[2];
#pragma unroll
    for (int j = 0; j < 4; ++j) { w[j][0] = *(const f32x4*)(cw + j * LRUW + c8); w[j][1] = *(const f32x4*)(cw + j * LRUW + c8 + 4); }
    bb[0] = *(const f32x4*)(cbias + c8); bb[1] = *(const f32x4*)(cbias + c8 + 4);
#pragma unroll 2
    for (int p = 0; p < 8; ++p) { const int rl = p * 32 + (tid >> 4), s = s0 + rl; const unsigned grow = (unsigned)(row0 + rl);
        f32x4 a0 = bb[0], a1 = bb[1];
#pragma unroll
        for (int j = 0; j < 4; ++j) { if (s - 3 + j >= 0) { const v4u uw = *(const v4u*)((const char*)U + ((grow - 3 + j) * LRUW + c8) * 2u);
            a0 += w[j][0] * (f32x4){bflo(uw.x), bfhi(uw.x), bflo(uw.y), bfhi(uw.y)}; a1 += w[j][1] * (f32x4){bflo(uw.z), bfhi(uw.z), bflo(uw.w), bfhi(uw.w)}; } }
        v4u o; o.x = pk2(a0.x, a0.y); o.y = pk2(a0.z, a0.w); o.z = pk2(a1.x, a1.y); o.w = pk2(a1.z, a1.w);
        *(v4u*)((char*)UC + (grow * LRUW + c8) * 2u) = o; }
}

__global__ void __launch_bounds__(NTHR, LB2) hymba_fwd(Args a) {
    extern __shared__ __attribute__((aligned(16))) unsigned char lds_raw[];
    cg::grid_group grid = cg::this_grid();
    LAS unsigned char* lds = (LAS unsigned char*)lds_raw;
    { const int t0 = threadIdx.x; if ((t0 & 63) == 0) *(volatile LAS int*)(lds + WTAB_OFF + hw_slot() * 4) = t0 >> 6;
      if (t0 < 2) *(volatile LAS unsigned*)(lds + XBST_OFF + t0 * 4) = 0u; }
    __syncthreads();
    const XcdBarrier xbar = xcd_barrier_post((unsigned*)a.ws, (volatile LAS unsigned*)(lds + XBST_OFF));
    const int G = gridDim.x, c = blockIdx.x;
#define WIN ((bf16*)(a.ws + WS_WIN))
#define WOUT ((bf16*)(a.ws + WS_WOUT))
#define WCQ ((bf16*)(a.ws + WS_WCQ))
#define WCKV ((bf16*)(a.ws + WS_WCKV))
#define WCO ((bf16*)(a.ws + WS_WCO))
#define WGU ((bf16*)(a.ws + WS_WGU))
#define WDN ((bf16*)(a.ws + WS_WDN))
#define WLRU ((bf16*)(a.ws + WS_WLRU))
#define XN ((bf16*)(a.ws + WS_XN))
#define MN ((bf16*)(a.ws + WS_MN))
#define Qh ((bf16*)(a.ws + WS_Q))
#define Kh ((bf16*)(a.ws + WS_K))
#define Vh ((bf16*)(a.ws + WS_V))
#define U ((bf16*)(a.ws + WS_U))
#define GG ((bf16*)(a.ws + WS_GG))
#define UC ((bf16*)(a.ws + WS_UC))
#define LF ((float*)(a.ws + WS_LF))
#define CK ((bf16*)(a.ws + WS_CK))
#define CV ((bf16*)(a.ws + WS_CV))
#define MIX ((bf16*)(a.ws + WS_MIX))
#define SSQF ((float*)(a.ws + WS_SSQF))
#define SSQL ((float*)(a.ws + WS_SSQL))
#define X1 ((float*)(a.ws + WS_X1))
#define X1B ((bf16*)(a.ws + WS_X1B))
#define SSQ1 ((float*)(a.ws + WS_SSQ1))
#define CQ ((bf16*)(a.ws + WS_CQ))
#define OX ((bf16*)(a.ws + WS_OX))
#define X2B ((bf16*)(a.ws + WS_X2B))
#define SSQ2 ((float*)(a.ws + WS_SSQ2))
#define H ((bf16*)(a.ws + WS_H))
#define HL ((bf16*)(a.ws + WS_HL))
#define AC ((bf16*)(a.ws + WS_AC))
#define ENDH ((float*)(a.ws + WS_ENDH))
#define ENDA ((float*)(a.ws + WS_ENDA))
#define red ((PG8_LAS float*)(lds + RED_OFF))

    for (int rep = 0; rep < 1 + ((REP >> 0) & 1); ++rep) {
    if (PH & 1) { int tid = my_tid(); p0_prologue(a, lds, __builtin_amdgcn_readfirstlane(tid >> 6), tid & 63, G); }
    GSYNC();
    if (a.ws == nullptr) grid.sync();
    }

    for (int rep = 0; rep < 1 + ((REP >> 1) & 1); ++rep) {
    if (PH & 2) {
        pg8::Gemm g{XN, WIN, M, INWP, DM, DM, DM}; pg8::StaticOrder S; S.init(M, INWP, G, c);
        pg8::EpiIn E{0, Qh, Kh, Vh, U, GG, LF, a.in[I_GQ], a.in[I_GK], a.in[I_BF], red};
        pg8::gemm_phase<pg8::EpiIn, pg8::StaticOrder, true, true>(lds, g, S, E);
        pg8::Gemm g2{MN, WCKV, MMEM, 2 * XW, DM, DM, DM}; pg8::StaticOrder S2; S2.init(MMEM, 2 * XW, G, (c + 16) % G);
        pg8::EpiCkv E2{0, CK, CV, a.in[I_GCK], red};
        pg8::gemm_phase<pg8::EpiCkv, pg8::StaticOrder, true, true>(lds, g2, S2, E2);
        if (G == 256 && c >= 160 && c < 240) { const int t2 = my_tid(); late_range(a, lds, 0, N_LATE_P1, (c - 160) * NWAVES + (t2 >> 6), 80 * NWAVES, __builtin_amdgcn_readfirstlane(t2 >> 6), t2 & 63); }
    }
    GSYNC();
    }

    for (int rep = 0; rep < 1 + ((REP >> 2) & 1); ++rep) {
    if (PH & 4) { int cL = c, tid = my_tid(); asm volatile("" : "+s"(cL));
      const int nl = G > 128 ? G - 128 : G;
      if (G <= 128 || cL >= 128)
      for (int L = (G > 128 ? cL - 128 : cL); L < 256; L += nl) {
            const int pm = L >> 3, nblk = L & 7, row0 = pm * 256;
            conv_chunk(U, UC, a.in[I_CONVW], a.in[I_CONVB], row0, (pm & 7) * 256, nblk, tid);
            VM_WAIT(); __syncthreads(); __builtin_amdgcn_fence(__ATOMIC_ACQUIRE, "agent");
            pg8::Gemm g{UC + (size_t)row0 * LRUW + nblk * 128, WLRU + (size_t)nblk * 256 * 128, 256, 256, 128, LRUW, 128}; pg8::OneUnit S;
            pg8::EpiLru E{0, UC, HL, AC, ENDH + pm * 1024, ENDA + pm * 1024, a.in[I_BRA], a.in[I_BRI], a.in[I_LAM], row0, nblk};
            pg8::gemm_phase<pg8::EpiLru, pg8::OneUnit, false, true>(lds, g, S, E);
      }
      if (G == 256 && cL >= 128) {
        VM_WAIT(); __syncthreads();
        if (my_tid() == 0) { unsigned* cnt = (unsigned*)(a.ws + 15360);
            __builtin_amdgcn_fence(__ATOMIC_RELEASE, "agent"); asm volatile("s_waitcnt vmcnt(0)" ::: "memory");
            (void)__hip_atomic_fetch_add(cnt, 1u, __ATOMIC_RELAXED, __HIP_MEMORY_SCOPE_AGENT);
            unsigned sp = 0; while (__hip_atomic_load(cnt, __ATOMIC_RELAXED, __HIP_MEMORY_SCOPE_AGENT) < 128u && ++sp < (1u << 22)) __builtin_amdgcn_s_sleep(1);
            __builtin_amdgcn_fence(__ATOMIC_ACQUIRE, "agent"); asm volatile("s_waitcnt vmcnt(0)" ::: "memory"); }
        __syncthreads();
#define P2B_FIRST (cL - 128)
#define P2B_STRIDE 128
    { int tid = my_tid();
      for (int L = P2B_FIRST; L < 256; L += P2B_STRIDE) { const int pm = L >> 3, nblk = L & 7, j = pm & 7, c8 = nblk * 128 + (tid & 15) * 8;
        f32x4 hi0 = {0.f, 0.f, 0.f, 0.f}, hi1 = {0.f, 0.f, 0.f, 0.f};
        for (int i = 0; i < j; ++i) { const float* eh = ENDH + (pm - j + i) * 1024 + c8; const float* ea = ENDA + (pm - j + i) * 1024 + c8;
            hi0 = *(const f32x4*)ea * hi0 + *(const f32x4*)eh; hi1 = *(const f32x4*)(ea + 4) * hi1 + *(const f32x4*)(eh + 4); }
#pragma unroll 2
        for (int p = 0; p < 8; ++p) { const unsigned row = (unsigned)(pm * 256 + p * 32 + (tid >> 4)), o = (row * 1024u + c8) * 2u;
            const v4u hw = __builtin_nontemporal_load((const v4u*)((const char*)HL + o)), aw = __builtin_nontemporal_load((const v4u*)((const char*)AC + o)), gw = __builtin_nontemporal_load((const v4u*)((const char*)GG + o));
            const f32x4 y0 = ((f32x4){bflo(hw.x), bfhi(hw.x), bflo(hw.y), bfhi(hw.y)} + (f32x4){bflo(aw.x), bfhi(aw.x), bflo(aw.y), bfhi(aw.y)} * hi0) * (f32x4){bflo(gw.x), bfhi(gw.x), bflo(gw.y), bfhi(gw.y)};
            const f32x4 y1 = ((f32x4){bflo(hw.z), bfhi(hw.z), bflo(hw.w), bfhi(hw.w)} + (f32x4){bflo(aw.z), bfhi(aw.z), bflo(aw.w), bfhi(aw.w)} * hi1) * (f32x4){bflo(gw.z), bfhi(gw.z), bflo(gw.w), bfhi(gw.w)};
            float ss = (y0.x * y0.x + y0.y * y0.y) + (y0.z * y0.z + y0.w * y0.w) + (y1.x * y1.x + y1.y * y1.y) + (y1.z * y1.z + y1.w * y1.w);
            v4u ow; ow.x = pk2(y0.x, y0.y); ow.y = pk2(y0.z, y0.w); ow.z = pk2(y1.x, y1.y); ow.w = pk2(y1.z, y1.w);
            *(v4u*)((char*)MIX + ((size_t)row * 2048 + 1024 + c8) * 2) = ow;
            ss += shx<1>(ss); ss += shx<2>(ss); ss += shx<4>(ss); ss += shx<8>(ss);
            if ((tid & 15) == 0) SSQL[row * 8 + nblk] = ss; } } }
#undef P2B_FIRST
#undef P2B_STRIDE
        { const int t2 = my_tid(); late_range(a, lds, N_LATE_P1, N_LATE_P2, (cL - 128) * NWAVES + (t2 >> 6), 128 * NWAVES, __builtin_amdgcn_readfirstlane(t2 >> 6), t2 & 63); } } }
    if (PH & 4) { int cF = c, tid = my_tid(); asm volatile("" : "+s"(cF)); const int lane = tid & 63, wave = __builtin_amdgcn_readfirstlane(tid >> 6);
      for (int L = cF; L < 128; L += G) {
        {
#if !defined(NO_FOX)
            const int it = L, bh = it >> 2, x = it & 3, b = bh >> 3, h = bh & 7;
            LAS float* cbl = (LAS float*)(lds + CB_OFF); LAS float* wsum = (LAS float*)(lds + WSUM_OFF);
            { const float* lf = LF + ((size_t)b * SEQ + tid * 4) * 8 + h;
              const float v0 = lf[0], v1 = lf[8], v2 = lf[16], v3 = lf[24]; const float t0 = v0, t1 = t0 + v1, t2 = t1 + v2, t3 = t2 + v3;
              wsum[tid] = t3; __syncthreads();
              for (int o = 1; o < 512; o <<= 1) { const float v = wsum[tid] + (tid >= o ? wsum[tid - o] : 0.f); __syncthreads(); wsum[tid] = v; __syncthreads(); }
              const float off = wsum[tid] - t3;
              const float ns = -1.0f / att::SCALE;
              *(LAS f32x4*)(cbl + tid * 4) = (f32x4){(off + t0) * ns, (off + t1) * ns, (off + t2) * ns, (off + t3) * ns};
              __syncthreads(); }
            typedef att::BlockRef<att::bf16, att::bf16> BR;
            BR cur, nxt;
            { const size_t hrow = (size_t)bh * SEQ;
              cur.Q = (const att::bf16*)Qh + (hrow + x * 256) * 128; cur.K = (const att::bf16*)Kh + hrow * 128; cur.V = (const att::bf16*)Vh + hrow * 128;
              cur.O = (att::bf16*)MIX + ((size_t)b * SEQ + x * 256) * 2048 + h * 128; cur.SS = FOX_SS; cur.P0 = x * 256;
              nxt = cur; const int d = (7 - 2 * x) * 256;
              nxt.Q += (size_t)d * 128; nxt.O += (size_t)d * 2048; nxt.SS += (size_t)d * 8; nxt.P0 += d; }
            att::Seam<att::bf16> S;
            att::causal_swa_prime<att::bf16, att::bf16>(cur, 1 << 20, (char*)lds_raw, S);
            for (int p = 0; p < 2; ++p) {
                att::causal_swa_block<att::bf16, att::bf16, 2048, FOX_HAS_SS>(cur, nxt, SEQ, 1 << 20, (char*)lds_raw, S, FOX_CB);
                cur = nxt; }
            VM_WAIT(); __syncthreads(); __builtin_amdgcn_fence(__ATOMIC_ACQUIRE, "agent");
            for (int p = 0; p < 16; ++p) { const int qb = (p < 8) ? x : 7 - x, rl = (p & 7) * 32 + (tid >> 4); const size_t trow = (size_t)b * SEQ + qb * 256 + rl;
                const v4u w = *(const v4u*)(MIX + trow * 2048 + h * 128 + (tid & 15) * 8);
                float ss = (bflo(w.x) * bflo(w.x) + bfhi(w.x) * bfhi(w.x)) + (bflo(w.y) * bflo(w.y) + bfhi(w.y) * bfhi(w.y)) + (bflo(w.z) * bflo(w.z) + bfhi(w.z) * bfhi(w.z)) + (bflo(w.w) * bflo(w.w) + bfhi(w.w) * bfhi(w.w));
                ss += shx<1>(ss); ss += shx<2>(ss); ss += shx<4>(ss); ss += shx<8>(ss);
                if ((tid & 15) == 0) SSQF[trow * 8 + h] = ss; }
            VM_WAIT(); __syncthreads();
#endif
        }
    } }
    GSYNC();
    }

    if (G != 256) {
#define P2B_FIRST c
#define P2B_STRIDE G
    { int tid = my_tid();
      for (int L = P2B_FIRST; L < 256; L += P2B_STRIDE) { const int pm = L >> 3, nblk = L & 7, j = pm & 7, c8 = nblk * 128 + (tid & 15) * 8;
        f32x4 hi0 = {0.f, 0.f, 0.f, 0.f}, hi1 = {0.f, 0.f, 0.f, 0.f};
        for (int i = 0; i < j; ++i) { const float* eh = ENDH + (pm - j + i) * 1024 + c8; const float* ea = ENDA + (pm - j + i) * 1024 + c8;
            hi0 = *(const f32x4*)ea * hi0 + *(const f32x4*)eh; hi1 = *(const f32x4*)(ea + 4) * hi1 + *(const f32x4*)(eh + 4); }
#pragma unroll 2
        for (int p = 0; p < 8; ++p) { const unsigned row = (unsigned)(pm * 256 + p * 32 + (tid >> 4)), o = (row * 1024u + c8) * 2u;
            const v4u hw = __builtin_nontemporal_load((const v4u*)((const char*)HL + o)), aw = __builtin_nontemporal_load((const v4u*)((const char*)AC + o)), gw = __builtin_nontemporal_load((const v4u*)((const char*)GG + o));
            const f32x4 y0 = ((f32x4){bflo(hw.x), bfhi(hw.x), bflo(hw.y), bfhi(hw.y)} + (f32x4){bflo(aw.x), bfhi(aw.x), bflo(aw.y), bfhi(aw.y)} * hi0) * (f32x4){bflo(gw.x), bfhi(gw.x), bflo(gw.y), bfhi(gw.y)};
            const f32x4 y1 = ((f32x4){bflo(hw.z), bfhi(hw.z), bflo(hw.w), bfhi(hw.w)} + (f32x4){bflo(aw.z), bfhi(aw.z), bflo(aw.w), bfhi(aw.w)} * hi1) * (f32x4){bflo(gw.z), bfhi(gw.z), bflo(gw.w), bfhi(gw.w)};
            float ss = (y0.x * y0.x + y0.y * y0.y) + (y0.z * y0.z + y0.w * y0.w) + (y1.x * y1.x + y1.y * y1.y) + (y1.z * y1.z + y1.w * y1.w);
            v4u ow; ow.x = pk2(y0.x, y0.y); ow.y = pk2(y0.z, y0.w); ow.z = pk2(y1.x, y1.y); ow.w = pk2(y1.z, y1.w);
            *(v4u*)((char*)MIX + ((size_t)row * 2048 + 1024 + c8) * 2) = ow;
            ss += shx<1>(ss); ss += shx<2>(ss); ss += shx<4>(ss); ss += shx<8>(ss);
            if ((tid & 15) == 0) SSQL[row * 8 + nblk] = ss; } } }
#undef P2B_FIRST
#undef P2B_STRIDE
    GSYNC(); }

    for (int rep = 0; rep < 1 + ((REP >> 3) & 1); ++rep) {
    if (PH & 8) {
        pg8::Gemm g{MIX, WOUT, M, DM, DM, DM, DM}; pg8::StaticOrder S; S.init(M, DM, G, c);
        pg8::EpiRes<true> E{16, a.in[I_X], nullptr, nullptr, X1B, SSQ1, SSQF, SSQL};
        pg8::gemm_phase<pg8::EpiRes<true>, pg8::StaticOrder, true, true>(lds, g, S, E);
    }
    GSYNC();
    }

    for (int rep = 0; rep < 1 + ((REP >> 4) & 1); ++rep) {
    if (PH & 16) {
        pg8::Gemm g{X1B, WCQ, M, XW, DM, DM, DM}; pg8::StaticOrder S; S.init(M, XW, G, c);
        pg8::EpiCq E{0, CQ, a.in[I_GCQ], SSQ1, red};
        pg8::gemm_phase<pg8::EpiCq, pg8::StaticOrder, true, true>(lds, g, S, E);
        if (G == 256 && c >= 64) { const int t2 = my_tid(); late_range(a, lds, N_LATE_P2, N_LATE, (c - 64) * NWAVES + (t2 >> 6), 192 * NWAVES, __builtin_amdgcn_readfirstlane(t2 >> 6), t2 & 63); }
    }
    GSYNC();
    }

    for (int rep = 0; rep < 1 + ((REP >> 5) & 1); ++rep) {
    if (PH & 32) for (int L = c; L < 128; L += G) {
        const int bh = L >> 3, qb = L & 7, b = bh >> 2, h = bh & 3;
        att::BlockRef<att::bf16, att::bf16> r;
        r.Q = (const att::bf16*)CQ + ((size_t)bh * SEQ + qb * 256) * 128; r.K = (const att::bf16*)CK + (size_t)bh * NMEM * 128; r.V = (const att::bf16*)CV + (size_t)bh * NMEM * 128;
        r.O = (att::bf16*)OX + ((size_t)b * SEQ + qb * 256) * XW + h * 128; r.SS = nullptr; r.P0 = 1 << 16;
        att::Seam<att::bf16> S;
        att::causal_swa_prime<att::bf16, att::bf16>(r, 1 << 20, (char*)lds_raw, S);
        att::causal_swa_block<att::bf16, att::bf16, XW, false>(r, r, NMEM, 1 << 20, (char*)lds_raw, S, -1);
        VM_WAIT(); __syncthreads();
    }
    GSYNC();
    }

    for (int rep = 0; rep < 1 + ((REP >> 6) & 1); ++rep) {
    if (PH & 64) {
        pg8::Gemm g{OX, WCO, M, DM, XW, XW, XW}; pg8::StaticOrder S; S.init(M, DM, G, c);
        pg8::EpiRes<false> E{0, nullptr, X1B, nullptr, X2B, SSQ2, nullptr, nullptr};
        pg8::gemm_phase<pg8::EpiRes<false>, pg8::StaticOrder, true, true>(lds, g, S, E);
    }
    GSYNC();
    }

    for (int rep = 0; rep < 1 + ((REP >> 7) & 1); ++rep) {
    if (PH & 128) {
        pg8::Gemm g{X2B, WGU, M, 2 * FFN, DM, DM, DM}; pg8::StaticOrder S; S.init(M, 2 * FFN, G, c);
        pg8::EpiGu E{0, H, SSQ2, red};
        pg8::gemm_phase<pg8::EpiGu, pg8::StaticOrder, true, true>(lds, g, S, E);
    }
    GSYNC();
    }

    if (PH & 256) {
        pg8::Gemm g{H, WDN, M, DM, FFN, FFN, FFN}; pg8::StaticOrder S; S.init(M, DM, G, c);
        pg8::EpiRes<false> E{0, nullptr, X2B, a.out, nullptr, nullptr, nullptr, nullptr};
        pg8::gemm_phase<pg8::EpiRes<false>, pg8::StaticOrder, true, true>(lds, g, S, E);
    }
}

#undef WIN
#undef WOUT
#undef WCQ
#undef WCKV
#undef WCO
#undef WGU
#undef WDN
#undef WLRU
#undef XN
#undef MN
#undef Qh
#undef Kh
#undef Vh
#undef U
#undef GG
#undef UC
#undef LF
#undef CK
#undef CV
#undef MIX
#undef SSQF
#undef SSQL
#undef X1
#undef X1B
#undef SSQ1
#undef CQ
#undef OX
#undef X2B
#undef SSQ2
#undef H
#undef HL
#undef AC
#undef ENDH
#undef ENDA
#undef red
extern "C" void kernel_launch(void* const* d_in, const int* in_sizes, int n_in, void* d_out, int out_size, void* d_ws, size_t ws_size, hipStream_t stream) {
    static int grid = 0;
    if (grid == 0) {
        if (n_in != 27 || in_sizes[0] != M * DM || out_size != M * DM || ws_size < WS_END) { fprintf(stderr, "kernel_launch: unexpected shapes (n_in %d, in0 %d, out %d, ws %zu)\n", n_in, n_in > 0 ? in_sizes[0] : -1, out_size, ws_size); grid = -1; return; }
        int dev = 0, cus = 0, per_cu = 0;
        (void)hipGetDevice(&dev); (void)hipDeviceGetAttribute(&cus, hipDeviceAttributeMultiprocessorCount, dev);
        if (hipFuncSetAttribute((const void*)hymba_fwd, hipFuncAttributeMaxDynamicSharedMemorySize, LDS_BYTES) != hipSuccess) { fprintf(stderr, "kernel_launch: hipFuncSetAttribute failed\n"); grid = -1; return; }
        if (hipOccupancyMaxActiveBlocksPerMultiprocessor(&per_cu, (const void*)hymba_fwd, NTHR, LDS_BYTES) != hipSuccess || per_cu < 1) { fprintf(stderr, "kernel_launch: occupancy query says %d\n", per_cu); per_cu = 1; }
        (void)hipGetLastError();
        grid = cus * per_cu;
    }
    if (grid < 0) return;
    Args a{};
    for (int i = 0; i < 27; ++i) a.in[i] = (const float*)d_in[i];
    a.out = (float*)d_out; a.ws = (unsigned char*)d_ws;
    if (hipMemsetAsync(d_ws, 0, 16384, stream) != hipSuccess) { fprintf(stderr, "kernel_launch: memset of the barrier words failed\n"); return; }
    void* args[] = {&a};
    hipError_t e = hipLaunchCooperativeKernel((const void*)hymba_fwd, dim3(grid), dim3(NTHR), args, LDS_BYTES, stream);
    if (e != hipSuccess) fprintf(stderr, "cooperative launch failed: %s (grid %d)\n", hipGetErrorString(e), grid);
}
```

```cpp
#include <hip/hip_runtime.h>
#include <hip/hip_bf16.h>
#include <hip/hip_cooperative_groups.h>
#include <cstdio>
#include <cstdint>
namespace cg = cooperative_groups;


template <int K> __device__ __forceinline__ float shx(float v) { static_assert(K < 32, "use sum32"); return __int_as_float(__builtin_amdgcn_ds_swizzle(__float_as_int(v), (K << 10) | 0x1f)); }
__device__ __forceinline__ float sum32(float v) { auto rr = __builtin_amdgcn_permlane32_swap(__float_as_uint(v), __float_as_uint(v), false, false); return __uint_as_float(rr[0]) + __uint_as_float(rr[1]); }
constexpr int WTAB_OFF = 147456 - 256, XBST_OFF = 147456 - 512;
__device__ __forceinline__ int hw_slot() { return (int)(__builtin_amdgcn_s_getreg((5 << 11) | 4) & 63u); }
__device__ __forceinline__ int my_tid() {
    const int slot = hw_slot();
    const int wave = __builtin_amdgcn_readfirstlane(*(volatile __attribute__((address_space(3))) int*)(unsigned)(WTAB_OFF + slot * 4));
    int l; asm volatile("v_mbcnt_lo_u32_b32 %0, -1, 0\n\tv_mbcnt_hi_u32_b32 %0, -1, %0" : "=v"(l));
    return wave * 64 + l;
}
namespace pg8 {
#define PG8_LAS __attribute__((address_space(3)))
typedef unsigned short bf16_t;
typedef short bf16x8 __attribute__((ext_vector_type(8)));
typedef float f32x4 __attribute__((ext_vector_type(4)));
typedef unsigned u32x4 __attribute__((ext_vector_type(4)));
constexpr int BM = 256, BK = 64, HALF = 128, HTB = HALF * BK * 2  , STAGE_BYTES = 8 * HTB, NXCD = 8, WGM = 8;

__host__ __device__ __forceinline__ int lds_byte(int r, int c) { const int st = (r >> 4) * 2 + (c >> 5), rr = r & 15, cc = c & 31, ob = rr * 64 + cc * 2; return st * 1024 + (ob ^ (((ob >> 9) & 1) << 5)); }
__host__ __device__ __forceinline__ void stage_rc(int b, int& R, int& C) { const int st = b / 1024, sb = b % 1024, swz = sb ^ (((sb >> 9) & 1) << 5); R = (st >> 1) * 16 + swz / 64; C = (st & 1) * 32 + (swz % 64) / 2; }
__host__ __device__ __forceinline__ int perm32(int rho) { const int n = rho >> 4, i = rho & 15; return 8 * (i >> 2) + 4 * n + (i & 3); }

struct Unit { int pm, pn; };
struct Gemm { const bf16_t* A; const bf16_t* Bt; int M, N, K, lda, ldb; };

struct StaticOrder {
    int nM, nN, nwg, G, c;
    __host__ __device__ void init(int M, int N, int G_, int c_) { nM = M / BM; nN = N / BM; nwg = nM * nN; G = G_; c = c_; }
    __host__ __device__ bool next(int i, Unit& u) const {
        const long L = (long)i * G + c; if (L >= nwg) return false;
        int wgid = (int)L; { const int q = nwg / NXCD, r = nwg % NXCD, xcd = wgid % NXCD, off = wgid / NXCD; wgid = (xcd < r ? xcd * (q + 1) : r * (q + 1) + (xcd - r) * q) + off; }
        const int nig = WGM * nN, gid = wgid / nig, fm = gid * WGM, gsz = (nM - fm) < WGM ? (nM - fm) : WGM;
        u.pm = fm + ((wgid % nig) % gsz); u.pn = (wgid % nig) / gsz; return true;
    }
    __device__ __forceinline__ void a_ready(const Unit&) const {}
    __device__ __forceinline__ void done(const Unit&) const {}
};

__device__ __forceinline__ unsigned cvt_pk_bf16(float lo, float hi) { unsigned r; asm volatile("v_cvt_pk_bf16_f32 %0, %1, %2" : "=v"(r) : "v"(lo), "v"(hi)); return r; }

typedef float f32x2 __attribute__((ext_vector_type(2)));
constexpr float RMS_EPS = 1e-6f;
struct OneUnit {
    __device__ __forceinline__ bool next(int i, Unit& u) const { if (i != 0) return false; u.pm = 0; u.pn = 0; return true; }
    __device__ __forceinline__ void a_ready(const Unit&) const {}
    __device__ __forceinline__ void done(const Unit&) const {}
};
struct OffsetOrder {
    StaticOrder S;
    __device__ __forceinline__ bool next(int i, Unit& u) const { return S.next(i, u); }
    __device__ __forceinline__ void a_ready(const Unit&) const {}
    __device__ __forceinline__ void done(const Unit&) const {}
};
__device__ __forceinline__ float fast_log1p(float x) { const float sr = x * (1.0f - x * (0.5f - x * (0.33333334f - x * (0.25f - x * (0.2f - x * 0.16666667f))))); return x < 0.0625f ? sr : __logf(1.0f + x); }
__device__ __forceinline__ float sigmoidf_(float x) { return __builtin_amdgcn_rcpf(1.0f + __expf(-x)); }
__device__ __forceinline__ float gelu_tanh(float x) { const float u = 0.7978845608028654f * (x + 0.044715f * x * x * x); return x * sigmoidf_(2.0f * u); }
__device__ __forceinline__ float sum_f(const float* p, int n4) { float s = 0.f; for (int i = 0; i < n4; ++i) { const f32x4 v = *(const f32x4*)(p + 4 * i); s += (v[0] + v[1]) + (v[2] + v[3]); } return s; }
__device__ __forceinline__ u32x4 pack8(const f32x4& a, const f32x4& b) { u32x4 w; w.x = cvt_pk_bf16(a[0], a[1]); w.y = cvt_pk_bf16(a[2], a[3]); w.z = cvt_pk_bf16(b[0], b[1]); w.w = cvt_pk_bf16(b[2], b[3]); return w; }

template <int ACT  >
__device__ __forceinline__ void store_tile(const f32x4 (&acc)[2][2][4][2], bf16_t* d0, bf16_t* d1, size_t ld, int wr, int wc, int fr, int fq) {
#pragma unroll
    for (int ai = 0; ai < 2; ++ai)
#pragma unroll
        for (int m = 0; m < 4; ++m) { const size_t ro = (size_t)(ai * HALF + wr * 64 + m * 16 + fr) * ld + wc * 32 + fq * 8;
#pragma unroll
            for (int bj = 0; bj < 2; ++bj) { f32x4 v0 = acc[ai][bj][m][0], v1 = acc[ai][bj][m][1];
                if (ACT == 1) {
#pragma unroll
                    for (int j = 0; j < 4; ++j) { v0[j] = gelu_tanh(v0[j]); v1[j] = gelu_tanh(v1[j]); } }
                *(u32x4*)((bj ? d1 : d0) + ro) = pack8(v0, v1); } }
}
template <bool ROWSCALE>
__device__ __forceinline__ void head_norm_store(const f32x4 (&acc)[2][2][4][2], const float (&rs)[2][4], const float* gain, bf16_t* d0, bf16_t* d1, PG8_LAS float* red, int wr, int wc, int fr, int fq) {
#pragma unroll
    for (int ai = 0; ai < 2; ++ai)
#pragma unroll
        for (int m = 0; m < 4; ++m)
#pragma unroll
            for (int bj = 0; bj < 2; ++bj) { float s = 0.f;
#pragma unroll
                for (int n = 0; n < 2; ++n) { f32x4 v = acc[ai][bj][m][n]; if (ROWSCALE) v = v * rs[ai][m]; s += (v[0] * v[0] + v[1] * v[1]) + (v[2] * v[2] + v[3] * v[3]); }
                s += shx<16>(s); s = sum32(s);
                if (fq == 0) red[((ai * HALF + wr * 64 + m * 16 + fr) * 2 + bj) * 4 + wc] = s; }
    asm volatile("s_waitcnt lgkmcnt(0)" ::: "memory"); __builtin_amdgcn_s_barrier(); asm volatile("" ::: "memory");
    const f32x4 g0 = *(const f32x4*)(gain + wc * 32 + fq * 8), g1 = *(const f32x4*)(gain + wc * 32 + fq * 8 + 4);
#pragma unroll
    for (int ai = 0; ai < 2; ++ai)
#pragma unroll
        for (int m = 0; m < 4; ++m) { const int rl = ai * HALF + wr * 64 + m * 16 + fr;
#pragma unroll
            for (int bj = 0; bj < 2; ++bj) { const PG8_LAS float* rp = red + (rl * 2 + bj) * 4;
                const float ss = (rp[0] + rp[1]) + (rp[2] + rp[3]);
                float sc = __builtin_amdgcn_rsqf(ss * (1.0f / 128.0f) + RMS_EPS); if (ROWSCALE) sc *= rs[ai][m];
                const f32x4 v0 = acc[ai][bj][m][0] * sc * g0, v1 = acc[ai][bj][m][1] * sc * g1;
                *(u32x4*)((bj ? d1 : d0) + (size_t)rl * 128 + wc * 32 + fq * 8) = pack8(v0, v1); } }
}

struct EpiIn {
    static constexpr bool PERM = true, AFTER_DRAIN = false, HAS_MID = false; int mid_t;
    bf16_t *Q, *Kh, *V, *U, *GG; float* LF; const float *g_q, *g_k, *b_f; PG8_LAS float* red;
    __device__ __forceinline__ void operator()(const f32x4 (&acc)[2][2][4][2], const Unit& u, int wr, int wc, int fr, int fq) const {
        asm volatile("" : "+v"(fr), "+v"(fq));
        const int pn = u.pn, row0 = u.pm * BM, b = row0 >> 11, s0 = row0 & 2047;
        if (pn < 12) {
            const int h0 = (pn & 3) * 2; bf16_t* const q_ = Q; bf16_t* const k_ = Kh; bf16_t* const v_ = V; const float* const gq_ = g_q; const float* const gk_ = g_k;
            bf16_t* base = pn < 4 ? q_ : (pn < 8 ? k_ : v_);
            bf16_t* d0 = base + ((size_t)(b * 8 + h0) * 2048 + s0) * 128; bf16_t* d1 = d0 + (size_t)2048 * 128;
            if (pn < 8) { float rs[2][4]; head_norm_store<false>(acc, rs, pn < 4 ? gq_ : gk_, d0, d1, red, wr, wc, fr, fq); }
            else store_tile<0>(acc, d0, d1, 128, wr, wc, fr, fq);
        } else if (pn < 16) { bf16_t* const u_ = U; bf16_t* d0 = u_ + (size_t)row0 * 1024 + (pn - 12) * 256; store_tile<0>(acc, d0, d0 + 128, 1024, wr, wc, fr, fq); }
        else if (pn < 20) { bf16_t* const g_ = GG; bf16_t* d0 = g_ + (size_t)row0 * 1024 + (pn - 16) * 256; store_tile<1>(acc, d0, d0 + 128, 1024, wr, wc, fr, fq); }
        else if (wc == 0 && fq == 0) {
            const f32x4 b0 = *(const f32x4*)b_f, b1 = *(const f32x4*)(b_f + 4);
#pragma unroll
            for (int ai = 0; ai < 2; ++ai)
#pragma unroll
                for (int m = 0; m < 4; ++m) { const int row = row0 + ai * HALF + wr * 64 + m * 16 + fr; f32x4 z0 = acc[ai][0][m][0] + b0, z1 = acc[ai][0][m][1] + b1;
#pragma unroll
                    for (int j = 0; j < 4; ++j) { z0[j] = fminf(z0[j], 0.f) - fast_log1p(__expf(-fabsf(z0[j]))); z1[j] = fminf(z1[j], 0.f) - fast_log1p(__expf(-fabsf(z1[j]))); }
                    *(f32x4*)(LF + (size_t)row * 8) = z0; *(f32x4*)(LF + (size_t)row * 8 + 4) = z1; }
        }
    }
};
struct EpiCkv {
    static constexpr bool PERM = true, AFTER_DRAIN = false, HAS_MID = false; int mid_t;
    bf16_t *CK, *CV; const float* g_ck; PG8_LAS float* red;
    __device__ __forceinline__ void operator()(const f32x4 (&acc)[2][2][4][2], const Unit& u, int wr, int wc, int fr, int fq) const {
        asm volatile("" : "+v"(fr), "+v"(fq));
        const int pn = u.pn, b = u.pm, h0 = (pn & 1) * 2;
        bf16_t* const ck_ = CK; bf16_t* const cv_ = CV; bf16_t* d0 = (pn < 2 ? ck_ : cv_) + ((size_t)(b * 4 + h0) * 256) * 128; bf16_t* d1 = d0 + (size_t)256 * 128;
        if (pn < 2) { float rs[2][4]; head_norm_store<false>(acc, rs, g_ck, d0, d1, red, wr, wc, fr, fq); }
        else store_tile<0>(acc, d0, d1, 128, wr, wc, fr, fq);
    }
};
struct EpiCq {
    static constexpr bool PERM = true, AFTER_DRAIN = false, HAS_MID = false; int mid_t;
    bf16_t* CQ; const float* g_cq; const float* SSQ; PG8_LAS float* red;
    __device__ __forceinline__ void operator()(const f32x4 (&acc)[2][2][4][2], const Unit& u, int wr, int wc, int fr, int fq) const {
        asm volatile("" : "+v"(fr), "+v"(fq));
        const int pn = u.pn, row0 = u.pm * BM, b = row0 >> 11, s0 = row0 & 2047, h0 = pn * 2, tid = (wr * 4 + wc) * 64 + fq * 16 + fr;
        PG8_LAS float* tab = red + 2048;
        if (tid < 256) tab[tid] = __builtin_amdgcn_rsqf(sum_f(SSQ + (size_t)(row0 + tid) * 32, 8) * (1.0f / 2048.0f) + RMS_EPS);
        asm volatile("s_waitcnt lgkmcnt(0)" ::: "memory"); __builtin_amdgcn_s_barrier(); asm volatile("" ::: "memory");
        float rs[2][4];
#pragma unroll
        for (int ai = 0; ai < 2; ++ai)
#pragma unroll
            for (int m = 0; m < 4; ++m) rs[ai][m] = tab[ai * HALF + wr * 64 + m * 16 + fr];
        bf16_t* d0 = CQ + ((size_t)(b * 4 + h0) * 2048 + s0) * 128; bf16_t* d1 = d0 + (size_t)2048 * 128;
        head_norm_store<true>(acc, rs, g_cq, d0, d1, red, wr, wc, fr, fq);
    }
};
template <bool MID> struct EpiRes {
    static constexpr bool PERM = true, AFTER_DRAIN = false, HAS_MID = MID; int mid_t;
    const float* resid; const bf16_t* residb; float* outf; bf16_t* outb; float* ssq_out; const float *ssqf, *ssql;
    __device__ __forceinline__ void mid(f32x4 (&acc)[2][2][4][2], const Unit& u, int wr, int wc, int fr, int fq) const {
        asm volatile("" : "+v"(fr), "+v"(fq));
#pragma unroll
        for (int ai = 0; ai < 2; ++ai)
#pragma unroll
            for (int m = 0; m < 4; ++m) { const size_t row = (size_t)u.pm * BM + ai * HALF + wr * 64 + m * 16 + fr;
                const float rf = __builtin_amdgcn_rsqf(sum_f(ssqf + row * 8, 2) * (1.0f / 1024.0f) + RMS_EPS), rl = __builtin_amdgcn_rsqf(sum_f(ssql + row * 8, 2) * (1.0f / 1024.0f) + RMS_EPS);
                const float ratio = rf / rl;
#pragma unroll
                for (int bj = 0; bj < 2; ++bj)
#pragma unroll
                    for (int n = 0; n < 2; ++n) acc[ai][bj][m][n] = acc[ai][bj][m][n] * ratio;
                __builtin_amdgcn_sched_barrier(0); }
    }
    __device__ __forceinline__ void operator()(const f32x4 (&acc)[2][2][4][2], const Unit& u, int wr, int wc, int fr, int fq) const {
        asm volatile("" : "+v"(fr), "+v"(fq));
#pragma unroll
        for (int ai = 0; ai < 2; ++ai)
#pragma unroll
            for (int m = 0; m < 4; ++m) { const size_t row = (size_t)u.pm * BM + ai * HALF + wr * 64 + m * 16 + fr;
                float sc = 1.f; if (MID) sc = __builtin_amdgcn_rsqf(sum_f(ssql + row * 8, 2) * (1.0f / 1024.0f) + RMS_EPS);
                float ss = 0.f;
#pragma unroll
                for (int bj = 0; bj < 2; ++bj) { const size_t o = row * 2048 + u.pn * BM + bj * HALF + wc * 32 + fq * 8;
                    f32x4 r0, r1;
                    if (residb) { const u32x4 w = __builtin_nontemporal_load((const u32x4*)(residb + o));     r0 = (f32x4){__uint_as_float(w.x << 16), __uint_as_float(w.x & 0xffff0000u), __uint_as_float(w.y << 16), __uint_as_float(w.y & 0xffff0000u)};
                                  r1 = (f32x4){__uint_as_float(w.z << 16), __uint_as_float(w.z & 0xffff0000u), __uint_as_float(w.w << 16), __uint_as_float(w.w & 0xffff0000u)}; }
                    else { r0 = __builtin_nontemporal_load((const f32x4*)(resid + o)); r1 = __builtin_nontemporal_load((const f32x4*)(resid + o + 4)); }
                    const f32x4 v0 = r0 + acc[ai][bj][m][0] * sc, v1 = r1 + acc[ai][bj][m][1] * sc;
                    if (outf) { __builtin_nontemporal_store(v0, (f32x4*)(outf + o)); __builtin_nontemporal_store(v1, (f32x4*)(outf + o + 4)); }
                    ss += (v0[0] * v0[0] + v0[1] * v0[1]) + (v0[2] * v0[2] + v0[3] * v0[3]) + (v1[0] * v1[0] + v1[1] * v1[1]) + (v1[2] * v1[2] + v1[3] * v1[3]);
                    if (outb) *(u32x4*)(outb + o) = pack8(v0, v1); }
                if (ssq_out) { ss += shx<16>(ss); ss = sum32(ss); if (fq == 0) ssq_out[row * 32 + u.pn * 4 + wc] = ss; }
                __builtin_amdgcn_sched_barrier(0); }
    }
};
struct EpiGu {
    static constexpr bool PERM = true, AFTER_DRAIN = false, HAS_MID = false; int mid_t;
    bf16_t* H; const float* SSQ; PG8_LAS float* red;
    __device__ __forceinline__ void operator()(const f32x4 (&acc)[2][2][4][2], const Unit& u, int wr, int wc, int fr, int fq) const {
        asm volatile("" : "+v"(fr), "+v"(fq));
        const int tid = (wr * 4 + wc) * 64 + fq * 16 + fr; PG8_LAS float* tab = red + 2048;
        if (tid < 256) tab[tid] = __builtin_amdgcn_rsqf(sum_f(SSQ + ((size_t)u.pm * BM + tid) * 32, 8) * (1.0f / 2048.0f) + RMS_EPS);
        asm volatile("s_waitcnt lgkmcnt(0)" ::: "memory"); __builtin_amdgcn_s_barrier(); asm volatile("" ::: "memory");
#pragma unroll
        for (int ai = 0; ai < 2; ++ai)
#pragma unroll
            for (int m = 0; m < 4; ++m) { const size_t row = (size_t)u.pm * BM + ai * HALF + wr * 64 + m * 16 + fr;
                const float rs = tab[ai * HALF + wr * 64 + m * 16 + fr];
                f32x4 h[2];
#pragma unroll
                for (int n = 0; n < 2; ++n) { const f32x4 g = acc[ai][0][m][n] * rs, up = acc[ai][1][m][n] * rs;
#pragma unroll
                    for (int j = 0; j < 4; ++j) h[n][j] = g[j] * sigmoidf_(g[j]) * up[j]; }
                *(u32x4*)(H + row * 5632 + u.pn * HALF + wc * 32 + fq * 8) = pack8(h[0], h[1]); }
    }
};
struct EpiLru {
    static constexpr bool PERM = true, AFTER_DRAIN = true, HAS_MID = false; int mid_t;
    const bf16_t* UC; bf16_t* HL; bf16_t* AC; float* ENDH; float* ENDA; const float *b_ra, *b_ri, *lam; int row0, nblk;
    __device__ __forceinline__ void fused(f32x4 (&acc)[2][2][4][2], const Unit&, int wr, int wc, int fr, int fq, PG8_LAS unsigned char* lds, int wid, int lane) const {
        asm volatile("" : "+v"(fr), "+v"(fq));
        PG8_LAS float* LA = (PG8_LAS float*)lds; PG8_LAS float* LB = LA + 128 * 132; PG8_LAS float* SX = LB + 128 * 132;
        const int tid = wid * 64 + lane, ch0 = nblk * 128 + wc * 32 + fq * 8;
#pragma unroll
        for (int ai = 0; ai < 2; ++ai) {
#pragma unroll
            for (int n = 0; n < 2; ++n) {
                const f32x4 bra = *(const f32x4*)(b_ra + ch0 + 4 * n), bri = *(const f32x4*)(b_ri + ch0 + 4 * n), lm = *(const f32x4*)(lam + ch0 + 4 * n); f32x4 sp;
#pragma unroll
                for (int j = 0; j < 4; ++j) sp[j] = -8.0f * fast_log1p(__expf(-lm[j]));
#pragma unroll
                for (int m = 0; m < 4; ++m) { const int rl = wr * 64 + m * 16 + fr; const unsigned grow = (unsigned)(row0 + ai * HALF + rl);
                    const f32x2 ucw = *(const f32x2*)((const char*)UC + (grow * 1024u + ch0 + 4 * n) * 2u); f32x4 av, bv;
#pragma unroll
                    for (int j = 0; j < 4; ++j) { const unsigned w = __float_as_uint(ucw[j >> 1]); const float uc = __uint_as_float((j & 1) ? (w & 0xffff0000u) : (w << 16));
                        const float r = sigmoidf_(acc[ai][0][m][n][j] + bra[j]), ig = sigmoidf_(acc[ai][1][m][n][j] + bri[j]);
                        const float la = r * sp[j], a_ = __expf(la); av[j] = a_; bv[j] = __builtin_amdgcn_sqrtf(fmaxf(fmaf(-a_, a_, 1.0f), 0.f)) * ig * uc; }
                    *(PG8_LAS f32x4*)(LA + rl * 132 + wc * 32 + fq * 8 + 4 * n) = av; *(PG8_LAS f32x4*)(LB + rl * 132 + wc * 32 + fq * 8 + 4 * n) = bv;
                    __builtin_amdgcn_sched_barrier(0); } }
            asm volatile("s_waitcnt lgkmcnt(0)" ::: "memory"); __builtin_amdgcn_s_barrier(); asm volatile("" ::: "memory");
            { const int cch = tid & 127, sg = tid >> 7; float h = 0.f, A = 1.f;
#pragma unroll 8
              for (int r = 0; r < 32; ++r) { const int rl = sg * 32 + r; const float a_ = LA[rl * 132 + cch]; h = a_ * h + LB[rl * 132 + cch]; A *= a_; LB[rl * 132 + cch] = h; LA[rl * 132 + cch] = A; }
              SX[(0 + sg) * 128 + cch] = h; SX[(4 + sg) * 128 + cch] = A; }
            asm volatile("s_waitcnt lgkmcnt(0)" ::: "memory"); __builtin_amdgcn_s_barrier(); asm volatile("" ::: "memory");
            if (tid < 128) { float H = ai == 0 ? 0.f : SX[16 * 128 + tid], A = ai == 0 ? 1.f : SX[17 * 128 + tid];
#pragma unroll
                for (int sg = 0; sg < 4; ++sg) { SX[(8 + sg) * 128 + tid] = H; SX[(12 + sg) * 128 + tid] = A; const float ae = SX[(4 + sg) * 128 + tid]; H = ae * H + SX[(0 + sg) * 128 + tid]; A *= ae; }
                SX[16 * 128 + tid] = H; SX[17 * 128 + tid] = A;
                if (ai == 1) { ENDH[nblk * 128 + tid] = H; ENDA[nblk * 128 + tid] = A; } }
            asm volatile("s_waitcnt lgkmcnt(0)" ::: "memory"); __builtin_amdgcn_s_barrier(); asm volatile("" ::: "memory");
            const int c8 = (tid & 15) * 8;
#pragma unroll
            for (int p = 0; p < 4; ++p) { const int rl = p * 32 + (tid >> 4); const unsigned o = ((unsigned)(row0 + ai * HALF + rl) * 1024u + nblk * 128 + c8) * 2u;
                const f32x4 ch0 = *(const PG8_LAS f32x4*)(SX + (8 + p) * 128 + c8), ch1 = *(const PG8_LAS f32x4*)(SX + (8 + p) * 128 + c8 + 4), ca0 = *(const PG8_LAS f32x4*)(SX + (12 + p) * 128 + c8), ca1 = *(const PG8_LAS f32x4*)(SX + (12 + p) * 128 + c8 + 4);
                const f32x4 a0 = *(const PG8_LAS f32x4*)(LA + rl * 132 + c8), a1 = *(const PG8_LAS f32x4*)(LA + rl * 132 + c8 + 4);
                const f32x4 h0 = *(const PG8_LAS f32x4*)(LB + rl * 132 + c8) + a0 * ch0, h1 = *(const PG8_LAS f32x4*)(LB + rl * 132 + c8 + 4) + a1 * ch1;
                *(u32x4*)((char*)HL + o) = pack8(h0, h1); *(u32x4*)((char*)AC + o) = pack8(a0 * ca0, a1 * ca1); }
            asm volatile("s_waitcnt lgkmcnt(0)" ::: "memory"); __builtin_amdgcn_s_barrier(); asm volatile("" ::: "memory");
        }
    }
};
template <class Epi, class Sched, bool ALIGN_EPI = false, bool SP2 = false>
__device__ __forceinline__ void gemm_phase(PG8_LAS unsigned char* lds, const Gemm g, const Sched& S, const Epi& E) {
    int tid_ = my_tid();
    const int tid = tid_, wid = __builtin_amdgcn_readfirstlane(tid >> 6), lane = tid & 63, wr = wid >> 2, wc = wid & 3, fr = lane & 15, fq = lane >> 4;
    const int K = g.K, nt = K / BK;
    unsigned voffA[2], voffB[2];
#pragma unroll
    for (int i = 0; i < 2; ++i) { int R, C; stage_rc(tid * 16 + i * 8192, R, C); const int Rb = Epi::PERM ? ((R & ~31) + perm32(R & 31)) : R;
        voffA[i] = (unsigned)(R * g.lda + C) * 2u; voffB[i] = (unsigned)(Rb * g.ldb + C) * 2u; }
    const size_t kstep = (size_t)(BK * 2);
    const size_t hstepA = (size_t)HALF * g.lda * 2, hstepB = (size_t)HALF * g.ldb * 2;
    const size_t tstepA = 2 * hstepA, tstepB = 2 * hstepB;
    const unsigned ldsw = (unsigned)wid * 1024u;
    const int aoff = lds_byte(wr * 64 + fr, fq * 8), boff = lds_byte(wc * 32 + fr, fq * 8);
#define PG8_SA(b, h) (((b) * 2 + (h)) * HTB)
#define PG8_SB(b, h) ((4 + (b) * 2 + (h)) * HTB)
#define PG8_STAGE(bufoff, gbase, voff) do { _Pragma("unroll") for (int _i = 0; _i < 2; ++_i) \
        __builtin_amdgcn_global_load_lds((const unsigned*)((const char*)(gbase) + (voff)[_i]), (PG8_LAS unsigned*)(lds + (bufoff) + ldsw + _i * 8192), 16, 0, 0); } while (0)
#define PG8_LDA(dst, b, h) do { _Pragma("unroll") for (int m = 0; m < 4; ++m) _Pragma("unroll") for (int k = 0; k < 2; ++k) dst[m][k] = *(const PG8_LAS bf16x8*)(lds + PG8_SA(b, h) + aoff + m * 2048 + k * 1024); } while (0)
#define PG8_LDB(dst, b, h) do { _Pragma("unroll") for (int n = 0; n < 2; ++n) _Pragma("unroll") for (int k = 0; k < 2; ++k) dst[n][k] = *(const PG8_LAS bf16x8*)(lds + PG8_SB(b, h) + boff + n * 2048 + k * 1024); } while (0)
#define PG8_MMA(ai, bj, At, Bt) do { __builtin_amdgcn_s_setprio(1); _Pragma("unroll") for (int m = 0; m < 4; ++m) _Pragma("unroll") for (int n = 0; n < 2; ++n) _Pragma("unroll") for (int k = 0; k < 2; ++k) \
        acc[ai][bj][m][n] = __builtin_amdgcn_mfma_f32_16x16x32_bf16(Bt[n][k], At[m][k], acc[ai][bj][m][n], 0, 0, 0); __builtin_amdgcn_s_setprio(0); } while (0)
#define PG8_WAIT_V(n) asm volatile("s_waitcnt vmcnt(" #n ")" ::: "memory")
#define PG8_WAIT_L(n) asm volatile("s_waitcnt lgkmcnt(" #n ")" ::: "memory")
#define PG8_BAR __builtin_amdgcn_s_barrier()
#define PG8_SCHED __builtin_amdgcn_sched_barrier(0)
    Unit cur, nxt; int ui = 0;
    if (!S.next(0, cur)) return;
    f32x4 acc[2][2][4][2];
#pragma unroll
    for (int a = 0; a < 2; ++a)
#pragma unroll
        for (int b = 0; b < 2; ++b)
#pragma unroll
            for (int m = 0; m < 4; ++m)
#pragma unroll
                for (int n = 0; n < 2; ++n) acc[a][b][m][n] = (f32x4){0.f, 0.f, 0.f, 0.f};
    bf16x8 At[4][2], B0[2][2], B1[2][2];
    const char* cA = (const char*)g.A + (size_t)cur.pm * tstepA; const char* cB = (const char*)g.Bt + (size_t)cur.pn * tstepB;
    S.a_ready(cur);
    if constexpr (SP2) {
        PG8_STAGE(PG8_SB(0, 0), cB, voffB); PG8_STAGE(PG8_SB(0, 1), cB + hstepB, voffB); PG8_STAGE(PG8_SA(0, 0), cA, voffA); PG8_STAGE(PG8_SA(0, 1), cA + hstepA, voffA);
        if (wr == 1) PG8_BAR;
        PG8_WAIT_V(2); PG8_BAR;
        PG8_STAGE(PG8_SB(1, 0), cB + kstep, voffB); PG8_STAGE(PG8_SA(1, 0), cA + kstep, voffA); PG8_STAGE(PG8_SB(1, 1), cB + hstepB + kstep, voffB);
        PG8_WAIT_V(6); PG8_BAR;
    } else {
        PG8_STAGE(PG8_SB(0, 0), cB, voffB); PG8_STAGE(PG8_SA(0, 0), cA, voffA); PG8_STAGE(PG8_SB(0, 1), cB + hstepB, voffB); PG8_STAGE(PG8_SA(0, 1), cA + hstepA, voffA);
        if (wr == 1) PG8_BAR;
        PG8_WAIT_V(4); PG8_BAR;
        PG8_STAGE(PG8_SB(1, 0), cB + kstep, voffB); PG8_STAGE(PG8_SA(1, 0), cA + kstep, voffA); PG8_STAGE(PG8_SB(1, 1), cB + hstepB + kstep, voffB);
        PG8_WAIT_V(6); PG8_BAR;
    }
    for (;;) {
        const bool has_next = S.next(ui + 1, nxt);
        const char* nA = has_next ? (const char*)g.A + (size_t)nxt.pm * tstepA : cA; const char* nB = has_next ? (const char*)g.Bt + (size_t)nxt.pn * tstepB : cB;
        for (int t = 0; t < nt; t += 2) {
            const bool last = (t == nt - 2);
            if constexpr (Epi::HAS_MID) { if (t == E.mid_t) E.mid(acc, cur, wr, wc, fr, fq); }
            const char* a1 = cA + (size_t)(t + 1) * kstep;
            const char* a2 = last ? nA : cA + (size_t)(t + 2) * kstep; const char* b2 = last ? nB : cB + (size_t)(t + 2) * kstep;
            const char* a3 = a2 + kstep; const char* b3 = b2 + kstep;
            if (last && has_next) S.a_ready(nxt);
            if constexpr (SP2) {
            PG8_LDB(B0, 0, 0); PG8_LDB(B1, 0, 1); PG8_SCHED; PG8_LDA(At, 0, 0); PG8_STAGE(PG8_SA(1, 1), a1 + hstepA, voffA);
            PG8_WAIT_V(8); PG8_WAIT_L(0); PG8_BAR; PG8_MMA(0, 0, At, B0); PG8_MMA(0, 1, At, B1); PG8_BAR; PG8_SCHED;
            PG8_LDA(At, 0, 1); PG8_STAGE(PG8_SB(0, 0), b2, voffB); PG8_STAGE(PG8_SB(0, 1), b2 + hstepB, voffB); PG8_STAGE(PG8_SA(0, 0), a2, voffA);
            PG8_WAIT_V(8); PG8_WAIT_L(0); PG8_BAR; PG8_MMA(1, 0, At, B0); PG8_MMA(1, 1, At, B1); PG8_BAR; PG8_SCHED;
            PG8_LDB(B0, 1, 0); PG8_LDB(B1, 1, 1); PG8_SCHED; PG8_LDA(At, 1, 0); PG8_STAGE(PG8_SA(0, 1), a2 + hstepA, voffA);
            PG8_WAIT_V(8); PG8_WAIT_L(0); PG8_BAR; PG8_MMA(0, 0, At, B0); PG8_MMA(0, 1, At, B1); PG8_BAR; PG8_SCHED;
            PG8_LDA(At, 1, 1); PG8_STAGE(PG8_SB(1, 0), b3, voffB); PG8_STAGE(PG8_SB(1, 1), b3 + hstepB, voffB); PG8_STAGE(PG8_SA(1, 0), a3, voffA);
            PG8_WAIT_V(8); PG8_WAIT_L(0); PG8_BAR; PG8_MMA(1, 0, At, B0); PG8_MMA(1, 1, At, B1); PG8_BAR; PG8_SCHED;
            } else {
            PG8_LDB(B0, 0, 0); PG8_SCHED; PG8_LDA(At, 0, 0); PG8_STAGE(PG8_SA(1, 1), a1 + hstepA, voffA);
            PG8_WAIT_L(8); PG8_BAR; PG8_WAIT_L(0); PG8_MMA(0, 0, At, B0); PG8_BAR; PG8_SCHED;
            PG8_LDB(B1, 0, 1); PG8_STAGE(PG8_SB(0, 0), b2, voffB);
            PG8_BAR; PG8_WAIT_L(0); PG8_MMA(0, 1, At, B1); PG8_BAR;
            PG8_LDA(At, 0, 1); PG8_STAGE(PG8_SA(0, 0), a2, voffA);
            PG8_BAR; PG8_WAIT_L(0); PG8_MMA(1, 0, At, B0); PG8_BAR; PG8_SCHED;
            PG8_STAGE(PG8_SB(0, 1), b2 + hstepB, voffB);
            PG8_WAIT_V(6); PG8_BAR; PG8_MMA(1, 1, At, B1); PG8_BAR;
            PG8_LDB(B0, 1, 0); PG8_SCHED; PG8_LDA(At, 1, 0); PG8_STAGE(PG8_SA(0, 1), a2 + hstepA, voffA);
            PG8_WAIT_L(8); PG8_BAR; PG8_WAIT_L(0); PG8_MMA(0, 0, At, B0); PG8_BAR; PG8_SCHED;
            PG8_LDB(B1, 1, 1); PG8_STAGE(PG8_SB(1, 0), b3, voffB);
            PG8_BAR; PG8_WAIT_L(0); PG8_MMA(0, 1, At, B1); PG8_BAR;
            PG8_LDA(At, 1, 1); PG8_STAGE(PG8_SA(1, 0), a3, voffA);
            PG8_BAR; PG8_WAIT_L(0); PG8_MMA(1, 0, At, B0); PG8_BAR; PG8_SCHED;
            PG8_STAGE(PG8_SB(1, 1), b3 + hstepB, voffB);
            PG8_WAIT_V(6); PG8_BAR; PG8_MMA(1, 1, At, B1); PG8_BAR;
            }
        }
        if constexpr (ALIGN_EPI) { if (wr == 0) PG8_BAR; }
        if constexpr (!Epi::AFTER_DRAIN) { E(acc, cur, wr, wc, fr, fq); S.done(cur); }
        if (!has_next) break;
#pragma unroll
        for (int a = 0; a < 2; ++a)
#pragma unroll
            for (int b = 0; b < 2; ++b)
#pragma unroll
                for (int m = 0; m < 4; ++m)
#pragma unroll
                    for (int n = 0; n < 2; ++n) acc[a][b][m][n] = (f32x4){0.f, 0.f, 0.f, 0.f};
        cur = nxt; cA = nA; cB = nB; ++ui;
        if constexpr (ALIGN_EPI) { if (wr == 1) PG8_BAR; }
    }
    PG8_WAIT_V(0);
    if constexpr (!ALIGN_EPI) { if (wr == 0) PG8_BAR; }
    PG8_BAR;
    if constexpr (Epi::AFTER_DRAIN) { E.fused(acc, cur, wr, wc, fr, fq, lds, wid, lane); S.done(cur); }
#undef PG8_SA
#undef PG8_SB
#undef PG8_STAGE
#undef PG8_LDA
#undef PG8_LDB
#undef PG8_MMA
#undef PG8_WAIT_V
#undef PG8_WAIT_L
#undef PG8_BAR
#undef PG8_SCHED
}
}
namespace att {
constexpr int D = 128;
constexpr float THR = 8.f;
constexpr bool WSKIP = false;
constexpr float SCALE = 0.08838834764831845f;
constexpr int NW = 8, QBLK = 32, KVBLK = 64, QB = NW * QBLK;
constexpr int SHM_V = KVBLK * D * 2, SHM_K = KVBLK * D * 2;
constexpr int LDS_BYTES = 2 * SHM_V + 2 * SHM_K + NW * 64 * 4;
using bf16 = __hip_bfloat16;
typedef short bf16x8 __attribute__((ext_vector_type(8)));
typedef short s16x4 __attribute__((ext_vector_type(4)));
typedef float f32x16 __attribute__((ext_vector_type(16)));
typedef float f32x4 __attribute__((ext_vector_type(4)));
typedef unsigned u32x4 __attribute__((ext_vector_type(4)));
template <class A, class Bt> struct same_t { static constexpr bool v = false; };
template <class A> struct same_t<A, A> { static constexpr bool v = true; };

#define KSWZ(row, colB) ((row) * 256 + ((colB) ^ (((row) & 7) << 4)))
#define SBAR() __builtin_amdgcn_sched_barrier(0)
__device__ __forceinline__ int v_st(int k, int c) { const int kk = (k & ~0xC) | ((k & 4) << 1) | ((k & 8) >> 1); return ((kk >> 3) * 4 + (c >> 5)) * 512 + ((kk & 7) * 32 + (c & 31)) * 2; }
__device__ __forceinline__ int v_rd_base(int lane) { return ((lane & 3) << 3) | (((lane >> 2) & 3) << 6) | (((lane >> 4) & 1) << 5) | (((lane >> 5) & 1) << 8); }
constexpr int v_rd_off(int d0, int ks, int half) { return d0 * 512 + ks * 4096 + half * 2048; }
__device__ __forceinline__ int crow(int r, int hi) { return (r & 3) + 8 * (r >> 2) + 4 * hi; }
__device__ __forceinline__ unsigned cvtpk(float lo, float hi) {
    unsigned r; asm volatile("v_cvt_pk_bf16_f32 %0, %1, %2" : "=v"(r) : "v"(lo), "v"(hi)); return r;
}
__device__ __forceinline__ bf16x8 pack8(f32x4 a, f32x4 b) {
    u32x4 w = {cvtpk(a[0], a[1]), cvtpk(a[2], a[3]), cvtpk(b[0], b[1]), cvtpk(b[2], b[3])};
    return *reinterpret_cast<bf16x8*>(&w);
}
template <class T> __device__ __forceinline__ bf16x8 load8(const T* p) {
    if constexpr (same_t<T, float>::v) { return pack8(*(const f32x4*)p, *(const f32x4*)(p + 4)); }
    else { return *reinterpret_cast<const bf16x8*>(p); }
}
__device__ __forceinline__ void mask_tile(f32x16& p0, f32x16& p1, int dq, unsigned W) {
    const float NEG = -__builtin_inff();
#pragma unroll
    for (int r = 0; r < 16; ++r) {
        const int c = (r & 3) + 8 * (r >> 2);
        if ((unsigned)(dq - c) >= W) p0[r] = NEG;
        if ((unsigned)(dq - c - 32) >= W) p1[r] = NEG;
    }
}
__device__ __forceinline__ void partialSM(f32x16& p0, f32x16& p1, float& m_reg, float& mn, float& alpha) {
    float pmax = p0[0]; for (int r = 1; r < 16; ++r) pmax = fmaxf(pmax, p0[r]); for (int r = 0; r < 16; ++r) pmax = fmaxf(pmax, p1[r]);
    { auto rr = __builtin_amdgcn_permlane32_swap(__float_as_uint(pmax), __float_as_uint(pmax), false, false);
      pmax = fmaxf(__uint_as_float(rr[0]), __uint_as_float(rr[1])); }
    constexpr float C2 = 1.4426950408889634f * SCALE;
    if (__builtin_expect(__all((pmax - m_reg) * SCALE <= THR), 1)) { mn = m_reg; alpha = 1.f; }
    else { mn = fmaxf(m_reg, pmax); alpha = __builtin_amdgcn_exp2f((m_reg - mn) * C2); m_reg = mn; }
    const float mnL = -mn * C2;
    for (int r = 0; r < 16; ++r) p0[r] = fmaf(p0[r], C2, mnL); for (int r = 0; r < 16; ++r) p1[r] = fmaf(p1[r], C2, mnL);
    for (int r = 0; r < 16; ++r) p0[r] = __builtin_amdgcn_exp2f(p0[r]);
}
__device__ __forceinline__ void finishSM(f32x16& p0, f32x16& p1, float alpha, float& l_reg, bf16x8& pa0, bf16x8& pa1, bf16x8& pa2, bf16x8& pa3) {
    for (int r = 0; r < 16; ++r) p1[r] = __builtin_amdgcn_exp2f(p1[r]);
    float ps = 0; for (int r = 0; r < 16; ++r) ps += p0[r]; for (int r = 0; r < 16; ++r) ps += p1[r];
    { auto rr = __builtin_amdgcn_permlane32_swap(__float_as_uint(ps), __float_as_uint(ps), false, false);
      ps = __uint_as_float(rr[0]) + __uint_as_float(rr[1]); }
    l_reg = l_reg * alpha + ps;
#define PK4(P, B_, OUT) do { unsigned a0 = cvtpk(P[B_+0], P[B_+1]), a1 = cvtpk(P[B_+2], P[B_+3]);                          \
        unsigned b0 = cvtpk(P[B_+4], P[B_+5]), b1 = cvtpk(P[B_+6], P[B_+7]);                                             \
        auto r0 = __builtin_amdgcn_permlane32_swap(a0, b0, false, false); auto r1 = __builtin_amdgcn_permlane32_swap(a1, b1, false, false); \
        u32x4 w = {r0[0], r1[0], r0[1], r1[1]}; OUT = *reinterpret_cast<bf16x8*>(&w); } while (0)
    PK4(p0, 0, pa0); PK4(p0, 8, pa1); PK4(p1, 0, pa2); PK4(p1, 8, pa3);
#undef PK4
}
template <int KB, bool SK>
__device__ __forceinline__ void qkt(f32x16& p0, f32x16& p1, const char* K_lds, int r32, int hi, const bf16x8* qr, bool act, int cbo  ) {
    if (SK && !act) { const float NEG = -__builtin_inff();
#pragma unroll
        for (int r = 0; r < 16; ++r) { p0[r] = NEG; p1[r] = NEG; } return; }
    if (cbo >= 0) { int a_ = cbo + hi * 16; asm volatile("" : "+v"(a_)); const __attribute__((address_space(3))) float* cb = (const __attribute__((address_space(3))) float*)(unsigned)a_;
#pragma unroll
        for (int q_ = 0; q_ < 4; ++q_) { const f32x4 v0_ = *(const __attribute__((address_space(3))) f32x4*)(cb + 8 * q_), v1_ = *(const __attribute__((address_space(3))) f32x4*)(cb + 32 + 8 * q_);
#pragma unroll
            for (int j_ = 0; j_ < 4; ++j_) { p0[4 * q_ + j_] = v0_[j_]; p1[4 * q_ + j_] = v1_[j_]; } }
    } else { p0 = f32x16{}; p1 = f32x16{}; }
    const char* kb[4];
#pragma unroll
    for (int dd = 0; dd < 4; ++dd) kb[dd] = K_lds + KB * SHM_K + KSWZ(r32, (dd * 16 + hi * 8) * 2);
#pragma unroll
    for (int d0 = 0; d0 < 8; ++d0) { const char* a = kb[d0 & 3] + (d0 >> 2) * 128;
        bf16x8 b0 = *reinterpret_cast<const bf16x8*>(a);
        bf16x8 b1 = *reinterpret_cast<const bf16x8*>(a + 32 * 256);
        p0 = __builtin_amdgcn_mfma_f32_32x32x16_bf16(b0, qr[d0], p0, 0, 0, 0);
        p1 = __builtin_amdgcn_mfma_f32_32x32x16_bf16(b1, qr[d0], p1, 0, 0, 0); }
}
template <int VB, bool SK>
__device__ __forceinline__ void pv_tile(f32x16* o, int vb0, bf16x8 pa0, bf16x8 pa1, bf16x8 pa2, bf16x8 pa3, bool act) {
    if (SK && !act) return;
#define TRRD(dst, off) asm volatile("ds_read_b64_tr_b16 %0, %1 offset:%2" : "=&v"(dst) : "v"(vb0), "i"(off) : "memory")
#define PV_D0(d0) do { s16x4 l0, l1, l2, l3, h0, h1, h2, h3; constexpr int b_ = VB * SHM_V + v_rd_off(d0, 0, 0);     \
        TRRD(l0, b_); TRRD(h0, b_ + 2048); TRRD(l1, b_ + 4096); TRRD(h1, b_ + 6144); TRRD(l2, b_ + 8192); TRRD(h2, b_ + 10240); TRRD(l3, b_ + 12288); TRRD(h3, b_ + 14336); \
        asm volatile("s_waitcnt lgkmcnt(0)" ::: "memory"); SBAR();                 \
        o[d0] = __builtin_amdgcn_mfma_f32_32x32x16_bf16(pa0, (bf16x8){l0[0], l0[1], l0[2], l0[3], h0[0], h0[1], h0[2], h0[3]}, o[d0], 0, 0, 0);   \
        o[d0] = __builtin_amdgcn_mfma_f32_32x32x16_bf16(pa1, (bf16x8){l1[0], l1[1], l1[2], l1[3], h1[0], h1[1], h1[2], h1[3]}, o[d0], 0, 0, 0);   \
        o[d0] = __builtin_amdgcn_mfma_f32_32x32x16_bf16(pa2, (bf16x8){l2[0], l2[1], l2[2], l2[3], h2[0], h2[1], h2[2], h2[3]}, o[d0], 0, 0, 0);   \
        o[d0] = __builtin_amdgcn_mfma_f32_32x32x16_bf16(pa3, (bf16x8){l3[0], l3[1], l3[2], l3[3], h3[0], h3[1], h3[2], h3[3]}, o[d0], 0, 0, 0); } while (0)
    PV_D0(0); PV_D0(1); PV_D0(2); PV_D0(3);
#undef PV_D0
#undef TRRD
}

template <class T> __device__ __forceinline__ T* uptr(T* p) { const unsigned long long v = (unsigned long long)p; const unsigned lo = __builtin_amdgcn_readfirstlane((unsigned)v), hi = __builtin_amdgcn_readfirstlane((unsigned)(v >> 32)); return (T*)(((unsigned long long)hi << 32) | lo); }
template <class TIn, class TOut> struct BlockRef { const TIn* Q; const TIn* K; const TIn* V; TOut* O; float* SS; int P0; };
template <class TIn> struct Seam {
    bf16x8 qr[8];
    bf16x8 st_v0, st_v1, st_k0, st_k1; f32x4 sf0, sf1, sf2, sf3;
    f32x4 tq[16];
};
__device__ __forceinline__ int swa_jlo(int P0, int W) { const int lowk = P0 - W + 1; return lowk > 0 ? lowk / KVBLK : 0; }
#define ROW(p, k0, rr) ((decltype(p))((const char*)(p) + (unsigned)(((k0) + (rr)) * D + sc) * (unsigned)sizeof(*(p))))
#define VMW() asm volatile("s_waitcnt vmcnt(0)" ::: "memory")
#define VMWN(n) asm volatile("s_waitcnt vmcnt(%0)" :: "i"(n) : "memory")
#define SLOAD_H(Kp, Vp, k0) do { S.st_v0 = load8<TIn>(ROW(Vp, k0, sr)); S.st_v1 = load8<TIn>(ROW(Vp, k0, 32 + sr));              \
                         S.st_k0 = load8<TIn>(ROW(Kp, k0, sr)); S.st_k1 = load8<TIn>(ROW(Kp, k0, 32 + sr)); } while (0)
#define SWRITE_HK(bf) do { *(bf16x8*)(K_lds + (bf) * SHM_K + kws) = S.st_k0; *(bf16x8*)(K_lds + (bf) * SHM_K + kws + 32 * 256) = S.st_k1; } while (0)
#define SWRITE_HV(bf) do { *(bf16x8*)(V_lds + (bf) * SHM_V + vst0) = S.st_v0; *(bf16x8*)(V_lds + (bf) * SHM_V + vst1) = S.st_v1; } while (0)
#define SWRITE_H(bf) do { SWRITE_HV(bf); SWRITE_HK(bf); } while (0)
#define SLOAD_F(p, k0) do { S.sf0 = *(const f32x4*)ROW(p, k0, sr); S.sf1 = *(const f32x4*)(ROW(p, k0, sr) + 4);                \
                            S.sf2 = *(const f32x4*)ROW(p, k0, 32 + sr); S.sf3 = *(const f32x4*)(ROW(p, k0, 32 + sr) + 4); } while (0)
#define SWRITE_KF(bf) do { *(bf16x8*)(K_lds + (bf) * SHM_K + kws) = pack8(S.sf0, S.sf1); *(bf16x8*)(K_lds + (bf) * SHM_K + kws + 32 * 256) = pack8(S.sf2, S.sf3); } while (0)
#define SWRITE_VF(bf) do { *(bf16x8*)(V_lds + (bf) * SHM_V + vst0) = pack8(S.sf0, S.sf1); *(bf16x8*)(V_lds + (bf) * SHM_V + vst1) = pack8(S.sf2, S.sf3); } while (0)
template <class TIn, class TOut>
__device__ __forceinline__ void causal_swa_prime(const BlockRef<TIn, TOut>& cur_, int W, char* lds, Seam<TIn>& S) {
    BlockRef<TIn, TOut> cur; cur.Q = uptr(cur_.Q); cur.K = uptr(cur_.K); cur.V = uptr(cur_.V); cur.O = nullptr; cur.SS = nullptr; cur.P0 = __builtin_amdgcn_readfirstlane(cur_.P0);
    constexpr bool F32 = same_t<TIn, float>::v;
    int tid_ = my_tid();
    const int tid = tid_, wid = __builtin_amdgcn_readfirstlane(tid >> 6), lane = tid & 63, r32 = lane & 31, hi = lane >> 5;
    const int sr = tid >> 4, sc = (tid & 15) * 8, kws = KSWZ(sr, sc * 2); char* K_lds = lds + 2 * SHM_V;
    const int kb0 = swa_jlo(cur.P0, W) * KVBLK;
    for (int d0 = 0; d0 < 8; ++d0) S.qr[d0] = load8<TIn>((const TIn*)((const char*)cur.Q + (unsigned)((wid * QBLK + r32) * D + d0 * 16 + hi * 8) * (unsigned)sizeof(TIn)));
    if constexpr (F32) { SLOAD_F((const float*)cur.K, kb0); VMW(); SWRITE_KF(0); SBAR(); SLOAD_F((const float*)cur.V, kb0); }
    else { SLOAD_H(cur.K, cur.V, kb0); VMW(); SWRITE_HK(0); }
    __syncthreads();
}
template <class TIn, class TOut, int ost, bool HAS_SS>
__device__ __forceinline__ void causal_swa_block(const BlockRef<TIn, TOut>& cur_, const BlockRef<TIn, TOut>& nxt_, int skv, int W, char* lds, Seam<TIn>& S, int cbl  ) {
    constexpr bool F32 = same_t<TIn, float>::v;
    BlockRef<TIn, TOut> cur, nxt; cur.Q = uptr(cur_.Q); cur.K = uptr(cur_.K); cur.V = uptr(cur_.V); cur.O = uptr(cur_.O); cur.SS = uptr(cur_.SS); cur.P0 = __builtin_amdgcn_readfirstlane(cur_.P0);
    nxt.Q = uptr(nxt_.Q); nxt.K = uptr(nxt_.K); nxt.V = uptr(nxt_.V); nxt.O = nullptr; nxt.SS = nullptr; nxt.P0 = __builtin_amdgcn_readfirstlane(nxt_.P0);
    int tid_ = my_tid();
    const int tid = tid_, wid = __builtin_amdgcn_readfirstlane(tid >> 6), lane = tid & 63, r32 = lane & 31, hi = lane >> 5;
    const int j_lo = swa_jlo(cur.P0, W);
    int j_hi = (cur.P0 + QB - 1) / KVBLK + 1; if (j_hi > skv / KVBLK) j_hi = skv / KVBLK;
    const int NT = j_hi - j_lo;
    const int kbn = swa_jlo(nxt.P0, W) * KVBLK;
    const int qlo = cur.P0 + wid * QBLK, qm = qlo + r32 - 4 * hi;
    char* V_lds = lds; char* K_lds = lds + 2 * SHM_V;
    float* ws = (float*)(lds + 2 * SHM_V + 2 * SHM_K) + wid * 64; float* li_l = ws, * al_l = ws + 32;
    float m_reg = -1e30f, l_reg = 0; f32x16 o[4] = {};
    const int sr = tid >> 4, sc = (tid & 15) * 8, vst0 = v_st(sr, sc), vst1 = v_st(32 + sr, sc), kws = KSWZ(sr, sc * 2);
    const int vb0 = (int)(uintptr_t)V_lds + v_rd_base(lane);
    const TIn* Kh = cur.K; const TIn* Vh = cur.V;
#define RESC(a) do { if (__any((a) < 1.f)) { if (hi == 0) al_l[r32] = (a); asm volatile("s_waitcnt lgkmcnt(0)" ::: "memory");              \
                     for (int d_ = 0; d_ < 4; ++d_) for (int r = 0; r < 16; ++r) o[d_][r] *= al_l[crow(r, hi)]; } } while (0)
#define KBASE(t) ((j_lo + (t)) * KVBLK)
#define CBT(t) (cbl >= 0 ? cbl + KBASE(t) * 4 : -1)
#define ACT(t) (KBASE(t) <= qlo + QBLK - 1 && KBASE(t) + KVBLK - 1 >= qlo - W + 1)
#define MASKT(P0_, P1_, t) do { const int kb_ = KBASE(t); if ((!SK || ACT(t)) && (kb_ + KVBLK - 1 > qlo || kb_ <= qlo + QBLK - 1 - W)) mask_tile(P0_, P1_, qm - kb_, (unsigned)W); } while (0)
    constexpr int NQL = F32 ? 16 : 8;
    constexpr bool SK = WSKIP && !F32;
#define SEAM_K0() do { VMWN(NQL); if constexpr (F32) { SWRITE_KF(0); SBAR(); SLOAD_F((const float*)nxt.V, kbn); } else { SWRITE_HK(0); } SBAR(); } while (0)
    f32x16 pA0, pA1, pB0, pB1; float mnA, mnB, alA, alB; bf16x8 pa0, pa1, pa2, pa3;
    if constexpr (F32) { VMW(); SWRITE_VF(0); SBAR(); } else { SWRITE_HV(0); SBAR(); }
    if (NT > 1) { if constexpr (F32) SLOAD_F((const float*)Kh, KBASE(1)); else SLOAD_H(Kh, Vh, KBASE(1)); }
    SBAR(); qkt<0, SK>(pA0, pA1, K_lds, r32, hi, S.qr, ACT(0), CBT(0));
    if constexpr (F32) { if (NT > 1) { VMW(); SWRITE_KF(1); SBAR(); SLOAD_F((const float*)Vh, KBASE(1)); } }
    MASKT(pA0, pA1, 0); partialSM(pA0, pA1, m_reg, mnA, alA);
    if (NT > 1) { VMW(); if constexpr (F32) { SWRITE_VF(1); SBAR(); if (NT > 2) SLOAD_F((const float*)Kh, KBASE(2)); } else SWRITE_H(1); }
    __syncthreads();
#define HALF_STEP(PX0, PX1, mnX, alX, PY0, PY1, alY, t, KB, VB, SB) do {                                                      \
        SBAR(); qkt<KB, SK>(PX0, PX1, K_lds, r32, hi, S.qr, ACT(t), CBT(t));                                             \
        finishSM(PY0, PY1, alY, l_reg, pa0, pa1, pa2, pa3); SBAR();                                                           \
        if ((t) + 1 < NT) { if constexpr (F32) { VMW(); SWRITE_KF(SB); SBAR(); SLOAD_F((const float*)Vh, KBASE((t) + 1)); }  \
                            else { SLOAD_H(Kh, Vh, KBASE((t) + 1)); } SBAR(); }                                               \
        pv_tile<VB, SK>(o, vb0, pa0, pa1, pa2, pa3, ACT((t) - 1)); MASKT(PX0, PX1, (t)); partialSM(PX0, PX1, m_reg, mnX, alX);                                        \
        __syncthreads();                                                                                                      \
        if ((t) + 1 < NT) { VMW(); if constexpr (F32) { SWRITE_VF(SB); SBAR(); if ((t) + 2 < NT) SLOAD_F((const float*)Kh, KBASE((t) + 2)); } \
                            else { SWRITE_H(SB); } }                                                                          \
        RESC(alX); __syncthreads(); } while (0)
    for (int t = 1; t + 1 < NT; t += 2) {
        HALF_STEP(pB0, pB1, mnB, alB, pA0, pA1, alA, t, 1, 0, 0);
        HALF_STEP(pA0, pA1, mnA, alA, pB0, pB1, alB, t + 1, 0, 1, 1);
    }
    const bool even = (NT & 1) == 0;
    if (even) { SBAR(); qkt<1, SK>(pB0, pB1, K_lds, r32, hi, S.qr, ACT(NT - 1), CBT(NT - 1)); SBAR(); }
#define QROW(e) (nxt.Q + (size_t)(wid * QBLK + r32) * D + ((e) >> 1) * 16 + hi * 8 + ((e) & 1) * 4)
    if constexpr (F32) { SLOAD_F((const float*)nxt.K, kbn); SBAR();
#pragma unroll
        for (int e = 0; e < 8; ++e) S.tq[e] = *(const f32x4*)QROW(e); }
    else { SLOAD_H(nxt.K, nxt.V, kbn); SBAR();
#pragma unroll
        for (int d0 = 0; d0 < 8; ++d0) S.qr[d0] = load8<TIn>((const TIn*)((const char*)nxt.Q + (unsigned)((wid * QBLK + r32) * D + d0 * 16 + hi * 8) * (unsigned)sizeof(TIn))); }
    SBAR();
    finishSM(pA0, pA1, alA, l_reg, pa0, pa1, pa2, pa3); SBAR();
    if constexpr (F32) {
#pragma unroll
        for (int e = 8; e < 16; ++e) S.tq[e] = *(const f32x4*)QROW(e); SBAR(); }
#undef QROW
    pv_tile<0, SK>(o, vb0, pa0, pa1, pa2, pa3, ACT(even ? NT - 2 : NT - 1));
    if (even) { MASKT(pB0, pB1, NT - 1); partialSM(pB0, pB1, m_reg, mnB, alB); __syncthreads(); RESC(alB);
        finishSM(pB0, pB1, alB, l_reg, pa0, pa1, pa2, pa3); SBAR(); pv_tile<1, SK>(o, vb0, pa0, pa1, pa2, pa3, ACT(NT - 1)); }
    SBAR(); SEAM_K0();
    if (hi == 0) li_l[r32] = l_reg; asm volatile("s_waitcnt lgkmcnt(0)" ::: "memory");
    float rli[16];
#pragma unroll
    for (int r = 0; r < 16; ++r) rli[r] = __builtin_amdgcn_rcpf(li_l[crow(r, hi)]);
    int r32e = r32, hie = hi; asm volatile("" : "+v"(r32e), "+v"(hie));
    char* Ob = (char*)cur.O; const unsigned ob0 = (unsigned)((wid * QBLK + 4 * hie) * ost + r32e) * 2u;
#pragma unroll
    for (int r = 0; r < 16; ++r) { const unsigned rowoff = ob0 + (unsigned)(((r & 3) + 8 * (r >> 2)) * ost * 2); float ss_ = 0.f;
#pragma unroll
        for (int d0 = 0; d0 < 4; ++d0) { const float v = o[d0][r] * rli[r]; ss_ += v * v;
            const float vn = shx<1>(v);
            if ((r32e & 1) == 0) *(unsigned*)(Ob + rowoff + d0 * 64) = cvtpk(v, vn); }
        if (HAS_SS) { ss_ += shx<1>(ss_); ss_ += shx<2>(ss_); ss_ += shx<4>(ss_); ss_ += shx<8>(ss_); ss_ += shx<16>(ss_);
            if (r32e == 0) *(float*)((char*)cur.SS + (unsigned)(wid * QBLK + 4 * hie + (r & 3) + 8 * (r >> 2)) * 32u) = ss_; }
        SBAR(); }
    if constexpr (F32) {
#pragma unroll
        for (int d0 = 0; d0 < 8; ++d0) S.qr[d0] = pack8(S.tq[2 * d0], S.tq[2 * d0 + 1]); }
    __syncthreads();
#undef RESC
#undef KBASE
#undef CBT
#undef ACT
#undef MASKT
#undef SEAM_K0
#undef HALF_STEP
}
#undef ROW
}

#define GAS __attribute__((address_space(1)))
#define LAS __attribute__((address_space(3)))
typedef unsigned short bf16;
typedef unsigned v4u __attribute__((ext_vector_type(4)));
typedef float f32x4 __attribute__((ext_vector_type(4)));
#define LDS_WAIT() asm volatile("s_waitcnt lgkmcnt(0)" ::: "memory")
#define VM_WAIT() asm volatile("s_waitcnt vmcnt(0)" ::: "memory")
__device__ __forceinline__ unsigned f2bf(float f) { unsigned u = __builtin_bit_cast(unsigned, f); return (u + 0x7fffu + ((u >> 16) & 1u)) >> 16; }
__device__ __forceinline__ unsigned pk2(float lo, float hi) { return f2bf(lo) | (f2bf(hi) << 16); }
__device__ __forceinline__ float bflo(unsigned w) { return __uint_as_float(w << 16); }
__device__ __forceinline__ float bfhi(unsigned w) { return __uint_as_float(w & 0xffff0000u); }

#ifndef LB2
#define LB2 2
#endif
#ifndef FOX_HAS_SS
#define FOX_HAS_SS false
#endif
#ifndef FOX_SS
#define FOX_SS (SSQF + ((size_t)b * SEQ + x * 256) * 8 + h)
#endif
#ifndef FOX_CB
#define FOX_CB CB_OFF
#endif
#ifndef USE_XB
#define USE_XB 1
#endif
#if USE_XB
#define GSYNC() xcd_barrier(xbar)
#else
#define GSYNC() grid.sync()
#endif
#ifndef REP
#define REP 0
#endif
#ifndef PH
#define PH 0x1ff
#endif
constexpr int NWAVES = 8, NTHR = 512;
constexpr int BATCH = 4, SEQ = 2048, DM = 2048, M = BATCH * SEQ, NMEM = 256, MMEM = BATCH * NMEM;
constexpr int FOXW = 1024, LRUW = 1024, INW = 5128, INWP = 5376, XW = 512, FFN = 5632;
constexpr float EPS = 1e-6f;
constexpr size_t MiB = 1u << 20;
constexpr size_t WS_WIN = 1 * MiB, WS_WOUT = 22 * MiB, WS_WCQ = 30 * MiB, WS_WCKV = 32 * MiB, WS_WCO = 36 * MiB, WS_WGU = 38 * MiB, WS_WDN = 82 * MiB, WS_WLRU = 104 * MiB;
constexpr size_t WS_XN = 105 * MiB, WS_MN = 137 * MiB, WS_Q = 141 * MiB, WS_K = 157 * MiB, WS_V = 173 * MiB, WS_U = 189 * MiB, WS_GG = 205 * MiB, WS_UC = 221 * MiB;
constexpr size_t WS_LF = 237 * MiB, WS_CK = 238 * MiB, WS_CV = 239 * MiB, WS_MIX = 240 * MiB, WS_SSQF = 272 * MiB, WS_SSQL = 273 * MiB, WS_X1 = 274 * MiB;
constexpr size_t WS_SSQ1 = 338 * MiB, WS_CQ = 339 * MiB, WS_SSQ2 = 347 * MiB, WS_END = 348 * MiB;
constexpr size_t WS_HL = WS_X1, WS_AC = WS_X1 + 16 * MiB, WS_ENDH = WS_SSQ2, WS_ENDA = WS_SSQ2 + 256 * 1024;
constexpr size_t WS_X1B = WS_XN  , WS_OX = WS_Q  , WS_X2B = WS_MIX  , WS_H = WS_Q  ;
constexpr int LDS_BYTES = 147456, RED_OFF = 131072, CB_OFF = 69632, WSUM_OFF = 77824;

__device__ __forceinline__ float wave_sum(float v) { v += shx<1>(v); v += shx<2>(v); v += shx<4>(v); v += shx<8>(v); v += shx<16>(v); return sum32(v); }
template <bool NT_ST>
__device__ __forceinline__ void transpose_item(const float* W, int ldw, int k0, int srcn0, int nvalid, const float* ks, bf16* WT, int ldt, int drow0, LAS float* scr, int lane) {
    f32x4 v[8];
#pragma unroll
    for (int i = 0; i < 8; ++i) { const int kk = 8 * i + (lane >> 3), n4 = (lane & 7) * 4;
        v[i] = (n4 < nvalid) ? __builtin_nontemporal_load((const GAS f32x4*)(W + (size_t)(k0 + kk) * ldw + srcn0 + n4)) : (f32x4){0.f, 0.f, 0.f, 0.f}; }
#pragma unroll
    for (int i = 0; i < 8; ++i) { const int kk = 8 * i + (lane >> 3), n4 = (lane & 7) * 4; f32x4 x = v[i]; if (ks) x = x * ks[k0 + kk];
        LAS float* d = scr + kk * 33 + n4; d[0] = x.x; d[1] = x.y; d[2] = x.z; d[3] = x.w; }
    LDS_WAIT(); asm volatile("" ::: "memory");
    const int c = lane & 7;
#pragma unroll
    for (int j = 0; j < 4; ++j) { const int n = (lane >> 3) + 8 * j; const LAS float* s = scr + (8 * c) * 33 + n;
        v4u o; o.x = pk2(s[0 * 33], s[1 * 33]); o.y = pk2(s[2 * 33], s[3 * 33]); o.z = pk2(s[4 * 33], s[5 * 33]); o.w = pk2(s[6 * 33], s[7 * 33]);
        if (NT_ST) __builtin_nontemporal_store(o, (GAS v4u*)(WT + (size_t)(drow0 + n) * ldt + k0 + 8 * c)); else *(GAS v4u*)(WT + (size_t)(drow0 + n) * ldt + k0 + 8 * c) = o; }
    LDS_WAIT(); asm volatile("" ::: "memory");
}
__device__ __forceinline__ void rms_row_to_bf16(const float* xrow, const float* g, bf16* orow, int lane) {
    const GAS f32x4* xr = (const GAS f32x4*)xrow + lane; const GAS f32x4* gr = (const GAS f32x4*)g + lane;
    f32x4 v[8]; float s = 0.f;
#pragma unroll
    for (int j = 0; j < 8; ++j) { v[j] = __builtin_nontemporal_load(xr + 64 * j); s += (v[j].x * v[j].x + v[j].y * v[j].y) + (v[j].z * v[j].z + v[j].w * v[j].w); }
    const float rstd = 1.0f / sqrtf(wave_sum(s) * (1.f / DM) + EPS);
    GAS unsigned long long* o8 = (GAS unsigned long long*)orow + lane;
#pragma unroll
    for (int j = 0; j < 8; ++j) { const f32x4 gg = gr[64 * j]; o8[64 * j] = (unsigned long long)pk2(v[j].x * rstd * gg.x, v[j].y * rstd * gg.y) | ((unsigned long long)pk2(v[j].z * rstd * gg.z, v[j].w * rstd * gg.w) << 32); }
}

#define XB_TMO      128
#define XB_XCNT(j)  (256  + 64 * (j))
#define XB_XSUB(j)  (1280 + 64 * (j))
#define XB_XGEN(j)  (2304 + 64 * (j))
#define XB_TOP      3328
#define XB_TOPGEN   3392
#define XCD_BAR_WORDS 3456
#define XB_SPIN_CAP (1u << 18)

__device__ __forceinline__ unsigned xb_ld(unsigned* p)              { return __hip_atomic_load(p, __ATOMIC_RELAXED, __HIP_MEMORY_SCOPE_AGENT); }
__device__ __forceinline__ unsigned xb_add(unsigned* p, unsigned v) { return __hip_atomic_fetch_add(p, v, __ATOMIC_RELAXED, __HIP_MEMORY_SCOPE_AGENT); }
__device__ __forceinline__ unsigned xb_xcc_id() { return (unsigned)__builtin_amdgcn_s_getreg((3 << 11) | 20) & 0xFu; }
#define XB_SPIN(cond, bar) do { unsigned _sp = 0; while (cond) { __builtin_amdgcn_s_sleep(1); \
    if ((++_sp & 255u) == 0u) { if (xb_ld(&(bar)[XB_TMO])) break; if (_sp > XB_SPIN_CAP) { atomicAdd(&(bar)[XB_TMO], 1u); break; } } } } while (0)

struct XcdBarrier {
    unsigned* bar; unsigned x;
    volatile LAS unsigned* st;
};

__device__ __forceinline__ XcdBarrier xcd_barrier_post(unsigned* bar, volatile LAS unsigned* st) {
    XcdBarrier b; b.bar = bar; b.x = xb_xcc_id(); b.st = st;
    if (my_tid() == 0) (void)xb_add(&bar[XB_XCNT(b.x)], 1u);
    return b;
}
__device__ __forceinline__ void xcd_barrier_complete(unsigned* bar, unsigned x, unsigned& nloc, unsigned& nx) {
    const unsigned G = gridDim.x * gridDim.y * gridDim.z;
    unsigned sum, cnt, mine, sp = 0u;
    for (;;) {
        sum = 0u; cnt = 0u; mine = 0u;
#pragma unroll
        for (unsigned j = 0; j < 16; ++j) { const unsigned c = xb_ld(&bar[XB_XCNT(j)]); sum += c; cnt += (c > 0u) ? 1u : 0u; mine = (j == x) ? c : mine; }
        if (sum == G) break;
        __builtin_amdgcn_s_sleep(1);
        if ((++sp & 255u) == 0u) { if (xb_ld(&bar[XB_TMO])) break; if (sp > XB_SPIN_CAP) { atomicAdd(&bar[XB_TMO], 1u); break; } }
    }
    nloc = mine > 0u ? mine : 1u; nx = cnt > 0u ? cnt : 1u;
}

__device__ __forceinline__ void xcd_barrier(const XcdBarrier& b) {
    asm volatile("s_waitcnt vmcnt(0)" ::: "memory");
    __syncthreads();
    if (my_tid() == 0) {
        unsigned* bar = b.bar;
        __builtin_amdgcn_s_waitcnt(0);
        unsigned nloc = b.st[0], nx = b.st[1];
        if (nloc == 0u) { xcd_barrier_complete(bar, b.x, nloc, nx); b.st[0] = nloc; b.st[1] = nx; }
        const unsigned old = xb_add(&bar[XB_XSUB(b.x)], 1u);
        const unsigned gen = old / nloc;
        if (old + 1u == (gen + 1u) * nloc) {
            __builtin_amdgcn_fence(__ATOMIC_RELEASE, "agent");
            asm volatile("s_waitcnt vmcnt(0)" ::: "memory");
            const unsigned og = xb_add(&bar[XB_TOP], 1u);
            const unsigned tg = og / nx;
            if (og + 1u == (tg + 1u) * nx) xb_add(&bar[XB_TOPGEN], 1u);
            else XB_SPIN(xb_ld(&bar[XB_TOPGEN]) == tg, bar);
            __builtin_amdgcn_fence(__ATOMIC_ACQUIRE, "agent");
            xb_add(&bar[XB_XGEN(b.x)], 1u);
            asm volatile("s_waitcnt vmcnt(0)" ::: "memory");
        } else {
            XB_SPIN(xb_ld(&bar[XB_XGEN(b.x)]) == gen, bar);
            __builtin_amdgcn_fence(__ATOMIC_ACQUIRE, "agent");
            asm volatile("s_waitcnt vmcnt(0)" ::: "memory");
        }
    }
    __syncthreads();
}

struct Args { const float* in[27]; float* out; unsigned char* ws; };
enum { I_X = 0, I_MEM, I_GMIX, I_WIN, I_BF, I_GQ, I_GK, I_CONVW, I_CONVB, I_WRA, I_BRA, I_WRI, I_BRI, I_LAM, I_GFOX, I_GLRU, I_WOUT, I_GXATTN, I_GMEM, I_WCQ, I_WCKV, I_GCQ, I_GCK, I_WCO, I_GFFN, I_WGU, I_WDN };

constexpr int KB_D = DM / 64;
constexpr int I0 = (INWP / 32) * KB_D, I3 = (2 * XW / 32) * KB_D, I7 = 16 * 4 * 2, N_EARLY = I0 + I3 + I7;
constexpr int I1 = (DM / 32) * KB_D, I2 = (XW / 32) * KB_D, I4 = (DM / 32) * (XW / 64), I5 = (2 * FFN / 32) * KB_D, I6 = (DM / 32) * (FFN / 64), N_LATE = I1 + I2 + I4 + I5 + I6;
constexpr int N_LATE_P1 = I1 + I2 + I4 + 2560;
constexpr int N_LATE_P2 = N_LATE_P1 + 2440;
__device__ __forceinline__ void early_item(const Args& a, int r, LAS float* scr, int lane) {
    unsigned char* ws = a.ws;
    if (r < I0) { const int rg = r / KB_D, kb = r % KB_D, d = rg * 32; int src = d, nv = 32;
        if (d >= 3072 && d < 5120) src = d + 8; else if (d == 5120) { src = 3072; nv = 8; } else if (d > 5120) { src = 0; nv = 0; }
        transpose_item<false>(a.in[I_WIN], INW, kb * 64, src, nv, nullptr, (bf16*)(ws + WS_WIN), DM, d, scr, lane); return; } r -= I0;
    if (r < I3) { const int rg = r / KB_D, kb = r % KB_D;
        transpose_item<false>(a.in[I_WCKV], 2 * XW, kb * 64, rg * 32, 32, nullptr, (bf16*)(ws + WS_WCKV), DM, rg * 32, scr, lane); return; } r -= I3;
    { const int mtx = r >> 3, sub = r & 7, rg = sub >> 1, kb = sub & 1, n = mtx >> 1, which = mtx & 1;
        transpose_item<false>((which ? a.in[I_WRI] : a.in[I_WRA]) + (size_t)n * 128 * 128, 128, kb * 64, rg * 32, 32, nullptr, (bf16*)(ws + WS_WLRU) + (size_t)(n * 256 + which * 128) * 128, 128, rg * 32, scr, lane); }
}
__device__ __forceinline__ void late_item(const Args& a, int r, LAS float* scr, int lane) {
    unsigned char* ws = a.ws;
    if (r < I1) { const int rg = r / KB_D, kb = r % KB_D; const float* ks = kb < 16 ? a.in[I_GFOX] : a.in[I_GLRU] - 1024;
        transpose_item<true>(a.in[I_WOUT], DM, kb * 64, rg * 32, 32, ks, (bf16*)(ws + WS_WOUT), DM, rg * 32, scr, lane); return; } r -= I1;
    if (r < I2) { const int rg = r / KB_D, kb = r % KB_D;
        transpose_item<true>(a.in[I_WCQ], XW, kb * 64, rg * 32, 32, a.in[I_GXATTN], (bf16*)(ws + WS_WCQ), DM, rg * 32, scr, lane); return; } r -= I2;
    if (r < I4) { const int rg = r / (XW / 64), kb = r % (XW / 64);
        transpose_item<true>(a.in[I_WCO], DM, kb * 64, rg * 32, 32, nullptr, (bf16*)(ws + WS_WCO), XW, rg * 32, scr, lane); return; } r -= I4;
    if (r < I5) { const int rg = r / KB_D, kb = r % KB_D, d = rg * 32, tile = d >> 8, w = d & 255; const int src = w < 128 ? tile * 128 + w : FFN + tile * 128 + (w - 128);
        transpose_item<true>(a.in[I_WGU], 2 * FFN, kb * 64, src, 32, a.in[I_GFFN], (bf16*)(ws + WS_WGU), DM, d, scr, lane); return; } r -= I5;
    { const int rg = r / (FFN / 64), kb = r % (FFN / 64);
        transpose_item<true>(a.in[I_WDN], DM, kb * 64, rg * 32, 32, nullptr, (bf16*)(ws + WS_WDN), FFN, rg * 32, scr, lane); }
}
__device__ __forceinline__ void late_range(const Args& a, LAS unsigned char* lds, int lo, int hi, int w, int nw, int wave, int lane) {
    LAS float* scr = (LAS float*)(lds + wave * 16384);
    for (int it = lo + w; it < hi; it += nw) late_item(a, it, scr, lane);
}
__device__ __forceinline__ void p0_prologue(const Args& a, LAS unsigned char* lds, int wave, int lane, int G) {
    unsigned char* ws = a.ws;
    LAS float* scr = (LAS float*)(lds + wave * 16384);
    const int gw = blockIdx.x * NWAVES + wave, NGW = G * NWAVES;
    for (int it = gw; it < N_EARLY; it += NGW) early_item(a, it, scr, lane);
    if (G != 256) for (int it = gw; it < N_LATE; it += NGW) late_item(a, it, scr, lane);
    for (int m = gw; m < M + MMEM; m += NGW) {
        if (m < M) rms_row_to_bf16(a.in[I_X] + (size_t)m * DM, a.in[I_GMIX], (bf16*)(ws + WS_XN) + (size_t)m * DM, lane);
        else rms_row_to_bf16(a.in[I_MEM] + (size_t)(m - M) * DM, a.in[I_GMEM], (bf16*)(ws + WS_MN) + (size_t)(m - M) * DM, lane);
    }
}

__device__ __forceinline__ void conv_chunk(const bf16* U, bf16* UC, const float* cw, const float* cbias, int row0, int s0, int nblk, int tid) {
    asm volatile("" : "+v"(tid));
    const int c8 = nblk * 128 + (tid & 15) * 8;
    f32x4 w[4][2], bb[2];
#pragma unroll
    for (int j = 0; j < 4; ++j) { w[j][0] = *(const f32x4*)(cw + j * LRUW + c8); w[j][1] = *(const f32x4*)(cw + j * LRUW + c8 + 4); }
    bb[0] = *(const f32x4*)(cbias + c8); bb[1] = *(const f32x4*)(cbias + c8 + 4);
#pragma unroll 2
    for (int p = 0; p < 8; ++p) { const int rl = p * 32 + (tid >> 4), s = s0 + rl; const unsigned grow = (unsigned)(row0 + rl);
        f32x4 a0 = bb[0], a1 = bb[1];
#pragma unroll
        for (int j = 0; j < 4; ++j) { if (s - 3 + j >= 0) { const v4u uw = *(const v4u*)((const char*)U + ((grow - 3 + j) * LRUW + c8) * 2u);
            a0 += w[j][0] * (f32x4){bflo(uw.x), bfhi(uw.x), bflo(uw.y), bfhi(uw.y)}; a1 += w[j][1] * (f32x4){bflo(uw.z), bfhi(uw.z), bflo(uw.w), bfhi(uw.w)}; } }
        v4u o; o.x = pk2(a0.x, a0.y); o.y = pk2(a0.z, a0.w); o.z = pk2(a1.x, a1.y); o.w = pk2(a1.z, a1.w);
        *(v4u*)((char*)UC + (grow * LRUW + c8) * 2u) = o; }
}

__global__ void __launch_bounds__(NTHR, LB2) hymba_fwd(Args a) {
    extern __shared__ __attribute__((aligned(16))) unsigned char lds_raw[];
    cg::grid_group grid = cg::this_grid();
    LAS unsigned char* lds = (LAS unsigned char*)lds_raw;
    { const int t0 = threadIdx.x; if ((t0 & 63) == 0) *(volatile LAS int*)(lds + WTAB_OFF + hw_slot() * 4) = t0 >> 6;
      if (t0 < 2) *(volatile LAS unsigned*)(lds + XBST_OFF + t0 * 4) = 0u; }
    __syncthreads();
    const XcdBarrier xbar = xcd_barrier_post((unsigned*)a.ws, (volatile LAS unsigned*)(lds + XBST_OFF));
    const int G = gridDim.x, c = blockIdx.x;
#define WIN ((bf16*)(a.ws + WS_WIN))
#define WOUT ((bf16*)(a.ws + WS_WOUT))
#define WCQ ((bf16*)(a.ws + WS_WCQ))
#define WCKV ((bf16*)(a.ws + WS_WCKV))
#define WCO ((bf16*)(a.ws + WS_WCO))
#define WGU ((bf16*)(a.ws + WS_WGU))
#define WDN ((bf16*)(a.ws + WS_WDN))
#define WLRU ((bf16*)(a.ws + WS_WLRU))
#define XN ((bf16*)(a.ws + WS_XN))
#define MN ((bf16*)(a.ws + WS_MN))
#define Qh ((bf16*)(a.ws + WS_Q))
#define Kh ((bf16*)(a.ws + WS_K))
#define Vh ((bf16*)(a.ws + WS_V))
#define U ((bf16*)(a.ws + WS_U))
#define GG ((bf16*)(a.ws + WS_GG))
#define UC ((bf16*)(a.ws + WS_UC))
#define LF ((float*)(a.ws + WS_LF))
#define CK ((bf16*)(a.ws + WS_CK))
#define CV ((bf16*)(a.ws + WS_CV))
#define MIX ((bf16*)(a.ws + WS_MIX))
#define SSQF ((float*)(a.ws + WS_SSQF))
#define SSQL ((float*)(a.ws + WS_SSQL))
#define X1 ((float*)(a.ws + WS_X1))
#define X1B ((bf16*)(a.ws + WS_X1B))
#define SSQ1 ((float*)(a.ws + WS_SSQ1))
#define CQ ((bf16*)(a.ws + WS_CQ))
#define OX ((bf16*)(a.ws + WS_OX))
#define X2B ((bf16*)(a.ws + WS_X2B))
#define SSQ2 ((float*)(a.ws + WS_SSQ2))
#define H ((bf16*)(a.ws + WS_H))
#define HL ((bf16*)(a.ws + WS_HL))
#define AC ((bf16*)(a.ws + WS_AC))
#define ENDH ((float*)(a.ws + WS_ENDH))
#define ENDA ((float*)(a.ws + WS_ENDA))
#define red ((PG8_LAS float*)(lds + RED_OFF))

    for (int rep = 0; rep < 1 + ((REP >> 0) & 1); ++rep) {
    if (PH & 1) { int tid = my_tid(); p0_prologue(a, lds, __builtin_amdgcn_readfirstlane(tid >> 6), tid & 63, G); }
    GSYNC();
    if (a.ws == nullptr) grid.sync();
    }

    for (int rep = 0; rep < 1 + ((REP >> 1) & 1); ++rep) {
    if (PH & 2) {
        pg8::Gemm g{XN, WIN, M, INWP, DM, DM, DM}; pg8::StaticOrder S; S.init(M, INWP, G, c);
        pg8::EpiIn E{0, Qh, Kh, Vh, U, GG, LF, a.in[I_GQ], a.in[I_GK], a.in[I_BF], red};
        pg8::gemm_phase<pg8::EpiIn, pg8::StaticOrder, true, true>(lds, g, S, E);
        pg8::Gemm g2{MN, WCKV, MMEM, 2 * XW, DM, DM, DM}; pg8::StaticOrder S2; S2.init(MMEM, 2 * XW, G, (c + 16) % G);
        pg8::EpiCkv E2{0, CK, CV, a.in[I_GCK], red};
        pg8::gemm_phase<pg8::EpiCkv, pg8::StaticOrder, true, true>(lds, g2, S2, E2);
        if (G == 256 && c >= 160 && c < 240) { const int t2 = my_tid(); late_range(a, lds, 0, N_LATE_P1, (c - 160) * NWAVES + (t2 >> 6), 80 * NWAVES, __builtin_amdgcn_readfirstlane(t2 >> 6), t2 & 63); }
    }
    GSYNC();
    }

    for (int rep = 0; rep < 1 + ((REP >> 2) & 1); ++rep) {
    if (PH & 4) { int cL = c, tid = my_tid(); asm volatile("" : "+s"(cL));
      const int nl = G > 128 ? G - 128 : G;
      if (G <= 128 || cL >= 128)
      for (int L = (G > 128 ? cL - 128 : cL); L < 256; L += nl) {
            const int pm = L >> 3, nblk = L & 7, row0 = pm * 256;
            conv_chunk(U, UC, a.in[I_CONVW], a.in[I_CONVB], row0, (pm & 7) * 256, nblk, tid);
            VM_WAIT(); __syncthreads(); __builtin_amdgcn_fence(__ATOMIC_ACQUIRE, "agent");
            pg8::Gemm g{UC + (size_t)row0 * LRUW + nblk * 128, WLRU + (size_t)nblk * 256 * 128, 256, 256, 128, LRUW, 128}; pg8::OneUnit S;
            pg8::EpiLru E{0, UC, HL, AC, ENDH + pm * 1024, ENDA + pm * 1024, a.in[I_BRA], a.in[I_BRI], a.in[I_LAM], row0, nblk};
            pg8::gemm_phase<pg8::EpiLru, pg8::OneUnit, false, true>(lds, g, S, E);
      }
      if (G == 256 && cL >= 128) {
        VM_WAIT(); __syncthreads();
        if (my_tid() == 0) { unsigned* cnt = (unsigned*)(a.ws + 15360);
            __builtin_amdgcn_fence(__ATOMIC_RELEASE, "agent"); asm volatile("s_waitcnt vmcnt(0)" ::: "memory");
            (void)__hip_atomic_fetch_add(cnt, 1u, __ATOMIC_RELAXED, __HIP_MEMORY_SCOPE_AGENT);
            unsigned sp = 0; while (__hip_atomic_load(cnt, __ATOMIC_RELAXED, __HIP_MEMORY_SCOPE_AGENT) < 128u && ++sp < (1u << 22)) __builtin_amdgcn_s_sleep(1);
            __builtin_amdgcn_fence(__ATOMIC_ACQUIRE, "agent"); asm volatile("s_waitcnt vmcnt(0)" ::: "memory"); }
        __syncthreads();
#define P2B_FIRST (cL - 128)
#define P2B_STRIDE 128
    { int tid = my_tid();
      for (int L = P2B_FIRST; L < 256; L += P2B_STRIDE) { const int pm = L >> 3, nblk = L & 7, j = pm & 7, c8 = nblk * 128 + (tid & 15) * 8;
        f32x4 hi0 = {0.f, 0.f, 0.f, 0.f}, hi1 = {0.f, 0.f, 0.f, 0.f};
        for (int i = 0; i < j; ++i) { const float* eh = ENDH + (pm - j + i) * 1024 + c8; const float* ea = ENDA + (pm - j + i) * 1024 + c8;
            hi0 = *(const f32x4*)ea * hi0 + *(const f32x4*)eh; hi1 = *(const f32x4*)(ea + 4) * hi1 + *(const f32x4*)(eh + 4); }
#pragma unroll 2
        for (int p = 0; p < 8; ++p) { const unsigned row = (unsigned)(pm * 256 + p * 32 + (tid >> 4)), o = (row * 1024u + c8) * 2u;
            const v4u hw = __builtin_nontemporal_load((const v4u*)((const char*)HL + o)), aw = __builtin_nontemporal_load((const v4u*)((const char*)AC + o)), gw = __builtin_nontemporal_load((const v4u*)((const char*)GG + o));
            const f32x4 y0 = ((f32x4){bflo(hw.x), bfhi(hw.x), bflo(hw.y), bfhi(hw.y)} + (f32x4){bflo(aw.x), bfhi(aw.x), bflo(aw.y), bfhi(aw.y)} * hi0) * (f32x4){bflo(gw.x), bfhi(gw.x), bflo(gw.y), bfhi(gw.y)};
            const f32x4 y1 = ((f32x4){bflo(hw.z), bfhi(hw.z), bflo(hw.w), bfhi(hw.w)} + (f32x4){bflo(aw.z), bfhi(aw.z), bflo(aw.w), bfhi(aw.w)} * hi1) * (f32x4){bflo(gw.z), bfhi(gw.z), bflo(gw.w), bfhi(gw.w)};
            float ss = (y0.x * y0.x + y0.y * y0.y) + (y0.z * y0.z + y0.w * y0.w) + (y1.x * y1.x + y1.y * y1.y) + (y1.z * y1.z + y1.w * y1.w);
            v4u ow; ow.x = pk2(y0.x, y0.y); ow.y = pk2(y0.z, y0.w); ow.z = pk2(y1.x, y1.y); ow.w = pk2(y1.z, y1.w);
            *(v4u*)((char*)MIX + ((size_t)row * 2048 + 1024 + c8) * 2) = ow;
            ss += shx<1>(ss); ss += shx<2>(ss); ss += shx<4>(ss); ss += shx<8>(ss);
            if ((tid & 15) == 0) SSQL[row * 8 + nblk] = ss; } } }
#undef P2B_FIRST
#undef P2B_STRIDE
        { const int t2 = my_tid(); late_range(a, lds, N_LATE_P1, N_LATE_P2, (cL - 128) * NWAVES + (t2 >> 6), 128 * NWAVES, __builtin_amdgcn_readfirstlane(t2 >> 6), t2 & 63); } } }
    if (PH & 4) { int cF = c, tid = my_tid(); asm volatile("" : "+s"(cF)); const int lane = tid & 63, wave = __builtin_amdgcn_readfirstlane(tid >> 6);
      for (int L = cF; L < 128; L += G) {
        {
#if !defined(NO_FOX)
            const int it = L, bh = it >> 2, x = it & 3, b = bh >> 3, h = bh & 7;
            LAS float* cbl = (LAS float*)(lds + CB_OFF); LAS float* wsum = (LAS float*)(lds + WSUM_OFF);
            { const float* lf = LF + ((size_t)b * SEQ + tid * 4) * 8 + h;
              const float v0 = lf[0], v1 = lf[8], v2 = lf[16], v3 = lf[24]; const float t0 = v0, t1 = t0 + v1, t2 = t1 + v2, t3 = t2 + v3;
              wsum[tid] = t3; __syncthreads();
              for (int o = 1; o < 512; o <<= 1) { const float v = wsum[tid] + (tid >= o ? wsum[tid - o] : 0.f); __syncthreads(); wsum[tid] = v; __syncthreads(); }
              const float off = wsum[tid] - t3;
              const float ns = -1.0f / att::SCALE;
              *(LAS f32x4*)(cbl + tid * 4) = (f32x4){(off + t0) * ns, (off + t1) * ns, (off + t2) * ns, (off + t3) * ns};
              __syncthreads(); }
            typedef att::BlockRef<att::bf16, att::bf16> BR;
            BR cur, nxt;
            { const size_t hrow = (size_t)bh * SEQ;
              cur.Q = (const att::bf16*)Qh + (hrow + x * 256) * 128; cur.K = (const att::bf16*)Kh + hrow * 128; cur.V = (const att::bf16*)Vh + hrow * 128;
              cur.O = (att::bf16*)MIX + ((size_t)b * SEQ + x * 256) * 2048 + h * 128; cur.SS = FOX_SS; cur.P0 = x * 256;
              nxt = cur; const int d = (7 - 2 * x) * 256;
              nxt.Q += (size_t)d * 128; nxt.O += (size_t)d * 2048; nxt.SS += (size_t)d * 8; nxt.P0 += d; }
            att::Seam<att::bf16> S;
            att::causal_swa_prime<att::bf16, att::bf16>(cur, 1 << 20, (char*)lds_raw, S);
            for (int p = 0; p < 2; ++p) {
                att::causal_swa_block<att::bf16, att::bf16, 2048, FOX_HAS_SS>(cur, nxt, SEQ, 1 << 20, (char*)lds_raw, S, FOX_CB);
                cur = nxt; }
            VM_WAIT(); __syncthreads(); __builtin_amdgcn_fence(__ATOMIC_ACQUIRE, "agent");
            for (int p = 0; p < 16; ++p) { const int qb = (p < 8) ? x : 7 - x, rl = (p & 7) * 32 + (tid >> 4); const size_t trow = (size_t)b * SEQ + qb * 256 + rl;
                const v4u w = *(const v4u*)(MIX + trow * 2048 + h * 128 + (tid & 15) * 8);
                float ss = (bflo(w.x) * bflo(w.x) + bfhi(w.x) * bfhi(w.x)) + (bflo(w.y) * bflo(w.y) + bfhi(w.y) * bfhi(w.y)) + (bflo(w.z) * bflo(w.z) + bfhi(w.z) * bfhi(w.z)) + (bflo(w.w) * bflo(w.w) + bfhi(w.w) * bfhi(w.w));
                ss += shx<1>(ss); ss += shx<2>(ss); ss += shx<4>(ss); ss += shx<8>(ss);
                if ((tid & 15) == 0) SSQF[trow * 8 + h] = ss; }
            VM_WAIT(); __syncthreads();
#endif
        }
    } }
    GSYNC();
    }

    if (G != 256) {
#define P2B_FIRST c
#define P2B_STRIDE G
    { int tid = my_tid();
      for (int L = P2B_FIRST; L < 256; L += P2B_STRIDE) { const int pm = L >> 3, nblk = L & 7, j = pm & 7, c8 = nblk * 128 + (tid & 15) * 8;
        f32x4 hi0 = {0.f, 0.f, 0.f, 0.f}, hi1 = {0.f, 0.f, 0.f, 0.f};
        for (int i = 0; i < j; ++i) { const float* eh = ENDH + (pm - j + i) * 1024 + c8; const float* ea = ENDA + (pm - j + i) * 1024 + c8;
            hi0 = *(const f32x4*)ea * hi0 + *(const f32x4*)eh; hi1 = *(const f32x4*)(ea + 4) * hi1 + *(const f32x4*)(eh + 4); }
#pragma unroll 2
        for (int p = 0; p < 8; ++p) { const unsigned row = (unsigned)(pm * 256 + p * 32 + (tid >> 4)), o = (row * 1024u + c8) * 2u;
            const v4u hw = __builtin_nontemporal_load((const v4u*)((const char*)HL + o)), aw = __builtin_nontemporal_load((const v4u*)((const char*)AC + o)), gw = __builtin_nontemporal_load((const v4u*)((const char*)GG + o));
            const f32x4 y0 = ((f32x4){bflo(hw.x), bfhi(hw.x), bflo(hw.y), bfhi(hw.y)} + (f32x4){bflo(aw.x), bfhi(aw.x), bflo(aw.y), bfhi(aw.y)} * hi0) * (f32x4){bflo(gw.x), bfhi(gw.x), bflo(gw.y), bfhi(gw.y)};
            const f32x4 y1 = ((f32x4){bflo(hw.z), bfhi(hw.z), bflo(hw.w), bfhi(hw.w)} + (f32x4){bflo(aw.z), bfhi(aw.z), bflo(aw.w), bfhi(aw.w)} * hi1) * (f32x4){bflo(gw.z), bfhi(gw.z), bflo(gw.w), bfhi(gw.w)};
            float ss = (y0.x * y0.x + y0.y * y0.y) + (y0.z * y0.z + y0.w * y0.w) + (y1.x * y1.x + y1.y * y1.y) + (y1.z * y1.z + y1.w * y1.w);
            v4u ow; ow.x = pk2(y0.x, y0.y); ow.y = pk2(y0.z, y0.w); ow.z = pk2(y1.x, y1.y); ow.w = pk2(y1.z, y1.w);
            *(v4u*)((char*)MIX + ((size_t)row * 2048 + 1024 + c8) * 2) = ow;
            ss += shx<1>(ss); ss += shx<2>(ss); ss += shx<4>(ss); ss += shx<8>(ss);
            if ((tid & 15) == 0) SSQL[row * 8 + nblk] = ss; } } }
#undef P2B_FIRST
#undef P2B_STRIDE
    GSYNC(); }

    for (int rep = 0; rep < 1 + ((REP >> 3) & 1); ++rep) {
    if (PH & 8) {
        pg8::Gemm g{MIX, WOUT, M, DM, DM, DM, DM}; pg8::StaticOrder S; S.init(M, DM, G, c);
        pg8::EpiRes<true> E{16, a.in[I_X], nullptr, nullptr, X1B, SSQ1, SSQF, SSQL};
        pg8::gemm_phase<pg8::EpiRes<true>, pg8::StaticOrder, true, true>(lds, g, S, E);
    }
    GSYNC();
    }

    for (int rep = 0; rep < 1 + ((REP >> 4) & 1); ++rep) {
    if (PH & 16) {
        pg8::Gemm g{X1B, WCQ, M, XW, DM, DM, DM}; pg8::StaticOrder S; S.init(M, XW, G, c);
        pg8::EpiCq E{0, CQ, a.in[I_GCQ], SSQ1, red};
        pg8::gemm_phase<pg8::EpiCq, pg8::StaticOrder, true, true>(lds, g, S, E);
        if (G == 256 && c >= 64) { const int t2 = my_tid(); late_range(a, lds, N_LATE_P2, N_LATE, (c - 64) * NWAVES + (t2 >> 6), 192 * NWAVES, __builtin_amdgcn_readfirstlane(t2 >> 6), t2 & 63); }
    }
    GSYNC();
    }

    for (int rep = 0; rep < 1 + ((REP >> 5) & 1); ++rep) {
    if (PH & 32) for (int L = c; L < 128; L += G) {
        const int bh = L >> 3, qb = L & 7, b = bh >> 2, h = bh & 3;
        att::BlockRef<att::bf16, att::bf16> r;
        r.Q = (const att::bf16*)CQ + ((size_t)bh * SEQ + qb * 256) * 128; r.K = (const att::bf16*)CK + (size_t)bh * NMEM * 128; r.V = (const att::bf16*)CV + (size_t)bh * NMEM * 128;
        r.O = (att::bf16*)OX + ((size_t)b * SEQ + qb * 256) * XW + h * 128; r.SS = nullptr; r.P0 = 1 << 16;
        att::Seam<att::bf16> S;
        att::causal_swa_prime<att::bf16, att::bf16>(r, 1 << 20, (char*)lds_raw, S);
        att::causal_swa_block<att::bf16, att::bf16, XW, false>(r, r, NMEM, 1 << 20, (char*)lds_raw, S, -1);
        VM_WAIT(); __syncthreads();
    }
    GSYNC();
    }

    for (int rep = 0; rep < 1 + ((REP >> 6) & 1); ++rep) {
    if (PH & 64) {
        pg8::Gemm g{OX, WCO, M, DM, XW, XW, XW}; pg8::StaticOrder S; S.init(M, DM, G, c);
        pg8::EpiRes<false> E{0, nullptr, X1B, nullptr, X2B, SSQ2, nullptr, nullptr};
        pg8::gemm_phase<pg8::EpiRes<false>, pg8::StaticOrder, true, true>(lds, g, S, E);
    }
    GSYNC();
    }

    for (int rep = 0; rep < 1 + ((REP >> 7) & 1); ++rep) {
    if (PH & 128) {
        pg8::Gemm g{X2B, WGU, M, 2 * FFN, DM, DM, DM}; pg8::StaticOrder S; S.init(M, 2 * FFN, G, c);
        pg8::EpiGu E{0, H, SSQ2, red};
        pg8::gemm_phase<pg8::EpiGu, pg8::StaticOrder, true, true>(lds, g, S, E);
    }
    GSYNC();
    }

    if (PH & 256) {
        pg8::Gemm g{H, WDN, M, DM, FFN, FFN, FFN}; pg8::StaticOrder S; S.init(M, DM, G, c);
        pg8::EpiRes<false> E{0, nullptr, X2B, a.out, nullptr, nullptr, nullptr, nullptr};
        pg8::gemm_phase<pg8::EpiRes<false>, pg8::StaticOrder, true, true>(lds, g, S, E);
    }
}

#undef WIN
#undef WOUT
#undef WCQ
#undef WCKV
#undef WCO
#undef WGU
#undef WDN
#undef WLRU
#undef XN
#undef MN
#undef Qh
#undef Kh
#undef Vh
#undef U
#undef GG
#undef UC
#undef LF
#undef CK
#undef CV
#undef MIX
#undef SSQF
#undef SSQL
#undef X1
#undef X1B
#undef SSQ1
#undef CQ
#undef OX
#undef X2B
#undef SSQ2
#undef H
#undef HL
#undef AC
#undef ENDH
#undef ENDA
#undef red
extern "C" void kernel_launch(void* const* d_in, const int* in_sizes, int n_in, void* d_out, int out_size, void* d_ws, size_t ws_size, hipStream_t stream) {
    static int grid = 0;
    if (grid == 0) {
        if (n_in != 27 || in_sizes[0] != M * DM || out_size != M * DM || ws_size < WS_END) { fprintf(stderr, "kernel_launch: unexpected shapes (n_in %d, in0 %d, out %d, ws %zu)\n", n_in, n_in > 0 ? in_sizes[0] : -1, out_size, ws_size); grid = -1; return; }
        int dev = 0, cus = 0, per_cu = 0;
        (void)hipGetDevice(&dev); (void)hipDeviceGetAttribute(&cus, hipDeviceAttributeMultiprocessorCount, dev);
        if (hipFuncSetAttribute((const void*)hymba_fwd, hipFuncAttributeMaxDynamicSharedMemorySize, LDS_BYTES) != hipSuccess) { fprintf(stderr, "kernel_launch: hipFuncSetAttribute failed\n"); grid = -1; return; }
        if (hipOccupancyMaxActiveBlocksPerMultiprocessor(&per_cu, (const void*)hymba_fwd, NTHR, LDS_BYTES) != hipSuccess || per_cu < 1) { fprintf(stderr, "kernel_launch: occupancy query says %d\n", per_cu); per_cu = 1; }
        (void)hipGetLastError();
        grid = cus * per_cu;
    }
    if (grid < 0) return;
    Args a{};
    for (int i = 0; i < 27; ++i) a.in[i] = (const float*)d_in[i];
    a.out = (float*)d_out; a.ws = (unsigned char*)d_ws;
    if (hipMemsetAsync(d_ws, 0, 16384, stream) != hipSuccess) { fprintf(stderr, "kernel_launch: memset of the barrier words failed\n"); return; }
    void* args[] = {&a};
    hipError_t e = hipLaunchCooperativeKernel((const void*)hymba_fwd, dim3(grid), dim3(NTHR), args, LDS_BYTES, stream);
    if (e != hipSuccess) fprintf(stderr, "cooperative launch failed: %s (grid %d)\n", hipGetErrorString(e), grid);
}
```

```cpp
#include <hip/hip_runtime.h>
#include <hip/hip_bf16.h>
#include <hip/hip_cooperative_groups.h>
#include <cstdio>
#include <cstdint>
namespace cg = cooperative_groups;


template <int K> __device__ __forceinline__ float shx(float v) { static_assert(K < 32, "use sum32"); return __int_as_float(__builtin_amdgcn_ds_swizzle(__float_as_int(v), (K << 10) | 0x1f)); }
__device__ __forceinline__ float sum32(float v) { auto rr = __builtin_amdgcn_permlane32_swap(__float_as_uint(v), __float_as_uint(v), false, false); return __uint_as_float(rr[0]) + __uint_as_float(rr[1]); }
constexpr int WTAB_OFF = 147456 - 256, XBST_OFF = 147456 - 512;
__device__ __forceinline__ int hw_slot() { return (int)(__builtin_amdgcn_s_getreg((5 << 11) | 4) & 63u); }
__device__ __forceinline__ int my_tid() {
    const int slot = hw_slot();
    const int wave = __builtin_amdgcn_readfirstlane(*(volatile __attribute__((address_space(3))) int*)(unsigned)(WTAB_OFF + slot * 4));
    int l; asm volatile("v_mbcnt_lo_u32_b32 %0, -1, 0\n\tv_mbcnt_hi_u32_b32 %0, -1, %0" : "=v"(l));
    return wave * 64 + l;
}
namespace pg8 {
#define PG8_LAS __attribute__((address_space(3)))
typedef unsigned short bf16_t;
typedef short bf16x8 __attribute__((ext_vector_type(8)));
typedef float f32x4 __attribute__((ext_vector_type(4)));
typedef unsigned u32x4 __attribute__((ext_vector_type(4)));
constexpr int BM = 256, BK = 64, HALF = 128, HTB = HALF * BK * 2  , STAGE_BYTES = 8 * HTB, NXCD = 8, WGM = 8;

__host__ __device__ __forceinline__ int lds_byte(int r, int c) { const int st = (r >> 4) * 2 + (c >> 5), rr = r & 15, cc = c & 31, ob = rr * 64 + cc * 2; return st * 1024 + (ob ^ (((ob >> 9) & 1) << 5)); }
__host__ __device__ __forceinline__ void stage_rc(int b, int& R, int& C) { const int st = b / 1024, sb = b % 1024, swz = sb ^ (((sb >> 9) & 1) << 5); R = (st >> 1) * 16 + swz / 64; C = (st & 1) * 32 + (swz % 64) / 2; }
__host__ __device__ __forceinline__ int perm32(int rho) { const int n = rho >> 4, i = rho & 15; return 8 * (i >> 2) + 4 * n + (i & 3); }

struct Unit { int pm, pn; };
struct Gemm { const bf16_t* A; const bf16_t* Bt; int M, N, K, lda, ldb; };

struct StaticOrder {
    int nM, nN, nwg, G, c;
    __host__ __device__ void init(int M, int N, int G_, int c_) { nM = M / BM; nN = N / BM; nwg = nM * nN; G = G_; c = c_; }
    __host__ __device__ bool next(int i, Unit& u) const {
        const long L = (long)i * G + c; if (L >= nwg) return false;
        int wgid = (int)L; { const int q = nwg / NXCD, r = nwg % NXCD, xcd = wgid % NXCD, off = wgid / NXCD; wgid = (xcd < r ? xcd * (q + 1) : r * (q + 1) + (xcd - r) * q) + off; }
        const int nig = WGM * nN, gid = wgid / nig, fm = gid * WGM, gsz = (nM - fm) < WGM ? (nM - fm) : WGM;
        u.pm = fm + ((wgid % nig) % gsz); u.pn = (wgid % nig) / gsz; return true;
    }
    __device__ __forceinline__ void a_ready(const Unit&) const {}
    __device__ __forceinline__ void done(const Unit&) const {}
};

__device__ __forceinline__ unsigned cvt_pk_bf16(float lo, float hi) { unsigned r; asm volatile("v_cvt_pk_bf16_f32 %0, %1, %2" : "=v"(r) : "v"(lo), "v"(hi)); return r; }

typedef float f32x2 __attribute__((ext_vector_type(2)));
constexpr float RMS_EPS = 1e-6f;
struct OneUnit {
    __device__ __forceinline__ bool next(int i, Unit& u) const { if (i != 0) return false; u.pm = 0; u.pn = 0; return true; }
    __device__ __forceinline__ void a_ready(const Unit&) const {}
    __device__ __forceinline__ void done(const Unit&) const {}
};
struct OffsetOrder {
    StaticOrder S;
    __device__ __forceinline__ bool next(int i, Unit& u) const { return S.next(i, u); }
    __device__ __forceinline__ void a_ready(const Unit&) const {}
    __device__ __forceinline__ void done(const Unit&) const {}
};
__device__ __forceinline__ float fast_log1p(float x) { const float sr = x * (1.0f - x * (0.5f - x * (0.33333334f - x * (0.25f - x * (0.2f - x * 0.16666667f))))); return x < 0.0625f ? sr : __logf(1.0f + x); }
__device__ __forceinline__ float sigmoidf_(float x) { return __builtin_amdgcn_rcpf(1.0f + __expf(-x)); }
__device__ __forceinline__ float gelu_tanh(float x) { const float u = 0.7978845608028654f * (x + 0.044715f * x * x * x); return x * sigmoidf_(2.0f * u); }
__device__ __forceinline__ float sum_f(const float* p, int n4) { float s = 0.f; for (int i = 0; i < n4; ++i) { const f32x4 v = *(const f32x4*)(p + 4 * i); s += (v[0] + v[1]) + (v[2] + v[3]); } return s; }
__device__ __forceinline__ u32x4 pack8(const f32x4& a, const f32x4& b) { u32x4 w; w.x = cvt_pk_bf16(a[0], a[1]); w.y = cvt_pk_bf16(a[2], a[3]); w.z = cvt_pk_bf16(b[0], b[1]); w.w = cvt_pk_bf16(b[2], b[3]); return w; }

template <int ACT  >
__device__ __forceinline__ void store_tile(const f32x4 (&acc)[2][2][4][2], bf16_t* d0, bf16_t* d1, size_t ld, int wr, int wc, int fr, int fq) {
#pragma unroll
    for (int ai = 0; ai < 2; ++ai)
#pragma unroll
        for (int m = 0; m < 4; ++m) { const size_t ro = (size_t)(ai * HALF + wr * 64 + m * 16 + fr) * ld + wc * 32 + fq * 8;
#pragma unroll
            for (int bj = 0; bj < 2; ++bj) { f32x4 v0 = acc[ai][bj][m][0], v1 = acc[ai][bj][m][1];
                if (ACT == 1) {
#pragma unroll
                    for (int j = 0; j < 4; ++j) { v0[j] = gelu_tanh(v0[j]); v1[j] = gelu_tanh(v1[j]); } }
                *(u32x4*)((bj ? d1 : d0) + ro) = pack8(v0, v1); } }
}
template <bool ROWSCALE>
__device__ __forceinline__ void head_norm_store(const f32x4 (&acc)[2][2][4][2], const float (&rs)[2][4], const float* gain, bf16_t* d0, bf16_t* d1, PG8_LAS float* red, int wr, int wc, int fr, int fq) {
#pragma unroll
    for (int ai = 0; ai < 2; ++ai)
#pragma unroll
        for (int m = 0; m < 4; ++m)
#pragma unroll
            for (int bj = 0; bj < 2; ++bj) { float s = 0.f;
#pragma unroll
                for (int n = 0; n < 2; ++n) { f32x4 v = acc[ai][bj][m][n]; if (ROWSCALE) v = v * rs[ai][m]; s += (v[0] * v[0] + v[1] * v[1]) + (v[2] * v[2] + v[3] * v[3]); }
                s += shx<16>(s); s = sum32(s);
                if (fq == 0) red[((ai * HALF + wr * 64 + m * 16 + fr) * 2 + bj) * 4 + wc] = s; }
    asm volatile("s_waitcnt lgkmcnt(0)" ::: "memory"); __builtin_amdgcn_s_barrier(); asm volatile("" ::: "memory");
    const f32x4 g0 = *(const f32x4*)(gain + wc * 32 + fq * 8), g1 = *(const f32x4*)(gain + wc * 32 + fq * 8 + 4);
#pragma unroll
    for (int ai = 0; ai < 2; ++ai)
#pragma unroll
        for (int m = 0; m < 4; ++m) { const int rl = ai * HALF + wr * 64 + m * 16 + fr;
#pragma unroll
            for (int bj = 0; bj < 2; ++bj) { const PG8_LAS float* rp = red + (rl * 2 + bj) * 4;
                const float ss = (rp[0] + rp[1]) + (rp[2] + rp[3]);
                float sc = __builtin_amdgcn_rsqf(ss * (1.0f / 128.0f) + RMS_EPS); if (ROWSCALE) sc *= rs[ai][m];
                const f32x4 v0 = acc[ai][bj][m][0] * sc * g0, v1 = acc[ai][bj][m][1] * sc * g1;
                *(u32x4*)((bj ? d1 : d0) + (size_t)rl * 128 + wc * 32 + fq * 8) = pack8(v0, v1); } }
}

struct EpiIn {
    static constexpr bool PERM = true, AFTER_DRAIN = false, HAS_MID = false; int mid_t;
    bf16_t *Q, *Kh, *V, *U, *GG; float* LF; const float *g_q, *g_k, *b_f; PG8_LAS float* red;
    __device__ __forceinline__ void operator()(const f32x4 (&acc)[2][2][4][2], const Unit& u, int wr, int wc, int fr, int fq) const {
        asm volatile("" : "+v"(fr), "+v"(fq));
        const int pn = u.pn, row0 = u.pm * BM, b = row0 >> 11, s0 = row0 & 2047;
        if (pn < 12) {
            const int h0 = (pn & 3) * 2; bf16_t* const q_ = Q; bf16_t* const k_ = Kh; bf16_t* const v_ = V; const float* const gq_ = g_q; const float* const gk_ = g_k;
            bf16_t* base = pn < 4 ? q_ : (pn < 8 ? k_ : v_);
            bf16_t* d0 = base + ((size_t)(b * 8 + h0) * 2048 + s0) * 128; bf16_t* d1 = d0 + (size_t)2048 * 128;
            if (pn < 8) { float rs[2][4]; head_norm_store<false>(acc, rs, pn < 4 ? gq_ : gk_, d0, d1, red, wr, wc, fr, fq); }
            else store_tile<0>(acc, d0, d1, 128, wr, wc, fr, fq);
        } else if (pn < 16) { bf16_t* const u_ = U; bf16_t* d0 = u_ + (size_t)row0 * 1024 + (pn - 12) * 256; store_tile<0>(acc, d0, d0 + 128, 1024, wr, wc, fr, fq); }
        else if (pn < 20) { bf16_t* const g_ = GG; bf16_t* d0 = g_ + (size_t)row0 * 1024 + (pn - 16) * 256; store_tile<1>(acc, d0, d0 + 128, 1024, wr, wc, fr, fq); }
        else if (wc == 0 && fq == 0) {
            const f32x4 b0 = *(const f32x4*)b_f, b1 = *(const f32x4*)(b_f + 4);
#pragma unroll
            for (int ai = 0; ai < 2; ++ai)
#pragma unroll
                for (int m = 0; m < 4; ++m) { const int row = row0 + ai * HALF + wr * 64 + m * 16 + fr; f32x4 z0 = acc[ai][0][m][0] + b0, z1 = acc[ai][0][m][1] + b1;
#pragma unroll
                    for (int j = 0; j < 4; ++j) { z0[j] = fminf(z0[j], 0.f) - fast_log1p(__expf(-fabsf(z0[j]))); z1[j] = fminf(z1[j], 0.f) - fast_log1p(__expf(-fabsf(z1[j]))); }
                    *(f32x4*)(LF + (size_t)row * 8) = z0; *(f32x4*)(LF + (size_t)row * 8 + 4) = z1; }
        }
    }
};
struct EpiCkv {
    static constexpr bool PERM = true, AFTER_DRAIN = false, HAS_MID = false; int mid_t;
    bf16_t *CK, *CV; const float* g_ck; PG8_LAS float* red;
    __device__ __forceinline__ void operator()(const f32x4 (&acc)[2][2][4][2], const Unit& u, int wr, int wc, int fr, int fq) const {
        asm volatile("" : "+v"(fr), "+v"(fq));
        const int pn = u.pn, b = u.pm, h0 = (pn & 1) * 2;
        bf16_t* const ck_ = CK; bf16_t* const cv_ = CV; bf16_t* d0 = (pn < 2 ? ck_ : cv_) + ((size_t)(b * 4 + h0) * 256) * 128; bf16_t* d1 = d0 + (size_t)256 * 128;
        if (pn < 2) { float rs[2][4]; head_norm_store<false>(acc, rs, g_ck, d0, d1, red, wr, wc, fr, fq); }
        else store_tile<0>(acc, d0, d1, 128, wr, wc, fr, fq);
    }
};
struct EpiCq {
    static constexpr bool PERM = true, AFTER_DRAIN = false, HAS_MID = false; int mid_t;
    bf16_t* CQ; const float* g_cq; const float* SSQ; PG8_LAS float* red;
    __device__ __forceinline__ void operator()(const f32x4 (&acc)[2][2][4][2], const Unit& u, int wr, int wc, int fr, int fq) const {
        asm volatile("" : "+v"(fr), "+v"(fq));
        const int pn = u.pn, row0 = u.pm * BM, b = row0 >> 11, s0 = row0 & 2047, h0 = pn * 2, tid = (wr * 4 + wc) * 64 + fq * 16 + fr;
        PG8_LAS float* tab = red + 2048;
        if (tid < 256) tab[tid] = __builtin_amdgcn_rsqf(sum_f(SSQ + (size_t)(row0 + tid) * 32, 8) * (1.0f / 2048.0f) + RMS_EPS);
        asm volatile("s_waitcnt lgkmcnt(0)" ::: "memory"); __builtin_amdgcn_s_barrier(); asm volatile("" ::: "memory");
        float rs[2][4];
#pragma unroll
        for (int ai = 0; ai < 2; ++ai)
#pragma unroll
            for (int m = 0; m < 4; ++m) rs[ai][m] = tab[ai * HALF + wr * 64 + m * 16 + fr];
        bf16_t* d0 = CQ + ((size_t)(b * 4 + h0) * 2048 + s0) * 128; bf16_t* d1 = d0 + (size_t)2048 * 128;
        head_norm_store<true>(acc, rs, g_cq, d0, d1, red, wr, wc, fr, fq);
    }
};
template <bool MID> struct EpiRes {
    static constexpr bool PERM = true, AFTER_DRAIN = false, HAS_MID = MID; int mid_t;
    const float* resid; const bf16_t* residb; float* outf; bf16_t* outb; float* ssq_out; const float *ssqf, *ssql;
    __device__ __forceinline__ void mid(f32x4 (&acc)[2][2][4][2], const Unit& u, int wr, int wc, int fr, int fq) const {
        asm volatile("" : "+v"(fr), "+v"(fq));
#pragma unroll
        for (int ai = 0; ai < 2; ++ai)
#pragma unroll
            for (int m = 0; m < 4; ++m) { const size_t row = (size_t)u.pm * BM + ai * HALF + wr * 64 + m * 16 + fr;
                const float rf = __builtin_amdgcn_rsqf(sum_f(ssqf + row * 8, 2) * (1.0f / 1024.0f) + RMS_EPS), rl = __builtin_amdgcn_rsqf(sum_f(ssql + row * 8, 2) * (1.0f / 1024.0f) + RMS_EPS);
                const float ratio = rf / rl;
#pragma unroll
                for (int bj = 0; bj < 2; ++bj)
#pragma unroll
                    for (int n = 0; n < 2; ++n) acc[ai][bj][m][n] = acc[ai][bj][m][n] * ratio;
                __builtin_amdgcn_sched_barrier(0); }
    }
    __device__ __forceinline__ void operator()(const f32x4 (&acc)[2][2][4][2], const Unit& u, int wr, int wc, int fr, int fq) const {
        asm volatile("" : "+v"(fr), "+v"(fq));
#pragma unroll
        for (int ai = 0; ai < 2; ++ai)
#pragma unroll
            for (int m = 0; m < 4; ++m) { const size_t row = (size_t)u.pm * BM + ai * HALF + wr * 64 + m * 16 + fr;
                float sc = 1.f; if (MID) sc = __builtin_amdgcn_rsqf(sum_f(ssql + row * 8, 2) * (1.0f / 1024.0f) + RMS_EPS);
                float ss = 0.f;
#pragma unroll
                for (int bj = 0; bj < 2; ++bj) { const size_t o = row * 2048 + u.pn * BM + bj * HALF + wc * 32 + fq * 8;
                    f32x4 r0, r1;
                    if (residb) { const u32x4 w = __builtin_nontemporal_load((const u32x4*)(residb + o));     r0 = (f32x4){__uint_as_float(w.x << 16), __uint_as_float(w.x & 0xffff0000u), __uint_as_float(w.y << 16), __uint_as_float(w.y & 0xffff0000u)};
                                  r1 = (f32x4){__uint_as_float(w.z << 16), __uint_as_float(w.z & 0xffff0000u), __uint_as_float(w.w << 16), __uint_as_float(w.w & 0xffff0000u)}; }
                    else { r0 = __builtin_nontemporal_load((const f32x4*)(resid + o)); r1 = __builtin_nontemporal_load((const f32x4*)(resid + o + 4)); }
                    const f32x4 v0 = r0 + acc[ai][bj][m][0] * sc, v1 = r1 + acc[ai][bj][m][1] * sc;
                    if (outf) { __builtin_nontemporal_store(v0, (f32x4*)(outf + o)); __builtin_nontemporal_store(v1, (f32x4*)(outf + o + 4)); }
                    ss += (v0[0] * v0[0] + v0[1] * v0[1]) + (v0[2] * v0[2] + v0[3] * v0[3]) + (v1[0] * v1[0] + v1[1] * v1[1]) + (v1[2] * v1[2] + v1[3] * v1[3]);
                    if (outb) *(u32x4*)(outb + o) = pack8(v0, v1); }
                if (ssq_out) { ss += shx<16>(ss); ss = sum32(ss); if (fq == 0) ssq_out[row * 32 + u.pn * 4 + wc] = ss; }
                __builtin_amdgcn_sched_barrier(0); }
    }
};
struct EpiGu {
    static constexpr bool PERM = true, AFTER_DRAIN = false, HAS_MID = false; int mid_t;
    bf16_t* H; const float* SSQ; PG8_LAS float* red;
    __device__ __forceinline__ void operator()(const f32x4 (&acc)[2][2][4][2], const Unit& u, int wr, int wc, int fr, int fq) const {
        asm volatile("" : "+v"(fr), "+v"(fq));
        const int tid = (wr * 4 + wc) * 64 + fq * 16 + fr; PG8_LAS float* tab = red + 2048; PG8_LAS int* tabpm = (PG8_LAS int*)(tab + 256);
        if (*(volatile PG8_LAS int*)tabpm != u.pm) {
            if (tid < 256) tab[tid] = __builtin_amdgcn_rsqf(sum_f(SSQ + ((size_t)u.pm * BM + tid) * 32, 8) * (1.0f / 2048.0f) + RMS_EPS);
            asm volatile("s_waitcnt lgkmcnt(0)" ::: "memory"); __builtin_amdgcn_s_barrier(); asm volatile("" ::: "memory");
            if (tid == 0) *(volatile PG8_LAS int*)tabpm = u.pm; }
#pragma unroll
        for (int ai = 0; ai < 2; ++ai)
#pragma unroll
            for (int m = 0; m < 4; ++m) { const size_t row = (size_t)u.pm * BM + ai * HALF + wr * 64 + m * 16 + fr;
                const float rs = tab[ai * HALF + wr * 64 + m * 16 + fr];
                f32x4 h[2];
#pragma unroll
                for (int n = 0; n < 2; ++n) { const f32x4 g = acc[ai][0][m][n] * rs, up = acc[ai][1][m][n] * rs;
#pragma unroll
                    for (int j = 0; j < 4; ++j) h[n][j] = g[j] * sigmoidf_(g[j]) * up[j]; }
                *(u32x4*)(H + row * 5632 + u.pn * HALF + wc * 32 + fq * 8) = pack8(h[0], h[1]); }
    }
};
struct EpiLru {
    static constexpr bool PERM = true, AFTER_DRAIN = true, HAS_MID = false; int mid_t;
    const bf16_t* UC; bf16_t* HL; bf16_t* AC; float* ENDH; float* ENDA; const float *b_ra, *b_ri, *lam; int row0, nblk;
    __device__ __forceinline__ void fused(f32x4 (&acc)[2][2][4][2], const Unit&, int wr, int wc, int fr, int fq, PG8_LAS unsigned char* lds, int wid, int lane) const {
        asm volatile("" : "+v"(fr), "+v"(fq));
        PG8_LAS float* LA = (PG8_LAS float*)lds; PG8_LAS float* LB = LA + 128 * 132; PG8_LAS float* SX = LB + 128 * 132;
        const int tid = wid * 64 + lane, ch0 = nblk * 128 + wc * 32 + fq * 8;
#pragma unroll
        for (int ai = 0; ai < 2; ++ai) {
#pragma unroll
            for (int n = 0; n < 2; ++n) {
                const f32x4 bra = *(const f32x4*)(b_ra + ch0 + 4 * n), bri = *(const f32x4*)(b_ri + ch0 + 4 * n), lm = *(const f32x4*)(lam + ch0 + 4 * n); f32x4 sp;
#pragma unroll
                for (int j = 0; j < 4; ++j) sp[j] = -8.0f * fast_log1p(__expf(-lm[j]));
#pragma unroll
                for (int m = 0; m < 4; ++m) { const int rl = wr * 64 + m * 16 + fr; const unsigned grow = (unsigned)(row0 + ai * HALF + rl);
                    const f32x2 ucw = *(const f32x2*)((const char*)UC + (grow * 1024u + ch0 + 4 * n) * 2u); f32x4 av, bv;
#pragma unroll
                    for (int j = 0; j < 4; ++j) { const unsigned w = __float_as_uint(ucw[j >> 1]); const float uc = __uint_as_float((j & 1) ? (w & 0xffff0000u) : (w << 16));
                        const float r = sigmoidf_(acc[ai][0][m][n][j] + bra[j]), ig = sigmoidf_(acc[ai][1][m][n][j] + bri[j]);
                        const float la = r * sp[j], a_ = __expf(la); av[j] = a_; bv[j] = __builtin_amdgcn_sqrtf(fmaxf(fmaf(-a_, a_, 1.0f), 0.f)) * ig * uc; }
                    *(PG8_LAS f32x4*)(LA + rl * 132 + wc * 32 + fq * 8 + 4 * n) = av; *(PG8_LAS f32x4*)(LB + rl * 132 + wc * 32 + fq * 8 + 4 * n) = bv;
                    __builtin_amdgcn_sched_barrier(0); } }
            asm volatile("s_waitcnt lgkmcnt(0)" ::: "memory"); __builtin_amdgcn_s_barrier(); asm volatile("" ::: "memory");
            { const int cch = tid & 127, sg = tid >> 7; float h = 0.f, A = 1.f;
#pragma unroll 8
              for (int r = 0; r < 32; ++r) { const int rl = sg * 32 + r; const float a_ = LA[rl * 132 + cch]; h = a_ * h + LB[rl * 132 + cch]; A *= a_; LB[rl * 132 + cch] = h; LA[rl * 132 + cch] = A; }
              SX[(0 + sg) * 128 + cch] = h; SX[(4 + sg) * 128 + cch] = A; }
            asm volatile("s_waitcnt lgkmcnt(0)" ::: "memory"); __builtin_amdgcn_s_barrier(); asm volatile("" ::: "memory");
            if (tid < 128) { float H = ai == 0 ? 0.f : SX[16 * 128 + tid], A = ai == 0 ? 1.f : SX[17 * 128 + tid];
#pragma unroll
                for (int sg = 0; sg < 4; ++sg) { SX[(8 + sg) * 128 + tid] = H; SX[(12 + sg) * 128 + tid] = A; const float ae = SX[(4 + sg) * 128 + tid]; H = ae * H + SX[(0 + sg) * 128 + tid]; A *= ae; }
                SX[16 * 128 + tid] = H; SX[17 * 128 + tid] = A;
                if (ai == 1) { ENDH[nblk * 128 + tid] = H; ENDA[nblk * 128 + tid] = A; } }
            asm volatile("s_waitcnt lgkmcnt(0)" ::: "memory"); __builtin_amdgcn_s_barrier(); asm volatile("" ::: "memory");
            const int c8 = (tid & 15) * 8;
#pragma unroll
            for (int p = 0; p < 4; ++p) { const int rl = p * 32 + (tid >> 4); const unsigned o = ((unsigned)(row0 + ai * HALF + rl) * 1024u + nblk * 128 + c8) * 2u;
                const f32x4 ch0 = *(const PG8_LAS f32x4*)(SX + (8 + p) * 128 + c8), ch1 = *(const PG8_LAS f32x4*)(SX + (8 + p) * 128 + c8 + 4), ca0 = *(const PG8_LAS f32x4*)(SX + (12 + p) * 128 + c8), ca1 = *(const PG8_LAS f32x4*)(SX + (12 + p) * 128 + c8 + 4);
                const f32x4 a0 = *(const PG8_LAS f32x4*)(LA + rl * 132 + c8), a1 = *(const PG8_LAS f32x4*)(LA + rl * 132 + c8 + 4);
                const f32x4 h0 = *(const PG8_LAS f32x4*)(LB + rl * 132 + c8) + a0 * ch0, h1 = *(const PG8_LAS f32x4*)(LB + rl * 132 + c8 + 4) + a1 * ch1;
                *(u32x4*)((char*)HL + o) = pack8(h0, h1); *(u32x4*)((char*)AC + o) = pack8(a0 * ca0, a1 * ca1); }
            asm volatile("s_waitcnt lgkmcnt(0)" ::: "memory"); __builtin_amdgcn_s_barrier(); asm volatile("" ::: "memory");
        }
    }
};
template <class Epi, class Sched, bool ALIGN_EPI = false, bool SP2 = false>
__device__ __forceinline__ void gemm_phase(PG8_LAS unsigned char* lds, const Gemm g, const Sched& S, const Epi& E) {
    int tid_ = my_tid();
    const int tid = tid_, wid = __builtin_amdgcn_readfirstlane(tid >> 6), lane = tid & 63, wr = wid >> 2, wc = wid & 3, fr = lane & 15, fq = lane >> 4;
    const int K = g.K, nt = K / BK;
    unsigned voffA[2], voffB[2];
#pragma unroll
    for (int i = 0; i < 2; ++i) { int R, C; stage_rc(tid * 16 + i * 8192, R, C); const int Rb = Epi::PERM ? ((R & ~31) + perm32(R & 31)) : R;
        voffA[i] = (unsigned)(R * g.lda + C) * 2u; voffB[i] = (unsigned)(Rb * g.ldb + C) * 2u; }
    const size_t kstep = (size_t)(BK * 2);
    const size_t hstepA = (size_t)HALF * g.lda * 2, hstepB = (size_t)HALF * g.ldb * 2;
    const size_t tstepA = 2 * hstepA, tstepB = 2 * hstepB;
    const unsigned ldsw = (unsigned)wid * 1024u;
    const int aoff = lds_byte(wr * 64 + fr, fq * 8), boff = lds_byte(wc * 32 + fr, fq * 8);
#define PG8_SA(b, h) (((b) * 2 + (h)) * HTB)
#define PG8_SB(b, h) ((4 + (b) * 2 + (h)) * HTB)
#define PG8_STAGE(bufoff, gbase, voff) do { _Pragma("unroll") for (int _i = 0; _i < 2; ++_i) \
        __builtin_amdgcn_global_load_lds((const unsigned*)((const char*)(gbase) + (voff)[_i]), (PG8_LAS unsigned*)(lds + (bufoff) + ldsw + _i * 8192), 16, 0, 0); } while (0)
#define PG8_LDA(dst, b, h) do { _Pragma("unroll") for (int m = 0; m < 4; ++m) _Pragma("unroll") for (int k = 0; k < 2; ++k) dst[m][k] = *(const PG8_LAS bf16x8*)(lds + PG8_SA(b, h) + aoff + m * 2048 + k * 1024); } while (0)
#define PG8_LDB(dst, b, h) do { _Pragma("unroll") for (int n = 0; n < 2; ++n) _Pragma("unroll") for (int k = 0; k < 2; ++k) dst[n][k] = *(const PG8_LAS bf16x8*)(lds + PG8_SB(b, h) + boff + n * 2048 + k * 1024); } while (0)
#define PG8_MMA(ai, bj, At, Bt) do { __builtin_amdgcn_s_setprio(1); _Pragma("unroll") for (int m = 0; m < 4; ++m) _Pragma("unroll") for (int n = 0; n < 2; ++n) _Pragma("unroll") for (int k = 0; k < 2; ++k) \
        acc[ai][bj][m][n] = __builtin_amdgcn_mfma_f32_16x16x32_bf16(Bt[n][k], At[m][k], acc[ai][bj][m][n], 0, 0, 0); __builtin_amdgcn_s_setprio(0); } while (0)
#define PG8_WAIT_V(n) asm volatile("s_waitcnt vmcnt(" #n ")" ::: "memory")
#define PG8_WAIT_L(n) asm volatile("s_waitcnt lgkmcnt(" #n ")" ::: "memory")
#define PG8_BAR __builtin_amdgcn_s_barrier()
#define PG8_SCHED __builtin_amdgcn_sched_barrier(0)
    Unit cur, nxt; int ui = 0;
    if (!S.next(0, cur)) return;
    f32x4 acc[2][2][4][2];
#pragma unroll
    for (int a = 0; a < 2; ++a)
#pragma unroll
        for (int b = 0; b < 2; ++b)
#pragma unroll
            for (int m = 0; m < 4; ++m)
#pragma unroll
                for (int n = 0; n < 2; ++n) acc[a][b][m][n] = (f32x4){0.f, 0.f, 0.f, 0.f};
    bf16x8 At[4][2], B0[2][2], B1[2][2];
    const char* cA = (const char*)g.A + (size_t)cur.pm * tstepA; const char* cB = (const char*)g.Bt + (size_t)cur.pn * tstepB;
    S.a_ready(cur);
    if constexpr (SP2) {
        PG8_STAGE(PG8_SB(0, 0), cB, voffB); PG8_STAGE(PG8_SB(0, 1), cB + hstepB, voffB); PG8_STAGE(PG8_SA(0, 0), cA, voffA); PG8_STAGE(PG8_SA(0, 1), cA + hstepA, voffA);
        if (wr == 1) PG8_BAR;
        PG8_WAIT_V(2); PG8_BAR;
        PG8_STAGE(PG8_SB(1, 0), cB + kstep, voffB); PG8_STAGE(PG8_SA(1, 0), cA + kstep, voffA); PG8_STAGE(PG8_SB(1, 1), cB + hstepB + kstep, voffB);
        PG8_WAIT_V(6); PG8_BAR;
    } else {
        PG8_STAGE(PG8_SB(0, 0), cB, voffB); PG8_STAGE(PG8_SA(0, 0), cA, voffA); PG8_STAGE(PG8_SB(0, 1), cB + hstepB, voffB); PG8_STAGE(PG8_SA(0, 1), cA + hstepA, voffA);
        if (wr == 1) PG8_BAR;
        PG8_WAIT_V(4); PG8_BAR;
        PG8_STAGE(PG8_SB(1, 0), cB + kstep, voffB); PG8_STAGE(PG8_SA(1, 0), cA + kstep, voffA); PG8_STAGE(PG8_SB(1, 1), cB + hstepB + kstep, voffB);
        PG8_WAIT_V(6); PG8_BAR;
    }
    for (;;) {
        const bool has_next = S.next(ui + 1, nxt);
        const char* nA = has_next ? (const char*)g.A + (size_t)nxt.pm * tstepA : cA; const char* nB = has_next ? (const char*)g.Bt + (size_t)nxt.pn * tstepB : cB;
        for (int t = 0; t < nt; t += 2) {
            const bool last = (t == nt - 2);
            if constexpr (Epi::HAS_MID) { if (t == E.mid_t) E.mid(acc, cur, wr, wc, fr, fq); }
            const char* a1 = cA + (size_t)(t + 1) * kstep;
            const char* a2 = last ? nA : cA + (size_t)(t + 2) * kstep; const char* b2 = last ? nB : cB + (size_t)(t + 2) * kstep;
            const char* a3 = a2 + kstep; const char* b3 = b2 + kstep;
            if (last && has_next) S.a_ready(nxt);
            if constexpr (SP2) {
            PG8_LDB(B0, 0, 0); PG8_LDB(B1, 0, 1); PG8_SCHED; PG8_LDA(At, 0, 0); PG8_STAGE(PG8_SA(1, 1), a1 + hstepA, voffA);
            PG8_WAIT_V(8); PG8_WAIT_L(0); PG8_BAR; PG8_MMA(0, 0, At, B0); PG8_MMA(0, 1, At, B1); PG8_BAR; PG8_SCHED;
            PG8_LDA(At, 0, 1); PG8_STAGE(PG8_SB(0, 0), b2, voffB); PG8_STAGE(PG8_SB(0, 1), b2 + hstepB, voffB); PG8_STAGE(PG8_SA(0, 0), a2, voffA);
            PG8_WAIT_V(8); PG8_WAIT_L(0); PG8_BAR; PG8_MMA(1, 0, At, B0); PG8_MMA(1, 1, At, B1); PG8_BAR; PG8_SCHED;
            PG8_LDB(B0, 1, 0); PG8_LDB(B1, 1, 1); PG8_SCHED; PG8_LDA(At, 1, 0); PG8_STAGE(PG8_SA(0, 1), a2 + hstepA, voffA);
            PG8_WAIT_V(8); PG8_WAIT_L(0); PG8_BAR; PG8_MMA(0, 0, At, B0); PG8_MMA(0, 1, At, B1); PG8_BAR; PG8_SCHED;
            PG8_LDA(At, 1, 1); PG8_STAGE(PG8_SB(1, 0), b3, voffB); PG8_STAGE(PG8_SB(1, 1), b3 + hstepB, voffB); PG8_STAGE(PG8_SA(1, 0), a3, voffA);
            PG8_WAIT_V(8); PG8_WAIT_L(0); PG8_BAR; PG8_MMA(1, 0, At, B0); PG8_MMA(1, 1, At, B1); PG8_BAR; PG8_SCHED;
            } else {
            PG8_LDB(B0, 0, 0); PG8_SCHED; PG8_LDA(At, 0, 0); PG8_STAGE(PG8_SA(1, 1), a1 + hstepA, voffA);
            PG8_WAIT_L(8); PG8_BAR; PG8_WAIT_L(0); PG8_MMA(0, 0, At, B0); PG8_BAR; PG8_SCHED;
            PG8_LDB(B1, 0, 1); PG8_STAGE(PG8_SB(0, 0), b2, voffB);
            PG8_BAR; PG8_WAIT_L(0); PG8_MMA(0, 1, At, B1); PG8_BAR;
            PG8_LDA(At, 0, 1); PG8_STAGE(PG8_SA(0, 0), a2, voffA);
            PG8_BAR; PG8_WAIT_L(0); PG8_MMA(1, 0, At, B0); PG8_BAR; PG8_SCHED;
            PG8_STAGE(PG8_SB(0, 1), b2 + hstepB, voffB);
            PG8_WAIT_V(6); PG8_BAR; PG8_MMA(1, 1, At, B1); PG8_BAR;
            PG8_LDB(B0, 1, 0); PG8_SCHED; PG8_LDA(At, 1, 0); PG8_STAGE(PG8_SA(0, 1), a2 + hstepA, voffA);
            PG8_WAIT_L(8); PG8_BAR; PG8_WAIT_L(0); PG8_MMA(0, 0, At, B0); PG8_BAR; PG8_SCHED;
            PG8_LDB(B1, 1, 1); PG8_STAGE(PG8_SB(1, 0), b3, voffB);
            PG8_BAR; PG8_WAIT_L(0); PG8_MMA(0, 1, At, B1); PG8_BAR;
            PG8_LDA(At, 1, 1); PG8_STAGE(PG8_SA(1, 0), a3, voffA);
            PG8_BAR; PG8_WAIT_L(0); PG8_MMA(1, 0, At, B0); PG8_BAR; PG8_SCHED;
            PG8_STAGE(PG8_SB(1, 1), b3 + hstepB, voffB);
            PG8_WAIT_V(6); PG8_BAR; PG8_MMA(1, 1, At, B1); PG8_BAR;
            }
        }
        if constexpr (ALIGN_EPI) { if (wr == 0) PG8_BAR; }
        if constexpr (!Epi::AFTER_DRAIN) { E(acc, cur, wr, wc, fr, fq); S.done(cur); }
        if (!has_next) break;
#pragma unroll
        for (int a = 0; a < 2; ++a)
#pragma unroll
            for (int b = 0; b < 2; ++b)
#pragma unroll
                for (int m = 0; m < 4; ++m)
#pragma unroll
                    for (int n = 0; n < 2; ++n) acc[a][b][m][n] = (f32x4){0.f, 0.f, 0.f, 0.f};
        cur = nxt; cA = nA; cB = nB; ++ui;
        if constexpr (ALIGN_EPI) { if (wr == 1) PG8_BAR; }
    }
    PG8_WAIT_V(0);
    if constexpr (!ALIGN_EPI) { if (wr == 0) PG8_BAR; }
    PG8_BAR;
    if constexpr (Epi::AFTER_DRAIN) { E.fused(acc, cur, wr, wc, fr, fq, lds, wid, lane); S.done(cur); }
#undef PG8_SA
#undef PG8_SB
#undef PG8_STAGE
#undef PG8_LDA
#undef PG8_LDB
#undef PG8_MMA
#undef PG8_WAIT_V
#undef PG8_WAIT_L
#undef PG8_BAR
#undef PG8_SCHED
}
}
namespace att {
constexpr int D = 128;
constexpr float THR = 8.f;
constexpr bool WSKIP = false;
constexpr float SCALE = 0.08838834764831845f;
constexpr int NW = 8, QBLK = 32, KVBLK = 64, QB = NW * QBLK;
constexpr int SHM_V = KVBLK * D * 2, SHM_K = KVBLK * D * 2;
constexpr int LDS_BYTES = 2 * SHM_V + 2 * SHM_K + NW * 64 * 4;
using bf16 = __hip_bfloat16;
typedef short bf16x8 __attribute__((ext_vector_type(8)));
typedef short s16x4 __attribute__((ext_vector_type(4)));
typedef float f32x16 __attribute__((ext_vector_type(16)));
typedef float f32x4 __attribute__((ext_vector_type(4)));
typedef unsigned u32x4 __attribute__((ext_vector_type(4)));
template <class A, class Bt> struct same_t { static constexpr bool v = false; };
template <class A> struct same_t<A, A> { static constexpr bool v = true; };

#define KSWZ(row, colB) ((row) * 256 + ((colB) ^ (((row) & 7) << 4)))
#define SBAR() __builtin_amdgcn_sched_barrier(0)
__device__ __forceinline__ int v_st(int k, int c) { const int kk = (k & ~0xC) | ((k & 4) << 1) | ((k & 8) >> 1); return ((kk >> 3) * 4 + (c >> 5)) * 512 + ((kk & 7) * 32 + (c & 31)) * 2; }
__device__ __forceinline__ int v_rd_base(int lane) { return ((lane & 3) << 3) | (((lane >> 2) & 3) << 6) | (((lane >> 4) & 1) << 5) | (((lane >> 5) & 1) << 8); }
constexpr int v_rd_off(int d0, int ks, int half) { return d0 * 512 + ks * 4096 + half * 2048; }
__device__ __forceinline__ int crow(int r, int hi) { return (r & 3) + 8 * (r >> 2) + 4 * hi; }
__device__ __forceinline__ unsigned cvtpk(float lo, float hi) {
    unsigned r; asm volatile("v_cvt_pk_bf16_f32 %0, %1, %2" : "=v"(r) : "v"(lo), "v"(hi)); return r;
}
__device__ __forceinline__ bf16x8 pack8(f32x4 a, f32x4 b) {
    u32x4 w = {cvtpk(a[0], a[1]), cvtpk(a[2], a[3]), cvtpk(b[0], b[1]), cvtpk(b[2], b[3])};
    return *reinterpret_cast<bf16x8*>(&w);
}
template <class T> __device__ __forceinline__ bf16x8 load8(const T* p) {
    if constexpr (same_t<T, float>::v) { return pack8(*(const f32x4*)p, *(const f32x4*)(p + 4)); }
    else { return *reinterpret_cast<const bf16x8*>(p); }
}
__device__ __forceinline__ void mask_tile(f32x16& p0, f32x16& p1, int dq, unsigned W) {
    const float NEG = -__builtin_inff();
#pragma unroll
    for (int r = 0; r < 16; ++r) {
        const int c = (r & 3) + 8 * (r >> 2);
        if ((unsigned)(dq - c) >= W) p0[r] = NEG;
        if ((unsigned)(dq - c - 32) >= W) p1[r] = NEG;
    }
}
__device__ __forceinline__ void partialSM(f32x16& p0, f32x16& p1, float& m_reg, float& mn, float& alpha) {
    float pmax = p0[0]; for (int r = 1; r < 16; ++r) pmax = fmaxf(pmax, p0[r]); for (int r = 0; r < 16; ++r) pmax = fmaxf(pmax, p1[r]);
    { auto rr = __builtin_amdgcn_permlane32_swap(__float_as_uint(pmax), __float_as_uint(pmax), false, false);
      pmax = fmaxf(__uint_as_float(rr[0]), __uint_as_float(rr[1])); }
    constexpr float C2 = 1.4426950408889634f * SCALE;
    if (__builtin_expect(__all((pmax - m_reg) * SCALE <= THR), 1)) { mn = m_reg; alpha = 1.f; }
    else { mn = fmaxf(m_reg, pmax); alpha = __builtin_amdgcn_exp2f((m_reg - mn) * C2); m_reg = mn; }
    const float mnL = -mn * C2;
    for (int r = 0; r < 16; ++r) p0[r] = fmaf(p0[r], C2, mnL); for (int r = 0; r < 16; ++r) p1[r] = fmaf(p1[r], C2, mnL);
    for (int r = 0; r < 16; ++r) p0[r] = __builtin_amdgcn_exp2f(p0[r]);
}
__device__ __forceinline__ void finishSM(f32x16& p0, f32x16& p1, float alpha, float& l_reg, bf16x8& pa0, bf16x8& pa1, bf16x8& pa2, bf16x8& pa3) {
    for (int r = 0; r < 16; ++r) p1[r] = __builtin_amdgcn_exp2f(p1[r]);
    float ps = 0; for (int r = 0; r < 16; ++r) ps += p0[r]; for (int r = 0; r < 16; ++r) ps += p1[r];
    { auto rr = __builtin_amdgcn_permlane32_swap(__float_as_uint(ps), __float_as_uint(ps), false, false);
      ps = __uint_as_float(rr[0]) + __uint_as_float(rr[1]); }
    l_reg = l_reg * alpha + ps;
#define PK4(P, B_, OUT) do { unsigned a0 = cvtpk(P[B_+0], P[B_+1]), a1 = cvtpk(P[B_+2], P[B_+3]);                          \
        unsigned b0 = cvtpk(P[B_+4], P[B_+5]), b1 = cvtpk(P[B_+6], P[B_+7]);                                             \
        auto r0 = __builtin_amdgcn_permlane32_swap(a0, b0, false, false); auto r1 = __builtin_amdgcn_permlane32_swap(a1, b1, false, false); \
        u32x4 w = {r0[0], r1[0], r0[1], r1[1]}; OUT = *reinterpret_cast<bf16x8*>(&w); } while (0)
    PK4(p0, 0, pa0); PK4(p0, 8, pa1); PK4(p1, 0, pa2); PK4(p1, 8, pa3);
#undef PK4
}
template <int KB, bool SK>
__device__ __forceinline__ void qkt(f32x16& p0, f32x16& p1, const char* K_lds, int r32, int hi, const bf16x8* qr, bool act, int cbo  ) {
    if (SK && !act) { const float NEG = -__builtin_inff();
#pragma unroll
        for (int r = 0; r < 16; ++r) { p0[r] = NEG; p1[r] = NEG; } return; }
    if (cbo >= 0) { int a_ = cbo + hi * 16; asm volatile("" : "+v"(a_)); const __attribute__((address_space(3))) float* cb = (const __attribute__((address_space(3))) float*)(unsigned)a_;
#pragma unroll
        for (int q_ = 0; q_ < 4; ++q_) { const f32x4 v0_ = *(const __attribute__((address_space(3))) f32x4*)(cb + 8 * q_), v1_ = *(const __attribute__((address_space(3))) f32x4*)(cb + 32 + 8 * q_);
#pragma unroll
            for (int j_ = 0; j_ < 4; ++j_) { p0[4 * q_ + j_] = v0_[j_]; p1[4 * q_ + j_] = v1_[j_]; } }
    } else { p0 = f32x16{}; p1 = f32x16{}; }
    const char* kb[4];
#pragma unroll
    for (int dd = 0; dd < 4; ++dd) kb[dd] = K_lds + KB * SHM_K + KSWZ(r32, (dd * 16 + hi * 8) * 2);
#pragma unroll
    for (int d0 = 0; d0 < 8; ++d0) { const char* a = kb[d0 & 3] + (d0 >> 2) * 128;
        bf16x8 b0 = *reinterpret_cast<const bf16x8*>(a);
        bf16x8 b1 = *reinterpret_cast<const bf16x8*>(a + 32 * 256);
        p0 = __builtin_amdgcn_mfma_f32_32x32x16_bf16(b0, qr[d0], p0, 0, 0, 0);
        p1 = __builtin_amdgcn_mfma_f32_32x32x16_bf16(b1, qr[d0], p1, 0, 0, 0); }
}
template <int VB, bool SK>
__device__ __forceinline__ void pv_tile(f32x16* o, int vb0, bf16x8 pa0, bf16x8 pa1, bf16x8 pa2, bf16x8 pa3, bool act) {
    if (SK && !act) return;
#define TRRD(dst, off) asm volatile("ds_read_b64_tr_b16 %0, %1 offset:%2" : "=&v"(dst) : "v"(vb0), "i"(off) : "memory")
#define PV_D0(d0) do { s16x4 l0, l1, l2, l3, h0, h1, h2, h3; constexpr int b_ = VB * SHM_V + v_rd_off(d0, 0, 0);     \
        TRRD(l0, b_); TRRD(h0, b_ + 2048); TRRD(l1, b_ + 4096); TRRD(h1, b_ + 6144); TRRD(l2, b_ + 8192); TRRD(h2, b_ + 10240); TRRD(l3, b_ + 12288); TRRD(h3, b_ + 14336); \
        asm volatile("s_waitcnt lgkmcnt(0)" ::: "memory"); SBAR();                 \
        o[d0] = __builtin_amdgcn_mfma_f32_32x32x16_bf16(pa0, (bf16x8){l0[0], l0[1], l0[2], l0[3], h0[0], h0[1], h0[2], h0[3]}, o[d0], 0, 0, 0);   \
        o[d0] = __builtin_amdgcn_mfma_f32_32x32x16_bf16(pa1, (bf16x8){l1[0], l1[1], l1[2], l1[3], h1[0], h1[1], h1[2], h1[3]}, o[d0], 0, 0, 0);   \
        o[d0] = __builtin_amdgcn_mfma_f32_32x32x16_bf16(pa2, (bf16x8){l2[0], l2[1], l2[2], l2[3], h2[0], h2[1], h2[2], h2[3]}, o[d0], 0, 0, 0);   \
        o[d0] = __builtin_amdgcn_mfma_f32_32x32x16_bf16(pa3, (bf16x8){l3[0], l3[1], l3[2], l3[3], h3[0], h3[1], h3[2], h3[3]}, o[d0], 0, 0, 0); } while (0)
    PV_D0(0); PV_D0(1); PV_D0(2); PV_D0(3);
#undef PV_D0
#undef TRRD
}

template <class T> __device__ __forceinline__ T* uptr(T* p) { const unsigned long long v = (unsigned long long)p; const unsigned lo = __builtin_amdgcn_readfirstlane((unsigned)v), hi = __builtin_amdgcn_readfirstlane((unsigned)(v >> 32)); return (T*)(((unsigned long long)hi << 32) | lo); }
template <class TIn, class TOut> struct BlockRef { const TIn* Q; const TIn* K; const TIn* V; TOut* O; float* SS; int P0; };
template <class TIn> struct Seam {
    bf16x8 qr[8];
    bf16x8 st_v0, st_v1, st_k0, st_k1; f32x4 sf0, sf1, sf2, sf3;
    f32x4 tq[16];
};
__device__ __forceinline__ int swa_jlo(int P0, int W) { const int lowk = P0 - W + 1; return lowk > 0 ? lowk / KVBLK : 0; }
#define ROW(p, k0, rr) ((decltype(p))((const char*)(p) + (unsigned)(((k0) + (rr)) * D + sc) * (unsigned)sizeof(*(p))))
#define VMW() asm volatile("s_waitcnt vmcnt(0)" ::: "memory")
#define VMWN(n) asm volatile("s_waitcnt vmcnt(%0)" :: "i"(n) : "memory")
#define SLOAD_H(Kp, Vp, k0) do { S.st_v0 = load8<TIn>(ROW(Vp, k0, sr)); S.st_v1 = load8<TIn>(ROW(Vp, k0, 32 + sr));              \
                         S.st_k0 = load8<TIn>(ROW(Kp, k0, sr)); S.st_k1 = load8<TIn>(ROW(Kp, k0, 32 + sr)); } while (0)
#define SWRITE_HK(bf) do { *(bf16x8*)(K_lds + (bf) * SHM_K + kws) = S.st_k0; *(bf16x8*)(K_lds + (bf) * SHM_K + kws + 32 * 256) = S.st_k1; } while (0)
#define SWRITE_HV(bf) do { *(bf16x8*)(V_lds + (bf) * SHM_V + vst0) = S.st_v0; *(bf16x8*)(V_lds + (bf) * SHM_V + vst1) = S.st_v1; } while (0)
#define SWRITE_H(bf) do { SWRITE_HV(bf); SWRITE_HK(bf); } while (0)
#define SLOAD_F(p, k0) do { S.sf0 = *(const f32x4*)ROW(p, k0, sr); S.sf1 = *(const f32x4*)(ROW(p, k0, sr) + 4);                \
                            S.sf2 = *(const f32x4*)ROW(p, k0, 32 + sr); S.sf3 = *(const f32x4*)(ROW(p, k0, 32 + sr) + 4); } while (0)
#define SWRITE_KF(bf) do { *(bf16x8*)(K_lds + (bf) * SHM_K + kws) = pack8(S.sf0, S.sf1); *(bf16x8*)(K_lds + (bf) * SHM_K + kws + 32 * 256) = pack8(S.sf2, S.sf3); } while (0)
#define SWRITE_VF(bf) do { *(bf16x8*)(V_lds + (bf) * SHM_V + vst0) = pack8(S.sf0, S.sf1); *(bf16x8*)(V_lds + (bf) * SHM_V + vst1) = pack8(S.sf2, S.sf3); } while (0)
template <class TIn, class TOut>
__device__ __forceinline__ void causal_swa_prime(const BlockRef<TIn, TOut>& cur_, int W, char* lds, Seam<TIn>& S) {
    BlockRef<TIn, TOut> cur; cur.Q = uptr(cur_.Q); cur.K = uptr(cur_.K); cur.V = uptr(cur_.V); cur.O = nullptr; cur.SS = nullptr; cur.P0 = __builtin_amdgcn_readfirstlane(cur_.P0);
    constexpr bool F32 = same_t<TIn, float>::v;
    int tid_ = my_tid();
    const int tid = tid_, wid = __builtin_amdgcn_readfirstlane(tid >> 6), lane = tid & 63, r32 = lane & 31, hi = lane >> 5;
    const int sr = tid >> 4, sc = (tid & 15) * 8, kws = KSWZ(sr, sc * 2); char* K_lds = lds + 2 * SHM_V;
    const int kb0 = swa_jlo(cur.P0, W) * KVBLK;
    for (int d0 = 0; d0 < 8; ++d0) S.qr[d0] = load8<TIn>((const TIn*)((const char*)cur.Q + (unsigned)((wid * QBLK + r32) * D + d0 * 16 + hi * 8) * (unsigned)sizeof(TIn)));
    if constexpr (F32) { SLOAD_F((const float*)cur.K, kb0); VMW(); SWRITE_KF(0); SBAR(); SLOAD_F((const float*)cur.V, kb0); }
    else { SLOAD_H(cur.K, cur.V, kb0); VMW(); SWRITE_HK(0); }
    __syncthreads();
}
template <class TIn, class TOut, int ost, bool HAS_SS>
__device__ __forceinline__ void causal_swa_block(const BlockRef<TIn, TOut>& cur_, const BlockRef<TIn, TOut>& nxt_, int skv, int W, char* lds, Seam<TIn>& S, int cbl  ) {
    constexpr bool F32 = same_t<TIn, float>::v;
    BlockRef<TIn, TOut> cur, nxt; cur.Q = uptr(cur_.Q); cur.K = uptr(cur_.K); cur.V = uptr(cur_.V); cur.O = uptr(cur_.O); cur.SS = uptr(cur_.SS); cur.P0 = __builtin_amdgcn_readfirstlane(cur_.P0);
    nxt.Q = uptr(nxt_.Q); nxt.K = uptr(nxt_.K); nxt.V = uptr(nxt_.V); nxt.O = nullptr; nxt.SS = nullptr; nxt.P0 = __builtin_amdgcn_readfirstlane(nxt_.P0);
    int tid_ = my_tid();
    const int tid = tid_, wid = __builtin_amdgcn_readfirstlane(tid >> 6), lane = tid & 63, r32 = lane & 31, hi = lane >> 5;
    const int j_lo = swa_jlo(cur.P0, W);
    int j_hi = (cur.P0 + QB - 1) / KVBLK + 1; if (j_hi > skv / KVBLK) j_hi = skv / KVBLK;
    const int NT = j_hi - j_lo;
    const int kbn = swa_jlo(nxt.P0, W) * KVBLK;
    const int qlo = cur.P0 + wid * QBLK, qm = qlo + r32 - 4 * hi;
    char* V_lds = lds; char* K_lds = lds + 2 * SHM_V;
    float* ws = (float*)(lds + 2 * SHM_V + 2 * SHM_K) + wid * 64; float* li_l = ws, * al_l = ws + 32;
    float m_reg = -1e30f, l_reg = 0; f32x16 o[4] = {};
    const int sr = tid >> 4, sc = (tid & 15) * 8, vst0 = v_st(sr, sc), vst1 = v_st(32 + sr, sc), kws = KSWZ(sr, sc * 2);
    const int vb0 = (int)(uintptr_t)V_lds + v_rd_base(lane);
    const TIn* Kh = cur.K; const TIn* Vh = cur.V;
#define RESC(a) do { if (__any((a) < 1.f)) { if (hi == 0) al_l[r32] = (a); asm volatile("s_waitcnt lgkmcnt(0)" ::: "memory");              \
                     for (int d_ = 0; d_ < 4; ++d_) for (int r = 0; r < 16; ++r) o[d_][r] *= al_l[crow(r, hi)]; } } while (0)
#define KBASE(t) ((j_lo + (t)) * KVBLK)
#define CBT(t) (cbl >= 0 ? cbl + KBASE(t) * 4 : -1)
#define ACT(t) (KBASE(t) <= qlo + QBLK - 1 && KBASE(t) + KVBLK - 1 >= qlo - W + 1)
#define MASKT(P0_, P1_, t) do { const int kb_ = KBASE(t); if ((!SK || ACT(t)) && (kb_ + KVBLK - 1 > qlo || kb_ <= qlo + QBLK - 1 - W)) mask_tile(P0_, P1_, qm - kb_, (unsigned)W); } while (0)
    constexpr int NQL = F32 ? 16 : 8;
    constexpr bool SK = WSKIP && !F32;
#define SEAM_K0() do { VMWN(NQL); if constexpr (F32) { SWRITE_KF(0); SBAR(); SLOAD_F((const float*)nxt.V, kbn); } else { SWRITE_HK(0); } SBAR(); } while (0)
    f32x16 pA0, pA1, pB0, pB1; float mnA, mnB, alA, alB; bf16x8 pa0, pa1, pa2, pa3;
    if constexpr (F32) { VMW(); SWRITE_VF(0); SBAR(); } else { SWRITE_HV(0); SBAR(); }
    if (NT > 1) { if constexpr (F32) SLOAD_F((const float*)Kh, KBASE(1)); else SLOAD_H(Kh, Vh, KBASE(1)); }
    SBAR(); qkt<0, SK>(pA0, pA1, K_lds, r32, hi, S.qr, ACT(0), CBT(0));
    if constexpr (F32) { if (NT > 1) { VMW(); SWRITE_KF(1); SBAR(); SLOAD_F((const float*)Vh, KBASE(1)); } }
    MASKT(pA0, pA1, 0); partialSM(pA0, pA1, m_reg, mnA, alA);
    if (NT > 1) { VMW(); if constexpr (F32) { SWRITE_VF(1); SBAR(); if (NT > 2) SLOAD_F((const float*)Kh, KBASE(2)); } else SWRITE_H(1); }
    __syncthreads();
#define HALF_STEP(PX0, PX1, mnX, alX, PY0, PY1, alY, t, KB, VB, SB) do {                                                      \
        SBAR(); qkt<KB, SK>(PX0, PX1, K_lds, r32, hi, S.qr, ACT(t), CBT(t));                                             \
        finishSM(PY0, PY1, alY, l_reg, pa0, pa1, pa2, pa3); SBAR();                                                           \
        if ((t) + 1 < NT) { if constexpr (F32) { VMW(); SWRITE_KF(SB); SBAR(); SLOAD_F((const float*)Vh, KBASE((t) + 1)); }  \
                            else { SLOAD_H(Kh, Vh, KBASE((t) + 1)); } SBAR(); }                                               \
        pv_tile<VB, SK>(o, vb0, pa0, pa1, pa2, pa3, ACT((t) - 1)); MASKT(PX0, PX1, (t)); partialSM(PX0, PX1, m_reg, mnX, alX);                                        \
        __syncthreads();                                                                                                      \
        if ((t) + 1 < NT) { VMW(); if constexpr (F32) { SWRITE_VF(SB); SBAR(); if ((t) + 2 < NT) SLOAD_F((const float*)Kh, KBASE((t) + 2)); } \
                            else { SWRITE_H(SB); } }                                                                          \
        RESC(alX); __syncthreads(); } while (0)
    for (int t = 1; t + 1 < NT; t += 2) {
        HALF_STEP(pB0, pB1, mnB, alB, pA0, pA1, alA, t, 1, 0, 0);
        HALF_STEP(pA0, pA1, mnA, alA, pB0, pB1, alB, t + 1, 0, 1, 1);
    }
    const bool even = (NT & 1) == 0;
    if (even) { SBAR(); qkt<1, SK>(pB0, pB1, K_lds, r32, hi, S.qr, ACT(NT - 1), CBT(NT - 1)); SBAR(); }
#define QROW(e) (nxt.Q + (size_t)(wid * QBLK + r32) * D + ((e) >> 1) * 16 + hi * 8 + ((e) & 1) * 4)
    if constexpr (F32) { SLOAD_F((const float*)nxt.K, kbn); SBAR();
#pragma unroll
        for (int e = 0; e < 8; ++e) S.tq[e] = *(const f32x4*)QROW(e); }
    else { SLOAD_H(nxt.K, nxt.V, kbn); SBAR();
#pragma unroll
        for (int d0 = 0; d0 < 8; ++d0) S.qr[d0] = load8<TIn>((const TIn*)((const char*)nxt.Q + (unsigned)((wid * QBLK + r32) * D + d0 * 16 + hi * 8) * (unsigned)sizeof(TIn))); }
    SBAR();
    finishSM(pA0, pA1, alA, l_reg, pa0, pa1, pa2, pa3); SBAR();
    if constexpr (F32) {
#pragma unroll
        for (int e = 8; e < 16; ++e) S.tq[e] = *(const f32x4*)QROW(e); SBAR(); }
#undef QROW
    pv_tile<0, SK>(o, vb0, pa0, pa1, pa2, pa3, ACT(even ? NT - 2 : NT - 1));
    if (even) { MASKT(pB0, pB1, NT - 1); partialSM(pB0, pB1, m_reg, mnB, alB); __syncthreads(); RESC(alB);
        finishSM(pB0, pB1, alB, l_reg, pa0, pa1, pa2, pa3); SBAR(); pv_tile<1, SK>(o, vb0, pa0, pa1, pa2, pa3, ACT(NT - 1)); }
    SBAR(); SEAM_K0();
    if (hi == 0) li_l[r32] = l_reg; asm volatile("s_waitcnt lgkmcnt(0)" ::: "memory");
    float rli[16];
#pragma unroll
    for (int r = 0; r < 16; ++r) rli[r] = __builtin_amdgcn_rcpf(li_l[crow(r, hi)]);
    int r32e = r32, hie = hi; asm volatile("" : "+v"(r32e), "+v"(hie));
    char* Ob = (char*)cur.O; const unsigned ob0 = (unsigned)((wid * QBLK + 4 * hie) * ost + r32e) * 2u;
#pragma unroll
    for (int r = 0; r < 16; ++r) { const unsigned rowoff = ob0 + (unsigned)(((r & 3) + 8 * (r >> 2)) * ost * 2); float ss_ = 0.f;
#pragma unroll
        for (int d0 = 0; d0 < 4; ++d0) { const float v = o[d0][r] * rli[r]; ss_ += v * v;
            const float vn = shx<1>(v);
            if ((r32e & 1) == 0) *(unsigned*)(Ob + rowoff + d0 * 64) = cvtpk(v, vn); }
        if (HAS_SS) { ss_ += shx<1>(ss_); ss_ += shx<2>(ss_); ss_ += shx<4>(ss_); ss_ += shx<8>(ss_); ss_ += shx<16>(ss_);
            if (r32e == 0) *(float*)((char*)cur.SS + (unsigned)(wid * QBLK + 4 * hie + (r & 3) + 8 * (r >> 2)) * 32u) = ss_; }
        SBAR(); }
    if constexpr (F32) {
#pragma unroll
        for (int d0 = 0; d0 < 8; ++d0) S.qr[d0] = pack8(S.tq[2 * d0], S.tq[2 * d0 + 1]); }
    __syncthreads();
#undef RESC
#undef KBASE
#undef CBT
#undef ACT
#undef MASKT
#undef SEAM_K0
#undef HALF_STEP
}
#undef ROW
}

#define GAS __attribute__((address_space(1)))
#define LAS __attribute__((address_space(3)))
typedef unsigned short bf16;
typedef unsigned v4u __attribute__((ext_vector_type(4)));
typedef float f32x4 __attribute__((ext_vector_type(4)));
#define LDS_WAIT() asm volatile("s_waitcnt lgkmcnt(0)" ::: "memory")
#define VM_WAIT() asm volatile("s_waitcnt vmcnt(0)" ::: "memory")
__device__ __forceinline__ unsigned f2bf(float f) { unsigned u = __builtin_bit_cast(unsigned, f); return (u + 0x7fffu + ((u >> 16) & 1u)) >> 16; }
__device__ __forceinline__ unsigned pk2(float lo, float hi) { return f2bf(lo) | (f2bf(hi) << 16); }
__device__ __forceinline__ float bflo(unsigned w) { return __uint_as_float(w << 16); }
__device__ __forceinline__ float bfhi(unsigned w) { return __uint_as_float(w & 0xffff0000u); }

#ifndef LB2
#define LB2 2
#endif
#ifndef FOX_HAS_SS
#define FOX_HAS_SS false
#endif
#ifndef FOX_SS
#define FOX_SS (SSQF + ((size_t)b * SEQ + x * 256) * 8 + h)
#endif
#ifndef FOX_CB
#define FOX_CB CB_OFF
#endif
#ifndef USE_XB
#define USE_XB 1
#endif
#if USE_XB
#define GSYNC() xcd_barrier(xbar)
#else
#define GSYNC() grid.sync()
#endif
#ifndef REP
#define REP 0
#endif
#ifndef PH
#define PH 0x1ff
#endif
constexpr int NWAVES = 8, NTHR = 512;
constexpr int BATCH = 4, SEQ = 2048, DM = 2048, M = BATCH * SEQ, NMEM = 256, MMEM = BATCH * NMEM;
constexpr int FOXW = 1024, LRUW = 1024, INW = 5128, INWP = 5376, XW = 512, FFN = 5632;
constexpr float EPS = 1e-6f;
constexpr size_t MiB = 1u << 20;
constexpr size_t WS_WIN = 1 * MiB, WS_WOUT = 22 * MiB, WS_WCQ = 30 * MiB, WS_WCKV = 32 * MiB, WS_WCO = 36 * MiB, WS_WGU = 38 * MiB, WS_WDN = 82 * MiB, WS_WLRU = 104 * MiB;
constexpr size_t WS_XN = 105 * MiB, WS_MN = 137 * MiB, WS_Q = 141 * MiB, WS_K = 157 * MiB, WS_V = 173 * MiB, WS_U = 189 * MiB, WS_GG = 205 * MiB, WS_UC = 221 * MiB;
constexpr size_t WS_LF = 237 * MiB, WS_CK = 238 * MiB, WS_CV = 239 * MiB, WS_MIX = 240 * MiB, WS_SSQF = 272 * MiB, WS_SSQL = 273 * MiB, WS_X1 = 274 * MiB;
constexpr size_t WS_SSQ1 = 338 * MiB, WS_CQ = 339 * MiB, WS_SSQ2 = 347 * MiB, WS_END = 348 * MiB;
constexpr size_t WS_HL = WS_X1, WS_AC = WS_X1 + 16 * MiB, WS_ENDH = WS_SSQ2, WS_ENDA = WS_SSQ2 + 256 * 1024;
constexpr size_t WS_X1B = WS_XN  , WS_OX = WS_Q  , WS_X2B = WS_MIX  , WS_H = WS_Q  ;
constexpr int LDS_BYTES = 147456, RED_OFF = 131072, CB_OFF = 69632, WSUM_OFF = 77824;

__device__ __forceinline__ float wave_sum(float v) { v += shx<1>(v); v += shx<2>(v); v += shx<4>(v); v += shx<8>(v); v += shx<16>(v); return sum32(v); }
template <bool NT_ST>
__device__ __forceinline__ void transpose_item(const float* W, int ldw, int k0, int srcn0, int nvalid, const float* ks, bf16* WT, int ldt, int drow0, LAS float* scr, int lane) {
    f32x4 v[8];
#pragma unroll
    for (int i = 0; i < 8; ++i) { const int kk = 8 * i + (lane >> 3), n4 = (lane & 7) * 4;
        v[i] = (n4 < nvalid) ? __builtin_nontemporal_load((const GAS f32x4*)(W + (size_t)(k0 + kk) * ldw + srcn0 + n4)) : (f32x4){0.f, 0.f, 0.f, 0.f}; }
#pragma unroll
    for (int i = 0; i < 8; ++i) { const int kk = 8 * i + (lane >> 3), n4 = (lane & 7) * 4; f32x4 x = v[i]; if (ks) x = x * ks[k0 + kk];
        LAS float* d = scr + kk * 33 + n4; d[0] = x.x; d[1] = x.y; d[2] = x.z; d[3] = x.w; }
    LDS_WAIT(); asm volatile("" ::: "memory");
    const int c = lane & 7;
#pragma unroll
    for (int j = 0; j < 4; ++j) { const int n = (lane >> 3) + 8 * j; const LAS float* s = scr + (8 * c) * 33 + n;
        v4u o; o.x = pk2(s[0 * 33], s[1 * 33]); o.y = pk2(s[2 * 33], s[3 * 33]); o.z = pk2(s[4 * 33], s[5 * 33]); o.w = pk2(s[6 * 33], s[7 * 33]);
        if (NT_ST) __builtin_nontemporal_store(o, (GAS v4u*)(WT + (size_t)(drow0 + n) * ldt + k0 + 8 * c)); else *(GAS v4u*)(WT + (size_t)(drow0 + n) * ldt + k0 + 8 * c) = o; }
    LDS_WAIT(); asm volatile("" ::: "memory");
}
__device__ __forceinline__ void rms_row_to_bf16(const float* xrow, const float* g, bf16* orow, int lane) {
    const GAS f32x4* xr = (const GAS f32x4*)xrow + lane; const GAS f32x4* gr = (const GAS f32x4*)g + lane;
    f32x4 v[8]; float s = 0.f;
#pragma unroll
    for (int j = 0; j < 8; ++j) { v[j] = __builtin_nontemporal_load(xr + 64 * j); s += (v[j].x * v[j].x + v[j].y * v[j].y) + (v[j].z * v[j].z + v[j].w * v[j].w); }
    const float rstd = 1.0f / sqrtf(wave_sum(s) * (1.f / DM) + EPS);
    GAS unsigned long long* o8 = (GAS unsigned long long*)orow + lane;
#pragma unroll
    for (int j = 0; j < 8; ++j) { const f32x4 gg = gr[64 * j]; o8[64 * j] = (unsigned long long)pk2(v[j].x * rstd * gg.x, v[j].y * rstd * gg.y) | ((unsigned long long)pk2(v[j].z * rstd * gg.z, v[j].w * rstd * gg.w) << 32); }
}

#define XB_TMO      128
#define XB_XCNT(j)  (256  + 64 * (j))
#define XB_XSUB(j)  (1280 + 64 * (j))
#define XB_XGEN(j)  (2304 + 64 * (j))
#define XB_TOP      3328
#define XB_TOPGEN   3392
#define XCD_BAR_WORDS 3456
#define XB_SPIN_CAP (1u << 18)

__device__ __forceinline__ unsigned xb_ld(unsigned* p)              { return __hip_atomic_load(p, __ATOMIC_RELAXED, __HIP_MEMORY_SCOPE_AGENT); }
__device__ __forceinline__ unsigned xb_add(unsigned* p, unsigned v) { return __hip_atomic_fetch_add(p, v, __ATOMIC_RELAXED, __HIP_MEMORY_SCOPE_AGENT); }
__device__ __forceinline__ unsigned xb_xcc_id() { return (unsigned)__builtin_amdgcn_s_getreg((3 << 11) | 20) & 0xFu; }
#define XB_SPIN(cond, bar) do { unsigned _sp = 0; while (cond) { __builtin_amdgcn_s_sleep(1); \
    if ((++_sp & 255u) == 0u) { if (xb_ld(&(bar)[XB_TMO])) break; if (_sp > XB_SPIN_CAP) { atomicAdd(&(bar)[XB_TMO], 1u); break; } } } } while (0)

struct XcdBarrier {
    unsigned* bar; unsigned x;
    volatile LAS unsigned* st;
};

__device__ __forceinline__ XcdBarrier xcd_barrier_post(unsigned* bar, volatile LAS unsigned* st) {
    XcdBarrier b; b.bar = bar; b.x = xb_xcc_id(); b.st = st;
    if (my_tid() == 0) (void)xb_add(&bar[XB_XCNT(b.x)], 1u);
    return b;
}
__device__ __forceinline__ void xcd_barrier_complete(unsigned* bar, unsigned x, unsigned& nloc, unsigned& nx) {
    const unsigned G = gridDim.x * gridDim.y * gridDim.z;
    unsigned sum, cnt, mine, sp = 0u;
    for (;;) {
        sum = 0u; cnt = 0u; mine = 0u;
#pragma unroll
        for (unsigned j = 0; j < 16; ++j) { const unsigned c = xb_ld(&bar[XB_XCNT(j)]); sum += c; cnt += (c > 0u) ? 1u : 0u; mine = (j == x) ? c : mine; }
        if (sum == G) break;
        __builtin_amdgcn_s_sleep(1);
        if ((++sp & 255u) == 0u) { if (xb_ld(&bar[XB_TMO])) break; if (sp > XB_SPIN_CAP) { atomicAdd(&bar[XB_TMO], 1u); break; } }
    }
    nloc = mine > 0u ? mine : 1u; nx = cnt > 0u ? cnt : 1u;
}

__device__ __forceinline__ void xcd_barrier(const XcdBarrier& b) {
    asm volatile("s_waitcnt vmcnt(0)" ::: "memory");
    __syncthreads();
    if (my_tid() == 0) {
        unsigned* bar = b.bar;
        __builtin_amdgcn_s_waitcnt(0);
        unsigned nloc = b.st[0], nx = b.st[1];
        if (nloc == 0u) { xcd_barrier_complete(bar, b.x, nloc, nx); b.st[0] = nloc; b.st[1] = nx; }
        const unsigned old = xb_add(&bar[XB_XSUB(b.x)], 1u);
        const unsigned gen = old / nloc;
        if (old + 1u == (gen + 1u) * nloc) {
            __builtin_amdgcn_fence(__ATOMIC_RELEASE, "agent");
            asm volatile("s_waitcnt vmcnt(0)" ::: "memory");
            const unsigned og = xb_add(&bar[XB_TOP], 1u);
            const unsigned tg = og / nx;
            if (og + 1u == (tg + 1u) * nx) xb_add(&bar[XB_TOPGEN], 1u);
            else XB_SPIN(xb_ld(&bar[XB_TOPGEN]) == tg, bar);
            __builtin_amdgcn_fence(__ATOMIC_ACQUIRE, "agent");
            xb_add(&bar[XB_XGEN(b.x)], 1u);
            asm volatile("s_waitcnt vmcnt(0)" ::: "memory");
        } else {
            XB_SPIN(xb_ld(&bar[XB_XGEN(b.x)]) == gen, bar);
            __builtin_amdgcn_fence(__ATOMIC_ACQUIRE, "agent");
            asm volatile("s_waitcnt vmcnt(0)" ::: "memory");
        }
    }
    __syncthreads();
}

struct Args { const float* in[27]; float* out; unsigned char* ws; };
enum { I_X = 0, I_MEM, I_GMIX, I_WIN, I_BF, I_GQ, I_GK, I_CONVW, I_CONVB, I_WRA, I_BRA, I_WRI, I_BRI, I_LAM, I_GFOX, I_GLRU, I_WOUT, I_GXATTN, I_GMEM, I_WCQ, I_WCKV, I_GCQ, I_GCK, I_WCO, I_GFFN, I_WGU, I_WDN };

constexpr int KB_D = DM / 64;
constexpr int I0 = (INWP / 32) * KB_D, I3 = (2 * XW / 32) * KB_D, I7 = 16 * 4 * 2, N_EARLY = I0 + I3 + I7;
constexpr int I1 = (DM / 32) * KB_D, I2 = (XW / 32) * KB_D, I4 = (DM / 32) * (XW / 64), I5 = (2 * FFN / 32) * KB_D, I6 = (DM / 32) * (FFN / 64), N_LATE = I1 + I2 + I4 + I5 + I6;
constexpr int N_LATE_P1 = I1 + I2 + I4 + 2560;
constexpr int N_LATE_P2 = N_LATE_P1 + 2440;
__device__ __forceinline__ void early_item(const Args& a, int r, LAS float* scr, int lane) {
    unsigned char* ws = a.ws;
    if (r < I0) { const int rg = r / KB_D, kb = r % KB_D, d = rg * 32; int src = d, nv = 32;
        if (d >= 3072 && d < 5120) src = d + 8; else if (d == 5120) { src = 3072; nv = 8; } else if (d > 5120) { src = 0; nv = 0; }
        transpose_item<false>(a.in[I_WIN], INW, kb * 64, src, nv, nullptr, (bf16*)(ws + WS_WIN), DM, d, scr, lane); return; } r -= I0;
    if (r < I3) { const int rg = r / KB_D, kb = r % KB_D;
        transpose_item<false>(a.in[I_WCKV], 2 * XW, kb * 64, rg * 32, 32, nullptr, (bf16*)(ws + WS_WCKV), DM, rg * 32, scr, lane); return; } r -= I3;
    { const int mtx = r >> 3, sub = r & 7, rg = sub >> 1, kb = sub & 1, n = mtx >> 1, which = mtx & 1;
        transpose_item<false>((which ? a.in[I_WRI] : a.in[I_WRA]) + (size_t)n * 128 * 128, 128, kb * 64, rg * 32, 32, nullptr, (bf16*)(ws + WS_WLRU) + (size_t)(n * 256 + which * 128) * 128, 128, rg * 32, scr, lane); }
}
__device__ __forceinline__ void late_item(const Args& a, int r, LAS float* scr, int lane) {
    unsigned char* ws = a.ws;
    if (r < I1) { const int rg = r / KB_D, kb = r % KB_D; const float* ks = kb < 16 ? a.in[I_GFOX] : a.in[I_GLRU] - 1024;
        transpose_item<true>(a.in[I_WOUT], DM, kb * 64, rg * 32, 32, ks, (bf16*)(ws + WS_WOUT), DM, rg * 32, scr, lane); return; } r -= I1;
    if (r < I2) { const int rg = r / KB_D, kb = r % KB_D;
        transpose_item<true>(a.in[I_WCQ], XW, kb * 64, rg * 32, 32, a.in[I_GXATTN], (bf16*)(ws + WS_WCQ), DM, rg * 32, scr, lane); return; } r -= I2;
    if (r < I4) { const int rg = r / (XW / 64), kb = r % (XW / 64);
        transpose_item<true>(a.in[I_WCO], DM, kb * 64, rg * 32, 32, nullptr, (bf16*)(ws + WS_WCO), XW, rg * 32, scr, lane); return; } r -= I4;
    if (r < I5) { const int rg = r / KB_D, kb = r % KB_D, d = rg * 32, tile = d >> 8, w = d & 255; const int src = w < 128 ? tile * 128 + w : FFN + tile * 128 + (w - 128);
        transpose_item<true>(a.in[I_WGU], 2 * FFN, kb * 64, src, 32, a.in[I_GFFN], (bf16*)(ws + WS_WGU), DM, d, scr, lane); return; } r -= I5;
    { const int rg = r / (FFN / 64), kb = r % (FFN / 64);
        transpose_item<true>(a.in[I_WDN], DM, kb * 64, rg * 32, 32, nullptr, (bf16*)(ws + WS_WDN), FFN, rg * 32, scr, lane); }
}
__device__ __forceinline__ void late_range(const Args& a, LAS unsigned char* lds, int lo, int hi, int w, int nw, int wave, int lane) {
    LAS float* scr = (LAS float*)(lds + wave * 16384);
    for (int it = lo + w; it < hi; it += nw) late_item(a, it, scr, lane);
}
__device__ __forceinline__ void p0_prologue(const Args& a, LAS unsigned char* lds, int wave, int lane, int G) {
    unsigned char* ws = a.ws;
    LAS float* scr = (LAS float*)(lds + wave * 16384);
    const int gw = blockIdx.x * NWAVES + wave, NGW = G * NWAVES;
    for (int it = gw; it < N_EARLY; it += NGW) early_item(a, it, scr, lane);
    if (G != 256) for (int it = gw; it < N_LATE; it += NGW) late_item(a, it, scr, lane);
    for (int m = gw; m < M + MMEM; m += NGW) {
        if (m < M) rms_row_to_bf16(a.in[I_X] + (size_t)m * DM, a.in[I_GMIX], (bf16*)(ws + WS_XN) + (size_t)m * DM, lane);
        else rms_row_to_bf16(a.in[I_MEM] + (size_t)(m - M) * DM, a.in[I_GMEM], (bf16*)(ws + WS_MN) + (size_t)(m - M) * DM, lane);
    }
}

__device__ __forceinline__ void conv_chunk(const bf16* U, bf16* UC, const float* cw, const float* cbias, int row0, int s0, int nblk, int tid) {
    asm volatile("" : "+v"(tid));
    const int c8 = nblk * 128 + (tid & 15) * 8;
    f32x4 w[4][2], bb[2];
#pragma unroll
    for (int j = 0; j < 4; ++j) { w[j][0] = *(const f32x4*)(cw + j * LRUW + c8); w[j][1] = *(const f32x4*)(cw + j * LRUW + c8 + 4); }
    bb[0] = *(const f32x4*)(cbias + c8); bb[1] = *(const f32x4*)(cbias + c8 + 4);
#pragma unroll 2
    for (int p = 0; p < 8; ++p) { const int rl = p * 32 + (tid >> 4), s = s0 + rl; const unsigned grow = (unsigned)(row0 + rl);
        f32x4 a0 = bb[0], a1 = bb[1];
#pragma unroll
        for (int j = 0; j < 4; ++j) { if (s - 3 + j >= 0) { const v4u uw = *(const v4u*)((const char*)U + ((grow - 3 + j) * LRUW + c8) * 2u);
            a0 += w[j][0] * (f32x4){bflo(uw.x), bfhi(uw.x), bflo(uw.y), bfhi(uw.y)}; a1 += w[j][1] * (f32x4){bflo(uw.z), bfhi(uw.z), bflo(uw.w), bfhi(uw.w)}; } }
        v4u o; o.x = pk2(a0.x, a0.y); o.y = pk2(a0.z, a0.w); o.z = pk2(a1.x, a1.y); o.w = pk2(a1.z, a1.w);
        *(v4u*)((char*)UC + (grow * LRUW + c8) * 2u) = o; }
}

__global__ void __launch_bounds__(NTHR, LB2) hymba_fwd(Args a) {
    extern __shared__ __attribute__((aligned(16))) unsigned char lds_raw[];
    cg::grid_group grid = cg::this_grid();
    LAS unsigned char* lds = (LAS unsigned char*)lds_raw;
    { const int t0 = threadIdx.x; if ((t0 & 63) == 0) *(volatile LAS int*)(lds + WTAB_OFF + hw_slot() * 4) = t0 >> 6;
      if (t0 < 2) *(volatile LAS unsigned*)(lds + XBST_OFF + t0 * 4) = 0u; }
    __syncthreads();
    const XcdBarrier xbar = xcd_barrier_post((unsigned*)a.ws, (volatile LAS unsigned*)(lds + XBST_OFF));
    const int G = gridDim.x, c = blockIdx.x;
#define WIN ((bf16*)(a.ws + WS_WIN))
#define WOUT ((bf16*)(a.ws + WS_WOUT))
#define WCQ ((bf16*)(a.ws + WS_WCQ))
#define WCKV ((bf16*)(a.ws + WS_WCKV))
#define WCO ((bf16*)(a.ws + WS_WCO))
#define WGU ((bf16*)(a.ws + WS_WGU))
#define WDN ((bf16*)(a.ws + WS_WDN))
#define WLRU ((bf16*)(a.ws + WS_WLRU))
#define XN ((bf16*)(a.ws + WS_XN))
#define MN ((bf16*)(a.ws + WS_MN))
#define Qh ((bf16*)(a.ws + WS_Q))
#define Kh ((bf16*)(a.ws + WS_K))
#define Vh ((bf16*)(a.ws + WS_V))
#define U ((bf16*)(a.ws + WS_U))
#define GG ((bf16*)(a.ws + WS_GG))
#define UC ((bf16*)(a.ws + WS_UC))
#define LF ((float*)(a.ws + WS_LF))
#define CK ((bf16*)(a.ws + WS_CK))
#define CV ((bf16*)(a.ws + WS_CV))
#define MIX ((bf16*)(a.ws + WS_MIX))
#define SSQF ((float*)(a.ws + WS_SSQF))
#define SSQL ((float*)(a.ws + WS_SSQL))
#define X1 ((float*)(a.ws + WS_X1))
#define X1B ((bf16*)(a.ws + WS_X1B))
#define SSQ1 ((float*)(a.ws + WS_SSQ1))
#define CQ ((bf16*)(a.ws + WS_CQ))
#define OX ((bf16*)(a.ws + WS_OX))
#define X2B ((bf16*)(a.ws + WS_X2B))
#define SSQ2 ((float*)(a.ws + WS_SSQ2))
#define H ((bf16*)(a.ws + WS_H))
#define HL ((bf16*)(a.ws + WS_HL))
#define AC ((bf16*)(a.ws + WS_AC))
#define ENDH ((float*)(a.ws + WS_ENDH))
#define ENDA ((float*)(a.ws + WS_ENDA))
#define red ((PG8_LAS float*)(lds + RED_OFF))

    for (int rep = 0; rep < 1 + ((REP >> 0) & 1); ++rep) {
    if (PH & 1) { int tid = my_tid(); p0_prologue(a, lds, __builtin_amdgcn_readfirstlane(tid >> 6), tid & 63, G); }
    GSYNC();
    if (a.ws == nullptr) grid.sync();
    }

    for (int rep = 0; rep < 1 + ((REP >> 1) & 1); ++rep) {
    if (PH & 2) {
        pg8::Gemm g{XN, WIN, M, INWP, DM, DM, DM}; pg8::StaticOrder S; S.init(M, INWP, G, c);
        pg8::EpiIn E{0, Qh, Kh, Vh, U, GG, LF, a.in[I_GQ], a.in[I_GK], a.in[I_BF], red};
        pg8::gemm_phase<pg8::EpiIn, pg8::StaticOrder, true, true>(lds, g, S, E);
        pg8::Gemm g2{MN, WCKV, MMEM, 2 * XW, DM, DM, DM}; pg8::StaticOrder S2; S2.init(MMEM, 2 * XW, G, (c + 16) % G);
        pg8::EpiCkv E2{0, CK, CV, a.in[I_GCK], red};
        pg8::gemm_phase<pg8::EpiCkv, pg8::StaticOrder, true, true>(lds, g2, S2, E2);
        if (G == 256 && c >= 160 && c < 240) { const int t2 = my_tid(); late_range(a, lds, 0, N_LATE_P1, (c - 160) * NWAVES + (t2 >> 6), 80 * NWAVES, __builtin_amdgcn_readfirstlane(t2 >> 6), t2 & 63); }
    }
    GSYNC();
    }

    for (int rep = 0; rep < 1 + ((REP >> 2) & 1); ++rep) {
    if (PH & 4) { int cL = c, tid = my_tid(); asm volatile("" : "+s"(cL));
      const int nl = G > 128 ? G - 128 : G;
      if (G <= 128 || cL >= 128)
      for (int L = (G > 128 ? cL - 128 : cL); L < 256; L += nl) {
            const int pm = L >> 3, nblk = L & 7, row0 = pm * 256;
            conv_chunk(U, UC, a.in[I_CONVW], a.in[I_CONVB], row0, (pm & 7) * 256, nblk, tid);
            VM_WAIT(); __syncthreads(); __builtin_amdgcn_fence(__ATOMIC_ACQUIRE, "agent");
            pg8::Gemm g{UC + (size_t)row0 * LRUW + nblk * 128, WLRU + (size_t)nblk * 256 * 128, 256, 256, 128, LRUW, 128}; pg8::OneUnit S;
            pg8::EpiLru E{0, UC, HL, AC, ENDH + pm * 1024, ENDA + pm * 1024, a.in[I_BRA], a.in[I_BRI], a.in[I_LAM], row0, nblk};
            pg8::gemm_phase<pg8::EpiLru, pg8::OneUnit, false, true>(lds, g, S, E);
      }
      if (G == 256 && cL >= 128) {
        VM_WAIT(); __syncthreads();
        if (my_tid() == 0) { unsigned* cnt = (unsigned*)(a.ws + 15360);
            __builtin_amdgcn_fence(__ATOMIC_RELEASE, "agent"); asm volatile("s_waitcnt vmcnt(0)" ::: "memory");
            (void)__hip_atomic_fetch_add(cnt, 1u, __ATOMIC_RELAXED, __HIP_MEMORY_SCOPE_AGENT);
            unsigned sp = 0; while (__hip_atomic_load(cnt, __ATOMIC_RELAXED, __HIP_MEMORY_SCOPE_AGENT) < 128u && ++sp < (1u << 22)) __builtin_amdgcn_s_sleep(1);
            __builtin_amdgcn_fence(__ATOMIC_ACQUIRE, "agent"); asm volatile("s_waitcnt vmcnt(0)" ::: "memory"); }
        __syncthreads();
#define P2B_FIRST (cL - 128)
#define P2B_STRIDE 128
    { int tid = my_tid();
      for (int L = P2B_FIRST; L < 256; L += P2B_STRIDE) { const int pm = L >> 3, nblk = L & 7, j = pm & 7, c8 = nblk * 128 + (tid & 15) * 8;
        f32x4 hi0 = {0.f, 0.f, 0.f, 0.f}, hi1 = {0.f, 0.f, 0.f, 0.f};
        for (int i = 0; i < j; ++i) { const float* eh = ENDH + (pm - j + i) * 1024 + c8; const float* ea = ENDA + (pm - j + i) * 1024 + c8;
            hi0 = *(const f32x4*)ea * hi0 + *(const f32x4*)eh; hi1 = *(const f32x4*)(ea + 4) * hi1 + *(const f32x4*)(eh + 4); }
#pragma unroll 2
        for (int p = 0; p < 8; ++p) { const unsigned row = (unsigned)(pm * 256 + p * 32 + (tid >> 4)), o = (row * 1024u + c8) * 2u;
            const v4u hw = __builtin_nontemporal_load((const v4u*)((const char*)HL + o)), aw = __builtin_nontemporal_load((const v4u*)((const char*)AC + o)), gw = __builtin_nontemporal_load((const v4u*)((const char*)GG + o));
            const f32x4 y0 = ((f32x4){bflo(hw.x), bfhi(hw.x), bflo(hw.y), bfhi(hw.y)} + (f32x4){bflo(aw.x), bfhi(aw.x), bflo(aw.y), bfhi(aw.y)} * hi0) * (f32x4){bflo(gw.x), bfhi(gw.x), bflo(gw.y), bfhi(gw.y)};
            const f32x4 y1 = ((f32x4){bflo(hw.z), bfhi(hw.z), bflo(hw.w), bfhi(hw.w)} + (f32x4){bflo(aw.z), bfhi(aw.z), bflo(aw.w), bfhi(aw.w)} * hi1) * (f32x4){bflo(gw.z), bfhi(gw.z), bflo(gw.w), bfhi(gw.w)};
            float ss = (y0.x * y0.x + y0.y * y0.y) + (y0.z * y0.z + y0.w * y0.w) + (y1.x * y1.x + y1.y * y1.y) + (y1.z * y1.z + y1.w * y1.w);
            v4u ow; ow.x = pk2(y0.x, y0.y); ow.y = pk2(y0.z, y0.w); ow.z = pk2(y1.x, y1.y); ow.w = pk2(y1.z, y1.w);
            *(v4u*)((char*)MIX + ((size_t)row * 2048 + 1024 + c8) * 2) = ow;
            ss += shx<1>(ss); ss += shx<2>(ss); ss += shx<4>(ss); ss += shx<8>(ss);
            if ((tid & 15) == 0) SSQL[row * 8 + nblk] = ss; } } }
#undef P2B_FIRST
#undef P2B_STRIDE
        { const int t2 = my_tid(); late_range(a, lds, N_LATE_P1, N_LATE_P2, (cL - 128) * NWAVES + (t2 >> 6), 128 * NWAVES, __builtin_amdgcn_readfirstlane(t2 >> 6), t2 & 63); } } }
    if (PH & 4) { int cF = c, tid = my_tid(); asm volatile("" : "+s"(cF)); const int lane = tid & 63, wave = __builtin_amdgcn_readfirstlane(tid >> 6);
      for (int L = cF; L < 128; L += G) {
        {
#if !defined(NO_FOX)
            const int it = L, bh = it >> 2, x = it & 3, b = bh >> 3, h = bh & 7;
            LAS float* cbl = (LAS float*)(lds + CB_OFF); LAS float* wsum = (LAS float*)(lds + WSUM_OFF);
            { const float* lf = LF + ((size_t)b * SEQ + tid * 4) * 8 + h;
              const float v0 = lf[0], v1 = lf[8], v2 = lf[16], v3 = lf[24]; const float t0 = v0, t1 = t0 + v1, t2 = t1 + v2, t3 = t2 + v3;
              wsum[tid] = t3; __syncthreads();
              for (int o = 1; o < 512; o <<= 1) { const float v = wsum[tid] + (tid >= o ? wsum[tid - o] : 0.f); __syncthreads(); wsum[tid] = v; __syncthreads(); }
              const float off = wsum[tid] - t3;
              const float ns = -1.0f / att::SCALE;
              *(LAS f32x4*)(cbl + tid * 4) = (f32x4){(off + t0) * ns, (off + t1) * ns, (off + t2) * ns, (off + t3) * ns};
              __syncthreads(); }
            typedef att::BlockRef<att::bf16, att::bf16> BR;
            BR cur, nxt;
            { const size_t hrow = (size_t)bh * SEQ;
              cur.Q = (const att::bf16*)Qh + (hrow + x * 256) * 128; cur.K = (const att::bf16*)Kh + hrow * 128; cur.V = (const att::bf16*)Vh + hrow * 128;
              cur.O = (att::bf16*)MIX + ((size_t)b * SEQ + x * 256) * 2048 + h * 128; cur.SS = FOX_SS; cur.P0 = x * 256;
              nxt = cur; const int d = (7 - 2 * x) * 256;
              nxt.Q += (size_t)d * 128; nxt.O += (size_t)d * 2048; nxt.SS += (size_t)d * 8; nxt.P0 += d; }
            att::Seam<att::bf16> S;
            att::causal_swa_prime<att::bf16, att::bf16>(cur, 1 << 20, (char*)lds_raw, S);
            for (int p = 0; p < 2; ++p) {
                att::causal_swa_block<att::bf16, att::bf16, 2048, FOX_HAS_SS>(cur, nxt, SEQ, 1 << 20, (char*)lds_raw, S, FOX_CB);
                cur = nxt; }
            VM_WAIT(); __syncthreads(); __builtin_amdgcn_fence(__ATOMIC_ACQUIRE, "agent");
            for (int p = 0; p < 16; ++p) { const int qb = (p < 8) ? x : 7 - x, rl = (p & 7) * 32 + (tid >> 4); const size_t trow = (size_t)b * SEQ + qb * 256 + rl;
                const v4u w = *(const v4u*)(MIX + trow * 2048 + h * 128 + (tid & 15) * 8);
                float ss = (bflo(w.x) * bflo(w.x) + bfhi(w.x) * bfhi(w.x)) + (bflo(w.y) * bflo(w.y) + bfhi(w.y) * bfhi(w.y)) + (bflo(w.z) * bflo(w.z) + bfhi(w.z) * bfhi(w.z)) + (bflo(w.w) * bflo(w.w) + bfhi(w.w) * bfhi(w.w));
                ss += shx<1>(ss); ss += shx<2>(ss); ss += shx<4>(ss); ss += shx<8>(ss);
                if ((tid & 15) == 0) SSQF[trow * 8 + h] = ss; }
            VM_WAIT(); __syncthreads();
#endif
        }
    } }
    GSYNC();
    }

    if (G != 256) {
#define P2B_FIRST c
#define P2B_STRIDE G
    { int tid = my_tid();
      for (int L = P2B_FIRST; L < 256; L += P2B_STRIDE) { const int pm = L >> 3, nblk = L & 7, j = pm & 7, c8 = nblk * 128 + (tid & 15) * 8;
        f32x4 hi0 = {0.f, 0.f, 0.f, 0.f}, hi1 = {0.f, 0.f, 0.f, 0.f};
        for (int i = 0; i < j; ++i) { const float* eh = ENDH + (pm - j + i) * 1024 + c8; const float* ea = ENDA + (pm - j + i) * 1024 + c8;
            hi0 = *(const f32x4*)ea * hi0 + *(const f32x4*)eh; hi1 = *(const f32x4*)(ea + 4) * hi1 + *(const f32x4*)(eh + 4); }
#pragma unroll 2
        for (int p = 0; p < 8; ++p) { const unsigned row = (unsigned)(pm * 256 + p * 32 + (tid >> 4)), o = (row * 1024u + c8) * 2u;
            const v4u hw = __builtin_nontemporal_load((const v4u*)((const char*)HL + o)), aw = __builtin_nontemporal_load((const v4u*)((const char*)AC + o)), gw = __builtin_nontemporal_load((const v4u*)((const char*)GG + o));
            const f32x4 y0 = ((f32x4){bflo(hw.x), bfhi(hw.x), bflo(hw.y), bfhi(hw.y)} + (f32x4){bflo(aw.x), bfhi(aw.x), bflo(aw.y), bfhi(aw.y)} * hi0) * (f32x4){bflo(gw.x), bfhi(gw.x), bflo(gw.y), bfhi(gw.y)};
            const f32x4 y1 = ((f32x4){bflo(hw.z), bfhi(hw.z), bflo(hw.w), bfhi(hw.w)} + (f32x4){bflo(aw.z), bfhi(aw.z), bflo(aw.w), bfhi(aw.w)} * hi1) * (f32x4){bflo(gw.z), bfhi(gw.z), bflo(gw.w), bfhi(gw.w)};
            float ss = (y0.x * y0.x + y0.y * y0.y) + (y0.z * y0.z + y0.w * y0.w) + (y1.x * y1.x + y1.y * y1.y) + (y1.z * y1.z + y1.w * y1.w);
            v4u ow; ow.x = pk2(y0.x, y0.y); ow.y = pk2(y0.z, y0.w); ow.z = pk2(y1.x, y1.y); ow.w = pk2(y1.z, y1.w);
            *(v4u*)((char*)MIX + ((size_t)row * 2048 + 1024 + c8) * 2) = ow;
            ss += shx<1>(ss); ss += shx<2>(ss); ss += shx<4>(ss); ss += shx<8>(ss);
            if ((tid & 15) == 0) SSQL[row * 8 + nblk] = ss; } } }
#undef P2B_FIRST
#undef P2B_STRIDE
    GSYNC(); }

    for (int rep = 0; rep < 1 + ((REP >> 3) & 1); ++rep) {
    if (PH & 8) {
        pg8::Gemm g{MIX, WOUT, M, DM, DM, DM, DM}; pg8::StaticOrder S; S.init(M, DM, G, c);
        pg8::EpiRes<true> E{16, a.in[I_X], nullptr, nullptr, X1B, SSQ1, SSQF, SSQL};
        pg8::gemm_phase<pg8::EpiRes<true>, pg8::StaticOrder, true, true>(lds, g, S, E);
    }
    GSYNC();
    }

    for (int rep = 0; rep < 1 + ((REP >> 4) & 1); ++rep) {
    if (PH & 16) {
        pg8::Gemm g{X1B, WCQ, M, XW, DM, DM, DM}; pg8::StaticOrder S; S.init(M, XW, G, c);
        pg8::EpiCq E{0, CQ, a.in[I_GCQ], SSQ1, red};
        pg8::gemm_phase<pg8::EpiCq, pg8::StaticOrder, true, true>(lds, g, S, E);
        if (G == 256 && c >= 64) { const int t2 = my_tid(); late_range(a, lds, N_LATE_P2, N_LATE, (c - 64) * NWAVES + (t2 >> 6), 192 * NWAVES, __builtin_amdgcn_readfirstlane(t2 >> 6), t2 & 63); }
    }
    GSYNC();
    }

    for (int rep = 0; rep < 1 + ((REP >> 5) & 1); ++rep) {
    if (PH & 32) for (int L = c; L < 128; L += G) {
        const int bh = L >> 3, qb = L & 7, b = bh >> 2, h = bh & 3;
        att::BlockRef<att::bf16, att::bf16> r;
        r.Q = (const att::bf16*)CQ + ((size_t)bh * SEQ + qb * 256) * 128; r.K = (const att::bf16*)CK + (size_t)bh * NMEM * 128; r.V = (const att::bf16*)CV + (size_t)bh * NMEM * 128;
        r.O = (att::bf16*)OX + ((size_t)b * SEQ + qb * 256) * XW + h * 128; r.SS = nullptr; r.P0 = 1 << 16;
        att::Seam<att::bf16> S;
        att::causal_swa_prime<att::bf16, att::bf16>(r, 1 << 20, (char*)lds_raw, S);
        att::causal_swa_block<att::bf16, att::bf16, XW, false>(r, r, NMEM, 1 << 20, (char*)lds_raw, S, -1);
        VM_WAIT(); __syncthreads();
    }
    GSYNC();
    }

    for (int rep = 0; rep < 1 + ((REP >> 6) & 1); ++rep) {
    if (PH & 64) {
        pg8::Gemm g{OX, WCO, M, DM, XW, XW, XW}; pg8::StaticOrder S; S.init(M, DM, G, c);
        pg8::EpiRes<false> E{0, nullptr, X1B, nullptr, X2B, SSQ2, nullptr, nullptr};
        pg8::gemm_phase<pg8::EpiRes<false>, pg8::StaticOrder, true, true>(lds, g, S, E);
    }
    GSYNC();
    }

    for (int rep = 0; rep < 1 + ((REP >> 7) & 1); ++rep) {
    if (PH & 128) {
        pg8::Gemm g{X2B, WGU, M, 2 * FFN, DM, DM, DM}; pg8::StaticOrder S; S.init(M, 2 * FFN, G, c);
        if (my_tid() == 0) *(volatile LAS int*)(lds + RED_OFF + 8192 + 1024) = -1;
        __syncthreads();
        pg8::EpiGu E{0, H, SSQ2, red};
        pg8::gemm_phase<pg8::EpiGu, pg8::StaticOrder, true, true>(lds, g, S, E);
    }
    GSYNC();
    }

    if (PH & 256) {
        pg8::Gemm g{H, WDN, M, DM, FFN, FFN, FFN}; pg8::StaticOrder S; S.init(M, DM, G, c);
        pg8::EpiRes<false> E{0, nullptr, X2B, a.out, nullptr, nullptr, nullptr, nullptr};
        pg8::gemm_phase<pg8::EpiRes<false>, pg8::StaticOrder, true, true>(lds, g, S, E);
    }
}

#undef WIN
#undef WOUT
#undef WCQ
#undef WCKV
#undef WCO
#undef WGU
#undef WDN
#undef WLRU
#undef XN
#undef MN
#undef Qh
#undef Kh
#undef Vh
#undef U
#undef GG
#undef UC
#undef LF
#undef CK
#undef CV
#undef MIX
#undef SSQF
#undef SSQL
#undef X1
#undef X1B
#undef SSQ1
#undef CQ
#undef OX
#undef X2B
#undef SSQ2
#undef H
#undef HL
#undef AC
#undef ENDH
#undef ENDA
#undef red
extern "C" void kernel_launch(void* const* d_in, const int* in_sizes, int n_in, void* d_out, int out_size, void* d_ws, size_t ws_size, hipStream_t stream) {
    static int grid = 0;
    if (grid == 0) {
        if (n_in != 27 || in_sizes[0] != M * DM || out_size != M * DM || ws_size < WS_END) { fprintf(stderr, "kernel_launch: unexpected shapes (n_in %d, in0 %d, out %d, ws %zu)\n", n_in, n_in > 0 ? in_sizes[0] : -1, out_size, ws_size); grid = -1; return; }
        int dev = 0, cus = 0, per_cu = 0;
        (void)hipGetDevice(&dev); (void)hipDeviceGetAttribute(&cus, hipDeviceAttributeMultiprocessorCount, dev);
        if (hipFuncSetAttribute((const void*)hymba_fwd, hipFuncAttributeMaxDynamicSharedMemorySize, LDS_BYTES) != hipSuccess) { fprintf(stderr, "kernel_launch: hipFuncSetAttribute failed\n"); grid = -1; return; }
        if (hipOccupancyMaxActiveBlocksPerMultiprocessor(&per_cu, (const void*)hymba_fwd, NTHR, LDS_BYTES) != hipSuccess || per_cu < 1) { fprintf(stderr, "kernel_launch: occupancy query says %d\n", per_cu); per_cu = 1; }
        (void)hipGetLastError();
        grid = cus * per_cu;
    }
    if (grid < 0) return;
    Args a{};
    for (int i = 0; i < 27; ++i) a.in[i] = (const float*)d_in[i];
    a.out = (float*)d_out; a.ws = (unsigned char*)d_ws;
    if (hipMemsetAsync(d_ws, 0, 16384, stream) != hipSuccess) { fprintf(stderr, "kernel_launch: memset of the barrier words failed\n"); return; }
    void* args[] = {&a};
    hipError_t e = hipLaunchCooperativeKernel((const void*)hymba_fwd, dim3(grid), dim3(NTHR), args, LDS_BYTES, stream);
    if (e != hipSuccess) fprintf(stderr, "cooperative launch failed: %s (grid %d)\n", hipGetErrorString(e), grid);
}
```
